# Optimizing an MI355X kernel written in HIP

```python
import math
import jax, jax.numpy as jnp
from jax import lax
import numpy as np

D_MODEL = 1024
BATCH = 16
SEQ = 256
DEPTH = 4
DEC_BATCH = 2
DEC_SEQ = 1024
PAST_LEN = 512

GRID_W = 64
D_MIX = D_MODEL
H_A = 4
DA = 64
H_B = 4
DB = 64
NA_ROWS = 8
NA_COLS = 16
NA_QCB = 16
NA_KCB = NA_QCB + NA_COLS
H_C = 4
DC = 64
CHUNK = 64
D_FF = 4 * D_MODEL
QBLK = 128
ROPE_BASE = 10000.0
EPS = 1e-5
ALPHA = (2 * DEPTH) ** 0.25
BETA = (8 * DEPTH) ** -0.25
A_QK = H_A * 2 * DA
A_V = H_A * 2 * DA
B_W = H_B * DB
C_W = H_C * DC
C_GATES = 4 * H_C
IN_SIZES = (A_QK, A_QK, A_V, B_W, B_W, B_W, C_W, C_W, C_W, C_W, C_GATES)
N_IN = A_QK * 2 + A_V + 3 * B_W + 4 * C_W + C_GATES

kernel_name = "hybrid_diffusion_paraheads_step"


def layer_norm(x, g, b):
    xf = x.astype(jnp.float32)
    mu = jnp.mean(xf, -1, keepdims=True)
    var = jnp.mean(jnp.square(xf - mu), -1, keepdims=True)
    return ((xf - mu) * lax.rsqrt(var + EPS) * g.astype(jnp.float32) + b.astype(jnp.float32)).astype(x.dtype)


def head_rms(x, g):
    xf = x.astype(jnp.float32)
    return xf * lax.rsqrt(jnp.mean(xf * xf, -1, keepdims=True) + EPS) * g.astype(jnp.float32)


def merge_heads(x):
    b, h, n, d = x.shape
    return x.transpose(0, 2, 1, 3).reshape(b, n, h * d)


def split_proj(p, gate_bias):
    b, n, _ = p.shape
    offs = np.cumsum(IN_SIZES)[:-1].tolist()
    aq, ak, av, bq, bk, bv, cq, ck, cv, co, cg = jnp.split(p, offs, axis=-1)
    two = lambda t: t.reshape(b, n, H_A, 2, DA).transpose(0, 2, 1, 3, 4)
    heads = lambda t, h: t.reshape(b, n, h, -1).transpose(0, 2, 1, 3)
    gates = (cg + gate_bias).astype(jnp.float32).reshape(b, n, 4, H_C).transpose(0, 2, 3, 1)
    return (two(aq), two(ak), heads(av, H_A), heads(bq, H_B), heads(bk, H_B), heads(bv, H_B),
            heads(cq, H_C), heads(ck, H_C), heads(cv, H_C), heads(co, H_C), gates)


def map_query_blocks(fn, q):
    b, h, nq = q.shape[:3]
    nb = nq // QBLK
    qb = jnp.moveaxis(q.reshape(b, h, nb, QBLK, *q.shape[3:]), 2, 0)
    out = lax.map(fn, qb)
    return jnp.moveaxis(out, 0, 2).reshape(b, h, nq, -1)


def rope_1d(x, cos, sin):
    half = x.shape[-1] // 2
    x1, x2 = x[..., :half], x[..., half:]
    return jnp.concatenate([x1 * cos - x2 * sin, x1 * sin + x2 * cos], axis=-1)


def axial_rope(x):
    n = x.shape[2]
    dh = DA // 2
    nf = dh // 2
    freqs = ROPE_BASE ** (-jnp.arange(nf, dtype=jnp.float32) / nf)
    t = jnp.arange(n)
    row = (t // GRID_W).astype(jnp.float32)
    col = (t % GRID_W).astype(jnp.float32)
    ar = (row[:, None] * freqs).reshape(n, 1, nf)
    ac = (col[:, None] * freqs).reshape(n, 1, nf)
    xf = x.astype(jnp.float32)
    out = jnp.concatenate([rope_1d(xf[..., :dh], jnp.cos(ar), jnp.sin(ar)),
                           rope_1d(xf[..., dh:], jnp.cos(ac), jnp.sin(ac))], axis=-1)
    return out.astype(x.dtype)


def diff_lambda_value(lp, lam_init):
    lp = lp.astype(jnp.float32)
    return jnp.exp(jnp.sum(lp[0] * lp[1])) - jnp.exp(jnp.sum(lp[2] * lp[3])) + lam_init


def diff_attention(q, k, v, lam, g, lam_init):
    scale = DA ** -0.5

    def block(qb):
        s = jnp.einsum('bhqmd,bhkmd->bhmqk', qb, k).astype(jnp.float32) * scale
        p = jax.nn.softmax(s, axis=-1)
        a = p[:, :, 0] - lam * p[:, :, 1]
        return jnp.einsum('bhqk,bhkv->bhqv', a.astype(v.dtype), v)

    o = map_query_blocks(block, q)
    return (head_rms(o, g) * (1.0 - lam_init)).astype(v.dtype)


def dense_attention(q, k, v):
    scale = q.shape[-1] ** -0.5

    def block(qb):
        s = jnp.einsum('bhqd,bhkd->bhqk', qb, k).astype(jnp.float32) * scale
        p = jax.nn.softmax(s, axis=-1)
        return jnp.einsum('bhqk,bhkd->bhqd', p.astype(v.dtype), v)

    return map_query_blocks(block, q)


def neighbourhood_attention(q, k, v, ctx_k, ctx_v, rpb):
    b, h, n, d = q.shape
    rows = n // GRID_W
    kh = min(NA_ROWS, rows)
    ncb = GRID_W // NA_QCB
    r = jnp.arange(rows)
    key_rows = jnp.clip(r - kh // 2, 0, rows - kh)[:, None] + jnp.arange(kh)[None, :]
    qcol = jnp.arange(GRID_W).reshape(ncb, NA_QCB)
    win_start = jnp.clip(qcol - NA_COLS // 2, 0, GRID_W - NA_COLS)
    blk_start = jnp.clip(jnp.arange(ncb) * NA_QCB - NA_COLS // 2, 0, GRID_W - NA_KCB)
    key_cols = blk_start[:, None] + jnp.arange(NA_KCB)[None, :]
    kc = key_cols[:, None, :]
    valid = (kc >= win_start[..., None]) & (kc < win_start[..., None] + NA_COLS)
    dr = key_rows - r[:, None] + NA_ROWS - 1
    dc = kc - qcol[..., None] + NA_COLS - 1
    bias = jnp.take(jnp.take(rpb, dr, axis=1, mode='clip'), dc, axis=3, mode='clip').astype(jnp.float32)
    bias = jnp.where(valid, bias, -jnp.inf).transpose(0, 1, 3, 4, 2, 5)
    qg = q.reshape(b, h, rows, ncb, NA_QCB, d)
    gather = lambda t: jnp.take(jnp.take(t.reshape(b, h, rows, GRID_W, d), key_rows, axis=2), key_cols, axis=4)
    kg = gather(k)
    vg = gather(v)
    scale = d ** -0.5
    s_loc = jnp.einsum('bhrjcd,bhrijkd->bhrjcik', qg, kg).astype(jnp.float32) * scale + bias[None]
    nloc = kh * NA_KCB
    s_loc = s_loc.reshape(b, h, rows, ncb, NA_QCB, nloc)
    s_ctx = jnp.einsum('bhrjcd,bhld->bhrjcl', qg, ctx_k).astype(jnp.float32) * scale
    p = jax.nn.softmax(jnp.concatenate([s_loc, s_ctx], axis=-1), axis=-1).astype(v.dtype)
    p_loc = p[..., :nloc].reshape(b, h, rows, ncb, NA_QCB, kh, NA_KCB)
    o = (jnp.einsum('bhrjcik,bhrijkd->bhrjcd', p_loc, vg)
         + jnp.einsum('bhrjcl,bhld->bhrjcd', p[..., nloc:], ctx_v))
    return o.reshape(b, h, n, d)


def mlstm_chunked(q, k, v, ig, lf, c0, n0, m0):
    b, h, n, _ = q.shape
    nc = n // CHUNK
    chunks = lambda t: jnp.moveaxis(t.reshape(b, h, nc, CHUNK, *t.shape[3:]), 2, 0)
    tri = jnp.tril(jnp.ones((CHUNK, CHUNK), bool))

    def step(carry, xs):
        cm, nm, m = carry
        qc, kc, vc, ic, fc = xs
        bcum = jnp.cumsum(fc, axis=-1)
        dmat = jnp.where(tri, bcum[..., :, None] - bcum[..., None, :] + ic[..., None, :], -jnp.inf)
        inter = bcum + m[..., None]
        m_t = jnp.maximum(inter, jnp.max(dmat, -1))
        s = jnp.einsum('bhtd,bhsd->bhts', qc, kc) * jnp.exp(dmat - m_t[..., None])
        e = jnp.exp(inter - m_t)
        num = e[..., None] * jnp.einsum('bhtd,bhdv->bhtv', qc, cm) + jnp.einsum('bhts,bhsv->bhtv', s, vc)
        den = e * jnp.einsum('bhtd,bhd->bht', qc, nm) + jnp.sum(s, -1)
        hout = num / jnp.maximum(jnp.abs(den), jnp.exp(-m_t))[..., None]
        b_tot = bcum[..., -1]
        g = b_tot[..., None] - bcum + ic
        m_new = jnp.maximum(b_tot + m, jnp.max(g, -1))
        decay = jnp.exp(b_tot + m - m_new)
        wk = jnp.exp(g - m_new[..., None])
        c_new = decay[..., None, None] * cm + jnp.einsum('bhs,bhsd,bhsv->bhdv', wk, kc, vc)
        n_new = decay[..., None] * nm + jnp.einsum('bhs,bhsd->bhd', wk, kc)
        return (c_new, n_new, m_new), hout

    (cf, nf, mf), hs = lax.scan(step, (c0, n0, m0), tuple(chunks(t) for t in (q, k, v, ig, lf)))
    return jnp.moveaxis(hs, 0, 2).reshape(b, h, n, -1), cf, nf, mf


def mlstm_mix(q, k, v, o, gates, g, c0, n0, m0):
    f32 = jnp.float32
    qf = q.astype(f32) * DC ** -0.5
    kf, vf = k.astype(f32), v.astype(f32)
    c0, n0, m0 = c0.astype(f32), n0.astype(f32), m0.astype(f32)
    i_fw, f_fw, i_bw, f_bw = gates[:, 0], gates[:, 1], gates[:, 2], gates[:, 3]
    h_f, cf, nf, mf = mlstm_chunked(qf, kf, vf, i_fw, jax.nn.log_sigmoid(f_fw), c0[:, 0], n0[:, 0], m0[:, 0])
    flip = lambda t: jnp.flip(t, axis=2)
    h_b, cb, nb, mb = mlstm_chunked(flip(qf), flip(kf), flip(vf), flip(i_bw), flip(jax.nn.log_sigmoid(f_bw)),
                                    c0[:, 1], n0[:, 1], m0[:, 1])
    hsum = h_f + flip(h_b)
    out = head_rms(hsum, g[:, None, :]) * jax.nn.sigmoid(o.astype(f32))
    return (out.astype(q.dtype), jnp.stack([cf, cb], 1), jnp.stack([nf, nb], 1), jnp.stack([mf, mb], 1))


def adaln(cond, w, b):
    return jnp.split(jax.nn.silu(cond) @ w + b, 6, axis=-1)


def channel_mix(x, shift, scale, gate, w1, w2, g, b):
    hmod = x * (1 + scale) + shift
    y = jnp.square(jax.nn.relu(hmod @ w1)) @ w2
    return layer_norm(ALPHA * x + gate * y, g, b)


def context_mix(h, wi, gb, lam, lam_init, dg, mg):
    b, l, _ = h.shape
    aq, ak, av, bq, bk, bv, cq, ck, cv, co, gates = split_proj(h @ wi, gb)
    oa = diff_attention(aq, ak, av, lam, dg, lam_init)
    ob = dense_attention(bq, bk, bv)
    zc = jnp.zeros((b, 2, H_C, DC, DC), jnp.float32)
    zn = jnp.zeros((b, 2, H_C, DC), jnp.float32)
    zm = jnp.zeros((b, 2, H_C), jnp.float32)
    oc, sc, sn, sm = mlstm_mix(cq, ck, cv, co, gates, mg, zc, zn, zm)
    mix = jnp.concatenate([merge_heads(oa), merge_heads(ob), merge_heads(oc)], -1).astype(h.dtype)
    return mix, ak.reshape(b, H_A, l, 2 * DA), av, bk, bv, sc, sn, sm


def latent_mix(h, wi, gb, lam, lam_init, dg, mg, rpb, ca_k, ca_v, cb_k, cb_v, s_c, s_n, s_m):
    b = h.shape[0]
    aq, ak, av, bq, bk, bv, cq, ck, cv, co, gates = split_proj(h @ wi, gb)
    lc = ca_k.shape[2]
    ka = jnp.concatenate([ca_k.reshape(b, H_A, lc, 2, DA).astype(ak.dtype), axial_rope(ak)], axis=2)
    va = jnp.concatenate([ca_v.astype(av.dtype), av], axis=2)
    oa = diff_attention(axial_rope(aq), ka, va, lam, dg, lam_init)
    ob = neighbourhood_attention(bq, bk, bv, cb_k.astype(bk.dtype), cb_v.astype(bv.dtype), rpb)
    oc, _, _, _ = mlstm_mix(cq, ck, cv, co, gates, mg, s_c, s_n, s_m)
    return jnp.concatenate([merge_heads(oa), merge_heads(ob), merge_heads(oc)], -1).astype(h.dtype)


def setup_inputs(seed: int = 0) -> dict:
    key = jax.random.key(seed)
    ks = jax.random.split(key, 32)
    nrm = lambda i, shape, s: jax.random.normal(ks[i], shape, jnp.float32) * s
    gate_i = nrm(20, (DEPTH, 2, 1, H_C), 0.1)
    gate_f = jnp.linspace(3.0, 6.0, H_C, dtype=jnp.float32)[None, None, None, :] + nrm(21, (DEPTH, 2, 1, H_C), 0.1)
    mlstm_gate_bias = jnp.concatenate([gate_i, gate_f], axis=2).reshape(DEPTH, C_GATES)
    return {
        'x_prompt': nrm(0, (BATCH, SEQ, D_MODEL), 1.0),
        'x_sample': nrm(1, (DEC_BATCH, DEC_SEQ, D_MODEL), 1.0),
        'cache_a_k': nrm(2, (DEC_BATCH, DEPTH, H_A, PAST_LEN, 2 * DA), 1.0),
        'cache_a_v': nrm(3, (DEC_BATCH, DEPTH, H_A, PAST_LEN, 2 * DA), 1.0),
        'cache_b_k': nrm(4, (DEC_BATCH, DEPTH, H_B, PAST_LEN, DB), 1.0),
        'cache_b_v': nrm(5, (DEC_BATCH, DEPTH, H_B, PAST_LEN, DB), 1.0),
        'state_c': nrm(6, (DEC_BATCH, DEPTH, 2, H_C, DC, DC), 0.1),
        'state_n': nrm(7, (DEC_BATCH, DEPTH, 2, H_C, DC), 1.0),
        'state_m': nrm(8, (DEC_BATCH, DEPTH, 2, H_C), 0.5),
        'c': nrm(9, (DEC_BATCH, D_MODEL), 1.0),
        'c_ctx': nrm(10, (D_MODEL,), 1.0),
        'w_in': nrm(11, (DEPTH, D_MODEL, N_IN), D_MODEL ** -0.5),
        'mlstm_gate_bias': mlstm_gate_bias,
        'diff_lambda': nrm(12, (DEPTH, 4, DA), 0.1),
        'diff_norm_g': 1.0 + nrm(13, (DEPTH, 2 * DA), 0.02),
        'nat_rpb': nrm(14, (DEPTH, H_B, 2 * NA_ROWS - 1, 2 * NA_COLS - 1), 0.1),
        'mlstm_norm_g': 1.0 + nrm(15, (DEPTH, H_C, DC), 0.02),
        'w_out': nrm(16, (DEPTH, D_MIX, D_MODEL), BETA * D_MIX ** -0.5),
        'ada_w': nrm(17, (DEPTH, D_MODEL, 6 * D_MODEL), D_MODEL ** -0.5),
        'ada_b': nrm(18, (DEPTH, 6 * D_MODEL), 0.02),
        'ln1_g': 1.0 + nrm(19, (DEPTH, D_MODEL), 0.02),
        'ln1_b': nrm(22, (DEPTH, D_MODEL), 0.02),
        'ln2_g': 1.0 + nrm(23, (DEPTH, D_MODEL), 0.02),
        'ln2_b': nrm(24, (DEPTH, D_MODEL), 0.02),
        'w_mlp1': nrm(25, (DEPTH, D_MODEL, D_FF), D_MODEL ** -0.5),
        'w_mlp2': nrm(26, (DEPTH, D_FF, D_MODEL), BETA * D_FF ** -0.5),
    }


def reference(x_prompt, x_sample, cache_a_k, cache_a_v, cache_b_k, cache_b_v, state_c, state_n, state_m,
              c, c_ctx, w_in, mlstm_gate_bias, diff_lambda, diff_norm_g, nat_rpb, mlstm_norm_g, w_out,
              ada_w, ada_b, ln1_g, ln1_b, ln2_g, ln2_b, w_mlp1, w_mlp2):
    xp = x_prompt
    xs = x_sample
    ak_l, av_l, bk_l, bv_l, sc_l, sn_l, sm_l = [], [], [], [], [], [], []
    for l in range(DEPTH):
        lam_init = 0.8 - 0.6 * math.exp(-0.3 * l)
        lam = diff_lambda_value(diff_lambda[l], lam_init)
        sh1, sc1, g1, sh2, sc2, g2 = adaln(c_ctx, ada_w[l], ada_b[l])
        mix, ak, av, bk, bv, sc, sn, sm = context_mix(xp * (1 + sc1) + sh1, w_in[l], mlstm_gate_bias[l], lam,
                                                      lam_init, diff_norm_g[l], mlstm_norm_g[l])
        xp = layer_norm(ALPHA * xp + g1 * (mix @ w_out[l]), ln1_g[l], ln1_b[l])
        xp = channel_mix(xp, sh2, sc2, g2, w_mlp1[l], w_mlp2[l], ln2_g[l], ln2_b[l])
        ak_l.append(ak); av_l.append(av); bk_l.append(bk); bv_l.append(bv)
        sc_l.append(sc); sn_l.append(sn); sm_l.append(sm)
        sh1, sc1, g1, sh2, sc2, g2 = [t[:, None, :] for t in adaln(c, ada_w[l], ada_b[l])]
        mix = latent_mix(xs * (1 + sc1) + sh1, w_in[l], mlstm_gate_bias[l], lam, lam_init, diff_norm_g[l],
                         mlstm_norm_g[l], nat_rpb[l], cache_a_k[:, l], cache_a_v[:, l], cache_b_k[:, l],
                         cache_b_v[:, l], state_c[:, l], state_n[:, l], state_m[:, l])
        xs = layer_norm(ALPHA * xs + g1 * (mix @ w_out[l]), ln1_g[l], ln1_b[l])
        xs = channel_mix(xs, sh2, sc2, g2, w_mlp1[l], w_mlp2[l], ln2_g[l], ln2_b[l])
    new_a_k = jnp.stack(ak_l, 1)
    new_a_v = jnp.stack(av_l, 1)
    new_b_k = jnp.stack(bk_l, 1)
    new_b_v = jnp.stack(bv_l, 1)
    new_c = jnp.stack(sc_l, 1)
    new_n = jnp.stack(sn_l, 1)
    new_m = jnp.stack(sm_l, 1)
    return (xp, xs, new_a_k, new_a_v, new_b_k, new_b_v, new_c, new_n, new_m)
```

```cpp
#include <hip/hip_runtime.h>
#include <hip/hip_cooperative_groups.h>
#include <cstdio>
namespace cg = cooperative_groups;

#ifndef IM
#define IM 0xffff
#endif
#ifndef PHM
#define PHM 0xffff
#endif
#ifndef SINGLE_LAUNCH
#define SINGLE_LAUNCH 1
#endif

typedef unsigned short bf16_t;
typedef __attribute__((ext_vector_type(8))) short bf16x8;
typedef __attribute__((ext_vector_type(4))) short bf16x4;
typedef __attribute__((ext_vector_type(4))) float f32x4;
#define DI __device__ __forceinline__

constexpr int NTOK = 6144, NCTX = 4096, DM = 1024, NIN = 3344, NINP = 3456, DFF = 4096;
constexpr float ALPHA = 1.681792830507429f;
constexpr float LOG2E = 1.4426950408889634f;
constexpr float LN_EPS = 1e-5f;

constexpr size_t al256(size_t x) { return (x + 255) & ~(size_t)255; }
constexpr size_t OFF_WT_IN = 0;
constexpr size_t OFF_WT_OUT = OFF_WT_IN + al256((size_t)4 * NINP * DM * 2);
constexpr size_t OFF_WT_1 = OFF_WT_OUT + al256((size_t)4 * DM * DM * 2);
constexpr size_t OFF_WT_2 = OFF_WT_1 + al256((size_t)4 * DFF * DM * 2);
constexpr size_t OFF_MOD = OFF_WT_2 + al256((size_t)4 * DFF * DM * 2);
constexpr size_t OFF_X = OFF_MOD + al256((size_t)4 * 3 * 6144 * 4);
constexpr size_t OFF_H = OFF_X + al256((size_t)NTOK * DM * 4);
constexpr size_t OFF_P = OFF_H + al256((size_t)NTOK * DM * 2);
constexpr size_t OFF_PT_AV = OFF_P + al256((size_t)NTOK * NIN * 2);
constexpr size_t OFF_PT_BV = OFF_PT_AV + al256((size_t)NTOK * 512 * 2);
constexpr size_t OFF_PT_CV = OFF_PT_BV + al256((size_t)NTOK * 256 * 2);
constexpr size_t OFF_PT_CK = OFF_PT_CV + al256((size_t)NTOK * 256 * 2);
constexpr size_t OFF_G = OFF_PT_CK + al256((size_t)NTOK * 256 * 2);
constexpr size_t OFF_MIX = OFF_G + al256((size_t)NTOK * 16 * 4);
constexpr size_t OFF_Y = OFF_MIX + al256((size_t)NTOK * DM * 2);
constexpr size_t OFF_U = OFF_Y + al256((size_t)NTOK * DM * 4);
constexpr size_t OFF_CAK = OFF_U + al256((size_t)NTOK * DFF * 2);
constexpr size_t OFF_CAVT = OFF_CAK + al256((size_t)32 * 512 * 128 * 2);
constexpr size_t OFF_CBK = OFF_CAVT + al256((size_t)32 * 512 * 128 * 2);
constexpr size_t OFF_CBVT = OFF_CBK + al256((size_t)32 * 512 * 64 * 2);
constexpr size_t OFF_C0T = OFF_CBVT + al256((size_t)32 * 512 * 64 * 2);
constexpr size_t OFF_ROPE = OFF_C0T + al256((size_t)64 * 64 * 64 * 2);
constexpr size_t OFF_LAM = OFF_ROPE + al256((size_t)2 * 1024 * 4);
constexpr size_t WS_END = OFF_LAM + 256;

constexpr size_t O_YP = 0, O_YS = 4194304, O_AK = 6291456, O_AV = 14680064, O_BK = 23068672, O_BV = 27262976,
                 O_NC = 31457280, O_NN = 33554432, O_NM = 33587200;

struct Params {
    const float* x_prompt; const float* x_sample; const float* cache_a_k; const float* cache_a_v;
    const float* cache_b_k; const float* cache_b_v; const float* state_c; const float* state_n;
    const float* state_m; const float* c; const float* c_ctx; const float* w_in; const float* gate_bias;
    const float* diff_lambda; const float* diff_norm_g; const float* nat_rpb; const float* mlstm_norm_g;
    const float* w_out; const float* ada_w; const float* ada_b; const float* ln1_g; const float* ln1_b;
    const float* ln2_g; const float* ln2_b; const float* w_mlp1; const float* w_mlp2;
    float* out; unsigned char* ws; int ph_lo; int ph_hi;
};

DI int opaque_v(int x) { asm volatile("" : "+v"(x)); return x; }
DI size_t opaque_zero() { size_t z = 0; asm volatile("" : "+s"(z)); return z; }
DI unsigned char* opaque_ws(unsigned char* w) { return w + opaque_zero(); }
DI float* opaque_out(float* w) { return w + opaque_zero(); }
DI unsigned short f2bf(float x) { unsigned u = __float_as_uint(x); u += 0x7fffu + ((u >> 16) & 1u); return (unsigned short)(u >> 16); }
DI float bf2f(unsigned short h) { return __uint_as_float(((unsigned)h) << 16); }
DI unsigned pack2(float a, float b) { return (unsigned)f2bf(a) | ((unsigned)f2bf(b) << 16); }
DI f32x4 mfma16(bf16x8 a, bf16x8 b, f32x4 c) { return __builtin_amdgcn_mfma_f32_16x16x32_bf16(a, b, c, 0, 0, 0); }
DI float fexp2(float x) { return __builtin_amdgcn_exp2f(x); }
DI bf16x8 pack8(float a0, float a1, float a2, float a3, float a4, float a5, float a6, float a7) {
    uint4 u; u.x = pack2(a0, a1); u.y = pack2(a2, a3); u.z = pack2(a4, a5); u.w = pack2(a6, a7);
    return __builtin_bit_cast(bf16x8, u);
}
DI bf16x8 cat4(bf16x4 a, bf16x4 b) { return __builtin_shufflevector(a, b, 0, 1, 2, 3, 4, 5, 6, 7); }
DI float wave_sum(float v) {
#pragma unroll
    for (int o = 32; o > 0; o >>= 1) v += __shfl_xor(v, o);
    return v;
}
DI float grp_sum(float v) { v += __shfl_xor(v, 16); v += __shfl_xor(v, 32); return v; }
DI float grp_max(float v) { v = fmaxf(v, __shfl_xor(v, 16)); v = fmaxf(v, __shfl_xor(v, 32)); return v; }

DI void transpose_job(const float* __restrict__ src, bf16_t* __restrict__ dst, int R, int C, int Cpad, int nmat, float* tile) {
    const int tid = threadIdx.x;
    const int rt = R >> 6, ct = Cpad >> 6, per = rt * ct, total = per * nmat;
    for (int it = blockIdx.x; it < total; it += gridDim.x) {
        const int mat = it / per, rem = it - mat * per;
        const int r0 = (rem / ct) << 6, c0 = (rem % ct) << 6;
        const float* s = src + (size_t)mat * R * C;
        bf16_t* d = dst + (size_t)mat * Cpad * R;
#pragma unroll
        for (int i = 0; i < 4; ++i) {
            const int r = (tid >> 4) + 16 * i, c = (tid & 15) * 4;
            float4 v = make_float4(0.f, 0.f, 0.f, 0.f);
            if (c0 + c < C) v = *(const float4*)(s + (size_t)(r0 + r) * C + c0 + c);
            tile[r * 65 + c + 0] = v.x; tile[r * 65 + c + 1] = v.y; tile[r * 65 + c + 2] = v.z; tile[r * 65 + c + 3] = v.w;
        }
        __syncthreads();
        {
            const int c = tid >> 2, rs = (tid & 3) * 16;
            uint4 o0, o1;
            o0.x = pack2(tile[(rs + 0) * 65 + c], tile[(rs + 1) * 65 + c]);
            o0.y = pack2(tile[(rs + 2) * 65 + c], tile[(rs + 3) * 65 + c]);
            o0.z = pack2(tile[(rs + 4) * 65 + c], tile[(rs + 5) * 65 + c]);
            o0.w = pack2(tile[(rs + 6) * 65 + c], tile[(rs + 7) * 65 + c]);
            o1.x = pack2(tile[(rs + 8) * 65 + c], tile[(rs + 9) * 65 + c]);
            o1.y = pack2(tile[(rs + 10) * 65 + c], tile[(rs + 11) * 65 + c]);
            o1.z = pack2(tile[(rs + 12) * 65 + c], tile[(rs + 13) * 65 + c]);
            o1.w = pack2(tile[(rs + 14) * 65 + c], tile[(rs + 15) * 65 + c]);
            uint4* dp = (uint4*)(d + (size_t)(c0 + c) * R + r0 + rs);
            dp[0] = o0; dp[1] = o1;
        }
        __syncthreads();
    }
}

DI void convert_job(const float* __restrict__ src, bf16_t* __restrict__ dst, size_t n) {
    for (size_t i = ((size_t)blockIdx.x * 256 + threadIdx.x) * 8; i < n; i += (size_t)gridDim.x * 256 * 8) {
        const float4 a = *(const float4*)(src + i), b = *(const float4*)(src + i + 4);
        uint4 o; o.x = pack2(a.x, a.y); o.y = pack2(a.z, a.w); o.z = pack2(b.x, b.y); o.w = pack2(b.z, b.w);
        *(uint4*)(dst + i) = o;
    }
}

DI void prep0(const Params& pin, unsigned char* smem) {
    const Params& p = pin; unsigned char* const ws_ = opaque_ws(pin.ws); float* const out_ = opaque_out(pin.out); const int tid = opaque_v(threadIdx.x);
    {
        float* sl = (float*)smem; float* red = (float*)(smem + 12288);
        for (int i = tid; i < 3072; i += 256) {
            const int cnd = i >> 10, k = i & 1023;
            const float v = (cnd == 0) ? p.c_ctx[k] : p.c[(cnd - 1) * 1024 + k];
            sl[i] = v / (1.f + __expf(-v));
        }
        __syncthreads();
        float* mod = (float*)(ws_ + OFF_MOD);
        const int kg = tid >> 4, cl = tid & 15;
        for (int it = blockIdx.x; it < 384; it += gridDim.x) {
            const int l = it / 96, j0 = (it % 96) * 64;
            const float* w = p.ada_w + (size_t)l * 1024 * 6144 + j0 + cl * 4;
            float4 a0 = make_float4(0, 0, 0, 0), a1 = a0, a2 = a0;
#pragma unroll 8
            for (int kk = 0; kk < 64; ++kk) {
                const int k = kg * 64 + kk;
                const float4 wv = *(const float4*)(w + (size_t)k * 6144);
                const float s0 = sl[k], s1 = sl[1024 + k], s2 = sl[2048 + k];
                a0.x += s0 * wv.x; a0.y += s0 * wv.y; a0.z += s0 * wv.z; a0.w += s0 * wv.w;
                a1.x += s1 * wv.x; a1.y += s1 * wv.y; a1.z += s1 * wv.z; a1.w += s1 * wv.w;
                a2.x += s2 * wv.x; a2.y += s2 * wv.y; a2.z += s2 * wv.z; a2.w += s2 * wv.w;
            }
            __syncthreads();
            float* r = red + kg * 192 + cl * 4;
            r[0] = a0.x; r[1] = a0.y; r[2] = a0.z; r[3] = a0.w;
            r[64] = a1.x; r[65] = a1.y; r[66] = a1.z; r[67] = a1.w;
            r[128] = a2.x; r[129] = a2.y; r[130] = a2.z; r[131] = a2.w;
            __syncthreads();
            if (tid < 192) {
                const int cnd = tid >> 6, col = tid & 63;
                float s = 0.f;
#pragma unroll
                for (int q = 0; q < 16; ++q) s += red[q * 192 + tid];
                mod[(l * 3 + cnd) * 6144 + j0 + col] = s + p.ada_b[l * 6144 + j0 + col];
            }
        }
        __syncthreads();
    }
    if (blockIdx.x == gridDim.x - 1) {
        float* rope = (float*)(ws_ + OFF_ROPE);
        for (int i = tid; i < 1024; i += 256) {
            const int pos = i >> 4, j = i & 15;
            const float freq = powf(10000.f, -(float)j / 16.f);
            float s, c; sincosf((float)pos * freq, &s, &c);
            rope[i] = c; rope[1024 + i] = s;
        }
        if (tid < 4) {
            const float* lp = p.diff_lambda + tid * 256;
            float s1 = 0.f, s2 = 0.f;
            for (int i = 0; i < 64; ++i) { s1 += lp[i] * lp[64 + i]; s2 += lp[128 + i] * lp[192 + i]; }
            const float li = 0.8f - 0.6f * expf(-0.3f * (float)tid);
            float* lam = (float*)(ws_ + OFF_LAM);
            lam[tid * 2] = expf(s1) - expf(s2) + li; lam[tid * 2 + 1] = li;
        }
    }
    float* tile = (float*)smem;
    transpose_job(p.w_in, (bf16_t*)(ws_ + OFF_WT_IN), 1024, NIN, NINP, 4, tile);
    transpose_job(p.w_out, (bf16_t*)(ws_ + OFF_WT_OUT), 1024, 1024, 1024, 4, tile);
    transpose_job(p.w_mlp1, (bf16_t*)(ws_ + OFF_WT_1), 1024, 4096, 4096, 4, tile);
    transpose_job(p.w_mlp2, (bf16_t*)(ws_ + OFF_WT_2), 4096, 1024, 1024, 4, tile);
    transpose_job(p.cache_a_v, (bf16_t*)(ws_ + OFF_CAVT), 512, 128, 128, 32, tile);
    transpose_job(p.cache_b_v, (bf16_t*)(ws_ + OFF_CBVT), 512, 64, 64, 32, tile);
    transpose_job(p.state_c, (bf16_t*)(ws_ + OFF_C0T), 64, 64, 64, 64, tile);
    convert_job(p.cache_a_k, (bf16_t*)(ws_ + OFF_CAK), (size_t)32 * 512 * 128);
    convert_job(p.cache_b_k, (bf16_t*)(ws_ + OFF_CBK), (size_t)32 * 512 * 64);
}

DI void prep1(const Params& pin) {
    const Params& p = pin; unsigned char* const ws_ = opaque_ws(pin.ws); float* const out_ = opaque_out(pin.out); const int tid_ = opaque_v(threadIdx.x); const int lane = tid_ & 63, wave = tid_ >> 6;
    const float* mod = (const float*)(ws_ + OFF_MOD);
    float* X = (float*)(ws_ + OFF_X);
    bf16_t* H = (bf16_t*)(ws_ + OFF_H);
    for (int row = blockIdx.x * 4 + wave; row < NTOK; row += gridDim.x * 4) {
        const float* src = row < NCTX ? p.x_prompt + (size_t)row * 1024 : p.x_sample + (size_t)(row - NCTX) * 1024;
        const int cnd = row < NCTX ? 0 : 1 + ((row - NCTX) >> 10);
        const float* md = mod + (size_t)cnd * 6144;
#pragma unroll
        for (int j = 0; j < 4; ++j) {
            const int c = lane * 4 + 256 * j;
            const float4 v = *(const float4*)(src + c);
            *(float4*)(X + (size_t)row * 1024 + c) = v;
            const float4 sh = *(const float4*)(md + c), sc = *(const float4*)(md + 1024 + c);
            uint2 o; o.x = pack2(v.x * (1.f + sc.x) + sh.x, v.y * (1.f + sc.y) + sh.y);
            o.y = pack2(v.z * (1.f + sc.z) + sh.z, v.w * (1.f + sc.w) + sh.w);
            *(uint2*)(H + (size_t)row * 1024 + c) = o;
        }
    }
}

template <int WHICH>
DI void ln_phase(const Params& pin, int l) {
    const Params& p = pin; unsigned char* const ws_ = opaque_ws(pin.ws); float* const out_ = opaque_out(pin.out); const int tid_ = opaque_v(threadIdx.x); const int lane = tid_ & 63, wave = tid_ >> 6;
    const float* mod = (const float*)(ws_ + OFF_MOD);
    float* X = (float*)(ws_ + OFF_X);
    const float* Y = (const float*)(ws_ + OFF_Y);
    bf16_t* H = (bf16_t*)(ws_ + OFF_H);
    const float* lg = (WHICH == 1 ? p.ln1_g : p.ln2_g) + l * 1024;
    const float* lb = (WHICH == 1 ? p.ln1_b : p.ln2_b) + l * 1024;
    const bool last = (WHICH == 2 && l == 3);
    for (int row = blockIdx.x * 4 + wave; row < NTOK; row += gridDim.x * 4) {
        const int cnd = row < NCTX ? 0 : 1 + ((row - NCTX) >> 10);
        const float* md = mod + (size_t)(l * 3 + cnd) * 6144;
        const float* gate = md + (WHICH == 1 ? 2048 : 5120);
        float4 v[4];
        float s = 0.f;
#pragma unroll
        for (int j = 0; j < 4; ++j) {
            const int c = lane * 4 + 256 * j;
            const float4 xv = *(const float4*)(X + (size_t)row * 1024 + c);
            const float4 yv = *(const float4*)(Y + (size_t)row * 1024 + c);
            const float4 gv = *(const float4*)(gate + c);
            v[j].x = ALPHA * xv.x + gv.x * yv.x; v[j].y = ALPHA * xv.y + gv.y * yv.y;
            v[j].z = ALPHA * xv.z + gv.z * yv.z; v[j].w = ALPHA * xv.w + gv.w * yv.w;
            s += v[j].x + v[j].y + v[j].z + v[j].w;
        }
        const float mu = wave_sum(s) * (1.f / 1024.f);
        float q = 0.f;
#pragma unroll
        for (int j = 0; j < 4; ++j) {
            v[j].x -= mu; v[j].y -= mu; v[j].z -= mu; v[j].w -= mu;
            q += v[j].x * v[j].x + v[j].y * v[j].y + v[j].z * v[j].z + v[j].w * v[j].w;
        }
        const float rstd = rsqrtf(wave_sum(q) * (1.f / 1024.f) + LN_EPS);
        const float* nmd = (WHICH == 1) ? md : mod + (size_t)((l + 1) * 3 + cnd) * 6144;
        const float* shp = nmd + (WHICH == 1 ? 3072 : 0);
        const float* scp = nmd + (WHICH == 1 ? 4096 : 1024);
#pragma unroll
        for (int j = 0; j < 4; ++j) {
            const int c = lane * 4 + 256 * j;
            const float4 g4 = *(const float4*)(lg + c), b4 = *(const float4*)(lb + c);
            float4 o;
            o.x = v[j].x * rstd * g4.x + b4.x; o.y = v[j].y * rstd * g4.y + b4.y;
            o.z = v[j].z * rstd * g4.z + b4.z; o.w = v[j].w * rstd * g4.w + b4.w;
            if (last) {
                *(float4*)(out_ + (size_t)row * 1024 + c) = o;
            } else {
                *(float4*)(X + (size_t)row * 1024 + c) = o;
                const float4 sh = *(const float4*)(shp + c), sc = *(const float4*)(scp + c);
                uint2 h; h.x = pack2(o.x * (1.f + sc.x) + sh.x, o.y * (1.f + sc.y) + sh.y);
                h.y = pack2(o.z * (1.f + sc.z) + sh.z, o.w * (1.f + sc.w) + sh.w);
                *(uint2*)(H + (size_t)row * 1024 + c) = h;
            }
        }
    }
}

enum { EPI_INPROJ = 0, EPI_Y = 1, EPI_RELU2 = 2 };

DI void epi_inproj(const Params& p, unsigned char* ws_, float* out_, int layer, const float* T, int rowbase, int colbase, int lane) {
    if (colbase >= NIN) return;
    bf16_t* P = (bf16_t*)(ws_ + OFF_P);
    const bool latent = rowbase >= NCTX;
    const int seq_tok0 = latent ? (NCTX + ((rowbase - NCTX) & ~1023)) : (rowbase & ~255);
    const int nseq = latent ? 1024 : 256;
    const int bctx = seq_tok0 >> 8;
    const int n0 = rowbase - seq_tok0;
    if (colbase >= 3328) {
        float* G = (float*)(ws_ + OFF_G);
        const float bias = p.gate_bias[layer * 16 + (lane & 15)];
        for (int rr = 0; rr < 16; ++rr) {
            const int r = rr * 4 + (lane >> 4);
            G[(size_t)(rowbase + r) * 16 + (lane & 15)] = T[r * 65 + (lane & 15)] + bias;
        }
        return;
    }
    bool toP = false, rope = false, toT = false, toO = false;
    size_t toff = 0, obase = 0; int tW = 0, tcr = 0, ohd = 64, ocr = 0;
    if (colbase < 1024) { toP = true; rope = latent; if (colbase >= 512) { toO = !latent; obase = O_AK; ohd = 128; ocr = colbase - 512; } }
    else if (colbase < 1536) { toT = true; toff = OFF_PT_AV; tW = 512; tcr = colbase - 1024; toO = !latent; obase = O_AV; ohd = 128; ocr = tcr; }
    else if (colbase < 1792) { toP = true; }
    else if (colbase < 2048) { toP = true; toO = !latent; obase = O_BK; ohd = 64; ocr = colbase - 1792; }
    else if (colbase < 2304) { toT = true; toff = OFF_PT_BV; tW = 256; tcr = colbase - 2048; toO = !latent; obase = O_BV; ohd = 64; ocr = tcr; }
    else if (colbase < 2560) { toP = true; }
    else if (colbase < 2816) { toP = true; toT = true; toff = OFF_PT_CK; tW = 256; tcr = colbase - 2560; }
    else if (colbase < 3072) { toT = true; toff = OFF_PT_CV; tW = 256; tcr = colbase - 2816; }
    else { toP = true; }
    if (toO) {
        const int h = ocr / ohd, w = ocr - h * ohd + lane;
        float* O = out_ + obase + (((size_t)(bctx * 4 + layer) * 4 + h) * 256 + n0) * ohd + w;
#pragma unroll 4
        for (int r = 0; r < 64; ++r) O[(size_t)r * ohd] = T[r * 65 + lane];
    }
    if (toP) {
        bf16_t* Pp = P + (size_t)rowbase * NIN + colbase + lane;
        if (rope) {
            const float* rc = (const float*)(ws_ + OFF_ROPE);
            const float* rs = rc + 1024;
#pragma unroll 4
            for (int r = 0; r < 64; ++r) {
                const float v = T[r * 65 + lane], vp = T[r * 65 + (lane ^ 16)];
                const int t = n0 + r;
                const int pos = (lane < 32) ? (t >> 6) : (t & 63);
                const float c = rc[pos * 16 + (lane & 15)], sn = rs[pos * 16 + (lane & 15)];
                const float o = (lane & 16) ? (vp * sn + v * c) : (v * c - vp * sn);
                Pp[(size_t)r * NIN] = f2bf(o);
            }
        } else {
#pragma unroll 4
            for (int r = 0; r < 64; ++r) Pp[(size_t)r * NIN] = f2bf(T[r * 65 + lane]);
        }
    }
    if (toT) {
        bf16_t* Tp = (bf16_t*)(ws_ + toff) + (size_t)seq_tok0 * tW + (size_t)tcr * nseq + n0 + lane;
#pragma unroll 4
        for (int c = 0; c < 64; ++c) Tp[(size_t)c * nseq] = f2bf(T[lane * 65 + c]);
    }
}

template <int EPI>
DI void gemm_phase(const Params& pin, int layer, size_t offA, size_t offB, int ntn, int K, int ldc,
                   unsigned char* smem) {
    const Params& p = pin; unsigned char* const ws_ = opaque_ws(pin.ws); float* const out_ = opaque_out(pin.out); const int tid = opaque_v(threadIdx.x), lane = tid & 63, wave = tid >> 6;
    const bf16_t* __restrict__ A = (const bf16_t*)(ws_ + offA); const bf16_t* __restrict__ Bt = (const bf16_t*)(ws_ + offB);
    const int wm = wave >> 1, wn = wave & 1;
    const int lr = lane & 15, g = lane >> 4;
    const int ntm = NTOK / 128;
    const int ntiles = ntm * ntn, nk = K >> 6;
    for (int tile = blockIdx.x; tile < ntiles; tile += gridDim.x) {
        const int tm = tile % ntm, tn = tile / ntm;
        const int m0 = tm * 128, n0 = tn * 128;
        f32x4 acc[4][4];
#pragma unroll
        for (int mi = 0; mi < 4; ++mi)
#pragma unroll
            for (int ni = 0; ni < 4; ++ni) acc[mi][ni] = (f32x4){0.f, 0.f, 0.f, 0.f};
        const bf16_t* Ag = A + (size_t)m0 * K;
        const bf16_t* Bg = Bt + (size_t)n0 * K;
        uint4 ra[4], rb[4];
#pragma unroll
        for (int i = 0; i < 4; ++i) {
            const int ci = tid + 256 * i, row = ci >> 3, ch = ci & 7;
            ra[i] = *(const uint4*)(Ag + (size_t)row * K + ch * 8);
            rb[i] = *(const uint4*)(Bg + (size_t)row * K + ch * 8);
        }
#pragma unroll
        for (int i = 0; i < 4; ++i) {
            const int ci = tid + 256 * i, row = ci >> 3, ch = ci & 7;
            const int off = row * 128 + ((ch ^ (row & 7)) << 4);
            *(uint4*)(smem + off) = ra[i];
            *(uint4*)(smem + 16384 + off) = rb[i];
        }
        __syncthreads();
        for (int kt = 0; kt < nk; ++kt) {
            const unsigned char* cur = smem + (kt & 1) * 32768;
            unsigned char* nxt = smem + ((kt + 1) & 1) * 32768;
            const bool more = (kt + 1 < nk);
            if (more) {
                const int k0 = (kt + 1) << 6;
#pragma unroll
                for (int i = 0; i < 4; ++i) {
                    const int ci = tid + 256 * i, row = ci >> 3, ch = ci & 7;
                    ra[i] = *(const uint4*)(Ag + (size_t)row * K + k0 + ch * 8);
                    rb[i] = *(const uint4*)(Bg + (size_t)row * K + k0 + ch * 8);
                }
            }
#pragma unroll
            for (int kk = 0; kk < 2; ++kk) {
                bf16x8 af[4], bfr[4];
#pragma unroll
                for (int mi = 0; mi < 4; ++mi) {
                    const int row = wm * 64 + mi * 16 + lr;
                    af[mi] = *(const bf16x8*)(cur + row * 128 + (((kk * 4 + g) ^ (row & 7)) << 4));
                }
#pragma unroll
                for (int ni = 0; ni < 4; ++ni) {
                    const int row = wn * 64 + ni * 16 + lr;
                    bfr[ni] = *(const bf16x8*)(cur + 16384 + row * 128 + (((kk * 4 + g) ^ (row & 7)) << 4));
                }
#pragma unroll
                for (int mi = 0; mi < 4; ++mi)
#pragma unroll
                    for (int ni = 0; ni < 4; ++ni) acc[mi][ni] = mfma16(af[mi], bfr[ni], acc[mi][ni]);
            }
            if (more) {
#pragma unroll
                for (int i = 0; i < 4; ++i) {
                    const int ci = tid + 256 * i, row = ci >> 3, ch = ci & 7;
                    const int off = row * 128 + ((ch ^ (row & 7)) << 4);
                    *(uint4*)(nxt + off) = ra[i];
                    *(uint4*)(nxt + 16384 + off) = rb[i];
                }
            }
            __syncthreads();
        }
        float* T = (float*)smem + wave * (64 * 65);
#pragma unroll
        for (int mi = 0; mi < 4; ++mi)
#pragma unroll
            for (int ni = 0; ni < 4; ++ni)
#pragma unroll
                for (int i = 0; i < 4; ++i) T[(mi * 16 + 4 * g + i) * 65 + ni * 16 + lr] = acc[mi][ni][i];
        const int rowbase = m0 + wm * 64, colbase = n0 + wn * 64;
        if (EPI == EPI_INPROJ) {
            epi_inproj(p, ws_, out_, layer, T, rowbase, colbase, lane);
        } else if (EPI == EPI_Y) {
            float* Y = (float*)(ws_ + OFF_Y) + (size_t)rowbase * ldc + colbase + lane;
#pragma unroll 4
            for (int r = 0; r < 64; ++r) Y[(size_t)r * ldc] = T[r * 65 + lane];
        } else {
            bf16_t* U = (bf16_t*)(ws_ + OFF_U) + (size_t)rowbase * ldc + colbase + lane;
#pragma unroll 4
            for (int r = 0; r < 64; ++r) { const float v = fmaxf(T[r * 65 + lane], 0.f); U[(size_t)r * ldc] = f2bf(v * v); }
        }
        __syncthreads();
    }
}

template <int NMAP, int DV>
struct AttnSt { f32x4 O[NMAP][DV / 16]; float m[NMAP]; float l[NMAP]; };
template <int NMAP, int DV>
struct UnitFrags { bf16x8 k[NMAP][2][2]; bf16x4 v[DV / 16][2]; };

template <int NMAP, int DV>
DI void load_k(UnitFrags<NMAP, DV>& f, const bf16_t* kp, int kstride) {
#pragma unroll
    for (int m = 0; m < NMAP; ++m)
#pragma unroll
        for (int b = 0; b < 2; ++b)
#pragma unroll
            for (int kk = 0; kk < 2; ++kk) f.k[m][b][kk] = *(const bf16x8*)(kp + (size_t)b * 16 * kstride + m * 64 + kk * 32);
}
template <int NMAP, int DV>
DI void load_v(UnitFrags<NMAP, DV>& f, const bf16_t* vp, int vstride) {
#pragma unroll
    for (int vb = 0; vb < DV / 16; ++vb) {
        f.v[vb][0] = *(const bf16x4*)(vp + (size_t)vb * 16 * vstride);
        f.v[vb][1] = *(const bf16x4*)(vp + (size_t)vb * 16 * vstride + 16);
    }
}
template <int NMAP, int DV>
DI void load_unit(UnitFrags<NMAP, DV>& f, const bf16_t* kp, int kstride, const bf16_t* vp, int vstride) {
    load_k<NMAP, DV>(f, kp, kstride);
    load_v<NMAP, DV>(f, vp, vstride);
}

template <int NMAP, int DV, bool HASBIAS>
DI void compute_unit(AttnSt<NMAP, DV>& st, const UnitFrags<NMAP, DV>& f, const bf16x8 (&qf)[NMAP][2], float sc, const float (&bias)[8]) {
    bf16x8 pk[NMAP];
#pragma unroll
    for (int m = 0; m < NMAP; ++m) {
        f32x4 sa = (f32x4){0.f, 0.f, 0.f, 0.f}, sb = sa;
        sa = mfma16(f.k[m][0][0], qf[m][0], sa); sa = mfma16(f.k[m][0][1], qf[m][1], sa);
        sb = mfma16(f.k[m][1][0], qf[m][0], sb); sb = mfma16(f.k[m][1][1], qf[m][1], sb);
        float s[8];
#pragma unroll
        for (int j = 0; j < 4; ++j) { s[j] = sa[j] * sc; s[4 + j] = sb[j] * sc; }
        if (HASBIAS) {
#pragma unroll
            for (int j = 0; j < 8; ++j) s[j] += bias[j];
        }
        float mx = fmaxf(fmaxf(fmaxf(s[0], s[1]), fmaxf(s[2], s[3])), fmaxf(fmaxf(s[4], s[5]), fmaxf(s[6], s[7])));
        mx = grp_max(mx);
        const float mnew = fmaxf(st.m[m], mx);
        const float alpha = fexp2(st.m[m] - mnew);
        float ps = 0.f;
#pragma unroll
        for (int j = 0; j < 8; ++j) { s[j] = fexp2(s[j] - mnew); ps += s[j]; }
        st.l[m] = st.l[m] * alpha + ps; st.m[m] = mnew;
#pragma unroll
        for (int vb = 0; vb < DV / 16; ++vb) st.O[m][vb] *= alpha;
        pk[m] = pack8(s[0], s[1], s[2], s[3], s[4], s[5], s[6], s[7]);
    }
#pragma unroll
    for (int vb = 0; vb < DV / 16; ++vb) {
        const bf16x8 vf = cat4(f.v[vb][0], f.v[vb][1]);
#pragma unroll
        for (int m = 0; m < NMAP; ++m) st.O[m][vb] = mfma16(vf, pk[m], st.O[m][vb]);
    }
}

template <int NMAP, int DV>
DI void run_segment(AttnSt<NMAP, DV>& st, const bf16x8 (&qf)[NMAP][2], const bf16_t* kp, int kstride, const bf16_t* vp, int vstride,
                    int nunits, float sc) {
    const float nob[8] = {0.f, 0.f, 0.f, 0.f, 0.f, 0.f, 0.f, 0.f};
    if (NMAP == 1) {
        UnitFrags<NMAP, DV> cur;
        load_k<NMAP, DV>(cur, kp, kstride);
        for (int u = 0; u < nunits; ++u) {
            const int un = (u + 1 < nunits) ? u + 1 : u;
            load_v<NMAP, DV>(cur, vp + u * 32, vstride);
            UnitFrags<NMAP, DV> nxt;
            load_k<NMAP, DV>(nxt, kp + (size_t)un * 32 * kstride, kstride);
            compute_unit<NMAP, DV, false>(st, cur, qf, sc, nob);
#pragma unroll
            for (int m = 0; m < NMAP; ++m)
#pragma unroll
                for (int b = 0; b < 2; ++b)
#pragma unroll
                    for (int kk = 0; kk < 2; ++kk) cur.k[m][b][kk] = nxt.k[m][b][kk];
        }
    } else {
        for (int u = 0; u < nunits; ++u) {
            UnitFrags<NMAP, DV> cur;
            load_unit<NMAP, DV>(cur, kp + (size_t)u * 32 * kstride, kstride, vp + u * 32, vstride);
            compute_unit<NMAP, DV, false>(st, cur, qf, sc, nob);
        }
    }
}

template <int NMAP, int DV>
DI void attn_init(AttnSt<NMAP, DV>& st) {
#pragma unroll
    for (int m = 0; m < NMAP; ++m) {
        st.m[m] = -INFINITY; st.l[m] = 0.f;
#pragma unroll
        for (int vb = 0; vb < DV / 16; ++vb) st.O[m][vb] = (f32x4){0.f, 0.f, 0.f, 0.f};
    }
}

template <bool LAT>
DI void item_diffattn(const Params& pin, int l, int seq, int h, int qt, int wave, int lane) {
    const Params& p = pin; unsigned char* const ws_ = opaque_ws(pin.ws); float* const out_ = opaque_out(pin.out); lane = opaque_v(lane);
    const int lr = lane & 15, g = lane >> 4;
    const int nseq = LAT ? 1024 : 256;
    const int tok0 = LAT ? NCTX + seq * 1024 : seq * 256;
    const bf16_t* P = (const bf16_t*)(ws_ + OFF_P);
    const int q0 = qt * 64 + wave * 16;
    bf16x8 qf[2][2];
    {
        const bf16_t* qp = P + (size_t)(tok0 + q0 + lr) * NIN + h * 128 + 8 * g;
#pragma unroll
        for (int m = 0; m < 2; ++m)
#pragma unroll
            for (int kk = 0; kk < 2; ++kk) qf[m][kk] = *(const bf16x8*)(qp + m * 64 + kk * 32);
    }
    AttnSt<2, 128> st;
    attn_init<2, 128>(st);
    const float sc = 0.125f * LOG2E;
    if (LAT) {
        const size_t hb = (size_t)((seq * 4 + l) * 4 + h);
        const bf16_t* kc = (const bf16_t*)(ws_ + OFF_CAK) + hb * 512 * 128 + lr * 128 + 8 * g;
        const bf16_t* vc = (const bf16_t*)(ws_ + OFF_CAVT) + hb * 128 * 512 + lr * 512 + 4 * g;
        run_segment<2, 128>(st, qf, kc, 128, vc, 512, 16, sc);
    }
    {
        const bf16_t* kn = P + (size_t)(tok0 + lr) * NIN + 512 + h * 128 + 8 * g;
        const bf16_t* vn = (const bf16_t*)(ws_ + OFF_PT_AV) + (size_t)tok0 * 512 + (size_t)(h * 128 + lr) * nseq + 4 * g;
        run_segment<2, 128>(st, qf, kn, NIN, vn, nseq, nseq / 32, sc);
    }
    const float inv0 = 1.f / grp_sum(st.l[0]), inv1 = 1.f / grp_sum(st.l[1]);
    const float* lamp = (const float*)(ws_ + OFF_LAM);
    const float lam = lamp[l * 2], lam_init = lamp[l * 2 + 1];
    const float c1 = lam * inv1;
    float ss = 0.f;
#pragma unroll
    for (int vb = 0; vb < 8; ++vb)
#pragma unroll
        for (int i = 0; i < 4; ++i) {
            const float o = st.O[0][vb][i] * inv0 - st.O[1][vb][i] * c1;
            st.O[0][vb][i] = o; ss += o * o;
        }
    ss = grp_sum(ss);
    const float r = rsqrtf(ss * (1.f / 128.f) + LN_EPS) * (1.f - lam_init);
    bf16_t* MIX = (bf16_t*)(ws_ + OFF_MIX) + (size_t)(tok0 + q0 + lr) * 1024 + h * 128;
    const float* gn = p.diff_norm_g + l * 128;
#pragma unroll
    for (int vb = 0; vb < 8; ++vb) {
        const int v = vb * 16 + 4 * g;
        const float4 g4 = *(const float4*)(gn + v);
        uint2 o; o.x = pack2(st.O[0][vb][0] * r * g4.x, st.O[0][vb][1] * r * g4.y);
        o.y = pack2(st.O[0][vb][2] * r * g4.z, st.O[0][vb][3] * r * g4.w);
        *(uint2*)(MIX + v) = o;
    }
}

DI void item_dense(const Params& pin, int seq, int h, int qt, int wave, int lane) {
    const Params& p = pin; unsigned char* const ws_ = opaque_ws(pin.ws); float* const out_ = opaque_out(pin.out); lane = opaque_v(lane);
    const int lr = lane & 15, g = lane >> 4;
    const int tok0 = seq * 256;
    const bf16_t* P = (const bf16_t*)(ws_ + OFF_P);
    const int q0 = qt * 64 + wave * 16;
    bf16x8 qf[1][2];
    {
        const bf16_t* qp = P + (size_t)(tok0 + q0 + lr) * NIN + 1536 + h * 64 + 8 * g;
        qf[0][0] = *(const bf16x8*)(qp); qf[0][1] = *(const bf16x8*)(qp + 32);
    }
    AttnSt<1, 64> st;
    attn_init<1, 64>(st);
    const bf16_t* kn = P + (size_t)(tok0 + lr) * NIN + 1792 + h * 64 + 8 * g;
    const bf16_t* vn = (const bf16_t*)(ws_ + OFF_PT_BV) + (size_t)tok0 * 256 + (size_t)(h * 64 + lr) * 256 + 4 * g;
    run_segment<1, 64>(st, qf, kn, NIN, vn, 256, 8, 0.125f * LOG2E);
    const float inv = 1.f / grp_sum(st.l[0]);
    bf16_t* MIX = (bf16_t*)(ws_ + OFF_MIX) + (size_t)(tok0 + q0 + lr) * 1024 + 512 + h * 64;
#pragma unroll
    for (int vb = 0; vb < 4; ++vb) {
        uint2 o; o.x = pack2(st.O[0][vb][0] * inv, st.O[0][vb][1] * inv); o.y = pack2(st.O[0][vb][2] * inv, st.O[0][vb][3] * inv);
        *(uint2*)(MIX + vb * 16 + 4 * g) = o;
    }
}

DI void item_na(const Params& pin, int l, int sb, int h, int r, int wave, int lane) {
    const Params& p = pin; unsigned char* const ws_ = opaque_ws(pin.ws); float* const out_ = opaque_out(pin.out); lane = opaque_v(lane);
    const int lr = lane & 15, g = lane >> 4;
    const int tok0 = NCTX + sb * 1024;
    const bf16_t* P = (const bf16_t*)(ws_ + OFF_P);
    const int qc = wave * 16 + lr;
    const int q0 = r * 64 + wave * 16;
    bf16x8 qf[1][2];
    {
        const bf16_t* qp = P + (size_t)(tok0 + q0 + lr) * NIN + 1536 + h * 64 + 8 * g;
        qf[0][0] = *(const bf16x8*)(qp); qf[0][1] = *(const bf16x8*)(qp + 32);
    }
    AttnSt<1, 64> st;
    attn_init<1, 64>(st);
    const float sc = 0.125f * LOG2E;
    {
        const size_t hb = (size_t)((sb * 4 + l) * 4 + h);
        const bf16_t* kc = (const bf16_t*)(ws_ + OFF_CBK) + hb * 512 * 64 + lr * 64 + 8 * g;
        const bf16_t* vc = (const bf16_t*)(ws_ + OFF_CBVT) + hb * 64 * 512 + lr * 512 + 4 * g;
        run_segment<1, 64>(st, qf, kc, 64, vc, 512, 16, sc);
    }
    const int kr0 = min(max(r - 4, 0), 8);
    const int bs = min(max(wave * 16 - 8, 0), 32);
    const int wstart = min(max(qc - 8, 0), 48);
    const float* rpb = p.nat_rpb + (size_t)(l * 4 + h) * 15 * 31;
    const bf16_t* vbase = (const bf16_t*)(ws_ + OFF_PT_BV) + (size_t)tok0 * 256 + (size_t)(h * 64 + lr) * 1024 + 4 * g;
    for (int u = 0; u < 8; ++u) {
        const int kr = kr0 + u;
        const int key0 = kr * 64 + bs;
        UnitFrags<1, 64> f;
        load_unit<1, 64>(f, P + (size_t)(tok0 + key0 + lr) * NIN + 1792 + h * 64 + 8 * g, NIN, vbase + key0, 1024);
        float bias[8];
        const float* rrow = rpb + (kr - r + 7) * 31;
#pragma unroll
        for (int j = 0; j < 8; ++j) {
            const int kc = bs + 4 * g + (j & 3) + ((j >> 2) << 4);
            const bool valid = (kc >= wstart) && (kc < wstart + 16);
            const int dc = min(max(kc - qc + 15, 0), 30);
            bias[j] = valid ? rrow[dc] * LOG2E : -INFINITY;
        }
        compute_unit<1, 64, true>(st, f, qf, sc, bias);
    }
    const float inv = 1.f / grp_sum(st.l[0]);
    bf16_t* MIX = (bf16_t*)(ws_ + OFF_MIX) + (size_t)(tok0 + q0 + lr) * 1024 + 512 + h * 64;
#pragma unroll
    for (int vb = 0; vb < 4; ++vb) {
        uint2 o; o.x = pack2(st.O[0][vb][0] * inv, st.O[0][vb][1] * inv); o.y = pack2(st.O[0][vb][2] * inv, st.O[0][vb][3] * inv);
        *(uint2*)(MIX + vb * 16 + 4 * g) = o;
    }
}

DI float wave_excl_sum(float v, int lane) {
    float x = v;
#pragma unroll
    for (int d = 1; d < 64; d <<= 1) { const float y = __shfl_up(x, d); if (lane >= d) x += y; }
    return x - v;
}
DI float wave_excl_max(float v, int lane, float init) {
    float x = v;
#pragma unroll
    for (int d = 1; d < 64; d <<= 1) { const float y = __shfl_up(x, d); if (lane >= d) x = fmaxf(x, y); }
    const float ex = __shfl_up(x, 1);
    return lane == 0 ? init : fmaxf(init, ex);
}
DI void mlstm_scan(const float* __restrict__ G, int h, int nseq, int dir, float* aA, float* MA, float* FA, float m0, int lane) {
    const int per = nseq >> 6;
    float run = 0.f;
    for (int e = 0; e < per; ++e) {
        const int idx = lane * per + e, pos = dir ? nseq - 1 - idx : idx;
        const float f = G[(size_t)pos * 16 + (dir ? 12 : 4) + h];
        const float lf = fminf(f, 0.f) - log1pf(expf(-fabsf(f)));
        run += lf; FA[pos] = run;
    }
    const float off = wave_excl_sum(run, lane);
    float rmax = -INFINITY;
    for (int e = 0; e < per; ++e) {
        const int idx = lane * per + e, pos = dir ? nseq - 1 - idx : idx;
        const float F = FA[pos] + off; FA[pos] = F;
        const float a = G[(size_t)pos * 16 + (dir ? 8 : 0) + h] - F;
        aA[pos] = a; rmax = fmaxf(rmax, a); MA[pos] = rmax;
    }
    const float pre = wave_excl_max(rmax, lane, m0);
    for (int e = 0; e < per; ++e) {
        const int idx = lane * per + e, pos = dir ? nseq - 1 - idx : idx;
        MA[pos] = fmaxf(MA[pos], pre);
    }
}

DI void mlstm_pass(f32x4 (&O)[4], float& den, int dir, int t, const bf16x8 (&qf)[2], const bf16_t* kbase, const bf16_t* vbase, int nseq,
                   const float* aA, float Mt, int u_lo, int u_hi, int g) {
    for (int u = u_lo; u <= u_hi; ++u) {
        const int key0 = u * 32;
        UnitFrags<1, 64> f;
        load_unit<1, 64>(f, kbase + (size_t)key0 * NIN, NIN, vbase + key0, nseq);
        f32x4 sa = (f32x4){0.f, 0.f, 0.f, 0.f}, sb = sa;
        sa = mfma16(f.k[0][0][0], qf[0], sa); sa = mfma16(f.k[0][0][1], qf[1], sa);
        sb = mfma16(f.k[0][1][0], qf[0], sb); sb = mfma16(f.k[0][1][1], qf[1], sb);
        const float4 a0 = *(const float4*)(aA + key0 + 4 * g), a1 = *(const float4*)(aA + key0 + 16 + 4 * g);
        const float av[8] = {a0.x, a0.y, a0.z, a0.w, a1.x, a1.y, a1.z, a1.w};
        float pv[8];
#pragma unroll
        for (int j = 0; j < 8; ++j) {
            const int key = key0 + 4 * g + (j & 3) + ((j >> 2) << 4);
            const bool ok = dir ? (key >= t) : (key <= t);
            const float w = ok ? fexp2((av[j] - Mt) * LOG2E) : 0.f;
            const float sv = (j < 4) ? sa[j & 3] : sb[j & 3];
            pv[j] = sv * 0.125f * w;
            den += pv[j];
        }
        const bf16x8 pk = pack8(pv[0], pv[1], pv[2], pv[3], pv[4], pv[5], pv[6], pv[7]);
#pragma unroll
        for (int vb = 0; vb < 4; ++vb) O[vb] = mfma16(cat4(f.v[vb][0], f.v[vb][1]), pk, O[vb]);
    }
}

template <bool LAT>
DI void item_mlstm(const Params& pin, int l, int seq, int h, int qt, unsigned char* smem, int wave, int lane) {
    const Params& p = pin; unsigned char* const ws_ = opaque_ws(pin.ws); float* const out_ = opaque_out(pin.out); lane = opaque_v(lane);
    const int lr = lane & 15, g = lane >> 4;
    const int nseq = LAT ? 1024 : 256;
    const int tok0 = LAT ? NCTX + seq * 1024 : seq * 256;
    float* aF = (float*)smem; float* MF = aF + 1024; float* FF = MF + 1024;
    float* aB = FF + 1024; float* MB = aB + 1024; float* FB = MB + 1024;
    const float* G = (const float*)(ws_ + OFF_G) + (size_t)tok0 * 16;
    float m0f = 0.f, m0b = 0.f;
    const int sidx_f = ((seq * 4 + l) * 2 + 0) * 4 + h, sidx_b = ((seq * 4 + l) * 2 + 1) * 4 + h;
    if (LAT) { m0f = p.state_m[sidx_f]; m0b = p.state_m[sidx_b]; }
    __syncthreads();
    if (wave == 0) mlstm_scan(G, h, nseq, 0, aF, MF, FF, m0f, lane);
    if (wave == 1) mlstm_scan(G, h, nseq, 1, aB, MB, FB, m0b, lane);
    __syncthreads();
    const bf16_t* P = (const bf16_t*)(ws_ + OFF_P);
    const int q0 = qt * 64 + wave * 16;
    const int t = q0 + lr;
    bf16x8 qf[2];
    {
        const bf16_t* qp = P + (size_t)(tok0 + t) * NIN + 2304 + h * 64 + 8 * g;
        qf[0] = *(const bf16x8*)(qp); qf[1] = *(const bf16x8*)(qp + 32);
    }
    const bf16_t* kbase = P + (size_t)(tok0 + lr) * NIN + 2560 + h * 64 + 8 * g;
    const bf16_t* vbase = (const bf16_t*)(ws_ + OFF_PT_CV) + (size_t)tok0 * 256 + (size_t)(h * 64 + lr) * nseq + 4 * g;
    const float Mf = MF[t], Mb = MB[t], Ff = FF[t], Fb = FB[t];
    f32x4 Of[4], Ob[4];
#pragma unroll
    for (int vb = 0; vb < 4; ++vb) { Of[vb] = (f32x4){0.f, 0.f, 0.f, 0.f}; Ob[vb] = Of[vb]; }
    float denf = 0.f, denb = 0.f;
    mlstm_pass(Of, denf, 0, t, qf, kbase, vbase, nseq, aF, Mf, 0, (q0 + 15) >> 5, g);
    mlstm_pass(Ob, denb, 1, t, qf, kbase, vbase, nseq, aB, Mb, q0 >> 5, (nseq >> 5) - 1, g);
    if (LAT) {
        const bf16_t* qp2 = P + (size_t)(tok0 + t) * NIN + 2304 + h * 64 + 4 * g;
#pragma unroll
        for (int dir = 0; dir < 2; ++dir) {
            const int sidx = dir ? sidx_b : sidx_f;
            const float e = fexp2(((dir ? m0b : m0f) - (dir ? Mb : Mf)) * LOG2E) * 0.125f;
            const bf16_t* c0t = (const bf16_t*)(ws_ + OFF_C0T) + (size_t)sidx * 4096 + lr * 64 + 4 * g;
            const float* n0 = p.state_n + (size_t)sidx * 64;
            float dacc = 0.f;
#pragma unroll
            for (int u2 = 0; u2 < 2; ++u2) {
                const bf16x4 qa = *(const bf16x4*)(qp2 + u2 * 32), qb = *(const bf16x4*)(qp2 + u2 * 32 + 16);
                const float4 na = *(const float4*)(n0 + u2 * 32 + 4 * g), nb = *(const float4*)(n0 + u2 * 32 + 16 + 4 * g);
                float pv[8];
#pragma unroll
                for (int j = 0; j < 4; ++j) { pv[j] = bf2f((unsigned short)qa[j]) * e; pv[4 + j] = bf2f((unsigned short)qb[j]) * e; }
                dacc += pv[0] * na.x + pv[1] * na.y + pv[2] * na.z + pv[3] * na.w + pv[4] * nb.x + pv[5] * nb.y + pv[6] * nb.z + pv[7] * nb.w;
                const bf16x8 pk = pack8(pv[0], pv[1], pv[2], pv[3], pv[4], pv[5], pv[6], pv[7]);
#pragma unroll
                for (int vb = 0; vb < 4; ++vb) {
                    const bf16_t* cp = c0t + (size_t)vb * 16 * 64 + u2 * 32;
                    const bf16x8 cf = cat4(*(const bf16x4*)(cp), *(const bf16x4*)(cp + 16));
                    if (dir) Ob[vb] = mfma16(cf, pk, Ob[vb]); else Of[vb] = mfma16(cf, pk, Of[vb]);
                }
            }
            if (dir) denb += dacc; else denf += dacc;
        }
    }
    denf = grp_sum(denf); denb = grp_sum(denb);
    const float rf = 1.f / fmaxf(fabsf(denf), expf(-(Ff + Mf)));
    const float rb = 1.f / fmaxf(fabsf(denb), expf(-(Fb + Mb)));
    float ss = 0.f;
#pragma unroll
    for (int vb = 0; vb < 4; ++vb)
#pragma unroll
        for (int i = 0; i < 4; ++i) { const float hs = Of[vb][i] * rf + Ob[vb][i] * rb; Of[vb][i] = hs; ss += hs * hs; }
    ss = grp_sum(ss);
    const float rn = rsqrtf(ss * (1.f / 64.f) + LN_EPS);
    const float* gn = p.mlstm_norm_g + (size_t)(l * 4 + h) * 64;
    const bf16_t* op = P + (size_t)(tok0 + t) * NIN + 3072 + h * 64;
    bf16_t* MIX = (bf16_t*)(ws_ + OFF_MIX) + (size_t)(tok0 + t) * 1024 + 768 + h * 64;
#pragma unroll
    for (int vb = 0; vb < 4; ++vb) {
        const int v = vb * 16 + 4 * g;
        const float4 g4 = *(const float4*)(gn + v);
        const bf16x4 o4 = *(const bf16x4*)(op + v);
        float sg[4];
#pragma unroll
        for (int i = 0; i < 4; ++i) sg[i] = 1.f / (1.f + __expf(-bf2f((unsigned short)o4[i])));
        uint2 o; o.x = pack2(Of[vb][0] * rn * g4.x * sg[0], Of[vb][1] * rn * g4.y * sg[1]);
        o.y = pack2(Of[vb][2] * rn * g4.z * sg[2], Of[vb][3] * rn * g4.w * sg[3]);
        *(uint2*)(MIX + v) = o;
    }
}

DI void item_mlstm_state(const Params& pin, int l, int b, int h, int dir, unsigned char* smem, int wave, int lane) {
    const Params& p = pin; unsigned char* const ws_ = opaque_ws(pin.ws); float* const out_ = opaque_out(pin.out); lane = opaque_v(lane);
    const int lr = lane & 15, g = lane >> 4;
    const int tok0 = b * 256;
    float* aA = (float*)smem; float* MA = aA + 1024; float* FA = MA + 1024;
    const float* G = (const float*)(ws_ + OFF_G) + (size_t)tok0 * 16;
    __syncthreads();
    if (wave == 0) mlstm_scan(G, h, 256, dir, aA, MA, FA, 0.f, lane);
    __syncthreads();
    const float Mfin = dir ? MA[0] : MA[255];
    const float Ffin = dir ? FA[0] : FA[255];
    const bf16_t* KT = (const bf16_t*)(ws_ + OFF_PT_CK) + (size_t)tok0 * 256 + (size_t)(h * 64 + wave * 16 + lr) * 256 + 8 * g;
    const bf16_t* VT = (const bf16_t*)(ws_ + OFF_PT_CV) + (size_t)tok0 * 256 + (size_t)(h * 64 + lr) * 256 + 8 * g;
    f32x4 C[4];
#pragma unroll
    for (int vb = 0; vb < 4; ++vb) C[vb] = (f32x4){0.f, 0.f, 0.f, 0.f};
    float nacc = 0.f;
    for (int u = 0; u < 8; ++u) {
        const int s0 = u * 32;
        const bf16x8 kf = *(const bf16x8*)(KT + s0);
        const float4 a0 = *(const float4*)(aA + s0 + 8 * g), a1 = *(const float4*)(aA + s0 + 8 * g + 4);
        const float av[8] = {a0.x, a0.y, a0.z, a0.w, a1.x, a1.y, a1.z, a1.w};
        float kw[8];
#pragma unroll
        for (int j = 0; j < 8; ++j) { kw[j] = bf2f((unsigned short)kf[j]) * fexp2((av[j] - Mfin) * LOG2E); nacc += kw[j]; }
        const bf16x8 af = pack8(kw[0], kw[1], kw[2], kw[3], kw[4], kw[5], kw[6], kw[7]);
#pragma unroll
        for (int vb = 0; vb < 4; ++vb) {
            const bf16x8 vf = *(const bf16x8*)(VT + (size_t)vb * 16 * 256 + s0);
            C[vb] = mfma16(af, vf, C[vb]);
        }
    }
    const size_t sidx = (size_t)((b * 4 + l) * 2 + dir) * 4 + h;
    float* oc = out_ + O_NC + sidx * 4096;
#pragma unroll
    for (int vb = 0; vb < 4; ++vb)
#pragma unroll
        for (int i = 0; i < 4; ++i) oc[(wave * 16 + 4 * g + i) * 64 + vb * 16 + lr] = C[vb][i];
    nacc = grp_sum(nacc);
    if (g == 0) out_[O_NN + sidx * 64 + wave * 16 + lr] = nacc;
    if (wave == 0 && lane == 0) out_[O_NM + sidx] = Ffin + Mfin;
}

DI void mixer_phase(const Params& p, int l, unsigned char* smem) {
    const int tid_ = opaque_v(threadIdx.x); const int lane = tid_ & 63, wave = tid_ >> 6;
    for (int it = blockIdx.x; it < 1280; it += gridDim.x) {
        if (it < 128) { if (IM & 1) item_diffattn<true>(p, l, it >> 6, (it >> 4) & 3, it & 15, wave, lane); }
        else if (it < 256) { const int i = it - 128; if (IM & 2) item_mlstm<true>(p, l, i >> 6, (i >> 4) & 3, i & 15, smem, wave, lane); }
        else if (it < 384) { const int i = it - 256; if (IM & 4) item_na(p, l, i >> 6, (i >> 4) & 3, i & 15, wave, lane); }
        else if (it < 640) { const int i = it - 384; if (IM & 8) item_diffattn<false>(p, l, i >> 4, (i >> 2) & 3, i & 3, wave, lane); }
        else if (it < 896) { const int i = it - 640; if (IM & 16) item_mlstm<false>(p, l, i >> 4, (i >> 2) & 3, i & 3, smem, wave, lane); }
        else if (it < 1152) { const int i = it - 896; if (IM & 32) item_dense(p, i >> 4, (i >> 2) & 3, i & 3, wave, lane); }
        else { const int i = it - 1152; if (IM & 64) item_mlstm_state(p, l, i >> 3, (i >> 1) & 3, i & 1, smem, wave, lane); }
    }
}

constexpr int N_PHASES = 2 + 7 * 4;

__global__ void __launch_bounds__(256, 2) fwd_kernel(Params p) {
    __shared__ __attribute__((aligned(16))) unsigned char smem[66560];
    for (int ph = p.ph_lo; ph < p.ph_hi; ++ph) {
        if (ph > p.ph_lo) cg::this_grid().sync();
        if (ph == 0) { if (PHM & 1) prep0(p, smem); }
        else if (ph == 1) { if (PHM & 2) prep1(p); }
        else {
            const int l = (ph - 2) / 7, s = (ph - 2) % 7;
            if (s == 0) { if (PHM & 4) gemm_phase<EPI_INPROJ>(p, l, OFF_H, OFF_WT_IN + (size_t)l * NINP * DM * 2, NINP / 128, 1024, 0, smem); }
            else if (s == 1) { if (PHM & 8) mixer_phase(p, l, smem); }
            else if (s == 2 && (PHM & 16)) gemm_phase<EPI_Y>(p, l, OFF_MIX, OFF_WT_OUT + (size_t)l * DM * DM * 2, 8, 1024, 1024, smem);
            else if (s == 3 && (PHM & 32)) ln_phase<1>(p, l);
            else if (s == 4 && (PHM & 64)) gemm_phase<EPI_RELU2>(p, l, OFF_H, OFF_WT_1 + (size_t)l * DFF * DM * 2, 32, 1024, 4096, smem);
            else if (s == 5 && (PHM & 128)) gemm_phase<EPI_Y>(p, l, OFF_U, OFF_WT_2 + (size_t)l * DM * DFF * 2, 8, 4096, 1024, smem);
            else if (s == 6 && (PHM & 256)) ln_phase<2>(p, l);
        }
    }
}

extern "C" void kernel_launch(void* const* d_in, const int* in_sizes, int n_in, void* d_out, int out_size, void* d_ws, size_t ws_size,
                              hipStream_t stream) {
    static int grid = 0;
    if (grid == 0) {
        if (n_in != 26 || ws_size < WS_END) { fprintf(stderr, "kernel_launch: unexpected n_in %d / ws %zu (need %zu)\n", n_in, ws_size, (size_t)WS_END); grid = -1; return; }
        int dev = 0, cus = 0, per_cu = 0;
        hipGetDevice(&dev);
        hipDeviceGetAttribute(&cus, hipDeviceAttributeMultiprocessorCount, dev);
        hipOccupancyMaxActiveBlocksPerMultiprocessor(&per_cu, (const void*)fwd_kernel, 256, 0);
        if (per_cu < 1) per_cu = 1;
        if (per_cu > 2) per_cu = 2;
        grid = cus * per_cu;
    }
    if (grid < 0) return;
    Params p{};
    const float** pp = (const float**)&p;
    for (int i = 0; i < 26; ++i) pp[i] = (const float*)d_in[i];
    p.out = (float*)d_out; p.ws = (unsigned char*)d_ws;
#if SINGLE_LAUNCH
    p.ph_lo = 0; p.ph_hi = N_PHASES;
    void* args[] = {&p};
    hipError_t e = hipLaunchCooperativeKernel((const void*)fwd_kernel, dim3(grid), dim3(256), args, 0, stream);
    if (e != hipSuccess) fprintf(stderr, "cooperative launch failed: %s (grid %d)\n", hipGetErrorString(e), grid);
#else
    for (int ph = 0; ph < N_PHASES; ++ph) {
        p.ph_lo = ph; p.ph_hi = ph + 1;
        void* args[] = {&p};
        hipError_t e = hipLaunchCooperativeKernel((const void*)fwd_kernel, dim3(grid), dim3(256), args, 0, stream);
        if (e != hipSuccess) { fprintf(stderr, "launch %d failed: %s (grid %d)\n", ph, hipGetErrorString(e), grid); break; }
    }
#endif
}
```

```cpp
#include <hip/hip_runtime.h>
#include <hip/hip_cooperative_groups.h>
#include <cstdio>
namespace cg = cooperative_groups;

#ifndef IM
#define IM 0xffff
#endif
#ifndef DUPM
#define DUPM 0
#endif
#ifndef PHM
#define PHM 0xffff
#endif
#ifndef SINGLE_LAUNCH
#define SINGLE_LAUNCH 1
#endif

#define LAS __attribute__((address_space(3)))
typedef unsigned short bf16_t;
typedef __attribute__((ext_vector_type(8))) short bf16x8;
typedef __attribute__((ext_vector_type(4))) short bf16x4;
typedef __attribute__((ext_vector_type(4))) float f32x4;
#define DI __device__ __forceinline__

constexpr int NTOK = 6144, NCTX = 4096, DM = 1024, NIN = 3344, NINP = 3456, DFF = 4096;
constexpr float ALPHA = 1.681792830507429f;
constexpr float LOG2E = 1.4426950408889634f;
constexpr float LN_EPS = 1e-5f;

constexpr size_t al256(size_t x) { return (x + 255) & ~(size_t)255; }
constexpr size_t OFF_WT_IN = 0;
constexpr size_t OFF_WT_OUT = OFF_WT_IN + al256((size_t)4 * NINP * DM * 2);
constexpr size_t OFF_WT_1 = OFF_WT_OUT + al256((size_t)4 * DM * DM * 2);
constexpr size_t OFF_WT_2 = OFF_WT_1 + al256((size_t)4 * DFF * DM * 2);
constexpr size_t OFF_MOD = OFF_WT_2 + al256((size_t)4 * DFF * DM * 2);
constexpr size_t OFF_X = OFF_MOD + al256((size_t)4 * 3 * 6144 * 4);
constexpr size_t OFF_H = OFF_X + al256((size_t)NTOK * DM * 4);
constexpr size_t OFF_P = OFF_H + al256((size_t)NTOK * DM * 2);
constexpr size_t OFF_PT_AV = OFF_P + al256((size_t)NTOK * NIN * 2);
constexpr size_t OFF_PT_BV = OFF_PT_AV + al256((size_t)NTOK * 512 * 2);
constexpr size_t OFF_PT_CV = OFF_PT_BV + al256((size_t)NTOK * 256 * 2);
constexpr size_t OFF_PT_CK = OFF_PT_CV + al256((size_t)NTOK * 256 * 2);
constexpr size_t OFF_G = OFF_PT_CK + al256((size_t)NTOK * 256 * 2);
constexpr size_t OFF_MIX = OFF_G + al256((size_t)NTOK * 16 * 4);
constexpr size_t OFF_Y = OFF_MIX + al256((size_t)NTOK * DM * 2);
constexpr size_t OFF_U = OFF_Y + al256((size_t)NTOK * DM * 4);
constexpr size_t OFF_CAK = OFF_U + al256((size_t)NTOK * DFF * 2);
constexpr size_t OFF_CAVT = OFF_CAK + al256((size_t)32 * 512 * 128 * 2);
constexpr size_t OFF_CBK = OFF_CAVT + al256((size_t)32 * 512 * 128 * 2);
constexpr size_t OFF_CBVT = OFF_CBK + al256((size_t)32 * 512 * 64 * 2);
constexpr size_t OFF_C0T = OFF_CBVT + al256((size_t)32 * 512 * 64 * 2);
constexpr size_t OFF_ROPE = OFF_C0T + al256((size_t)64 * 64 * 64 * 2);
constexpr size_t OFF_LAM = OFF_ROPE + al256((size_t)2 * 1024 * 4);
constexpr size_t OFF_BAR = OFF_LAM + 256;
constexpr size_t WS_END = OFF_BAR + 16384;

constexpr size_t O_YP = 0, O_YS = 4194304, O_AK = 6291456, O_AV = 14680064, O_BK = 23068672, O_BV = 27262976,
                 O_NC = 31457280, O_NN = 33554432, O_NM = 33587200;

struct Params {
    const float* x_prompt; const float* x_sample; const float* cache_a_k; const float* cache_a_v;
    const float* cache_b_k; const float* cache_b_v; const float* state_c; const float* state_n;
    const float* state_m; const float* c; const float* c_ctx; const float* w_in; const float* gate_bias;
    const float* diff_lambda; const float* diff_norm_g; const float* nat_rpb; const float* mlstm_norm_g;
    const float* w_out; const float* ada_w; const float* ada_b; const float* ln1_g; const float* ln1_b;
    const float* ln2_g; const float* ln2_b; const float* w_mlp1; const float* w_mlp2;
    float* out; unsigned char* ws; int ph_lo; int ph_hi;
};

DI int opaque_v(int x) { asm volatile("" : "+v"(x)); return x; }
DI size_t opaque_zero() { size_t z = 0; asm volatile("" : "+s"(z)); return z; }
DI unsigned char* opaque_ws(unsigned char* w) { return w + opaque_zero(); }
DI float* opaque_out(float* w) { return w + opaque_zero(); }
DI unsigned short f2bf(float x) { unsigned u = __float_as_uint(x); u += 0x7fffu + ((u >> 16) & 1u); return (unsigned short)(u >> 16); }
DI float bf2f(unsigned short h) { return __uint_as_float(((unsigned)h) << 16); }
DI unsigned pack2(float a, float b) { return (unsigned)f2bf(a) | ((unsigned)f2bf(b) << 16); }
DI f32x4 mfma16(bf16x8 a, bf16x8 b, f32x4 c) { return __builtin_amdgcn_mfma_f32_16x16x32_bf16(a, b, c, 0, 0, 0); }
DI float fexp2(float x) { return __builtin_amdgcn_exp2f(x); }
DI bf16x8 pack8(float a0, float a1, float a2, float a3, float a4, float a5, float a6, float a7) {
    uint4 u; u.x = pack2(a0, a1); u.y = pack2(a2, a3); u.z = pack2(a4, a5); u.w = pack2(a6, a7);
    return __builtin_bit_cast(bf16x8, u);
}
DI bf16x8 cat4(bf16x4 a, bf16x4 b) { return __builtin_shufflevector(a, b, 0, 1, 2, 3, 4, 5, 6, 7); }
DI float wave_sum(float v) {
#pragma unroll
    for (int o = 32; o > 0; o >>= 1) v += __shfl_xor(v, o);
    return v;
}
DI float grp_sum(float v) { v += __shfl_xor(v, 16); v += __shfl_xor(v, 32); return v; }
DI float grp_max(float v) { v = fmaxf(v, __shfl_xor(v, 16)); v = fmaxf(v, __shfl_xor(v, 32)); return v; }

DI void transpose_job(const float* __restrict__ src, bf16_t* __restrict__ dst, int R, int C, int Cpad, int nmat, float* tile) {
    const int tid = threadIdx.x;
    const int rt = R >> 6, ct = Cpad >> 6, per = rt * ct, total = per * nmat;
    for (int it = blockIdx.x; it < total; it += gridDim.x) {
        const int mat = it / per, rem = it - mat * per;
        const int r0 = (rem / ct) << 6, c0 = (rem % ct) << 6;
        const float* s = src + (size_t)mat * R * C;
        bf16_t* d = dst + (size_t)mat * Cpad * R;
#pragma unroll
        for (int i = 0; i < 4; ++i) {
            const int r = (tid >> 4) + 16 * i, c = (tid & 15) * 4;
            float4 v = make_float4(0.f, 0.f, 0.f, 0.f);
            if (c0 + c < C) v = *(const float4*)(s + (size_t)(r0 + r) * C + c0 + c);
            tile[r * 65 + c + 0] = v.x; tile[r * 65 + c + 1] = v.y; tile[r * 65 + c + 2] = v.z; tile[r * 65 + c + 3] = v.w;
        }
        __syncthreads();
        {
            const int c = tid >> 2, rs = (tid & 3) * 16;
            uint4 o0, o1;
            o0.x = pack2(tile[(rs + 0) * 65 + c], tile[(rs + 1) * 65 + c]);
            o0.y = pack2(tile[(rs + 2) * 65 + c], tile[(rs + 3) * 65 + c]);
            o0.z = pack2(tile[(rs + 4) * 65 + c], tile[(rs + 5) * 65 + c]);
            o0.w = pack2(tile[(rs + 6) * 65 + c], tile[(rs + 7) * 65 + c]);
            o1.x = pack2(tile[(rs + 8) * 65 + c], tile[(rs + 9) * 65 + c]);
            o1.y = pack2(tile[(rs + 10) * 65 + c], tile[(rs + 11) * 65 + c]);
            o1.z = pack2(tile[(rs + 12) * 65 + c], tile[(rs + 13) * 65 + c]);
            o1.w = pack2(tile[(rs + 14) * 65 + c], tile[(rs + 15) * 65 + c]);
            uint4* dp = (uint4*)(d + (size_t)(c0 + c) * R + r0 + rs);
            dp[0] = o0; dp[1] = o1;
        }
        __syncthreads();
    }
}

DI void convert_job(const float* __restrict__ src, bf16_t* __restrict__ dst, size_t n) {
    for (size_t i = ((size_t)blockIdx.x * 256 + threadIdx.x) * 8; i < n; i += (size_t)gridDim.x * 256 * 8) {
        const float4 a = *(const float4*)(src + i), b = *(const float4*)(src + i + 4);
        uint4 o; o.x = pack2(a.x, a.y); o.y = pack2(a.z, a.w); o.z = pack2(b.x, b.y); o.w = pack2(b.z, b.w);
        *(uint4*)(dst + i) = o;
    }
}

DI void prep0(const Params& pin, unsigned char* smem) {
    const Params& p = pin; unsigned char* const ws_ = opaque_ws(pin.ws); float* const out_ = opaque_out(pin.out); const int tid = opaque_v(threadIdx.x);
    {
        float* sl = (float*)smem; float* red = (float*)(smem + 12288);
        for (int i = tid; i < 3072; i += 256) {
            const int cnd = i >> 10, k = i & 1023;
            const float v = (cnd == 0) ? p.c_ctx[k] : p.c[(cnd - 1) * 1024 + k];
            sl[i] = v / (1.f + __expf(-v));
        }
        __syncthreads();
        float* mod = (float*)(ws_ + OFF_MOD);
        const int kg = tid >> 4, cl = tid & 15;
        for (int it = blockIdx.x; it < 384; it += gridDim.x) {
            const int l = it / 96, j0 = (it % 96) * 64;
            const float* w = p.ada_w + (size_t)l * 1024 * 6144 + j0 + cl * 4;
            float4 a0 = make_float4(0, 0, 0, 0), a1 = a0, a2 = a0;
#pragma unroll 8
            for (int kk = 0; kk < 64; ++kk) {
                const int k = kg * 64 + kk;
                const float4 wv = *(const float4*)(w + (size_t)k * 6144);
                const float s0 = sl[k], s1 = sl[1024 + k], s2 = sl[2048 + k];
                a0.x += s0 * wv.x; a0.y += s0 * wv.y; a0.z += s0 * wv.z; a0.w += s0 * wv.w;
                a1.x += s1 * wv.x; a1.y += s1 * wv.y; a1.z += s1 * wv.z; a1.w += s1 * wv.w;
                a2.x += s2 * wv.x; a2.y += s2 * wv.y; a2.z += s2 * wv.z; a2.w += s2 * wv.w;
            }
            __syncthreads();
            float* r = red + kg * 192 + cl * 4;
            r[0] = a0.x; r[1] = a0.y; r[2] = a0.z; r[3] = a0.w;
            r[64] = a1.x; r[65] = a1.y; r[66] = a1.z; r[67] = a1.w;
            r[128] = a2.x; r[129] = a2.y; r[130] = a2.z; r[131] = a2.w;
            __syncthreads();
            if (tid < 192) {
                const int cnd = tid >> 6, col = tid & 63;
                float s = 0.f;
#pragma unroll
                for (int q = 0; q < 16; ++q) s += red[q * 192 + tid];
                mod[(l * 3 + cnd) * 6144 + j0 + col] = s + p.ada_b[l * 6144 + j0 + col];
            }
        }
        __syncthreads();
    }
    if (blockIdx.x == gridDim.x - 1) {
        float* rope = (float*)(ws_ + OFF_ROPE);
        for (int i = tid; i < 1024; i += 256) {
            const int pos = i >> 4, j = i & 15;
            const float freq = powf(10000.f, -(float)j / 16.f);
            float s, c; sincosf((float)pos * freq, &s, &c);
            rope[i] = c; rope[1024 + i] = s;
        }
        if (tid < 4) {
            const float* lp = p.diff_lambda + tid * 256;
            float s1 = 0.f, s2 = 0.f;
            for (int i = 0; i < 64; ++i) { s1 += lp[i] * lp[64 + i]; s2 += lp[128 + i] * lp[192 + i]; }
            const float li = 0.8f - 0.6f * expf(-0.3f * (float)tid);
            float* lam = (float*)(ws_ + OFF_LAM);
            lam[tid * 2] = expf(s1) - expf(s2) + li; lam[tid * 2 + 1] = li;
        }
    }
    float* tile = (float*)smem;
    transpose_job(p.w_in, (bf16_t*)(ws_ + OFF_WT_IN), 1024, NIN, NINP, 4, tile);
    transpose_job(p.w_out, (bf16_t*)(ws_ + OFF_WT_OUT), 1024, 1024, 1024, 4, tile);
    transpose_job(p.w_mlp1, (bf16_t*)(ws_ + OFF_WT_1), 1024, 4096, 4096, 4, tile);
    transpose_job(p.w_mlp2, (bf16_t*)(ws_ + OFF_WT_2), 4096, 1024, 1024, 4, tile);
    transpose_job(p.cache_a_v, (bf16_t*)(ws_ + OFF_CAVT), 512, 128, 128, 32, tile);
    transpose_job(p.cache_b_v, (bf16_t*)(ws_ + OFF_CBVT), 512, 64, 64, 32, tile);
    transpose_job(p.state_c, (bf16_t*)(ws_ + OFF_C0T), 64, 64, 64, 64, tile);
    convert_job(p.cache_a_k, (bf16_t*)(ws_ + OFF_CAK), (size_t)32 * 512 * 128);
    convert_job(p.cache_b_k, (bf16_t*)(ws_ + OFF_CBK), (size_t)32 * 512 * 64);
}

DI void prep1(const Params& pin) {
    const Params& p = pin; unsigned char* const ws_ = opaque_ws(pin.ws); float* const out_ = opaque_out(pin.out); const int tid_ = opaque_v(threadIdx.x); const int lane = tid_ & 63, wave = tid_ >> 6;
    const float* mod = (const float*)(ws_ + OFF_MOD);
    float* X = (float*)(ws_ + OFF_X);
    bf16_t* H = (bf16_t*)(ws_ + OFF_H);
    for (int row = blockIdx.x * 4 + wave; row < NTOK; row += gridDim.x * 4) {
        const float* src = row < NCTX ? p.x_prompt + (size_t)row * 1024 : p.x_sample + (size_t)(row - NCTX) * 1024;
        const int cnd = row < NCTX ? 0 : 1 + ((row - NCTX) >> 10);
        const float* md = mod + (size_t)cnd * 6144;
#pragma unroll
        for (int j = 0; j < 4; ++j) {
            const int c = lane * 4 + 256 * j;
            const float4 v = *(const float4*)(src + c);
            *(float4*)(X + (size_t)row * 1024 + c) = v;
            const float4 sh = *(const float4*)(md + c), sc = *(const float4*)(md + 1024 + c);
            uint2 o; o.x = pack2(v.x * (1.f + sc.x) + sh.x, v.y * (1.f + sc.y) + sh.y);
            o.y = pack2(v.z * (1.f + sc.z) + sh.z, v.w * (1.f + sc.w) + sh.w);
            *(uint2*)(H + (size_t)row * 1024 + c) = o;
        }
    }
}

template <int WHICH>
DI void ln_phase(const Params& pin, int l) {
    const Params& p = pin; unsigned char* const ws_ = opaque_ws(pin.ws); float* const out_ = opaque_out(pin.out); const int tid_ = opaque_v(threadIdx.x); const int lane = tid_ & 63, wave = tid_ >> 6;
    const float* mod = (const float*)(ws_ + OFF_MOD);
    float* X = (float*)(ws_ + OFF_X);
    const float* Y = (const float*)(ws_ + OFF_Y);
    bf16_t* H = (bf16_t*)(ws_ + OFF_H);
    const float* lg = (WHICH == 1 ? p.ln1_g : p.ln2_g) + l * 1024;
    const float* lb = (WHICH == 1 ? p.ln1_b : p.ln2_b) + l * 1024;
    const bool last = (WHICH == 2 && l == 3);
    for (int row = blockIdx.x * 4 + wave; row < NTOK; row += gridDim.x * 4) {
        const int cnd = row < NCTX ? 0 : 1 + ((row - NCTX) >> 10);
        const float* md = mod + (size_t)(l * 3 + cnd) * 6144;
        const float* gate = md + (WHICH == 1 ? 2048 : 5120);
        float4 v[4];
        float s = 0.f;
#pragma unroll
        for (int j = 0; j < 4; ++j) {
            const int c = lane * 4 + 256 * j;
            const float4 xv = *(const float4*)(X + (size_t)row * 1024 + c);
            const float4 yv = *(const float4*)(Y + (size_t)row * 1024 + c);
            const float4 gv = *(const float4*)(gate + c);
            v[j].x = ALPHA * xv.x + gv.x * yv.x; v[j].y = ALPHA * xv.y + gv.y * yv.y;
            v[j].z = ALPHA * xv.z + gv.z * yv.z; v[j].w = ALPHA * xv.w + gv.w * yv.w;
            s += v[j].x + v[j].y + v[j].z + v[j].w;
        }
        const float mu = wave_sum(s) * (1.f / 1024.f);
        float q = 0.f;
#pragma unroll
        for (int j = 0; j < 4; ++j) {
            v[j].x -= mu; v[j].y -= mu; v[j].z -= mu; v[j].w -= mu;
            q += v[j].x * v[j].x + v[j].y * v[j].y + v[j].z * v[j].z + v[j].w * v[j].w;
        }
        const float rstd = rsqrtf(wave_sum(q) * (1.f / 1024.f) + LN_EPS);
        const float* nmd = (WHICH == 1) ? md : mod + (size_t)((l + 1) * 3 + cnd) * 6144;
        const float* shp = nmd + (WHICH == 1 ? 3072 : 0);
        const float* scp = nmd + (WHICH == 1 ? 4096 : 1024);
#pragma unroll
        for (int j = 0; j < 4; ++j) {
            const int c = lane * 4 + 256 * j;
            const float4 g4 = *(const float4*)(lg + c), b4 = *(const float4*)(lb + c);
            float4 o;
            o.x = v[j].x * rstd * g4.x + b4.x; o.y = v[j].y * rstd * g4.y + b4.y;
            o.z = v[j].z * rstd * g4.z + b4.z; o.w = v[j].w * rstd * g4.w + b4.w;
            if (last) {
                *(float4*)(out_ + (size_t)row * 1024 + c) = o;
            } else {
                *(float4*)(X + (size_t)row * 1024 + c) = o;
                const float4 sh = *(const float4*)(shp + c), sc = *(const float4*)(scp + c);
                uint2 h; h.x = pack2(o.x * (1.f + sc.x) + sh.x, o.y * (1.f + sc.y) + sh.y);
                h.y = pack2(o.z * (1.f + sc.z) + sh.z, o.w * (1.f + sc.w) + sh.w);
                *(uint2*)(H + (size_t)row * 1024 + c) = h;
            }
        }
    }
}

enum { EPI_INPROJ = 0, EPI_Y = 1, EPI_RELU2 = 2 };

DI void epi_inproj(const Params& p, unsigned char* ws_, float* out_, int layer, const float* T, int rowbase, int colbase, int lane) {
    if (colbase >= NIN) return;
    bf16_t* P = (bf16_t*)(ws_ + OFF_P);
    const bool latent = rowbase >= NCTX;
    const int seq_tok0 = latent ? (NCTX + ((rowbase - NCTX) & ~1023)) : (rowbase & ~255);
    const int nseq = latent ? 1024 : 256;
    const int bctx = seq_tok0 >> 8;
    const int n0 = rowbase - seq_tok0;
    if (colbase >= 3328) {
        float* G = (float*)(ws_ + OFF_G);
        const float bias = p.gate_bias[layer * 16 + (lane & 15)];
        for (int rr = 0; rr < 16; ++rr) {
            const int r = rr * 4 + (lane >> 4);
            G[(size_t)(rowbase + r) * 16 + (lane & 15)] = T[r * 65 + (lane & 15)] + bias;
        }
        return;
    }
    bool toP = false, rope = false, toT = false, toO = false;
    size_t toff = 0, obase = 0; int tW = 0, tcr = 0, ohd = 64, ocr = 0;
    if (colbase < 1024) { toP = true; rope = latent; if (colbase >= 512) { toO = !latent; obase = O_AK; ohd = 128; ocr = colbase - 512; } }
    else if (colbase < 1536) { toT = true; toff = OFF_PT_AV; tW = 512; tcr = colbase - 1024; toO = !latent; obase = O_AV; ohd = 128; ocr = tcr; }
    else if (colbase < 1792) { toP = true; }
    else if (colbase < 2048) { toP = true; toO = !latent; obase = O_BK; ohd = 64; ocr = colbase - 1792; }
    else if (colbase < 2304) { toT = true; toff = OFF_PT_BV; tW = 256; tcr = colbase - 2048; toO = !latent; obase = O_BV; ohd = 64; ocr = tcr; }
    else if (colbase < 2560) { toP = true; }
    else if (colbase < 2816) { toP = true; toT = true; toff = OFF_PT_CK; tW = 256; tcr = colbase - 2560; }
    else if (colbase < 3072) { toT = true; toff = OFF_PT_CV; tW = 256; tcr = colbase - 2816; }
    else { toP = true; }
    if (toO) {
        const int h = ocr / ohd, w = ocr - h * ohd + lane;
        float* O = out_ + obase + (((size_t)(bctx * 4 + layer) * 4 + h) * 256 + n0) * ohd + w;
#pragma unroll 4
        for (int r = 0; r < 64; ++r) O[(size_t)r * ohd] = T[r * 65 + lane];
    }
    if (toP) {
        bf16_t* Pp = P + (size_t)rowbase * NIN + colbase + lane;
        if (rope) {
            const float* rc = (const float*)(ws_ + OFF_ROPE);
            const float* rs = rc + 1024;
#pragma unroll 4
            for (int r = 0; r < 64; ++r) {
                const float v = T[r * 65 + lane], vp = T[r * 65 + (lane ^ 16)];
                const int t = n0 + r;
                const int pos = (lane < 32) ? (t >> 6) : (t & 63);
                const float c = rc[pos * 16 + (lane & 15)], sn = rs[pos * 16 + (lane & 15)];
                const float o = (lane & 16) ? (vp * sn + v * c) : (v * c - vp * sn);
                Pp[(size_t)r * NIN] = f2bf(o);
            }
        } else {
#pragma unroll 4
            for (int r = 0; r < 64; ++r) Pp[(size_t)r * NIN] = f2bf(T[r * 65 + lane]);
        }
    }
    if (toT) {
        bf16_t* Tp = (bf16_t*)(ws_ + toff) + (size_t)seq_tok0 * tW + (size_t)tcr * nseq + n0 + lane;
#pragma unroll 4
        for (int c = 0; c < 64; ++c) Tp[(size_t)c * nseq] = f2bf(T[lane * 65 + c]);
    }
}

template <int EPI>
DI void gemm_phase(const Params& pin, int layer, size_t offA, size_t offB, int ntn, int K, int ldc,
                   unsigned char* smem) {
    const Params& p = pin; unsigned char* const ws_ = opaque_ws(pin.ws); float* const out_ = opaque_out(pin.out); const int tid = opaque_v(threadIdx.x), lane = tid & 63, wave = tid >> 6;
    const bf16_t* __restrict__ A = (const bf16_t*)(ws_ + offA); const bf16_t* __restrict__ Bt = (const bf16_t*)(ws_ + offB);
    const int wm = wave >> 1, wn = wave & 1;
    const int lr = lane & 15, g = lane >> 4;
    const int ntm = NTOK / 128;
    const int ntiles = ntm * ntn, nk = K >> 6;
    for (int tile = blockIdx.x; tile < ntiles; tile += gridDim.x) {
        const int tm = tile % ntm, tn = tile / ntm;
        const int m0 = tm * 128, n0 = tn * 128;
        f32x4 acc[4][4];
#pragma unroll
        for (int mi = 0; mi < 4; ++mi)
#pragma unroll
            for (int ni = 0; ni < 4; ++ni) acc[mi][ni] = (f32x4){0.f, 0.f, 0.f, 0.f};
        const bf16_t* Ag = A + (size_t)m0 * K;
        const bf16_t* Bg = Bt + (size_t)n0 * K;
        const bf16_t* ag = Ag + (size_t)(wave * 32 + (lane >> 3)) * K + (((lane & 7) ^ (lane >> 3)) << 3);
        const bf16_t* bg = Bg + (size_t)(wave * 32 + (lane >> 3)) * K + (((lane & 7) ^ (lane >> 3)) << 3);
#pragma unroll
        for (int j = 0; j < 4; ++j) {
            __builtin_amdgcn_global_load_lds((const unsigned*)(ag + (size_t)j * 8 * K), (LAS unsigned*)(smem + (wave * 4 + j) * 1024), 16, 0, 0);
            __builtin_amdgcn_global_load_lds((const unsigned*)(bg + (size_t)j * 8 * K), (LAS unsigned*)(smem + 16384 + (wave * 4 + j) * 1024), 16, 0, 0);
        }
        asm volatile("s_waitcnt vmcnt(0)" ::: "memory");
        __syncthreads();
        for (int kt = 0; kt < nk; ++kt) {
            const unsigned char* cur = smem + (kt & 1) * 32768;
            unsigned char* nxt = smem + ((kt + 1) & 1) * 32768;
            if (kt + 1 < nk) {
                const int k0 = (kt + 1) << 6;
#pragma unroll
                for (int j = 0; j < 4; ++j) {
                    __builtin_amdgcn_global_load_lds((const unsigned*)(ag + (size_t)j * 8 * K + k0), (LAS unsigned*)(nxt + (wave * 4 + j) * 1024), 16, 0, 0);
                    __builtin_amdgcn_global_load_lds((const unsigned*)(bg + (size_t)j * 8 * K + k0), (LAS unsigned*)(nxt + 16384 + (wave * 4 + j) * 1024), 16, 0, 0);
                }
            }
#pragma unroll
            for (int kk = 0; kk < 2; ++kk) {
                bf16x8 af[4], bfr[4];
#pragma unroll
                for (int mi = 0; mi < 4; ++mi) {
                    const int row = wm * 64 + mi * 16 + lr;
                    af[mi] = *(const bf16x8*)(cur + row * 128 + (((kk * 4 + g) ^ (row & 7)) << 4));
                }
#pragma unroll
                for (int ni = 0; ni < 4; ++ni) {
                    const int row = wn * 64 + ni * 16 + lr;
                    bfr[ni] = *(const bf16x8*)(cur + 16384 + row * 128 + (((kk * 4 + g) ^ (row & 7)) << 4));
                }
#pragma unroll
                for (int mi = 0; mi < 4; ++mi)
#pragma unroll
                    for (int ni = 0; ni < 4; ++ni) acc[mi][ni] = mfma16(af[mi], bfr[ni], acc[mi][ni]);
            }
            asm volatile("s_waitcnt vmcnt(0)" ::: "memory");
            __syncthreads();
        }
        float* T = (float*)smem + wave * (64 * 65);
#pragma unroll
        for (int mi = 0; mi < 4; ++mi)
#pragma unroll
            for (int ni = 0; ni < 4; ++ni)
#pragma unroll
                for (int i = 0; i < 4; ++i) T[(mi * 16 + 4 * g + i) * 65 + ni * 16 + lr] = acc[mi][ni][i];
        const int rowbase = m0 + wm * 64, colbase = n0 + wn * 64;
        if (EPI == EPI_INPROJ) {
            epi_inproj(p, ws_, out_, layer, T, rowbase, colbase, lane);
        } else if (EPI == EPI_Y) {
            float* Y = (float*)(ws_ + OFF_Y) + (size_t)rowbase * ldc + colbase + lane;
#pragma unroll 4
            for (int r = 0; r < 64; ++r) Y[(size_t)r * ldc] = T[r * 65 + lane];
        } else {
            bf16_t* U = (bf16_t*)(ws_ + OFF_U) + (size_t)rowbase * ldc + colbase + lane;
#pragma unroll 4
            for (int r = 0; r < 64; ++r) { const float v = fmaxf(T[r * 65 + lane], 0.f); U[(size_t)r * ldc] = f2bf(v * v); }
        }
        __syncthreads();
    }
}

template <int NMAP, int DV>
struct AttnSt { f32x4 O[NMAP][DV / 16]; float m[NMAP]; float l[NMAP]; };
template <int NMAP, int DV>
struct UnitFrags { bf16x8 k[NMAP][2][2]; bf16x4 v[DV / 16][2]; };

template <int NMAP, int DV>
DI void load_k(UnitFrags<NMAP, DV>& f, const bf16_t* kp, int kstride) {
#pragma unroll
    for (int m = 0; m < NMAP; ++m)
#pragma unroll
        for (int b = 0; b < 2; ++b)
#pragma unroll
            for (int kk = 0; kk < 2; ++kk) f.k[m][b][kk] = *(const bf16x8*)(kp + (size_t)b * 16 * kstride + m * 64 + kk * 32);
}
template <int NMAP, int DV>
DI void load_v(UnitFrags<NMAP, DV>& f, const bf16_t* vp, int vstride) {
#pragma unroll
    for (int vb = 0; vb < DV / 16; ++vb) {
        f.v[vb][0] = *(const bf16x4*)(vp + (size_t)vb * 16 * vstride);
        f.v[vb][1] = *(const bf16x4*)(vp + (size_t)vb * 16 * vstride + 16);
    }
}
template <int NMAP, int DV>
DI void load_unit(UnitFrags<NMAP, DV>& f, const bf16_t* kp, int kstride, const bf16_t* vp, int vstride) {
    load_k<NMAP, DV>(f, kp, kstride);
    load_v<NMAP, DV>(f, vp, vstride);
}

template <int NMAP, int DV, bool HASBIAS>
DI void compute_unit(AttnSt<NMAP, DV>& st, const UnitFrags<NMAP, DV>& f, const bf16x8 (&qf)[NMAP][2], float sc, const float (&bias)[8]) {
    bf16x8 pk[NMAP];
#pragma unroll
    for (int m = 0; m < NMAP; ++m) {
        f32x4 sa = (f32x4){0.f, 0.f, 0.f, 0.f}, sb = sa;
        sa = mfma16(f.k[m][0][0], qf[m][0], sa); sa = mfma16(f.k[m][0][1], qf[m][1], sa);
        sb = mfma16(f.k[m][1][0], qf[m][0], sb); sb = mfma16(f.k[m][1][1], qf[m][1], sb);
        float s[8];
#pragma unroll
        for (int j = 0; j < 4; ++j) { s[j] = sa[j] * sc; s[4 + j] = sb[j] * sc; }
        if (HASBIAS) {
#pragma unroll
            for (int j = 0; j < 8; ++j) s[j] += bias[j];
        }
        float mx = fmaxf(fmaxf(fmaxf(s[0], s[1]), fmaxf(s[2], s[3])), fmaxf(fmaxf(s[4], s[5]), fmaxf(s[6], s[7])));
        mx = grp_max(mx);
        const float mnew = fmaxf(st.m[m], mx);
        const float alpha = fexp2(st.m[m] - mnew);
        float ps = 0.f;
#pragma unroll
        for (int j = 0; j < 8; ++j) { s[j] = fexp2(s[j] - mnew); ps += s[j]; }
        st.l[m] = st.l[m] * alpha + ps; st.m[m] = mnew;
#pragma unroll
        for (int vb = 0; vb < DV / 16; ++vb) st.O[m][vb] *= alpha;
        pk[m] = pack8(s[0], s[1], s[2], s[3], s[4], s[5], s[6], s[7]);
    }
#pragma unroll
    for (int vb = 0; vb < DV / 16; ++vb) {
        const bf16x8 vf = cat4(f.v[vb][0], f.v[vb][1]);
#pragma unroll
        for (int m = 0; m < NMAP; ++m) st.O[m][vb] = mfma16(vf, pk[m], st.O[m][vb]);
    }
}

template <int NMAP, int DV>
DI void run_segment(AttnSt<NMAP, DV>& st, const bf16x8 (&qf)[NMAP][2], const bf16_t* kp, int kstride, const bf16_t* vp, int vstride,
                    int nunits, float sc) {
    const float nob[8] = {0.f, 0.f, 0.f, 0.f, 0.f, 0.f, 0.f, 0.f};
    if (NMAP == 1) {
        UnitFrags<NMAP, DV> cur;
        load_k<NMAP, DV>(cur, kp, kstride);
        for (int u = 0; u < nunits; ++u) {
            const int un = (u + 1 < nunits) ? u + 1 : u;
            load_v<NMAP, DV>(cur, vp + u * 32, vstride);
            UnitFrags<NMAP, DV> nxt;
            load_k<NMAP, DV>(nxt, kp + (size_t)un * 32 * kstride, kstride);
            compute_unit<NMAP, DV, false>(st, cur, qf, sc, nob);
#pragma unroll
            for (int m = 0; m < NMAP; ++m)
#pragma unroll
                for (int b = 0; b < 2; ++b)
#pragma unroll
                    for (int kk = 0; kk < 2; ++kk) cur.k[m][b][kk] = nxt.k[m][b][kk];
        }
    } else {
        for (int u = 0; u < nunits; ++u) {
            UnitFrags<NMAP, DV> cur;
            load_unit<NMAP, DV>(cur, kp + (size_t)u * 32 * kstride, kstride, vp + u * 32, vstride);
            compute_unit<NMAP, DV, false>(st, cur, qf, sc, nob);
        }
    }
}

template <int NMAP, int DV>
DI void attn_init(AttnSt<NMAP, DV>& st) {
#pragma unroll
    for (int m = 0; m < NMAP; ++m) {
        st.m[m] = -INFINITY; st.l[m] = 0.f;
#pragma unroll
        for (int vb = 0; vb < DV / 16; ++vb) st.O[m][vb] = (f32x4){0.f, 0.f, 0.f, 0.f};
    }
}

template <bool LAT>
DI void item_diffattn(const Params& pin, int l, int seq, int h, int qt, int wave, int lane) {
    const Params& p = pin; unsigned char* const ws_ = opaque_ws(pin.ws); float* const out_ = opaque_out(pin.out); lane = opaque_v(lane);
    const int lr = lane & 15, g = lane >> 4;
    const int nseq = LAT ? 1024 : 256;
    const int tok0 = LAT ? NCTX + seq * 1024 : seq * 256;
    const bf16_t* P = (const bf16_t*)(ws_ + OFF_P);
    const int q0 = qt * 64 + wave * 16;
    bf16x8 qf[2][2];
    {
        const bf16_t* qp = P + (size_t)(tok0 + q0 + lr) * NIN + h * 128 + 8 * g;
#pragma unroll
        for (int m = 0; m < 2; ++m)
#pragma unroll
            for (int kk = 0; kk < 2; ++kk) qf[m][kk] = *(const bf16x8*)(qp + m * 64 + kk * 32);
    }
    AttnSt<2, 128> st;
    attn_init<2, 128>(st);
    const float sc = 0.125f * LOG2E;
    if (LAT) {
        const size_t hb = (size_t)((seq * 4 + l) * 4 + h);
        const bf16_t* kc = (const bf16_t*)(ws_ + OFF_CAK) + hb * 512 * 128 + lr * 128 + 8 * g;
        const bf16_t* vc = (const bf16_t*)(ws_ + OFF_CAVT) + hb * 128 * 512 + lr * 512 + 4 * g;
        run_segment<2, 128>(st, qf, kc, 128, vc, 512, 16, sc);
    }
    {
        const bf16_t* kn = P + (size_t)(tok0 + lr) * NIN + 512 + h * 128 + 8 * g;
        const bf16_t* vn = (const bf16_t*)(ws_ + OFF_PT_AV) + (size_t)tok0 * 512 + (size_t)(h * 128 + lr) * nseq + 4 * g;
        run_segment<2, 128>(st, qf, kn, NIN, vn, nseq, nseq / 32, sc);
    }
    const float inv0 = 1.f / grp_sum(st.l[0]), inv1 = 1.f / grp_sum(st.l[1]);
    const float* lamp = (const float*)(ws_ + OFF_LAM);
    const float lam = lamp[l * 2], lam_init = lamp[l * 2 + 1];
    const float c1 = lam * inv1;
    float ss = 0.f;
#pragma unroll
    for (int vb = 0; vb < 8; ++vb)
#pragma unroll
        for (int i = 0; i < 4; ++i) {
            const float o = st.O[0][vb][i] * inv0 - st.O[1][vb][i] * c1;
            st.O[0][vb][i] = o; ss += o * o;
        }
    ss = grp_sum(ss);
    const float r = rsqrtf(ss * (1.f / 128.f) + LN_EPS) * (1.f - lam_init);
    bf16_t* MIX = (bf16_t*)(ws_ + OFF_MIX) + (size_t)(tok0 + q0 + lr) * 1024 + h * 128;
    const float* gn = p.diff_norm_g + l * 128;
#pragma unroll
    for (int vb = 0; vb < 8; ++vb) {
        const int v = vb * 16 + 4 * g;
        const float4 g4 = *(const float4*)(gn + v);
        uint2 o; o.x = pack2(st.O[0][vb][0] * r * g4.x, st.O[0][vb][1] * r * g4.y);
        o.y = pack2(st.O[0][vb][2] * r * g4.z, st.O[0][vb][3] * r * g4.w);
        *(uint2*)(MIX + v) = o;
    }
}

DI void item_dense(const Params& pin, int seq, int h, int qt, int wave, int lane) {
    const Params& p = pin; unsigned char* const ws_ = opaque_ws(pin.ws); float* const out_ = opaque_out(pin.out); lane = opaque_v(lane);
    const int lr = lane & 15, g = lane >> 4;
    const int tok0 = seq * 256;
    const bf16_t* P = (const bf16_t*)(ws_ + OFF_P);
    const int q0 = qt * 64 + wave * 16;
    bf16x8 qf[1][2];
    {
        const bf16_t* qp = P + (size_t)(tok0 + q0 + lr) * NIN + 1536 + h * 64 + 8 * g;
        qf[0][0] = *(const bf16x8*)(qp); qf[0][1] = *(const bf16x8*)(qp + 32);
    }
    AttnSt<1, 64> st;
    attn_init<1, 64>(st);
    const bf16_t* kn = P + (size_t)(tok0 + lr) * NIN + 1792 + h * 64 + 8 * g;
    const bf16_t* vn = (const bf16_t*)(ws_ + OFF_PT_BV) + (size_t)tok0 * 256 + (size_t)(h * 64 + lr) * 256 + 4 * g;
    run_segment<1, 64>(st, qf, kn, NIN, vn, 256, 8, 0.125f * LOG2E);
    const float inv = 1.f / grp_sum(st.l[0]);
    bf16_t* MIX = (bf16_t*)(ws_ + OFF_MIX) + (size_t)(tok0 + q0 + lr) * 1024 + 512 + h * 64;
#pragma unroll
    for (int vb = 0; vb < 4; ++vb) {
        uint2 o; o.x = pack2(st.O[0][vb][0] * inv, st.O[0][vb][1] * inv); o.y = pack2(st.O[0][vb][2] * inv, st.O[0][vb][3] * inv);
        *(uint2*)(MIX + vb * 16 + 4 * g) = o;
    }
}

DI void item_na(const Params& pin, int l, int sb, int h, int r, int wave, int lane) {
    const Params& p = pin; unsigned char* const ws_ = opaque_ws(pin.ws); float* const out_ = opaque_out(pin.out); lane = opaque_v(lane);
    const int lr = lane & 15, g = lane >> 4;
    const int tok0 = NCTX + sb * 1024;
    const bf16_t* P = (const bf16_t*)(ws_ + OFF_P);
    const int qc = wave * 16 + lr;
    const int q0 = r * 64 + wave * 16;
    bf16x8 qf[1][2];
    {
        const bf16_t* qp = P + (size_t)(tok0 + q0 + lr) * NIN + 1536 + h * 64 + 8 * g;
        qf[0][0] = *(const bf16x8*)(qp); qf[0][1] = *(const bf16x8*)(qp + 32);
    }
    AttnSt<1, 64> st;
    attn_init<1, 64>(st);
    const float sc = 0.125f * LOG2E;
    {
        const size_t hb = (size_t)((sb * 4 + l) * 4 + h);
        const bf16_t* kc = (const bf16_t*)(ws_ + OFF_CBK) + hb * 512 * 64 + lr * 64 + 8 * g;
        const bf16_t* vc = (const bf16_t*)(ws_ + OFF_CBVT) + hb * 64 * 512 + lr * 512 + 4 * g;
        run_segment<1, 64>(st, qf, kc, 64, vc, 512, 16, sc);
    }
    const int kr0 = min(max(r - 4, 0), 8);
    const int bs = min(max(wave * 16 - 8, 0), 32);
    const int wstart = min(max(qc - 8, 0), 48);
    const float* rpb = p.nat_rpb + (size_t)(l * 4 + h) * 15 * 31;
    const bf16_t* vbase = (const bf16_t*)(ws_ + OFF_PT_BV) + (size_t)tok0 * 256 + (size_t)(h * 64 + lr) * 1024 + 4 * g;
    for (int u = 0; u < 8; ++u) {
        const int kr = kr0 + u;
        const int key0 = kr * 64 + bs;
        UnitFrags<1, 64> f;
        load_unit<1, 64>(f, P + (size_t)(tok0 + key0 + lr) * NIN + 1792 + h * 64 + 8 * g, NIN, vbase + key0, 1024);
        float bias[8];
        const float* rrow = rpb + (kr - r + 7) * 31;
#pragma unroll
        for (int j = 0; j < 8; ++j) {
            const int kc = bs + 4 * g + (j & 3) + ((j >> 2) << 4);
            const bool valid = (kc >= wstart) && (kc < wstart + 16);
            const int dc = min(max(kc - qc + 15, 0), 30);
            bias[j] = valid ? rrow[dc] * LOG2E : -INFINITY;
        }
        compute_unit<1, 64, true>(st, f, qf, sc, bias);
    }
    const float inv = 1.f / grp_sum(st.l[0]);
    bf16_t* MIX = (bf16_t*)(ws_ + OFF_MIX) + (size_t)(tok0 + q0 + lr) * 1024 + 512 + h * 64;
#pragma unroll
    for (int vb = 0; vb < 4; ++vb) {
        uint2 o; o.x = pack2(st.O[0][vb][0] * inv, st.O[0][vb][1] * inv); o.y = pack2(st.O[0][vb][2] * inv, st.O[0][vb][3] * inv);
        *(uint2*)(MIX + vb * 16 + 4 * g) = o;
    }
}

DI float wave_excl_sum(float v, int lane) {
    float x = v;
#pragma unroll
    for (int d = 1; d < 64; d <<= 1) { const float y = __shfl_up(x, d); if (lane >= d) x += y; }
    return x - v;
}
DI float wave_excl_max(float v, int lane, float init) {
    float x = v;
#pragma unroll
    for (int d = 1; d < 64; d <<= 1) { const float y = __shfl_up(x, d); if (lane >= d) x = fmaxf(x, y); }
    const float ex = __shfl_up(x, 1);
    return lane == 0 ? init : fmaxf(init, ex);
}
DI void mlstm_scan(const float* __restrict__ G, int h, int nseq, int dir, float* aA, float* MA, float* FA, float m0, int lane) {
    const int per = nseq >> 6;
    float run = 0.f;
    for (int e = 0; e < per; ++e) {
        const int idx = lane * per + e, pos = dir ? nseq - 1 - idx : idx;
        const float f = G[(size_t)pos * 16 + (dir ? 12 : 4) + h];
        const float lf = fminf(f, 0.f) - log1pf(expf(-fabsf(f)));
        run += lf; FA[pos] = run;
    }
    const float off = wave_excl_sum(run, lane);
    float rmax = -INFINITY;
    for (int e = 0; e < per; ++e) {
        const int idx = lane * per + e, pos = dir ? nseq - 1 - idx : idx;
        const float F = FA[pos] + off; FA[pos] = F;
        const float a = G[(size_t)pos * 16 + (dir ? 8 : 0) + h] - F;
        aA[pos] = a; rmax = fmaxf(rmax, a); MA[pos] = rmax;
    }
    const float pre = wave_excl_max(rmax, lane, m0);
    for (int e = 0; e < per; ++e) {
        const int idx = lane * per + e, pos = dir ? nseq - 1 - idx : idx;
        MA[pos] = fmaxf(MA[pos], pre);
    }
}

DI void mlstm_pass(f32x4 (&O)[4], float& den, int dir, int t, const bf16x8 (&qf)[2], const bf16_t* kbase, const bf16_t* vbase, int nseq,
                   const float* aA, float Mt, int u_lo, int u_hi, int g) {
    for (int u = u_lo; u <= u_hi; ++u) {
        const int key0 = u * 32;
        UnitFrags<1, 64> f;
        load_unit<1, 64>(f, kbase + (size_t)key0 * NIN, NIN, vbase + key0, nseq);
        f32x4 sa = (f32x4){0.f, 0.f, 0.f, 0.f}, sb = sa;
        sa = mfma16(f.k[0][0][0], qf[0], sa); sa = mfma16(f.k[0][0][1], qf[1], sa);
        sb = mfma16(f.k[0][1][0], qf[0], sb); sb = mfma16(f.k[0][1][1], qf[1], sb);
        const float4 a0 = *(const float4*)(aA + key0 + 4 * g), a1 = *(const float4*)(aA + key0 + 16 + 4 * g);
        const float av[8] = {a0.x, a0.y, a0.z, a0.w, a1.x, a1.y, a1.z, a1.w};
        float pv[8];
#pragma unroll
        for (int j = 0; j < 8; ++j) {
            const int key = key0 + 4 * g + (j & 3) + ((j >> 2) << 4);
            const bool ok = dir ? (key >= t) : (key <= t);
            const float w = ok ? fexp2((av[j] - Mt) * LOG2E) : 0.f;
            const float sv = (j < 4) ? sa[j & 3] : sb[j & 3];
            pv[j] = sv * 0.125f * w;
            den += pv[j];
        }
        const bf16x8 pk = pack8(pv[0], pv[1], pv[2], pv[3], pv[4], pv[5], pv[6], pv[7]);
#pragma unroll
        for (int vb = 0; vb < 4; ++vb) O[vb] = mfma16(cat4(f.v[vb][0], f.v[vb][1]), pk, O[vb]);
    }
}

template <bool LAT>
DI void item_mlstm(const Params& pin, int l, int seq, int h, int qt, unsigned char* smem, int wave, int lane) {
    const Params& p = pin; unsigned char* const ws_ = opaque_ws(pin.ws); float* const out_ = opaque_out(pin.out); lane = opaque_v(lane);
    const int lr = lane & 15, g = lane >> 4;
    const int nseq = LAT ? 1024 : 256;
    const int tok0 = LAT ? NCTX + seq * 1024 : seq * 256;
    float* aF = (float*)smem; float* MF = aF + 1024; float* FF = MF + 1024;
    float* aB = FF + 1024; float* MB = aB + 1024; float* FB = MB + 1024;
    const float* G = (const float*)(ws_ + OFF_G) + (size_t)tok0 * 16;
    float m0f = 0.f, m0b = 0.f;
    const int sidx_f = ((seq * 4 + l) * 2 + 0) * 4 + h, sidx_b = ((seq * 4 + l) * 2 + 1) * 4 + h;
    if (LAT) { m0f = p.state_m[sidx_f]; m0b = p.state_m[sidx_b]; }
    __syncthreads();
    if (wave == 0) mlstm_scan(G, h, nseq, 0, aF, MF, FF, m0f, lane);
    if (wave == 1) mlstm_scan(G, h, nseq, 1, aB, MB, FB, m0b, lane);
    __syncthreads();
    const bf16_t* P = (const bf16_t*)(ws_ + OFF_P);
    const int q0 = qt * 64 + wave * 16;
    const int t = q0 + lr;
    bf16x8 qf[2];
    {
        const bf16_t* qp = P + (size_t)(tok0 + t) * NIN + 2304 + h * 64 + 8 * g;
        qf[0] = *(const bf16x8*)(qp); qf[1] = *(const bf16x8*)(qp + 32);
    }
    const bf16_t* kbase = P + (size_t)(tok0 + lr) * NIN + 2560 + h * 64 + 8 * g;
    const bf16_t* vbase = (const bf16_t*)(ws_ + OFF_PT_CV) + (size_t)tok0 * 256 + (size_t)(h * 64 + lr) * nseq + 4 * g;
    const float Mf = MF[t], Mb = MB[t], Ff = FF[t], Fb = FB[t];
    f32x4 Of[4], Ob[4];
#pragma unroll
    for (int vb = 0; vb < 4; ++vb) { Of[vb] = (f32x4){0.f, 0.f, 0.f, 0.f}; Ob[vb] = Of[vb]; }
    float denf = 0.f, denb = 0.f;
    mlstm_pass(Of, denf, 0, t, qf, kbase, vbase, nseq, aF, Mf, 0, (q0 + 15) >> 5, g);
    mlstm_pass(Ob, denb, 1, t, qf, kbase, vbase, nseq, aB, Mb, q0 >> 5, (nseq >> 5) - 1, g);
    if (LAT) {
        const bf16_t* qp2 = P + (size_t)(tok0 + t) * NIN + 2304 + h * 64 + 4 * g;
#pragma unroll
        for (int dir = 0; dir < 2; ++dir) {
            const int sidx = dir ? sidx_b : sidx_f;
            const float e = fexp2(((dir ? m0b : m0f) - (dir ? Mb : Mf)) * LOG2E) * 0.125f;
            const bf16_t* c0t = (const bf16_t*)(ws_ + OFF_C0T) + (size_t)sidx * 4096 + lr * 64 + 4 * g;
            const float* n0 = p.state_n + (size_t)sidx * 64;
            float dacc = 0.f;
#pragma unroll
            for (int u2 = 0; u2 < 2; ++u2) {
                const bf16x4 qa = *(const bf16x4*)(qp2 + u2 * 32), qb = *(const bf16x4*)(qp2 + u2 * 32 + 16);
                const float4 na = *(const float4*)(n0 + u2 * 32 + 4 * g), nb = *(const float4*)(n0 + u2 * 32 + 16 + 4 * g);
                float pv[8];
#pragma unroll
                for (int j = 0; j < 4; ++j) { pv[j] = bf2f((unsigned short)qa[j]) * e; pv[4 + j] = bf2f((unsigned short)qb[j]) * e; }
                dacc += pv[0] * na.x + pv[1] * na.y + pv[2] * na.z + pv[3] * na.w + pv[4] * nb.x + pv[5] * nb.y + pv[6] * nb.z + pv[7] * nb.w;
                const bf16x8 pk = pack8(pv[0], pv[1], pv[2], pv[3], pv[4], pv[5], pv[6], pv[7]);
#pragma unroll
                for (int vb = 0; vb < 4; ++vb) {
                    const bf16_t* cp = c0t + (size_t)vb * 16 * 64 + u2 * 32;
                    const bf16x8 cf = cat4(*(const bf16x4*)(cp), *(const bf16x4*)(cp + 16));
                    if (dir) Ob[vb] = mfma16(cf, pk, Ob[vb]); else Of[vb] = mfma16(cf, pk, Of[vb]);
                }
            }
            if (dir) denb += dacc; else denf += dacc;
        }
    }
    denf = grp_sum(denf); denb = grp_sum(denb);
    const float rf = 1.f / fmaxf(fabsf(denf), expf(-(Ff + Mf)));
    const float rb = 1.f / fmaxf(fabsf(denb), expf(-(Fb + Mb)));
    float ss = 0.f;
#pragma unroll
    for (int vb = 0; vb < 4; ++vb)
#pragma unroll
        for (int i = 0; i < 4; ++i) { const float hs = Of[vb][i] * rf + Ob[vb][i] * rb; Of[vb][i] = hs; ss += hs * hs; }
    ss = grp_sum(ss);
    const float rn = rsqrtf(ss * (1.f / 64.f) + LN_EPS);
    const float* gn = p.mlstm_norm_g + (size_t)(l * 4 + h) * 64;
    const bf16_t* op = P + (size_t)(tok0 + t) * NIN + 3072 + h * 64;
    bf16_t* MIX = (bf16_t*)(ws_ + OFF_MIX) + (size_t)(tok0 + t) * 1024 + 768 + h * 64;
#pragma unroll
    for (int vb = 0; vb < 4; ++vb) {
        const int v = vb * 16 + 4 * g;
        const float4 g4 = *(const float4*)(gn + v);
        const bf16x4 o4 = *(const bf16x4*)(op + v);
        float sg[4];
#pragma unroll
        for (int i = 0; i < 4; ++i) sg[i] = 1.f / (1.f + __expf(-bf2f((unsigned short)o4[i])));
        uint2 o; o.x = pack2(Of[vb][0] * rn * g4.x * sg[0], Of[vb][1] * rn * g4.y * sg[1]);
        o.y = pack2(Of[vb][2] * rn * g4.z * sg[2], Of[vb][3] * rn * g4.w * sg[3]);
        *(uint2*)(MIX + v) = o;
    }
}

DI void item_mlstm_state(const Params& pin, int l, int b, int h, int dir, unsigned char* smem, int wave, int lane) {
    const Params& p = pin; unsigned char* const ws_ = opaque_ws(pin.ws); float* const out_ = opaque_out(pin.out); lane = opaque_v(lane);
    const int lr = lane & 15, g = lane >> 4;
    const int tok0 = b * 256;
    float* aA = (float*)smem; float* MA = aA + 1024; float* FA = MA + 1024;
    const float* G = (const float*)(ws_ + OFF_G) + (size_t)tok0 * 16;
    __syncthreads();
    if (wave == 0) mlstm_scan(G, h, 256, dir, aA, MA, FA, 0.f, lane);
    __syncthreads();
    const float Mfin = dir ? MA[0] : MA[255];
    const float Ffin = dir ? FA[0] : FA[255];
    const bf16_t* KT = (const bf16_t*)(ws_ + OFF_PT_CK) + (size_t)tok0 * 256 + (size_t)(h * 64 + wave * 16 + lr) * 256 + 8 * g;
    const bf16_t* VT = (const bf16_t*)(ws_ + OFF_PT_CV) + (size_t)tok0 * 256 + (size_t)(h * 64 + lr) * 256 + 8 * g;
    f32x4 C[4];
#pragma unroll
    for (int vb = 0; vb < 4; ++vb) C[vb] = (f32x4){0.f, 0.f, 0.f, 0.f};
    float nacc = 0.f;
    for (int u = 0; u < 8; ++u) {
        const int s0 = u * 32;
        const bf16x8 kf = *(const bf16x8*)(KT + s0);
        const float4 a0 = *(const float4*)(aA + s0 + 8 * g), a1 = *(const float4*)(aA + s0 + 8 * g + 4);
        const float av[8] = {a0.x, a0.y, a0.z, a0.w, a1.x, a1.y, a1.z, a1.w};
        float kw[8];
#pragma unroll
        for (int j = 0; j < 8; ++j) { kw[j] = bf2f((unsigned short)kf[j]) * fexp2((av[j] - Mfin) * LOG2E); nacc += kw[j]; }
        const bf16x8 af = pack8(kw[0], kw[1], kw[2], kw[3], kw[4], kw[5], kw[6], kw[7]);
#pragma unroll
        for (int vb = 0; vb < 4; ++vb) {
            const bf16x8 vf = *(const bf16x8*)(VT + (size_t)vb * 16 * 256 + s0);
            C[vb] = mfma16(af, vf, C[vb]);
        }
    }
    const size_t sidx = (size_t)((b * 4 + l) * 2 + dir) * 4 + h;
    float* oc = out_ + O_NC + sidx * 4096;
#pragma unroll
    for (int vb = 0; vb < 4; ++vb)
#pragma unroll
        for (int i = 0; i < 4; ++i) oc[(wave * 16 + 4 * g + i) * 64 + vb * 16 + lr] = C[vb][i];
    nacc = grp_sum(nacc);
    if (g == 0) out_[O_NN + sidx * 64 + wave * 16 + lr] = nacc;
    if (wave == 0 && lane == 0) out_[O_NM + sidx] = Ffin + Mfin;
}

DI void mixer_phase(const Params& p, int l, unsigned char* smem) {
    const int tid_ = opaque_v(threadIdx.x); const int lane = tid_ & 63, wave = tid_ >> 6;
    for (int it = blockIdx.x; it < 1280; it += gridDim.x) {
        if (it < 128) { if (IM & 1) item_diffattn<true>(p, l, it >> 6, (it >> 4) & 3, it & 15, wave, lane); }
        else if (it < 256) { const int i = it - 128; if (IM & 2) item_mlstm<true>(p, l, i >> 6, (i >> 4) & 3, i & 15, smem, wave, lane); }
        else if (it < 384) { const int i = it - 256; if (IM & 4) item_na(p, l, i >> 6, (i >> 4) & 3, i & 15, wave, lane); }
        else if (it < 640) { const int i = it - 384; if (IM & 8) item_diffattn<false>(p, l, i >> 4, (i >> 2) & 3, i & 3, wave, lane); }
        else if (it < 896) { const int i = it - 640; if (IM & 16) item_mlstm<false>(p, l, i >> 4, (i >> 2) & 3, i & 3, smem, wave, lane); }
        else if (it < 1152) { const int i = it - 896; if (IM & 32) item_dense(p, i >> 4, (i >> 2) & 3, i & 3, wave, lane); }
        else { const int i = it - 1152; if (IM & 64) item_mlstm_state(p, l, i >> 3, (i >> 1) & 3, i & 1, smem, wave, lane); }
    }
}

#define XB_TMO      128
#define XB_XCNT(j)  (256  + 64 * (j))
#define XB_XSUB(j)  (1280 + 64 * (j))
#define XB_XGEN(j)  (2304 + 64 * (j))
#define XB_TOP      3328
#define XB_TOPGEN   3392
#define XCD_BAR_WORDS 3456
#define XB_SPIN_CAP (1u << 18)

__device__ __forceinline__ unsigned xb_ld(unsigned* p)              { return __hip_atomic_load(p, __ATOMIC_RELAXED, __HIP_MEMORY_SCOPE_AGENT); }
__device__ __forceinline__ unsigned xb_add(unsigned* p, unsigned v) { return __hip_atomic_fetch_add(p, v, __ATOMIC_RELAXED, __HIP_MEMORY_SCOPE_AGENT); }
__device__ __forceinline__ unsigned xb_xcc_id() { return (unsigned)__builtin_amdgcn_s_getreg((3 << 11) | 20) & 0xFu; }
#define XB_SPIN(cond, bar) do { unsigned _sp = 0; while (cond) { __builtin_amdgcn_s_sleep(1); \
    if ((++_sp & 255u) == 0u) { if (xb_ld(&(bar)[XB_TMO])) break; if (_sp > XB_SPIN_CAP) { atomicAdd(&(bar)[XB_TMO], 1u); break; } } } } while (0)

struct XcdBarrier {
    unsigned* bar; unsigned x;
    volatile LAS unsigned* st;
};

__device__ __forceinline__ XcdBarrier xcd_barrier_post(unsigned* bar, volatile LAS unsigned* st) {
    XcdBarrier b; b.bar = bar; b.x = xb_xcc_id(); b.st = st;
    if (threadIdx.x == 0) (void)xb_add(&bar[XB_XCNT(b.x)], 1u);
    return b;
}
__device__ __forceinline__ void xcd_barrier_complete(unsigned* bar, unsigned x, unsigned& nloc, unsigned& nx) {
    const unsigned G = gridDim.x * gridDim.y * gridDim.z;
    unsigned sum, cnt, mine, sp = 0u;
    for (;;) {
        sum = 0u; cnt = 0u; mine = 0u;
#pragma unroll
        for (unsigned j = 0; j < 16; ++j) { const unsigned c = xb_ld(&bar[XB_XCNT(j)]); sum += c; cnt += (c > 0u) ? 1u : 0u; mine = (j == x) ? c : mine; }
        if (sum == G) break;
        __builtin_amdgcn_s_sleep(1);
        if ((++sp & 255u) == 0u) { if (xb_ld(&bar[XB_TMO])) break; if (sp > XB_SPIN_CAP) { atomicAdd(&bar[XB_TMO], 1u); break; } }
    }
    nloc = mine > 0u ? mine : 1u; nx = cnt > 0u ? cnt : 1u;
}

__device__ __forceinline__ void xcd_barrier(const XcdBarrier& b) {
    asm volatile("s_waitcnt vmcnt(0)" ::: "memory");
    __syncthreads();
    if (threadIdx.x == 0) {
        unsigned* bar = b.bar;
        __builtin_amdgcn_s_waitcnt(0);
        unsigned nloc = b.st[0], nx = b.st[1];
        if (nloc == 0u) { xcd_barrier_complete(bar, b.x, nloc, nx); b.st[0] = nloc; b.st[1] = nx; }
        const unsigned old = xb_add(&bar[XB_XSUB(b.x)], 1u);
        const unsigned gen = old / nloc;
        if (old + 1u == (gen + 1u) * nloc) {
            __builtin_amdgcn_fence(__ATOMIC_RELEASE, "agent");
            asm volatile("s_waitcnt vmcnt(0)" ::: "memory");
            const unsigned og = xb_add(&bar[XB_TOP], 1u);
            const unsigned tg = og / nx;
            if (og + 1u == (tg + 1u) * nx) xb_add(&bar[XB_TOPGEN], 1u);
            else XB_SPIN(xb_ld(&bar[XB_TOPGEN]) == tg, bar);
            __builtin_amdgcn_fence(__ATOMIC_ACQUIRE, "agent");
            xb_add(&bar[XB_XGEN(b.x)], 1u);
            asm volatile("s_waitcnt vmcnt(0)" ::: "memory");
        } else {
            XB_SPIN(xb_ld(&bar[XB_XGEN(b.x)]) == gen, bar);
            __builtin_amdgcn_fence(__ATOMIC_ACQUIRE, "agent");
            asm volatile("s_waitcnt vmcnt(0)" ::: "memory");
        }
    }
    __syncthreads();
}


constexpr int N_PHASES = 2 + 7 * 4;

__global__ void __launch_bounds__(256, 2) fwd_kernel(Params p) {
    __shared__ __attribute__((aligned(16))) unsigned char smem[66560 + 16];
    if (threadIdx.x == 0) *(uint4*)(smem + 66560) = make_uint4(0u, 0u, 0u, 0u);
    __syncthreads();
    XcdBarrier xb = xcd_barrier_post((unsigned*)(p.ws + OFF_BAR), (volatile LAS unsigned*)(smem + 66560));
    for (int ph = p.ph_lo; ph < p.ph_hi; ++ph) {
        if (ph > p.ph_lo) {
            if (p.ph_hi > 1000) cg::this_grid().sync();
            xcd_barrier(xb);
        }
        const int l = ph < 2 ? 0 : (ph - 2) / 7, s = ph < 2 ? ph - 2 : (ph - 2) % 7;
        const int bit = 1 << (s + 2);
        const int reps = (DUPM & bit) ? 2 : 1;
        for (int rep = 0; rep < reps; ++rep) {
            if (rep) __syncthreads();
            if (s == -2) prep0(p, smem);
            else if (s == -1) prep1(p);
            else if (s == 0) gemm_phase<EPI_INPROJ>(p, l, OFF_H, OFF_WT_IN + (size_t)l * NINP * DM * 2, NINP / 128, 1024, 0, smem);
            else if (s == 1) mixer_phase(p, l, smem);
            else if (s == 2) gemm_phase<EPI_Y>(p, l, OFF_MIX, OFF_WT_OUT + (size_t)l * DM * DM * 2, 8, 1024, 1024, smem);
            else if (s == 3) ln_phase<1>(p, l);
            else if (s == 4) gemm_phase<EPI_RELU2>(p, l, OFF_H, OFF_WT_1 + (size_t)l * DFF * DM * 2, 32, 1024, 4096, smem);
            else if (s == 5) gemm_phase<EPI_Y>(p, l, OFF_U, OFF_WT_2 + (size_t)l * DM * DFF * 2, 8, 4096, 1024, smem);
            else ln_phase<2>(p, l);
        }
    }
}

extern "C" void kernel_launch(void* const* d_in, const int* in_sizes, int n_in, void* d_out, int out_size, void* d_ws, size_t ws_size,
                              hipStream_t stream) {
    static int grid = 0;
    if (grid == 0) {
        if (n_in != 26 || ws_size < WS_END) { fprintf(stderr, "kernel_launch: unexpected n_in %d / ws %zu (need %zu)\n", n_in, ws_size, (size_t)WS_END); grid = -1; return; }
        int dev = 0, cus = 0, per_cu = 0;
        hipGetDevice(&dev);
        hipDeviceGetAttribute(&cus, hipDeviceAttributeMultiprocessorCount, dev);
        hipOccupancyMaxActiveBlocksPerMultiprocessor(&per_cu, (const void*)fwd_kernel, 256, 0);
        if (per_cu < 1) per_cu = 1;
        if (per_cu > 2) per_cu = 2;
        grid = cus * per_cu;
    }
    if (grid < 0) return;
    Params p{};
    const float** pp = (const float**)&p;
    for (int i = 0; i < 26; ++i) pp[i] = (const float*)d_in[i];
    p.out = (float*)d_out; p.ws = (unsigned char*)d_ws;
    (void)hipMemsetAsync((unsigned char*)d_ws + OFF_BAR, 0, 16384, stream);
#if SINGLE_LAUNCH
    p.ph_lo = 0; p.ph_hi = N_PHASES;
    void* args[] = {&p};
    hipError_t e = hipLaunchCooperativeKernel((const void*)fwd_kernel, dim3(grid), dim3(256), args, 0, stream);
    if (e != hipSuccess) fprintf(stderr, "cooperative launch failed: %s (grid %d)\n", hipGetErrorString(e), grid);
#else
    for (int ph = 0; ph < N_PHASES; ++ph) {
        p.ph_lo = ph; p.ph_hi = ph + 1;
        void* args[] = {&p};
        hipError_t e = hipLaunchCooperativeKernel((const void*)fwd_kernel, dim3(grid), dim3(256), args, 0, stream);
        if (e != hipSuccess) { fprintf(stderr, "launch %d failed: %s (grid %d)\n", ph, hipGetErrorString(e), grid); break; }
    }
#endif
}
```

```cpp
#include <hip/hip_runtime.h>
#include <hip/hip_cooperative_groups.h>
#include <cstdio>
namespace cg = cooperative_groups;

#ifndef IM
#define IM 0xffff
#endif
#ifndef DUPM
#define DUPM 0
#endif
#ifndef PHM
#define PHM 0xffff
#endif
#ifndef SINGLE_LAUNCH
#define SINGLE_LAUNCH 1
#endif

#define LAS __attribute__((address_space(3)))
typedef unsigned short bf16_t;
typedef __attribute__((ext_vector_type(8))) short bf16x8;
typedef __attribute__((ext_vector_type(4))) short bf16x4;
typedef __attribute__((ext_vector_type(4))) float f32x4;
#define DI __device__ __forceinline__

constexpr int NTOK = 6144, NCTX = 4096, DM = 1024, NIN = 3344, NINP = 3456, DFF = 4096;
constexpr float ALPHA = 1.681792830507429f;
constexpr float LOG2E = 1.4426950408889634f;
constexpr float LN_EPS = 1e-5f;

constexpr size_t al256(size_t x) { return (x + 255) & ~(size_t)255; }
constexpr size_t OFF_WT_IN = 0;
constexpr size_t OFF_WT_OUT = OFF_WT_IN + al256((size_t)4 * NINP * DM * 2);
constexpr size_t OFF_WT_1 = OFF_WT_OUT + al256((size_t)4 * DM * DM * 2);
constexpr size_t OFF_WT_2 = OFF_WT_1 + al256((size_t)4 * DFF * DM * 2);
constexpr size_t OFF_MOD = OFF_WT_2 + al256((size_t)4 * DFF * DM * 2);
constexpr size_t OFF_X = OFF_MOD + al256((size_t)4 * 3 * 6144 * 4);
constexpr size_t OFF_H = OFF_X + al256((size_t)NTOK * DM * 4);
constexpr size_t OFF_P = OFF_H + al256((size_t)NTOK * DM * 2);
constexpr size_t OFF_PT_AV = OFF_P + al256((size_t)NTOK * NIN * 2);
constexpr size_t OFF_PT_BV = OFF_PT_AV + al256((size_t)NTOK * 512 * 2);
constexpr size_t OFF_PT_CV = OFF_PT_BV + al256((size_t)NTOK * 256 * 2);
constexpr size_t OFF_PT_CK = OFF_PT_CV + al256((size_t)NTOK * 256 * 2);
constexpr size_t OFF_G = OFF_PT_CK + al256((size_t)NTOK * 256 * 2);
constexpr size_t OFF_MIX = OFF_G + al256((size_t)NTOK * 16 * 4);
constexpr size_t OFF_Y = OFF_MIX + al256((size_t)NTOK * DM * 2);
constexpr size_t OFF_U = OFF_Y + al256((size_t)NTOK * DM * 4);
constexpr size_t OFF_CAK = OFF_U + al256((size_t)NTOK * DFF * 2);
constexpr size_t OFF_CAVT = OFF_CAK + al256((size_t)32 * 512 * 128 * 2);
constexpr size_t OFF_CBK = OFF_CAVT + al256((size_t)32 * 512 * 128 * 2);
constexpr size_t OFF_CBVT = OFF_CBK + al256((size_t)32 * 512 * 64 * 2);
constexpr size_t OFF_C0T = OFF_CBVT + al256((size_t)32 * 512 * 64 * 2);
constexpr size_t OFF_ROPE = OFF_C0T + al256((size_t)64 * 64 * 64 * 2);
constexpr size_t OFF_LAM = OFF_ROPE + al256((size_t)2 * 1024 * 4);
constexpr size_t OFF_BAR = OFF_LAM + 256;
constexpr size_t WS_END = OFF_BAR + 16384;

constexpr size_t O_YP = 0, O_YS = 4194304, O_AK = 6291456, O_AV = 14680064, O_BK = 23068672, O_BV = 27262976,
                 O_NC = 31457280, O_NN = 33554432, O_NM = 33587200;

struct Params {
    const float* x_prompt; const float* x_sample; const float* cache_a_k; const float* cache_a_v;
    const float* cache_b_k; const float* cache_b_v; const float* state_c; const float* state_n;
    const float* state_m; const float* c; const float* c_ctx; const float* w_in; const float* gate_bias;
    const float* diff_lambda; const float* diff_norm_g; const float* nat_rpb; const float* mlstm_norm_g;
    const float* w_out; const float* ada_w; const float* ada_b; const float* ln1_g; const float* ln1_b;
    const float* ln2_g; const float* ln2_b; const float* w_mlp1; const float* w_mlp2;
    float* out; unsigned char* ws; int ph_lo; int ph_hi;
};

DI int opaque_v(int x) { asm volatile("" : "+v"(x)); return x; }
DI size_t opaque_zero() { size_t z = 0; asm volatile("" : "+s"(z)); return z; }
DI unsigned char* opaque_ws(unsigned char* w) { return w + opaque_zero(); }
DI float* opaque_out(float* w) { return w + opaque_zero(); }
DI unsigned short f2bf(float x) { unsigned u = __float_as_uint(x); u += 0x7fffu + ((u >> 16) & 1u); return (unsigned short)(u >> 16); }
DI float bf2f(unsigned short h) { return __uint_as_float(((unsigned)h) << 16); }
DI unsigned pack2(float a, float b) { return (unsigned)f2bf(a) | ((unsigned)f2bf(b) << 16); }
DI f32x4 mfma16(bf16x8 a, bf16x8 b, f32x4 c) { return __builtin_amdgcn_mfma_f32_16x16x32_bf16(a, b, c, 0, 0, 0); }
DI float fexp2(float x) { return __builtin_amdgcn_exp2f(x); }
DI bf16x8 pack8(float a0, float a1, float a2, float a3, float a4, float a5, float a6, float a7) {
    uint4 u; u.x = pack2(a0, a1); u.y = pack2(a2, a3); u.z = pack2(a4, a5); u.w = pack2(a6, a7);
    return __builtin_bit_cast(bf16x8, u);
}
DI bf16x8 cat4(bf16x4 a, bf16x4 b) { return __builtin_shufflevector(a, b, 0, 1, 2, 3, 4, 5, 6, 7); }
DI float wave_sum(float v) {
#pragma unroll
    for (int o = 32; o > 0; o >>= 1) v += __shfl_xor(v, o);
    return v;
}
DI float grp_sum(float v) { v += __shfl_xor(v, 16); v += __shfl_xor(v, 32); return v; }
DI float grp_max(float v) { v = fmaxf(v, __shfl_xor(v, 16)); v = fmaxf(v, __shfl_xor(v, 32)); return v; }

DI void transpose_job(const float* __restrict__ src, bf16_t* __restrict__ dst, int R, int C, int Cpad, int nmat, float* tile, bool blocked = false) {
    const int tid = threadIdx.x;
    const int rt = R >> 6, ct = Cpad >> 6, per = rt * ct, total = per * nmat;
    for (int it = blockIdx.x; it < total; it += gridDim.x) {
        const int mat = it / per, rem = it - mat * per;
        const int r0 = (rem / ct) << 6, c0 = (rem % ct) << 6;
        const float* s = src + (size_t)mat * R * C;
        bf16_t* d = dst + (size_t)mat * Cpad * R;
#pragma unroll
        for (int i = 0; i < 4; ++i) {
            const int r = (tid >> 4) + 16 * i, c = (tid & 15) * 4;
            float4 v = make_float4(0.f, 0.f, 0.f, 0.f);
            if (c0 + c < C) v = *(const float4*)(s + (size_t)(r0 + r) * C + c0 + c);
            tile[r * 65 + c + 0] = v.x; tile[r * 65 + c + 1] = v.y; tile[r * 65 + c + 2] = v.z; tile[r * 65 + c + 3] = v.w;
        }
        __syncthreads();
        {
            const int c = tid >> 2, rs = (tid & 3) * 16;
            uint4 o0, o1;
            o0.x = pack2(tile[(rs + 0) * 65 + c], tile[(rs + 1) * 65 + c]);
            o0.y = pack2(tile[(rs + 2) * 65 + c], tile[(rs + 3) * 65 + c]);
            o0.z = pack2(tile[(rs + 4) * 65 + c], tile[(rs + 5) * 65 + c]);
            o0.w = pack2(tile[(rs + 6) * 65 + c], tile[(rs + 7) * 65 + c]);
            o1.x = pack2(tile[(rs + 8) * 65 + c], tile[(rs + 9) * 65 + c]);
            o1.y = pack2(tile[(rs + 10) * 65 + c], tile[(rs + 11) * 65 + c]);
            o1.z = pack2(tile[(rs + 12) * 65 + c], tile[(rs + 13) * 65 + c]);
            o1.w = pack2(tile[(rs + 14) * 65 + c], tile[(rs + 15) * 65 + c]);
            uint4* dp = blocked ? (uint4*)(d + ((size_t)((r0 + rs) >> 5) * Cpad + (c0 + c)) * 32 + ((r0 + rs) & 31))
                                : (uint4*)(d + (size_t)(c0 + c) * R + r0 + rs);
            dp[0] = o0; dp[1] = o1;
        }
        __syncthreads();
    }
}

DI void convert_job(const float* __restrict__ src, bf16_t* __restrict__ dst, size_t n) {
    for (size_t i = ((size_t)blockIdx.x * 256 + threadIdx.x) * 8; i < n; i += (size_t)gridDim.x * 256 * 8) {
        const float4 a = *(const float4*)(src + i), b = *(const float4*)(src + i + 4);
        uint4 o; o.x = pack2(a.x, a.y); o.y = pack2(a.z, a.w); o.z = pack2(b.x, b.y); o.w = pack2(b.z, b.w);
        *(uint4*)(dst + i) = o;
    }
}

DI void prep0(const Params& pin, unsigned char* smem) {
    const Params& p = pin; unsigned char* const ws_ = opaque_ws(pin.ws); float* const out_ = opaque_out(pin.out); const int tid = opaque_v(threadIdx.x);
    {
        float* sl = (float*)smem; float* red = (float*)(smem + 12288);
        for (int i = tid; i < 3072; i += 256) {
            const int cnd = i >> 10, k = i & 1023;
            const float v = (cnd == 0) ? p.c_ctx[k] : p.c[(cnd - 1) * 1024 + k];
            sl[i] = v / (1.f + __expf(-v));
        }
        __syncthreads();
        float* mod = (float*)(ws_ + OFF_MOD);
        const int kg = tid >> 4, cl = tid & 15;
        for (int it = blockIdx.x; it < 384; it += gridDim.x) {
            const int l = it / 96, j0 = (it % 96) * 64;
            const float* w = p.ada_w + (size_t)l * 1024 * 6144 + j0 + cl * 4;
            float4 a0 = make_float4(0, 0, 0, 0), a1 = a0, a2 = a0;
#pragma unroll 8
            for (int kk = 0; kk < 64; ++kk) {
                const int k = kg * 64 + kk;
                const float4 wv = *(const float4*)(w + (size_t)k * 6144);
                const float s0 = sl[k], s1 = sl[1024 + k], s2 = sl[2048 + k];
                a0.x += s0 * wv.x; a0.y += s0 * wv.y; a0.z += s0 * wv.z; a0.w += s0 * wv.w;
                a1.x += s1 * wv.x; a1.y += s1 * wv.y; a1.z += s1 * wv.z; a1.w += s1 * wv.w;
                a2.x += s2 * wv.x; a2.y += s2 * wv.y; a2.z += s2 * wv.z; a2.w += s2 * wv.w;
            }
            __syncthreads();
            float* r = red + kg * 192 + cl * 4;
            r[0] = a0.x; r[1] = a0.y; r[2] = a0.z; r[3] = a0.w;
            r[64] = a1.x; r[65] = a1.y; r[66] = a1.z; r[67] = a1.w;
            r[128] = a2.x; r[129] = a2.y; r[130] = a2.z; r[131] = a2.w;
            __syncthreads();
            if (tid < 192) {
                const int cnd = tid >> 6, col = tid & 63;
                float s = 0.f;
#pragma unroll
                for (int q = 0; q < 16; ++q) s += red[q * 192 + tid];
                mod[(l * 3 + cnd) * 6144 + j0 + col] = s + p.ada_b[l * 6144 + j0 + col];
            }
        }
        __syncthreads();
    }
    if (blockIdx.x == gridDim.x - 1) {
        float* rope = (float*)(ws_ + OFF_ROPE);
        for (int i = tid; i < 1024; i += 256) {
            const int pos = i >> 4, j = i & 15;
            const float freq = powf(10000.f, -(float)j / 16.f);
            float s, c; sincosf((float)pos * freq, &s, &c);
            rope[i] = c; rope[1024 + i] = s;
        }
        if (tid < 4) {
            const float* lp = p.diff_lambda + tid * 256;
            float s1 = 0.f, s2 = 0.f;
            for (int i = 0; i < 64; ++i) { s1 += lp[i] * lp[64 + i]; s2 += lp[128 + i] * lp[192 + i]; }
            const float li = 0.8f - 0.6f * expf(-0.3f * (float)tid);
            float* lam = (float*)(ws_ + OFF_LAM);
            lam[tid * 2] = expf(s1) - expf(s2) + li; lam[tid * 2 + 1] = li;
        }
    }
    float* tile = (float*)smem;
    transpose_job(p.w_in, (bf16_t*)(ws_ + OFF_WT_IN), 1024, NIN, NINP, 4, tile);
    transpose_job(p.w_out, (bf16_t*)(ws_ + OFF_WT_OUT), 1024, 1024, 1024, 4, tile);
    transpose_job(p.w_mlp1, (bf16_t*)(ws_ + OFF_WT_1), 1024, 4096, 4096, 4, tile);
    transpose_job(p.w_mlp2, (bf16_t*)(ws_ + OFF_WT_2), 4096, 1024, 1024, 4, tile);
    transpose_job(p.cache_a_v, (bf16_t*)(ws_ + OFF_CAVT), 512, 128, 128, 32, tile, true);
    transpose_job(p.cache_b_v, (bf16_t*)(ws_ + OFF_CBVT), 512, 64, 64, 32, tile, true);
    transpose_job(p.state_c, (bf16_t*)(ws_ + OFF_C0T), 64, 64, 64, 64, tile);
    convert_job(p.cache_a_k, (bf16_t*)(ws_ + OFF_CAK), (size_t)32 * 512 * 128);
    convert_job(p.cache_b_k, (bf16_t*)(ws_ + OFF_CBK), (size_t)32 * 512 * 64);
}

DI void prep1(const Params& pin) {
    const Params& p = pin; unsigned char* const ws_ = opaque_ws(pin.ws); float* const out_ = opaque_out(pin.out); const int tid_ = opaque_v(threadIdx.x); const int lane = tid_ & 63, wave = tid_ >> 6;
    const float* mod = (const float*)(ws_ + OFF_MOD);
    float* X = (float*)(ws_ + OFF_X);
    bf16_t* H = (bf16_t*)(ws_ + OFF_H);
    for (int row = blockIdx.x * 4 + wave; row < NTOK; row += gridDim.x * 4) {
        const float* src = row < NCTX ? p.x_prompt + (size_t)row * 1024 : p.x_sample + (size_t)(row - NCTX) * 1024;
        const int cnd = row < NCTX ? 0 : 1 + ((row - NCTX) >> 10);
        const float* md = mod + (size_t)cnd * 6144;
#pragma unroll
        for (int j = 0; j < 4; ++j) {
            const int c = lane * 4 + 256 * j;
            const float4 v = *(const float4*)(src + c);
            *(float4*)(X + (size_t)row * 1024 + c) = v;
            const float4 sh = *(const float4*)(md + c), sc = *(const float4*)(md + 1024 + c);
            uint2 o; o.x = pack2(v.x * (1.f + sc.x) + sh.x, v.y * (1.f + sc.y) + sh.y);
            o.y = pack2(v.z * (1.f + sc.z) + sh.z, v.w * (1.f + sc.w) + sh.w);
            *(uint2*)(H + (size_t)row * 1024 + c) = o;
        }
    }
}

template <int WHICH>
DI void ln_phase(const Params& pin, int l) {
    const Params& p = pin; unsigned char* const ws_ = opaque_ws(pin.ws); float* const out_ = opaque_out(pin.out); const int tid_ = opaque_v(threadIdx.x); const int lane = tid_ & 63, wave = tid_ >> 6;
    const float* mod = (const float*)(ws_ + OFF_MOD);
    float* X = (float*)(ws_ + OFF_X);
    const float* Y = (const float*)(ws_ + OFF_Y);
    bf16_t* H = (bf16_t*)(ws_ + OFF_H);
    const float* lg = (WHICH == 1 ? p.ln1_g : p.ln2_g) + l * 1024;
    const float* lb = (WHICH == 1 ? p.ln1_b : p.ln2_b) + l * 1024;
    const bool last = (WHICH == 2 && l == 3);
    for (int row = blockIdx.x * 4 + wave; row < NTOK; row += gridDim.x * 4) {
        const int cnd = row < NCTX ? 0 : 1 + ((row - NCTX) >> 10);
        const float* md = mod + (size_t)(l * 3 + cnd) * 6144;
        const float* gate = md + (WHICH == 1 ? 2048 : 5120);
        float4 v[4];
        float s = 0.f;
#pragma unroll
        for (int j = 0; j < 4; ++j) {
            const int c = lane * 4 + 256 * j;
            const float4 xv = *(const float4*)(X + (size_t)row * 1024 + c);
            const float4 yv = *(const float4*)(Y + (size_t)row * 1024 + c);
            const float4 gv = *(const float4*)(gate + c);
            v[j].x = ALPHA * xv.x + gv.x * yv.x; v[j].y = ALPHA * xv.y + gv.y * yv.y;
            v[j].z = ALPHA * xv.z + gv.z * yv.z; v[j].w = ALPHA * xv.w + gv.w * yv.w;
            s += v[j].x + v[j].y + v[j].z + v[j].w;
        }
        const float mu = wave_sum(s) * (1.f / 1024.f);
        float q = 0.f;
#pragma unroll
        for (int j = 0; j < 4; ++j) {
            v[j].x -= mu; v[j].y -= mu; v[j].z -= mu; v[j].w -= mu;
            q += v[j].x * v[j].x + v[j].y * v[j].y + v[j].z * v[j].z + v[j].w * v[j].w;
        }
        const float rstd = rsqrtf(wave_sum(q) * (1.f / 1024.f) + LN_EPS);
        const float* nmd = (WHICH == 1) ? md : mod + (size_t)((l + 1) * 3 + cnd) * 6144;
        const float* shp = nmd + (WHICH == 1 ? 3072 : 0);
        const float* scp = nmd + (WHICH == 1 ? 4096 : 1024);
#pragma unroll
        for (int j = 0; j < 4; ++j) {
            const int c = lane * 4 + 256 * j;
            const float4 g4 = *(const float4*)(lg + c), b4 = *(const float4*)(lb + c);
            float4 o;
            o.x = v[j].x * rstd * g4.x + b4.x; o.y = v[j].y * rstd * g4.y + b4.y;
            o.z = v[j].z * rstd * g4.z + b4.z; o.w = v[j].w * rstd * g4.w + b4.w;
            if (last) {
                *(float4*)(out_ + (size_t)row * 1024 + c) = o;
            } else {
                *(float4*)(X + (size_t)row * 1024 + c) = o;
                const float4 sh = *(const float4*)(shp + c), sc = *(const float4*)(scp + c);
                uint2 h; h.x = pack2(o.x * (1.f + sc.x) + sh.x, o.y * (1.f + sc.y) + sh.y);
                h.y = pack2(o.z * (1.f + sc.z) + sh.z, o.w * (1.f + sc.w) + sh.w);
                *(uint2*)(H + (size_t)row * 1024 + c) = h;
            }
        }
    }
}

enum { EPI_INPROJ = 0, EPI_Y = 1, EPI_RELU2 = 2 };

DI void epi_inproj(const Params& p, unsigned char* ws_, float* out_, int layer, const float* T, int rowbase, int colbase, int lane) {
    if (colbase >= NIN) return;
    bf16_t* P = (bf16_t*)(ws_ + OFF_P);
    const bool latent = rowbase >= NCTX;
    const int seq_tok0 = latent ? (NCTX + ((rowbase - NCTX) & ~1023)) : (rowbase & ~255);
    const int nseq = latent ? 1024 : 256;
    const int bctx = seq_tok0 >> 8;
    const int n0 = rowbase - seq_tok0;
    if (colbase >= 3328) {
        float* G = (float*)(ws_ + OFF_G);
        const float bias = p.gate_bias[layer * 16 + (lane & 15)];
        for (int rr = 0; rr < 16; ++rr) {
            const int r = rr * 4 + (lane >> 4);
            G[(size_t)(rowbase + r) * 16 + (lane & 15)] = T[r * 65 + (lane & 15)] + bias;
        }
        return;
    }
    bool toP = false, rope = false, toT = false, toO = false;
    size_t toff = 0, obase = 0; int tW = 0, tcr = 0, ohd = 64, ocr = 0;
    if (colbase < 1024) { toP = true; rope = latent; if (colbase >= 512) { toO = !latent; obase = O_AK; ohd = 128; ocr = colbase - 512; } }
    else if (colbase < 1536) { toT = true; toff = OFF_PT_AV; tW = 512; tcr = colbase - 1024; toO = !latent; obase = O_AV; ohd = 128; ocr = tcr; }
    else if (colbase < 1792) { toP = true; }
    else if (colbase < 2048) { toP = true; toO = !latent; obase = O_BK; ohd = 64; ocr = colbase - 1792; }
    else if (colbase < 2304) { toT = true; toff = OFF_PT_BV; tW = 256; tcr = colbase - 2048; toO = !latent; obase = O_BV; ohd = 64; ocr = tcr; }
    else if (colbase < 2560) { toP = true; }
    else if (colbase < 2816) { toP = true; toT = true; toff = OFF_PT_CK; tW = 256; tcr = colbase - 2560; }
    else if (colbase < 3072) { toT = true; toff = OFF_PT_CV; tW = 256; tcr = colbase - 2816; }
    else { toP = true; }
    if (toO) {
        const int h = ocr / ohd, w = ocr - h * ohd + lane;
        float* O = out_ + obase + (((size_t)(bctx * 4 + layer) * 4 + h) * 256 + n0) * ohd + w;
#pragma unroll 4
        for (int r = 0; r < 64; ++r) O[(size_t)r * ohd] = T[r * 65 + lane];
    }
    if (toP) {
        bf16_t* Pp = P + (size_t)rowbase * NIN + colbase + lane;
        if (rope) {
            const float* rc = (const float*)(ws_ + OFF_ROPE);
            const float* rs = rc + 1024;
#pragma unroll 4
            for (int r = 0; r < 64; ++r) {
                const float v = T[r * 65 + lane], vp = T[r * 65 + (lane ^ 16)];
                const int t = n0 + r;
                const int pos = (lane < 32) ? (t >> 6) : (t & 63);
                const float c = rc[pos * 16 + (lane & 15)], sn = rs[pos * 16 + (lane & 15)];
                const float o = (lane & 16) ? (vp * sn + v * c) : (v * c - vp * sn);
                Pp[(size_t)r * NIN] = f2bf(o);
            }
        } else {
#pragma unroll 4
            for (int r = 0; r < 64; ++r) Pp[(size_t)r * NIN] = f2bf(T[r * 65 + lane]);
        }
    }
    if (toT) {
        const int n = n0 + lane;
        bf16_t* Tp = (bf16_t*)(ws_ + toff) + (size_t)seq_tok0 * tW + ((size_t)(n >> 5) * tW + tcr) * 32 + (n & 31);
#pragma unroll 4
        for (int c = 0; c < 64; ++c) Tp[(size_t)c * 32] = f2bf(T[lane * 65 + c]);
    }
}

template <int EPI>
DI void gemm_phase(const Params& pin, int layer, size_t offA, size_t offB, int ntn, int K, int ldc,
                   unsigned char* smem) {
    const Params& p = pin; unsigned char* const ws_ = opaque_ws(pin.ws); float* const out_ = opaque_out(pin.out); const int tid = opaque_v(threadIdx.x), lane = tid & 63, wave = tid >> 6;
    const bf16_t* __restrict__ A = (const bf16_t*)(ws_ + offA); const bf16_t* __restrict__ Bt = (const bf16_t*)(ws_ + offB);
    const int wm = wave >> 1, wn = wave & 1;
    const int lr = lane & 15, g = lane >> 4;
    const int ntm = NTOK / 128;
    const int ntiles = ntm * ntn, nk = K >> 6;
    for (int tile = blockIdx.x; tile < ntiles; tile += gridDim.x) {
        const int tm = tile % ntm, tn = tile / ntm;
        const int m0 = tm * 128, n0 = tn * 128;
        f32x4 acc[4][4];
#pragma unroll
        for (int mi = 0; mi < 4; ++mi)
#pragma unroll
            for (int ni = 0; ni < 4; ++ni) acc[mi][ni] = (f32x4){0.f, 0.f, 0.f, 0.f};
        const bf16_t* Ag = A + (size_t)m0 * K;
        const bf16_t* Bg = Bt + (size_t)n0 * K;
        const bf16_t* ag = Ag + (size_t)(wave * 32 + (lane >> 3)) * K + (((lane & 7) ^ (lane >> 3)) << 3);
        const bf16_t* bg = Bg + (size_t)(wave * 32 + (lane >> 3)) * K + (((lane & 7) ^ (lane >> 3)) << 3);
#pragma unroll
        for (int j = 0; j < 4; ++j) {
            __builtin_amdgcn_global_load_lds((const unsigned*)(ag + (size_t)j * 8 * K), (LAS unsigned*)(smem + (wave * 4 + j) * 1024), 16, 0, 0);
            __builtin_amdgcn_global_load_lds((const unsigned*)(bg + (size_t)j * 8 * K), (LAS unsigned*)(smem + 16384 + (wave * 4 + j) * 1024), 16, 0, 0);
        }
        asm volatile("s_waitcnt vmcnt(0)" ::: "memory");
        __syncthreads();
        for (int kt = 0; kt < nk; ++kt) {
            const unsigned char* cur = smem + (kt & 1) * 32768;
            unsigned char* nxt = smem + ((kt + 1) & 1) * 32768;
            if (kt + 1 < nk) {
                const int k0 = (kt + 1) << 6;
#pragma unroll
                for (int j = 0; j < 4; ++j) {
                    __builtin_amdgcn_global_load_lds((const unsigned*)(ag + (size_t)j * 8 * K + k0), (LAS unsigned*)(nxt + (wave * 4 + j) * 1024), 16, 0, 0);
                    __builtin_amdgcn_global_load_lds((const unsigned*)(bg + (size_t)j * 8 * K + k0), (LAS unsigned*)(nxt + 16384 + (wave * 4 + j) * 1024), 16, 0, 0);
                }
            }
#pragma unroll
            for (int kk = 0; kk < 2; ++kk) {
                bf16x8 af[4], bfr[4];
#pragma unroll
                for (int mi = 0; mi < 4; ++mi) {
                    const int row = wm * 64 + mi * 16 + lr;
                    af[mi] = *(const bf16x8*)(cur + row * 128 + (((kk * 4 + g) ^ (row & 7)) << 4));
                }
#pragma unroll
                for (int ni = 0; ni < 4; ++ni) {
                    const int row = wn * 64 + ni * 16 + lr;
                    bfr[ni] = *(const bf16x8*)(cur + 16384 + row * 128 + (((kk * 4 + g) ^ (row & 7)) << 4));
                }
#pragma unroll
                for (int mi = 0; mi < 4; ++mi)
#pragma unroll
                    for (int ni = 0; ni < 4; ++ni) acc[mi][ni] = mfma16(af[mi], bfr[ni], acc[mi][ni]);
            }
            asm volatile("s_waitcnt vmcnt(0)" ::: "memory");
            __syncthreads();
        }
        float* T = (float*)smem + wave * (64 * 65);
#pragma unroll
        for (int mi = 0; mi < 4; ++mi)
#pragma unroll
            for (int ni = 0; ni < 4; ++ni)
#pragma unroll
                for (int i = 0; i < 4; ++i) T[(mi * 16 + 4 * g + i) * 65 + ni * 16 + lr] = acc[mi][ni][i];
        const int rowbase = m0 + wm * 64, colbase = n0 + wn * 64;
        if (EPI == EPI_INPROJ) {
            epi_inproj(p, ws_, out_, layer, T, rowbase, colbase, lane);
        } else if (EPI == EPI_Y) {
            float* Y = (float*)(ws_ + OFF_Y) + (size_t)rowbase * ldc + colbase + lane;
#pragma unroll 4
            for (int r = 0; r < 64; ++r) Y[(size_t)r * ldc] = T[r * 65 + lane];
        } else {
            bf16_t* U = (bf16_t*)(ws_ + OFF_U) + (size_t)rowbase * ldc + colbase + lane;
#pragma unroll 4
            for (int r = 0; r < 64; ++r) { const float v = fmaxf(T[r * 65 + lane], 0.f); U[(size_t)r * ldc] = f2bf(v * v); }
        }
        __syncthreads();
    }
}

template <int NMAP, int DV>
struct AttnSt { f32x4 O[NMAP][DV / 16]; float m[NMAP]; float l[NMAP]; };
template <int NMAP, int DV>
struct UnitFrags { bf16x8 k[NMAP][2][2]; bf16x8 v[DV / 16]; };

template <int NMAP, int DV>
DI void load_k(UnitFrags<NMAP, DV>& f, const bf16_t* kp, int kstride) {
#pragma unroll
    for (int m = 0; m < NMAP; ++m)
#pragma unroll
        for (int b = 0; b < 2; ++b)
#pragma unroll
            for (int kk = 0; kk < 2; ++kk) f.k[m][b][kk] = *(const bf16x8*)(kp + (size_t)b * 4 * kstride + m * 64 + kk * 32);
}
template <int NMAP, int DV>
DI void load_v(UnitFrags<NMAP, DV>& f, const bf16_t* vp) {
#pragma unroll
    for (int vb = 0; vb < DV / 16; ++vb) f.v[vb] = *(const bf16x8*)(vp + vb * 16 * 32);
}
template <int NMAP, int DV>
DI void load_unit(UnitFrags<NMAP, DV>& f, const bf16_t* kp, int kstride, const bf16_t* vp) {
    load_k<NMAP, DV>(f, kp, kstride);
    load_v<NMAP, DV>(f, vp);
}

template <int NMAP, int DV, bool HASBIAS>
DI void compute_unit(AttnSt<NMAP, DV>& st, const UnitFrags<NMAP, DV>& f, const bf16x8 (&qf)[NMAP][2], float sc, const float (&bias)[8]) {
    bf16x8 pk[NMAP];
#pragma unroll
    for (int m = 0; m < NMAP; ++m) {
        f32x4 sa = (f32x4){0.f, 0.f, 0.f, 0.f}, sb = sa;
        sa = mfma16(f.k[m][0][0], qf[m][0], sa); sa = mfma16(f.k[m][0][1], qf[m][1], sa);
        sb = mfma16(f.k[m][1][0], qf[m][0], sb); sb = mfma16(f.k[m][1][1], qf[m][1], sb);
        float s[8];
#pragma unroll
        for (int j = 0; j < 4; ++j) { s[j] = sa[j] * sc; s[4 + j] = sb[j] * sc; }
        if (HASBIAS) {
#pragma unroll
            for (int j = 0; j < 8; ++j) s[j] += bias[j];
        }
        float mx = fmaxf(fmaxf(fmaxf(s[0], s[1]), fmaxf(s[2], s[3])), fmaxf(fmaxf(s[4], s[5]), fmaxf(s[6], s[7])));
        mx = grp_max(mx);
        const float mnew = fmaxf(st.m[m], mx);
        const float alpha = fexp2(st.m[m] - mnew);
        float ps = 0.f;
#pragma unroll
        for (int j = 0; j < 8; ++j) { s[j] = fexp2(s[j] - mnew); ps += s[j]; }
        st.l[m] = st.l[m] * alpha + ps; st.m[m] = mnew;
#pragma unroll
        for (int vb = 0; vb < DV / 16; ++vb) st.O[m][vb] *= alpha;
        pk[m] = pack8(s[0], s[1], s[2], s[3], s[4], s[5], s[6], s[7]);
    }
#pragma unroll
    for (int vb = 0; vb < DV / 16; ++vb) {
#pragma unroll
        for (int m = 0; m < NMAP; ++m) st.O[m][vb] = mfma16(f.v[vb], pk[m], st.O[m][vb]);
    }
}

template <int NMAP, int DV>
DI void run_segment(AttnSt<NMAP, DV>& st, const bf16x8 (&qf)[NMAP][2], const bf16_t* kp, int kstride, const bf16_t* vp, int vunit,
                    int nunits, float sc) {
    const float nob[8] = {0.f, 0.f, 0.f, 0.f, 0.f, 0.f, 0.f, 0.f};
    UnitFrags<NMAP, DV> cur;
    load_k<NMAP, DV>(cur, kp, kstride);
    for (int u = 0; u < nunits; ++u) {
        const int un = (u + 1 < nunits) ? u + 1 : u;
        load_v<NMAP, DV>(cur, vp + (size_t)u * vunit);
        UnitFrags<NMAP, DV> nxt;
        load_k<NMAP, DV>(nxt, kp + (size_t)un * 32 * kstride, kstride);
        compute_unit<NMAP, DV, false>(st, cur, qf, sc, nob);
#pragma unroll
        for (int m = 0; m < NMAP; ++m)
#pragma unroll
            for (int b = 0; b < 2; ++b)
#pragma unroll
                for (int kk = 0; kk < 2; ++kk) cur.k[m][b][kk] = nxt.k[m][b][kk];
    }
}

template <int NMAP, int DV>
DI void attn_init(AttnSt<NMAP, DV>& st) {
#pragma unroll
    for (int m = 0; m < NMAP; ++m) {
        st.m[m] = -INFINITY; st.l[m] = 0.f;
#pragma unroll
        for (int vb = 0; vb < DV / 16; ++vb) st.O[m][vb] = (f32x4){0.f, 0.f, 0.f, 0.f};
    }
}

template <bool LAT>
DI void item_diffattn(const Params& pin, int l, int seq, int h, int qt, unsigned char* smem, int wave, int lane) {
    const Params& p = pin; unsigned char* const ws_ = opaque_ws(pin.ws); float* const out_ = opaque_out(pin.out); lane = opaque_v(lane);
    const int lr = lane & 15, g = lane >> 4;
    const int nseq = LAT ? 1024 : 256;
    const int tok0 = LAT ? NCTX + seq * 1024 : seq * 256;
    const bf16_t* P = (const bf16_t*)(ws_ + OFF_P);
    const int q0 = LAT ? qt * 16 : qt * 64 + wave * 16;
    bf16x8 qf[2][2];
    {
        const bf16_t* qp = P + (size_t)(tok0 + q0 + lr) * NIN + h * 128 + 8 * g;
#pragma unroll
        for (int m = 0; m < 2; ++m)
#pragma unroll
            for (int kk = 0; kk < 2; ++kk) qf[m][kk] = *(const bf16x8*)(qp + m * 64 + kk * 32);
    }
    AttnSt<2, 128> st;
    attn_init<2, 128>(st);
    const float sc = 0.125f * LOG2E;
    const int krow = (lr >> 2) * 8 + (lr & 3);
    const bf16_t* kn = P + (size_t)(tok0 + krow) * NIN + 512 + h * 128 + 8 * g;
    const bf16_t* vn = (const bf16_t*)(ws_ + OFF_PT_AV) + (size_t)tok0 * 512 + (size_t)(h * 128 + lr) * 32 + 8 * g;
    if (LAT) {
        const size_t hb = (size_t)((seq * 4 + l) * 4 + h);
        const bf16_t* kc = (const bf16_t*)(ws_ + OFF_CAK) + hb * 512 * 128 + krow * 128 + 8 * g;
        const bf16_t* vc = (const bf16_t*)(ws_ + OFF_CAVT) + hb * 128 * 512 + lr * 32 + 8 * g;
        const int u0 = wave * 12, u1 = u0 + 12;
        const int c0 = min(u0, 16), c1 = min(u1, 16), n0 = max(u0, 16) - 16, n1 = max(u1, 16) - 16;
        if (c1 > c0) run_segment<2, 128>(st, qf, kc + (size_t)c0 * 32 * 128, 128, vc + (size_t)c0 * 128 * 32, 128 * 32, c1 - c0, sc);
        if (n1 > n0) run_segment<2, 128>(st, qf, kn + (size_t)n0 * 32 * NIN, NIN, vn + (size_t)n0 * 512 * 32, 512 * 32, n1 - n0, sc);
    } else {
        run_segment<2, 128>(st, qf, kn, NIN, vn, 512 * 32, nseq / 32, sc);
    }
    st.l[0] = grp_sum(st.l[0]); st.l[1] = grp_sum(st.l[1]);
    if (LAT) {
        float* cb = (float*)smem;
        __syncthreads();
        if (wave > 0) {
            float* w = cb + (wave - 1) * 68 * 64 + lane;
#pragma unroll
            for (int m = 0; m < 2; ++m) {
#pragma unroll
                for (int vb = 0; vb < 8; ++vb)
#pragma unroll
                    for (int i = 0; i < 4; ++i) w[((m * 8 + vb) * 4 + i) * 64] = st.O[m][vb][i];
                w[(64 + m) * 64] = st.m[m]; w[(66 + m) * 64] = st.l[m];
            }
        }
        __syncthreads();
        if (wave > 0) return;
        for (int ww = 0; ww < 3; ++ww) {
            const float* w = cb + ww * 68 * 64 + lane;
#pragma unroll
            for (int m = 0; m < 2; ++m) {
                const float mw = w[(64 + m) * 64], lw = w[(66 + m) * 64];
                const float mn = fmaxf(st.m[m], mw);
                const float fa = fexp2(st.m[m] - mn), fb = fexp2(mw - mn);
                st.m[m] = mn; st.l[m] = st.l[m] * fa + lw * fb;
#pragma unroll
                for (int vb = 0; vb < 8; ++vb)
#pragma unroll
                    for (int i = 0; i < 4; ++i) st.O[m][vb][i] = st.O[m][vb][i] * fa + w[((m * 8 + vb) * 4 + i) * 64] * fb;
            }
        }
    }
    const float inv0 = 1.f / st.l[0], inv1 = 1.f / st.l[1];
    const float* lamp = (const float*)(ws_ + OFF_LAM);
    const float lam = lamp[l * 2], lam_init = lamp[l * 2 + 1];
    const float c1 = lam * inv1;
    float ss = 0.f;
#pragma unroll
    for (int vb = 0; vb < 8; ++vb)
#pragma unroll
        for (int i = 0; i < 4; ++i) {
            const float o = st.O[0][vb][i] * inv0 - st.O[1][vb][i] * c1;
            st.O[0][vb][i] = o; ss += o * o;
        }
    ss = grp_sum(ss);
    const float r = rsqrtf(ss * (1.f / 128.f) + LN_EPS) * (1.f - lam_init);
    bf16_t* MIX = (bf16_t*)(ws_ + OFF_MIX) + (size_t)(tok0 + q0 + lr) * 1024 + h * 128;
    const float* gn = p.diff_norm_g + l * 128;
#pragma unroll
    for (int vb = 0; vb < 8; ++vb) {
        const int v = vb * 16 + 4 * g;
        const float4 g4 = *(const float4*)(gn + v);
        uint2 o; o.x = pack2(st.O[0][vb][0] * r * g4.x, st.O[0][vb][1] * r * g4.y);
        o.y = pack2(st.O[0][vb][2] * r * g4.z, st.O[0][vb][3] * r * g4.w);
        *(uint2*)(MIX + v) = o;
    }
}

DI void item_dense(const Params& pin, int seq, int h, int qt, int wave, int lane) {
    const Params& p = pin; unsigned char* const ws_ = opaque_ws(pin.ws); float* const out_ = opaque_out(pin.out); lane = opaque_v(lane);
    const int lr = lane & 15, g = lane >> 4;
    const int tok0 = seq * 256;
    const bf16_t* P = (const bf16_t*)(ws_ + OFF_P);
    const int q0 = qt * 64 + wave * 16;
    bf16x8 qf[1][2];
    {
        const bf16_t* qp = P + (size_t)(tok0 + q0 + lr) * NIN + 1536 + h * 64 + 8 * g;
        qf[0][0] = *(const bf16x8*)(qp); qf[0][1] = *(const bf16x8*)(qp + 32);
    }
    AttnSt<1, 64> st;
    attn_init<1, 64>(st);
    const int krow = (lr >> 2) * 8 + (lr & 3);
    const bf16_t* kn = P + (size_t)(tok0 + krow) * NIN + 1792 + h * 64 + 8 * g;
    const bf16_t* vn = (const bf16_t*)(ws_ + OFF_PT_BV) + (size_t)tok0 * 256 + (size_t)(h * 64 + lr) * 32 + 8 * g;
    run_segment<1, 64>(st, qf, kn, NIN, vn, 256 * 32, 8, 0.125f * LOG2E);
    const float inv = 1.f / grp_sum(st.l[0]);
    bf16_t* MIX = (bf16_t*)(ws_ + OFF_MIX) + (size_t)(tok0 + q0 + lr) * 1024 + 512 + h * 64;
#pragma unroll
    for (int vb = 0; vb < 4; ++vb) {
        uint2 o; o.x = pack2(st.O[0][vb][0] * inv, st.O[0][vb][1] * inv); o.y = pack2(st.O[0][vb][2] * inv, st.O[0][vb][3] * inv);
        *(uint2*)(MIX + vb * 16 + 4 * g) = o;
    }
}

DI void item_na(const Params& pin, int l, int sb, int h, int r, int wave, int lane) {
    const Params& p = pin; unsigned char* const ws_ = opaque_ws(pin.ws); float* const out_ = opaque_out(pin.out); lane = opaque_v(lane);
    const int lr = lane & 15, g = lane >> 4;
    const int tok0 = NCTX + sb * 1024;
    const bf16_t* P = (const bf16_t*)(ws_ + OFF_P);
    const int qc = wave * 16 + lr;
    const int krow = (lr >> 2) * 8 + (lr & 3);
    const int q0 = r * 64 + wave * 16;
    bf16x8 qf[1][2];
    {
        const bf16_t* qp = P + (size_t)(tok0 + q0 + lr) * NIN + 1536 + h * 64 + 8 * g;
        qf[0][0] = *(const bf16x8*)(qp); qf[0][1] = *(const bf16x8*)(qp + 32);
    }
    AttnSt<1, 64> st;
    attn_init<1, 64>(st);
    const float sc = 0.125f * LOG2E;
    {
        const size_t hb = (size_t)((sb * 4 + l) * 4 + h);
        const bf16_t* kc = (const bf16_t*)(ws_ + OFF_CBK) + hb * 512 * 64 + krow * 64 + 8 * g;
        const bf16_t* vc = (const bf16_t*)(ws_ + OFF_CBVT) + hb * 64 * 512 + lr * 32 + 8 * g;
        run_segment<1, 64>(st, qf, kc, 64, vc, 64 * 32, 16, sc);
    }
    const int kr0 = min(max(r - 4, 0), 8);
    const int bs = min(max(wave * 16 - 8, 0), 32);
    const int wstart = min(max(qc - 8, 0), 48);
    const float* rpb = p.nat_rpb + (size_t)(l * 4 + h) * 15 * 31;
    const bf16_t* vbase = (const bf16_t*)(ws_ + OFF_PT_BV) + (size_t)tok0 * 256 + (size_t)(h * 64 + lr) * 32;
    for (int u = 0; u < 8; ++u) {
        const int kr = kr0 + u;
        const int key0 = kr * 64 + bs;
        UnitFrags<1, 64> f;
        const int nl = key0 + 8 * g;
        load_unit<1, 64>(f, P + (size_t)(tok0 + key0 + krow) * NIN + 1792 + h * 64 + 8 * g, NIN, vbase + (size_t)(nl >> 5) * 256 * 32 + (nl & 31));
        float bias[8];
        const float* rrow = rpb + (kr - r + 7) * 31;
#pragma unroll
        for (int j = 0; j < 8; ++j) {
            const int kc = bs + 8 * g + j;
            const bool valid = (kc >= wstart) && (kc < wstart + 16);
            const int dc = min(max(kc - qc + 15, 0), 30);
            bias[j] = valid ? rrow[dc] * LOG2E : -INFINITY;
        }
        compute_unit<1, 64, true>(st, f, qf, sc, bias);
    }
    const float inv = 1.f / grp_sum(st.l[0]);
    bf16_t* MIX = (bf16_t*)(ws_ + OFF_MIX) + (size_t)(tok0 + q0 + lr) * 1024 + 512 + h * 64;
#pragma unroll
    for (int vb = 0; vb < 4; ++vb) {
        uint2 o; o.x = pack2(st.O[0][vb][0] * inv, st.O[0][vb][1] * inv); o.y = pack2(st.O[0][vb][2] * inv, st.O[0][vb][3] * inv);
        *(uint2*)(MIX + vb * 16 + 4 * g) = o;
    }
}

DI float wave_excl_sum(float v, int lane) {
    float x = v;
#pragma unroll
    for (int d = 1; d < 64; d <<= 1) { const float y = __shfl_up(x, d); if (lane >= d) x += y; }
    return x - v;
}
DI float wave_excl_max(float v, int lane, float init) {
    float x = v;
#pragma unroll
    for (int d = 1; d < 64; d <<= 1) { const float y = __shfl_up(x, d); if (lane >= d) x = fmaxf(x, y); }
    const float ex = __shfl_up(x, 1);
    return lane == 0 ? init : fmaxf(init, ex);
}
DI void mlstm_scan(const float* __restrict__ G, int h, int nseq, int dir, float* aA, float* MA, float* FA, float m0, int lane) {
    const int per = nseq >> 6;
    float run = 0.f;
    for (int e = 0; e < per; ++e) {
        const int idx = lane * per + e, pos = dir ? nseq - 1 - idx : idx;
        const float f = G[(size_t)pos * 16 + (dir ? 12 : 4) + h];
        const float lf = fminf(f, 0.f) - log1pf(expf(-fabsf(f)));
        run += lf; FA[pos] = run;
    }
    const float off = wave_excl_sum(run, lane);
    float rmax = -INFINITY;
    for (int e = 0; e < per; ++e) {
        const int idx = lane * per + e, pos = dir ? nseq - 1 - idx : idx;
        const float F = FA[pos] + off; FA[pos] = F;
        const float a = G[(size_t)pos * 16 + (dir ? 8 : 0) + h] - F;
        aA[pos] = a; rmax = fmaxf(rmax, a); MA[pos] = rmax;
    }
    const float pre = wave_excl_max(rmax, lane, m0);
    for (int e = 0; e < per; ++e) {
        const int idx = lane * per + e, pos = dir ? nseq - 1 - idx : idx;
        MA[pos] = fmaxf(MA[pos], pre);
    }
}

DI void mlstm_pass(f32x4 (&O)[4], float& den, int dir, int t, const bf16x8 (&qf)[2], const bf16_t* kbase, const bf16_t* vbase, int nseq,
                   const float* aA, float Mt, int u_lo, int u_hi, int g) {
    if (u_lo > u_hi) return;
    UnitFrags<1, 64> f;
    load_k<1, 64>(f, kbase + (size_t)u_lo * 32 * NIN, NIN);
    for (int u = u_lo; u <= u_hi; ++u) {
        const int key0 = u * 32;
        const int un = (u < u_hi) ? u + 1 : u;
        load_v<1, 64>(f, vbase + (size_t)u * 256 * 32);
        UnitFrags<1, 64> nx;
        load_k<1, 64>(nx, kbase + (size_t)un * 32 * NIN, NIN);
        f32x4 sa = (f32x4){0.f, 0.f, 0.f, 0.f}, sb = sa;
        sa = mfma16(f.k[0][0][0], qf[0], sa); sa = mfma16(f.k[0][0][1], qf[1], sa);
        sb = mfma16(f.k[0][1][0], qf[0], sb); sb = mfma16(f.k[0][1][1], qf[1], sb);
        const float4 a0 = *(const float4*)(aA + key0 + 8 * g), a1 = *(const float4*)(aA + key0 + 8 * g + 4);
        const float av[8] = {a0.x, a0.y, a0.z, a0.w, a1.x, a1.y, a1.z, a1.w};
        float pv[8];
#pragma unroll
        for (int j = 0; j < 8; ++j) {
            const int key = key0 + 8 * g + j;
            const bool ok = dir ? (key >= t) : (key <= t);
            const float w = ok ? fexp2((av[j] - Mt) * LOG2E) : 0.f;
            const float sv = (j < 4) ? sa[j & 3] : sb[j & 3];
            pv[j] = sv * 0.125f * w;
            den += pv[j];
        }
        const bf16x8 pk = pack8(pv[0], pv[1], pv[2], pv[3], pv[4], pv[5], pv[6], pv[7]);
#pragma unroll
        for (int vb = 0; vb < 4; ++vb) O[vb] = mfma16(f.v[vb], pk, O[vb]);
#pragma unroll
        for (int b = 0; b < 2; ++b)
#pragma unroll
            for (int kk = 0; kk < 2; ++kk) f.k[0][b][kk] = nx.k[0][b][kk];
    }
}

template <bool LAT>
DI void item_mlstm(const Params& pin, int l, int seq, int h, int qt, unsigned char* smem, int wave, int lane) {
    const Params& p = pin; unsigned char* const ws_ = opaque_ws(pin.ws); float* const out_ = opaque_out(pin.out); lane = opaque_v(lane);
    const int lr = lane & 15, g = lane >> 4;
    const int nseq = LAT ? 1024 : 256;
    const int tok0 = LAT ? NCTX + seq * 1024 : seq * 256;
    float* aF = (float*)smem; float* MF = aF + 1024; float* FF = MF + 1024;
    float* aB = FF + 1024; float* MB = aB + 1024; float* FB = MB + 1024;
    float* cb = FB + 1024;
    const float* G = (const float*)(ws_ + OFF_G) + (size_t)tok0 * 16;
    float m0f = 0.f, m0b = 0.f;
    const int sidx_f = ((seq * 4 + l) * 2 + 0) * 4 + h, sidx_b = ((seq * 4 + l) * 2 + 1) * 4 + h;
    if (LAT) { m0f = p.state_m[sidx_f]; m0b = p.state_m[sidx_b]; }
    __syncthreads();
    if (wave == 0) mlstm_scan(G, h, nseq, 0, aF, MF, FF, m0f, lane);
    if (wave == 1) mlstm_scan(G, h, nseq, 1, aB, MB, FB, m0b, lane);
    __syncthreads();
    const bf16_t* P = (const bf16_t*)(ws_ + OFF_P);
    const int q0 = LAT ? qt * 16 : qt * 64 + wave * 16;
    const int t = q0 + lr;
    bf16x8 qf[2];
    {
        const bf16_t* qp = P + (size_t)(tok0 + t) * NIN + 2304 + h * 64 + 8 * g;
        qf[0] = *(const bf16x8*)(qp); qf[1] = *(const bf16x8*)(qp + 32);
    }
    const bf16_t* kbase = P + (size_t)(tok0 + (lr >> 2) * 8 + (lr & 3)) * NIN + 2560 + h * 64 + 8 * g;
    const bf16_t* vbase = (const bf16_t*)(ws_ + OFF_PT_CV) + (size_t)tok0 * 256 + (size_t)(h * 64 + lr) * 32 + 8 * g;
    const float Mf = MF[t], Mb = MB[t], Ff = FF[t], Fb = FB[t];
    f32x4 Of[4], Ob[4];
#pragma unroll
    for (int vb = 0; vb < 4; ++vb) { Of[vb] = (f32x4){0.f, 0.f, 0.f, 0.f}; Ob[vb] = Of[vb]; }
    float denf = 0.f, denb = 0.f;
    const int fhi = (q0 + 15) >> 5, blo = q0 >> 5, bhi = (nseq >> 5) - 1;
    if (!LAT) {
        mlstm_pass(Of, denf, 0, t, qf, kbase, vbase, nseq, aF, Mf, 0, fhi, g);
        mlstm_pass(Ob, denb, 1, t, qf, kbase, vbase, nseq, aB, Mb, blo, bhi, g);
    } else {
        const int dir = wave >> 1, half = wave & 1;
        const int lo = dir ? blo : 0, hi = dir ? bhi : fhi;
        const int mid = lo + ((hi - lo + 1) >> 1);
        mlstm_pass(Of, denf, dir, t, qf, kbase, vbase, nseq, dir ? aB : aF, dir ? Mb : Mf, half ? mid : lo, half ? hi : mid - 1, g);
        if (half == 0) {
            const bf16_t* qp2 = P + (size_t)(tok0 + t) * NIN + 2304 + h * 64 + 4 * g;
            const int sidx = dir ? sidx_b : sidx_f;
            const float e = fexp2(((dir ? m0b : m0f) - (dir ? Mb : Mf)) * LOG2E) * 0.125f;
            const bf16_t* c0t = (const bf16_t*)(ws_ + OFF_C0T) + (size_t)sidx * 4096 + lr * 64 + 4 * g;
            const float* n0 = p.state_n + (size_t)sidx * 64;
            float dacc = 0.f;
#pragma unroll
            for (int u2 = 0; u2 < 2; ++u2) {
                const bf16x4 qa = *(const bf16x4*)(qp2 + u2 * 32), qb = *(const bf16x4*)(qp2 + u2 * 32 + 16);
                const float4 na = *(const float4*)(n0 + u2 * 32 + 4 * g), nb = *(const float4*)(n0 + u2 * 32 + 16 + 4 * g);
                float pv[8];
#pragma unroll
                for (int j = 0; j < 4; ++j) { pv[j] = bf2f((unsigned short)qa[j]) * e; pv[4 + j] = bf2f((unsigned short)qb[j]) * e; }
                dacc += pv[0] * na.x + pv[1] * na.y + pv[2] * na.z + pv[3] * na.w + pv[4] * nb.x + pv[5] * nb.y + pv[6] * nb.z + pv[7] * nb.w;
                const bf16x8 pk = pack8(pv[0], pv[1], pv[2], pv[3], pv[4], pv[5], pv[6], pv[7]);
#pragma unroll
                for (int vb = 0; vb < 4; ++vb) {
                    const bf16_t* cp = c0t + (size_t)vb * 16 * 64 + u2 * 32;
                    const bf16x8 cf = cat4(*(const bf16x4*)(cp), *(const bf16x4*)(cp + 16));
                    Of[vb] = mfma16(cf, pk, Of[vb]);
                }
            }
            denf += dacc;
        }
        if (wave > 0) {
            float* w = cb + (wave - 1) * 17 * 64 + lane;
#pragma unroll
            for (int vb = 0; vb < 4; ++vb)
#pragma unroll
                for (int i = 0; i < 4; ++i) w[(vb * 4 + i) * 64] = Of[vb][i];
            w[16 * 64] = denf;
        }
        __syncthreads();
        if (wave > 0) return;
        {
            const float* w1 = cb + lane; const float* w2 = cb + 17 * 64 + lane; const float* w3 = cb + 2 * 17 * 64 + lane;
#pragma unroll
            for (int vb = 0; vb < 4; ++vb)
#pragma unroll
                for (int i = 0; i < 4; ++i) {
                    Of[vb][i] += w1[(vb * 4 + i) * 64];
                    Ob[vb][i] = w2[(vb * 4 + i) * 64] + w3[(vb * 4 + i) * 64];
                }
            denf += w1[16 * 64]; denb = w2[16 * 64] + w3[16 * 64];
        }
    }
    denf = grp_sum(denf); denb = grp_sum(denb);
    const float rf = 1.f / fmaxf(fabsf(denf), expf(-(Ff + Mf)));
    const float rb = 1.f / fmaxf(fabsf(denb), expf(-(Fb + Mb)));
    float ss = 0.f;
#pragma unroll
    for (int vb = 0; vb < 4; ++vb)
#pragma unroll
        for (int i = 0; i < 4; ++i) { const float hs = Of[vb][i] * rf + Ob[vb][i] * rb; Of[vb][i] = hs; ss += hs * hs; }
    ss = grp_sum(ss);
    const float rn = rsqrtf(ss * (1.f / 64.f) + LN_EPS);
    const float* gn = p.mlstm_norm_g + (size_t)(l * 4 + h) * 64;
    const bf16_t* op = P + (size_t)(tok0 + t) * NIN + 3072 + h * 64;
    bf16_t* MIX = (bf16_t*)(ws_ + OFF_MIX) + (size_t)(tok0 + t) * 1024 + 768 + h * 64;
#pragma unroll
    for (int vb = 0; vb < 4; ++vb) {
        const int v = vb * 16 + 4 * g;
        const float4 g4 = *(const float4*)(gn + v);
        const bf16x4 o4 = *(const bf16x4*)(op + v);
        float sg[4];
#pragma unroll
        for (int i = 0; i < 4; ++i) sg[i] = 1.f / (1.f + __expf(-bf2f((unsigned short)o4[i])));
        uint2 o; o.x = pack2(Of[vb][0] * rn * g4.x * sg[0], Of[vb][1] * rn * g4.y * sg[1]);
        o.y = pack2(Of[vb][2] * rn * g4.z * sg[2], Of[vb][3] * rn * g4.w * sg[3]);
        *(uint2*)(MIX + v) = o;
    }
}

DI void item_mlstm_state(const Params& pin, int l, int b, int h, int dir, unsigned char* smem, int wave, int lane) {
    const Params& p = pin; unsigned char* const ws_ = opaque_ws(pin.ws); float* const out_ = opaque_out(pin.out); lane = opaque_v(lane);
    const int lr = lane & 15, g = lane >> 4;
    const int tok0 = b * 256;
    float* aA = (float*)smem; float* MA = aA + 1024; float* FA = MA + 1024;
    const float* G = (const float*)(ws_ + OFF_G) + (size_t)tok0 * 16;
    __syncthreads();
    if (wave == 0) mlstm_scan(G, h, 256, dir, aA, MA, FA, 0.f, lane);
    __syncthreads();
    const float Mfin = dir ? MA[0] : MA[255];
    const float Ffin = dir ? FA[0] : FA[255];
    const bf16_t* KT = (const bf16_t*)(ws_ + OFF_PT_CK) + (size_t)tok0 * 256 + (size_t)(h * 64 + wave * 16 + lr) * 32 + 8 * g;
    const bf16_t* VT = (const bf16_t*)(ws_ + OFF_PT_CV) + (size_t)tok0 * 256 + (size_t)(h * 64 + lr) * 32 + 8 * g;
    f32x4 C[4];
#pragma unroll
    for (int vb = 0; vb < 4; ++vb) C[vb] = (f32x4){0.f, 0.f, 0.f, 0.f};
    float nacc = 0.f;
    for (int u = 0; u < 8; ++u) {
        const int s0 = u * 32;
        const bf16x8 kf = *(const bf16x8*)(KT + (size_t)u * 256 * 32);
        const float4 a0 = *(const float4*)(aA + s0 + 8 * g), a1 = *(const float4*)(aA + s0 + 8 * g + 4);
        const float av[8] = {a0.x, a0.y, a0.z, a0.w, a1.x, a1.y, a1.z, a1.w};
        float kw[8];
#pragma unroll
        for (int j = 0; j < 8; ++j) { kw[j] = bf2f((unsigned short)kf[j]) * fexp2((av[j] - Mfin) * LOG2E); nacc += kw[j]; }
        const bf16x8 af = pack8(kw[0], kw[1], kw[2], kw[3], kw[4], kw[5], kw[6], kw[7]);
#pragma unroll
        for (int vb = 0; vb < 4; ++vb) {
            const bf16x8 vf = *(const bf16x8*)(VT + (size_t)u * 256 * 32 + vb * 16 * 32);
            C[vb] = mfma16(af, vf, C[vb]);
        }
    }
    const size_t sidx = (size_t)((b * 4 + l) * 2 + dir) * 4 + h;
    float* oc = out_ + O_NC + sidx * 4096;
#pragma unroll
    for (int vb = 0; vb < 4; ++vb)
#pragma unroll
        for (int i = 0; i < 4; ++i) oc[(wave * 16 + 4 * g + i) * 64 + vb * 16 + lr] = C[vb][i];
    nacc = grp_sum(nacc);
    if (g == 0) out_[O_NN + sidx * 64 + wave * 16 + lr] = nacc;
    if (wave == 0 && lane == 0) out_[O_NM + sidx] = Ffin + Mfin;
}

DI void mixer_phase(const Params& p, int l, unsigned char* smem) {
    const int tid_ = opaque_v(threadIdx.x); const int lane = tid_ & 63, wave = tid_ >> 6;
    for (int it = blockIdx.x; it < 2048; it += gridDim.x) {
        if (it < 512) { item_diffattn<true>(p, l, it >> 8, (it >> 6) & 3, it & 63, smem, wave, lane); }
        else if (it < 1024) { const int i = it - 512; item_mlstm<true>(p, l, i >> 8, (i >> 6) & 3, i & 63, smem, wave, lane); }
        else if (it < 1152) { const int i = it - 1024; item_na(p, l, i >> 6, (i >> 4) & 3, i & 15, wave, lane); }
        else if (it < 1408) { const int i = it - 1152; item_diffattn<false>(p, l, i >> 4, (i >> 2) & 3, i & 3, smem, wave, lane); }
        else if (it < 1664) { const int i = it - 1408; item_mlstm<false>(p, l, i >> 4, (i >> 2) & 3, i & 3, smem, wave, lane); }
        else if (it < 1920) { const int i = it - 1664; item_dense(p, i >> 4, (i >> 2) & 3, i & 3, wave, lane); }
        else { const int i = it - 1920; item_mlstm_state(p, l, i >> 3, (i >> 1) & 3, i & 1, smem, wave, lane); }
    }
}

#define XB_TMO      128
#define XB_XCNT(j)  (256  + 64 * (j))
#define XB_XSUB(j)  (1280 + 64 * (j))
#define XB_XGEN(j)  (2304 + 64 * (j))
#define XB_TOP      3328
#define XB_TOPGEN   3392
#define XCD_BAR_WORDS 3456
#define XB_SPIN_CAP (1u << 18)

__device__ __forceinline__ unsigned xb_ld(unsigned* p)              { return __hip_atomic_load(p, __ATOMIC_RELAXED, __HIP_MEMORY_SCOPE_AGENT); }
__device__ __forceinline__ unsigned xb_add(unsigned* p, unsigned v) { return __hip_atomic_fetch_add(p, v, __ATOMIC_RELAXED, __HIP_MEMORY_SCOPE_AGENT); }
__device__ __forceinline__ unsigned xb_xcc_id() { return (unsigned)__builtin_amdgcn_s_getreg((3 << 11) | 20) & 0xFu; }
#define XB_SPIN(cond, bar) do { unsigned _sp = 0; while (cond) { __builtin_amdgcn_s_sleep(1); \
    if ((++_sp & 255u) == 0u) { if (xb_ld(&(bar)[XB_TMO])) break; if (_sp > XB_SPIN_CAP) { atomicAdd(&(bar)[XB_TMO], 1u); break; } } } } while (0)

struct XcdBarrier {
    unsigned* bar; unsigned x;
    volatile LAS unsigned* st;
};

__device__ __forceinline__ XcdBarrier xcd_barrier_post(unsigned* bar, volatile LAS unsigned* st) {
    XcdBarrier b; b.bar = bar; b.x = xb_xcc_id(); b.st = st;
    if (threadIdx.x == 0) (void)xb_add(&bar[XB_XCNT(b.x)], 1u);
    return b;
}
__device__ __forceinline__ void xcd_barrier_complete(unsigned* bar, unsigned x, unsigned& nloc, unsigned& nx) {
    const unsigned G = gridDim.x * gridDim.y * gridDim.z;
    unsigned sum, cnt, mine, sp = 0u;
    for (;;) {
        sum = 0u; cnt = 0u; mine = 0u;
#pragma unroll
        for (unsigned j = 0; j < 16; ++j) { const unsigned c = xb_ld(&bar[XB_XCNT(j)]); sum += c; cnt += (c > 0u) ? 1u : 0u; mine = (j == x) ? c : mine; }
        if (sum == G) break;
        __builtin_amdgcn_s_sleep(1);
        if ((++sp & 255u) == 0u) { if (xb_ld(&bar[XB_TMO])) break; if (sp > XB_SPIN_CAP) { atomicAdd(&bar[XB_TMO], 1u); break; } }
    }
    nloc = mine > 0u ? mine : 1u; nx = cnt > 0u ? cnt : 1u;
}

__device__ __forceinline__ void xcd_barrier(const XcdBarrier& b) {
    asm volatile("s_waitcnt vmcnt(0)" ::: "memory");
    __syncthreads();
    if (threadIdx.x == 0) {
        unsigned* bar = b.bar;
        __builtin_amdgcn_s_waitcnt(0);
        unsigned nloc = b.st[0], nx = b.st[1];
        if (nloc == 0u) { xcd_barrier_complete(bar, b.x, nloc, nx); b.st[0] = nloc; b.st[1] = nx; }
        const unsigned old = xb_add(&bar[XB_XSUB(b.x)], 1u);
        const unsigned gen = old / nloc;
        if (old + 1u == (gen + 1u) * nloc) {
            __builtin_amdgcn_fence(__ATOMIC_RELEASE, "agent");
            asm volatile("s_waitcnt vmcnt(0)" ::: "memory");
            const unsigned og = xb_add(&bar[XB_TOP], 1u);
            const unsigned tg = og / nx;
            if (og + 1u == (tg + 1u) * nx) xb_add(&bar[XB_TOPGEN], 1u);
            else XB_SPIN(xb_ld(&bar[XB_TOPGEN]) == tg, bar);
            __builtin_amdgcn_fence(__ATOMIC_ACQUIRE, "agent");
            xb_add(&bar[XB_XGEN(b.x)], 1u);
            asm volatile("s_waitcnt vmcnt(0)" ::: "memory");
        } else {
            XB_SPIN(xb_ld(&bar[XB_XGEN(b.x)]) == gen, bar);
            __builtin_amdgcn_fence(__ATOMIC_ACQUIRE, "agent");
            asm volatile("s_waitcnt vmcnt(0)" ::: "memory");
        }
    }
    __syncthreads();
}


constexpr int N_PHASES = 2 + 7 * 4;

__global__ void __launch_bounds__(256, 2) fwd_kernel(Params p) {
    __shared__ __attribute__((aligned(16))) unsigned char smem[66560 + 16];
    if (threadIdx.x == 0) *(uint4*)(smem + 66560) = make_uint4(0u, 0u, 0u, 0u);
    __syncthreads();
    XcdBarrier xb = xcd_barrier_post((unsigned*)(p.ws + OFF_BAR), (volatile LAS unsigned*)(smem + 66560));
    for (int ph = p.ph_lo; ph < p.ph_hi; ++ph) {
        if (ph > p.ph_lo) {
            if (p.ph_hi > 1000) cg::this_grid().sync();
            xcd_barrier(xb);
        }
        const int l = ph < 2 ? 0 : (ph - 2) / 7, s = ph < 2 ? ph - 2 : (ph - 2) % 7;
        const int bit = 1 << (s + 2);
        const int reps = (DUPM & bit) ? 2 : 1;
        for (int rep = 0; rep < reps; ++rep) {
            if (rep) __syncthreads();
            if (s == -2) prep0(p, smem);
            else if (s == -1) prep1(p);
            else if (s == 0) gemm_phase<EPI_INPROJ>(p, l, OFF_H, OFF_WT_IN + (size_t)l * NINP * DM * 2, NINP / 128, 1024, 0, smem);
            else if (s == 1) mixer_phase(p, l, smem);
            else if (s == 2) gemm_phase<EPI_Y>(p, l, OFF_MIX, OFF_WT_OUT + (size_t)l * DM * DM * 2, 8, 1024, 1024, smem);
            else if (s == 3) ln_phase<1>(p, l);
            else if (s == 4) gemm_phase<EPI_RELU2>(p, l, OFF_H, OFF_WT_1 + (size_t)l * DFF * DM * 2, 32, 1024, 4096, smem);
            else if (s == 5) gemm_phase<EPI_Y>(p, l, OFF_U, OFF_WT_2 + (size_t)l * DM * DFF * 2, 8, 4096, 1024, smem);
            else ln_phase<2>(p, l);
        }
    }
}

extern "C" void kernel_launch(void* const* d_in, const int* in_sizes, int n_in, void* d_out, int out_size, void* d_ws, size_t ws_size,
                              hipStream_t stream) {
    static int grid = 0;
    if (grid == 0) {
        if (n_in != 26 || ws_size < WS_END) { fprintf(stderr, "kernel_launch: unexpected n_in %d / ws %zu (need %zu)\n", n_in, ws_size, (size_t)WS_END); grid = -1; return; }
        int dev = 0, cus = 0, per_cu = 0;
        hipGetDevice(&dev);
        hipDeviceGetAttribute(&cus, hipDeviceAttributeMultiprocessorCount, dev);
        hipOccupancyMaxActiveBlocksPerMultiprocessor(&per_cu, (const void*)fwd_kernel, 256, 0);
        if (per_cu < 1) per_cu = 1;
        if (per_cu > 2) per_cu = 2;
        grid = cus * per_cu;
    }
    if (grid < 0) return;
    Params p{};
    const float** pp = (const float**)&p;
    for (int i = 0; i < 26; ++i) pp[i] = (const float*)d_in[i];
    p.out = (float*)d_out; p.ws = (unsigned char*)d_ws;
    (void)hipMemsetAsync((unsigned char*)d_ws + OFF_BAR, 0, 16384, stream);
#if SINGLE_LAUNCH
    p.ph_lo = 0; p.ph_hi = N_PHASES;
    void* args[] = {&p};
    hipError_t e = hipLaunchCooperativeKernel((const void*)fwd_kernel, dim3(grid), dim3(256), args, 0, stream);
    if (e != hipSuccess) fprintf(stderr, "cooperative launch failed: %s (grid %d)\n", hipGetErrorString(e), grid);
#else
    for (int ph = 0; ph < N_PHASES; ++ph) {
        p.ph_lo = ph; p.ph_hi = ph + 1;
        void* args[] = {&p};
        hipError_t e = hipLaunchCooperativeKernel((const void*)fwd_kernel, dim3(grid), dim3(256), args, 0, stream);
        if (e != hipSuccess) { fprintf(stderr, "launch %d failed: %s (grid %d)\n", ph, hipGetErrorString(e), grid); break; }
    }
#endif
}
```

```cpp
#include <hip/hip_runtime.h>
#include <hip/hip_cooperative_groups.h>
#include <cstdio>
namespace cg = cooperative_groups;

#ifndef IM
#define IM 0xffff
#endif
#ifndef IM
#define IM 0xffff
#endif
#ifndef DUPM
#define DUPM 0
#endif
#ifndef PHM
#define PHM 0xffff
#endif
#ifndef SINGLE_LAUNCH
#define SINGLE_LAUNCH 1
#endif

#define LAS __attribute__((address_space(3)))
typedef unsigned short bf16_t;
typedef __attribute__((ext_vector_type(8))) short bf16x8;
typedef __attribute__((ext_vector_type(4))) short bf16x4;
typedef __attribute__((ext_vector_type(4))) float f32x4;
#define DI __device__ __forceinline__

constexpr int NTOK = 6144, NCTX = 4096, DM = 1024, NIN = 3344, NINP = 3456, DFF = 4096;
constexpr float ALPHA = 1.681792830507429f;
constexpr float LOG2E = 1.4426950408889634f;
constexpr float LN_EPS = 1e-5f;

constexpr size_t al256(size_t x) { return (x + 255) & ~(size_t)255; }
constexpr size_t OFF_WT_IN = 0;
constexpr size_t OFF_WT_OUT = OFF_WT_IN + al256((size_t)4 * NINP * DM * 2);
constexpr size_t OFF_WT_1 = OFF_WT_OUT + al256((size_t)4 * DM * DM * 2);
constexpr size_t OFF_WT_2 = OFF_WT_1 + al256((size_t)4 * DFF * DM * 2);
constexpr size_t OFF_MOD = OFF_WT_2 + al256((size_t)4 * DFF * DM * 2);
constexpr size_t OFF_X = OFF_MOD + al256((size_t)4 * 3 * 6144 * 4);
constexpr size_t OFF_H = OFF_X + al256((size_t)NTOK * DM * 4);
constexpr size_t OFF_P = OFF_H + al256((size_t)NTOK * DM * 2);
constexpr size_t OFF_PT_AV = OFF_P + al256((size_t)NTOK * NIN * 2);
constexpr size_t OFF_PT_BV = OFF_PT_AV + al256((size_t)NTOK * 512 * 2);
constexpr size_t OFF_PT_CV = OFF_PT_BV + al256((size_t)NTOK * 256 * 2);
constexpr size_t OFF_PT_CK = OFF_PT_CV + al256((size_t)NTOK * 256 * 2);
constexpr size_t OFF_G = OFF_PT_CK + al256((size_t)NTOK * 256 * 2);
constexpr size_t OFF_MIX = OFF_G + al256((size_t)NTOK * 16 * 4);
constexpr size_t OFF_Y = OFF_MIX + al256((size_t)NTOK * DM * 2);
constexpr size_t OFF_U = OFF_Y + al256((size_t)NTOK * DM * 4);
constexpr size_t OFF_CAK = OFF_U + al256((size_t)NTOK * DFF * 2);
constexpr size_t OFF_CAVT = OFF_CAK + al256((size_t)32 * 512 * 128 * 2);
constexpr size_t OFF_CBK = OFF_CAVT + al256((size_t)32 * 512 * 128 * 2);
constexpr size_t OFF_CBVT = OFF_CBK + al256((size_t)32 * 512 * 64 * 2);
constexpr size_t OFF_C0T = OFF_CBVT + al256((size_t)32 * 512 * 64 * 2);
constexpr size_t OFF_ROPE = OFF_C0T + al256((size_t)64 * 64 * 64 * 2);
constexpr size_t OFF_LAM = OFF_ROPE + al256((size_t)2 * 1024 * 4);
constexpr size_t OFF_BAR = OFF_LAM + 256;
constexpr size_t OFF_LNCNT = OFF_BAR + 13824;
constexpr size_t OFF_STATS = OFF_BAR + 16384;
constexpr size_t WS_END = OFF_STATS + (size_t)NTOK * 16 * 8;

constexpr size_t O_YP = 0, O_YS = 4194304, O_AK = 6291456, O_AV = 14680064, O_BK = 23068672, O_BV = 27262976,
                 O_NC = 31457280, O_NN = 33554432, O_NM = 33587200;

struct Params {
    const float* x_prompt; const float* x_sample; const float* cache_a_k; const float* cache_a_v;
    const float* cache_b_k; const float* cache_b_v; const float* state_c; const float* state_n;
    const float* state_m; const float* c; const float* c_ctx; const float* w_in; const float* gate_bias;
    const float* diff_lambda; const float* diff_norm_g; const float* nat_rpb; const float* mlstm_norm_g;
    const float* w_out; const float* ada_w; const float* ada_b; const float* ln1_g; const float* ln1_b;
    const float* ln2_g; const float* ln2_b; const float* w_mlp1; const float* w_mlp2;
    float* out; unsigned char* ws; int ph_lo; int ph_hi;
};

DI int opaque_v(int x) { asm volatile("" : "+v"(x)); return x; }
DI int opaque_s(int x) { x = __builtin_amdgcn_readfirstlane(x); asm volatile("" : "+s"(x)); return x; }
DI size_t opaque_zero() { size_t z = 0; asm volatile("" : "+s"(z)); return z; }
DI unsigned char* opaque_ws(unsigned char* w) { return w + opaque_zero(); }
DI float* opaque_out(float* w) { return w + opaque_zero(); }
DI unsigned short f2bf(float x) { unsigned u = __float_as_uint(x); u += 0x7fffu + ((u >> 16) & 1u); return (unsigned short)(u >> 16); }
DI float bf2f(unsigned short h) { return __uint_as_float(((unsigned)h) << 16); }
DI unsigned pack2(float a, float b) { return (unsigned)f2bf(a) | ((unsigned)f2bf(b) << 16); }
DI f32x4 mfma16(bf16x8 a, bf16x8 b, f32x4 c) { return __builtin_amdgcn_mfma_f32_16x16x32_bf16(a, b, c, 0, 0, 0); }
DI float fexp2(float x) { return __builtin_amdgcn_exp2f(x); }
DI bf16x8 pack8(float a0, float a1, float a2, float a3, float a4, float a5, float a6, float a7) {
    uint4 u; u.x = pack2(a0, a1); u.y = pack2(a2, a3); u.z = pack2(a4, a5); u.w = pack2(a6, a7);
    return __builtin_bit_cast(bf16x8, u);
}
DI bf16x8 cat4(bf16x4 a, bf16x4 b) { return __builtin_shufflevector(a, b, 0, 1, 2, 3, 4, 5, 6, 7); }
DI float wave_sum(float v) {
#pragma unroll
    for (int o = 32; o > 0; o >>= 1) v += __shfl_xor(v, o);
    return v;
}
DI float grp_sum(float v) { v += __shfl_xor(v, 16); v += __shfl_xor(v, 32); return v; }
DI float grp_max(float v) { v = fmaxf(v, __shfl_xor(v, 16)); v = fmaxf(v, __shfl_xor(v, 32)); return v; }

DI void transpose_job(const float* __restrict__ src, bf16_t* __restrict__ dst, int R, int C, int Cpad, int nmat, float* tile, bool blocked = false) {
    const int tid = threadIdx.x;
    const int rt = R >> 6, ct = Cpad >> 6, per = rt * ct, total = per * nmat;
    for (int it = blockIdx.x; it < total; it += gridDim.x) {
        const int mat = it / per, rem = it - mat * per;
        const int r0 = (rem / ct) << 6, c0 = (rem % ct) << 6;
        const float* s = src + (size_t)mat * R * C;
        bf16_t* d = dst + (size_t)mat * Cpad * R;
#pragma unroll
        for (int i = 0; i < 4; ++i) {
            const int r = (tid >> 4) + 16 * i, c = (tid & 15) * 4;
            float4 v = make_float4(0.f, 0.f, 0.f, 0.f);
            if (c0 + c < C) v = *(const float4*)(s + (size_t)(r0 + r) * C + c0 + c);
            tile[r * 65 + c + 0] = v.x; tile[r * 65 + c + 1] = v.y; tile[r * 65 + c + 2] = v.z; tile[r * 65 + c + 3] = v.w;
        }
        __syncthreads();
        {
            const int c = tid >> 2, rs = (tid & 3) * 16;
            uint4 o0, o1;
            o0.x = pack2(tile[(rs + 0) * 65 + c], tile[(rs + 1) * 65 + c]);
            o0.y = pack2(tile[(rs + 2) * 65 + c], tile[(rs + 3) * 65 + c]);
            o0.z = pack2(tile[(rs + 4) * 65 + c], tile[(rs + 5) * 65 + c]);
            o0.w = pack2(tile[(rs + 6) * 65 + c], tile[(rs + 7) * 65 + c]);
            o1.x = pack2(tile[(rs + 8) * 65 + c], tile[(rs + 9) * 65 + c]);
            o1.y = pack2(tile[(rs + 10) * 65 + c], tile[(rs + 11) * 65 + c]);
            o1.z = pack2(tile[(rs + 12) * 65 + c], tile[(rs + 13) * 65 + c]);
            o1.w = pack2(tile[(rs + 14) * 65 + c], tile[(rs + 15) * 65 + c]);
            uint4* dp = blocked ? (uint4*)(d + ((size_t)((r0 + rs) >> 5) * Cpad + (c0 + c)) * 32 + ((r0 + rs) & 31))
                                : (uint4*)(d + (size_t)(c0 + c) * R + r0 + rs);
            dp[0] = o0; dp[1] = o1;
        }
        __syncthreads();
    }
}

DI void convert_job(const float* __restrict__ src, bf16_t* __restrict__ dst, size_t n) {
    for (size_t i = ((size_t)blockIdx.x * 256 + threadIdx.x) * 8; i < n; i += (size_t)gridDim.x * 256 * 8) {
        const float4 a = *(const float4*)(src + i), b = *(const float4*)(src + i + 4);
        uint4 o; o.x = pack2(a.x, a.y); o.y = pack2(a.z, a.w); o.z = pack2(b.x, b.y); o.w = pack2(b.z, b.w);
        *(uint4*)(dst + i) = o;
    }
}

DI void prep0(const Params& pin, unsigned char* smem) {
    const Params& p = pin; unsigned char* const ws_ = opaque_ws(pin.ws); float* const out_ = opaque_out(pin.out); const int tid = opaque_v(threadIdx.x);
    {
        float* sl = (float*)smem; float* red = (float*)(smem + 12288);
        for (int i = tid; i < 3072; i += 256) {
            const int cnd = i >> 10, k = i & 1023;
            const float v = (cnd == 0) ? p.c_ctx[k] : p.c[(cnd - 1) * 1024 + k];
            sl[i] = v / (1.f + __expf(-v));
        }
        __syncthreads();
        float* mod = (float*)(ws_ + OFF_MOD);
        const int kg = tid >> 4, cl = tid & 15;
        for (int it = blockIdx.x; it < 384; it += gridDim.x) {
            const int l = it / 96, j0 = (it % 96) * 64;
            const float* w = p.ada_w + (size_t)l * 1024 * 6144 + j0 + cl * 4;
            float4 a0 = make_float4(0, 0, 0, 0), a1 = a0, a2 = a0;
#pragma unroll 8
            for (int kk = 0; kk < 64; ++kk) {
                const int k = kg * 64 + kk;
                const float4 wv = *(const float4*)(w + (size_t)k * 6144);
                const float s0 = sl[k], s1 = sl[1024 + k], s2 = sl[2048 + k];
                a0.x += s0 * wv.x; a0.y += s0 * wv.y; a0.z += s0 * wv.z; a0.w += s0 * wv.w;
                a1.x += s1 * wv.x; a1.y += s1 * wv.y; a1.z += s1 * wv.z; a1.w += s1 * wv.w;
                a2.x += s2 * wv.x; a2.y += s2 * wv.y; a2.z += s2 * wv.z; a2.w += s2 * wv.w;
            }
            __syncthreads();
            float* r = red + kg * 192 + cl * 4;
            r[0] = a0.x; r[1] = a0.y; r[2] = a0.z; r[3] = a0.w;
            r[64] = a1.x; r[65] = a1.y; r[66] = a1.z; r[67] = a1.w;
            r[128] = a2.x; r[129] = a2.y; r[130] = a2.z; r[131] = a2.w;
            __syncthreads();
            if (tid < 192) {
                const int cnd = tid >> 6, col = tid & 63;
                float s = 0.f;
#pragma unroll
                for (int q = 0; q < 16; ++q) s += red[q * 192 + tid];
                mod[(l * 3 + cnd) * 6144 + j0 + col] = s + p.ada_b[l * 6144 + j0 + col];
            }
        }
        __syncthreads();
    }
    if (blockIdx.x == gridDim.x - 1) {
        float* rope = (float*)(ws_ + OFF_ROPE);
        for (int i = tid; i < 1024; i += 256) {
            const int pos = i >> 4, j = i & 15;
            const float freq = powf(10000.f, -(float)j / 16.f);
            float s, c; sincosf((float)pos * freq, &s, &c);
            rope[i] = c; rope[1024 + i] = s;
        }
        if (tid < 4) {
            const float* lp = p.diff_lambda + tid * 256;
            float s1 = 0.f, s2 = 0.f;
            for (int i = 0; i < 64; ++i) { s1 += lp[i] * lp[64 + i]; s2 += lp[128 + i] * lp[192 + i]; }
            const float li = 0.8f - 0.6f * expf(-0.3f * (float)tid);
            float* lam = (float*)(ws_ + OFF_LAM);
            lam[tid * 2] = expf(s1) - expf(s2) + li; lam[tid * 2 + 1] = li;
        }
    }
    float* tile = (float*)smem;
    transpose_job(p.w_in, (bf16_t*)(ws_ + OFF_WT_IN), 1024, NIN, NINP, 4, tile);
    transpose_job(p.w_out, (bf16_t*)(ws_ + OFF_WT_OUT), 1024, 1024, 1024, 4, tile);
    transpose_job(p.w_mlp1, (bf16_t*)(ws_ + OFF_WT_1), 1024, 4096, 4096, 4, tile);
    transpose_job(p.w_mlp2, (bf16_t*)(ws_ + OFF_WT_2), 4096, 1024, 1024, 4, tile);
    transpose_job(p.cache_a_v, (bf16_t*)(ws_ + OFF_CAVT), 512, 128, 128, 32, tile, true);
    transpose_job(p.cache_b_v, (bf16_t*)(ws_ + OFF_CBVT), 512, 64, 64, 32, tile, true);
    transpose_job(p.state_c, (bf16_t*)(ws_ + OFF_C0T), 64, 64, 64, 64, tile);
    convert_job(p.cache_a_k, (bf16_t*)(ws_ + OFF_CAK), (size_t)32 * 512 * 128);
    convert_job(p.cache_b_k, (bf16_t*)(ws_ + OFF_CBK), (size_t)32 * 512 * 64);
}

DI void prep1(const Params& pin) {
    const Params& p = pin; unsigned char* const ws_ = opaque_ws(pin.ws); float* const out_ = opaque_out(pin.out); const int tid_ = opaque_v(threadIdx.x); const int lane = tid_ & 63, wave = tid_ >> 6;
    const float* mod = (const float*)(ws_ + OFF_MOD);
    float* X = (float*)(ws_ + OFF_X);
    bf16_t* H = (bf16_t*)(ws_ + OFF_H);
    for (int row = blockIdx.x * 4 + wave; row < NTOK; row += gridDim.x * 4) {
        const float* src = row < NCTX ? p.x_prompt + (size_t)row * 1024 : p.x_sample + (size_t)(row - NCTX) * 1024;
        const int cnd = row < NCTX ? 0 : 1 + ((row - NCTX) >> 10);
        const float* md = mod + (size_t)cnd * 6144;
#pragma unroll
        for (int j = 0; j < 4; ++j) {
            const int c = lane * 4 + 256 * j;
            const float4 v = *(const float4*)(src + c);
            *(float4*)(X + (size_t)row * 1024 + c) = v;
            const float4 sh = *(const float4*)(md + c), sc = *(const float4*)(md + 1024 + c);
            uint2 o; o.x = pack2(v.x * (1.f + sc.x) + sh.x, v.y * (1.f + sc.y) + sh.y);
            o.y = pack2(v.z * (1.f + sc.z) + sh.z, v.w * (1.f + sc.w) + sh.w);
            *(uint2*)(H + (size_t)row * 1024 + c) = o;
        }
    }
}

enum { EPI_INPROJ = 0, EPI_LN1 = 1, EPI_RELU2 = 2, EPI_LN2 = 3 };

DI void epi_inproj(const Params& p, unsigned char* ws_, float* out_, int layer, const float* T, int rowbase, int colbase, int lane) {
    if (colbase >= NIN) return;
    bf16_t* P = (bf16_t*)(ws_ + OFF_P);
    const bool latent = rowbase >= NCTX;
    const int seq_tok0 = latent ? (NCTX + ((rowbase - NCTX) & ~1023)) : (rowbase & ~255);
    const int nseq = latent ? 1024 : 256;
    const int bctx = seq_tok0 >> 8;
    const int n0 = rowbase - seq_tok0;
    if (colbase >= 3328) {
        float* G = (float*)(ws_ + OFF_G);
        const float bias = p.gate_bias[layer * 16 + (lane & 15)];
        for (int rr = 0; rr < 16; ++rr) {
            const int r = rr * 4 + (lane >> 4);
            G[(size_t)(rowbase + r) * 16 + (lane & 15)] = T[r * 65 + (lane & 15)] + bias;
        }
        return;
    }
    bool toP = false, rope = false, toT = false, toO = false;
    size_t toff = 0, obase = 0; int tW = 0, tcr = 0, ohd = 64, ocr = 0;
    if (colbase < 1024) { toP = true; rope = latent; if (colbase >= 512) { toO = !latent; obase = O_AK; ohd = 128; ocr = colbase - 512; } }
    else if (colbase < 1536) { toT = true; toff = OFF_PT_AV; tW = 512; tcr = colbase - 1024; toO = !latent; obase = O_AV; ohd = 128; ocr = tcr; }
    else if (colbase < 1792) { toP = true; }
    else if (colbase < 2048) { toP = true; toO = !latent; obase = O_BK; ohd = 64; ocr = colbase - 1792; }
    else if (colbase < 2304) { toT = true; toff = OFF_PT_BV; tW = 256; tcr = colbase - 2048; toO = !latent; obase = O_BV; ohd = 64; ocr = tcr; }
    else if (colbase < 2560) { toP = true; }
    else if (colbase < 2816) { toP = true; toT = true; toff = OFF_PT_CK; tW = 256; tcr = colbase - 2560; }
    else if (colbase < 3072) { toT = true; toff = OFF_PT_CV; tW = 256; tcr = colbase - 2816; }
    else { toP = true; }
    if (toO) {
        const int h = ocr / ohd, w = ocr - h * ohd + lane;
        float* O = out_ + obase + (((size_t)(bctx * 4 + layer) * 4 + h) * 256 + n0) * ohd + w;
#pragma unroll 4
        for (int r = 0; r < 64; ++r) O[(size_t)r * ohd] = T[r * 65 + lane];
    }
    if (toP) {
        bf16_t* Pp = P + (size_t)rowbase * NIN + colbase + lane;
        if (rope) {
            const float* rc = (const float*)(ws_ + OFF_ROPE);
            const float* rs = rc + 1024;
#pragma unroll 4
            for (int r = 0; r < 64; ++r) {
                const float v = T[r * 65 + lane], vp = T[r * 65 + (lane ^ 16)];
                const int t = n0 + r;
                const int pos = (lane < 32) ? (t >> 6) : (t & 63);
                const float c = rc[pos * 16 + (lane & 15)], sn = rs[pos * 16 + (lane & 15)];
                const float o = (lane & 16) ? (vp * sn + v * c) : (v * c - vp * sn);
                Pp[(size_t)r * NIN] = f2bf(o);
            }
        } else {
#pragma unroll 4
            for (int r = 0; r < 64; ++r) Pp[(size_t)r * NIN] = f2bf(T[r * 65 + lane]);
        }
    }
    if (toT) {
        const int n = n0 + lane;
        bf16_t* Tp = (bf16_t*)(ws_ + toff) + (size_t)seq_tok0 * tW + ((size_t)(n >> 5) * tW + tcr) * 32 + (n & 31);
#pragma unroll 4
        for (int c = 0; c < 64; ++c) Tp[(size_t)c * 32] = f2bf(T[lane * 65 + c]);
    }
}

template <int WHICH>
DI void epi_ln(const Params& p, unsigned char* ws_, float* out_, int l, float* T, int tm, int tn, int wn, int rowbase, int colbase, int lane, int tid) {
    const float* mod = (const float*)(ws_ + OFF_MOD);
    float* X = (float*)(ws_ + OFF_X);
    bf16_t* H = (bf16_t*)(ws_ + OFF_H);
    const int cnd = rowbase < NCTX ? 0 : 1 + ((rowbase - NCTX) >> 10);
    const float* md = mod + (size_t)(l * 3 + cnd) * 6144;
    const int col = colbase + lane;
    const bool last = (WHICH == 2 && l == 3);
    float s1 = 0.f, s2 = 0.f;
#pragma unroll 8
    for (int c = 0; c < 64; ++c) { const float v = T[lane * 65 + c]; s1 += v; s2 += v * v; }
    unsigned long long* stats = (unsigned long long*)(ws_ + OFF_STATS);
    __hip_atomic_store(stats + (size_t)(rowbase + lane) * 16 + tn * 2 + wn,
                       ((unsigned long long)__float_as_uint(s2) << 32) | (unsigned long long)__float_as_uint(s1), __ATOMIC_RELAXED, __HIP_MEMORY_SCOPE_AGENT);
    unsigned* cnt = (unsigned*)(ws_ + OFF_LNCNT) + (l * 2 + (WHICH - 1)) * 48 + tm;
    asm volatile("s_waitcnt vmcnt(0)" ::: "memory");
    __syncthreads();
    if (tid == 0) {
        (void)__hip_atomic_fetch_add(cnt, 1u, __ATOMIC_RELAXED, __HIP_MEMORY_SCOPE_AGENT);
        unsigned sp = 0;
        while (__hip_atomic_load(cnt, __ATOMIC_RELAXED, __HIP_MEMORY_SCOPE_AGENT) < 8u) { __builtin_amdgcn_s_sleep(1); if (++sp > (1u << 22)) break; }
    }
    __syncthreads();
    float t1 = 0.f, t2 = 0.f;
    {
        unsigned long long* sp8 = stats + (size_t)(rowbase + lane) * 16;
        unsigned long long a[16];
#pragma unroll
        for (int q = 0; q < 16; ++q) a[q] = __hip_atomic_load(sp8 + q, __ATOMIC_RELAXED, __HIP_MEMORY_SCOPE_AGENT);
#pragma unroll
        for (int q = 0; q < 16; ++q) { t1 += __uint_as_float((unsigned)a[q]); t2 += __uint_as_float((unsigned)(a[q] >> 32)); }
    }
    const float mu = t1 * (1.f / 1024.f);
    const float rstd = rsqrtf(fmaxf(t2 * (1.f / 1024.f) - mu * mu, 0.f) + LN_EPS);
    const float lng = (WHICH == 1 ? p.ln1_g : p.ln2_g)[l * 1024 + col], lnb = (WHICH == 1 ? p.ln1_b : p.ln2_b)[l * 1024 + col];
    if (last) {
        float* op = out_ + (size_t)rowbase * 1024 + col;
#pragma unroll 8
        for (int r = 0; r < 64; ++r) op[(size_t)r * 1024] = (T[r * 65 + lane] - __shfl(mu, r)) * __shfl(rstd, r) * lng + lnb;
    } else {
        const float* nmd = (WHICH == 1) ? md : mod + (size_t)((l + 1) * 3 + cnd) * 6144;
        const float sh = nmd[(WHICH == 1 ? 3072 : 0) + col], sc1p = 1.f + nmd[(WHICH == 1 ? 4096 : 1024) + col];
        float* xp = X + (size_t)rowbase * 1024 + col;
        bf16_t* hp = H + (size_t)rowbase * 1024 + col;
#pragma unroll 8
        for (int r = 0; r < 64; ++r) {
            const float o = (T[r * 65 + lane] - __shfl(mu, r)) * __shfl(rstd, r) * lng + lnb;
            xp[(size_t)r * 1024] = o;
            hp[(size_t)r * 1024] = f2bf(o * sc1p + sh);
        }
    }
}

template <int EPI>
DI void gemm_phase(const Params& pin, int layer, size_t offA, size_t offB, int ntn, int K, int ldc,
                   unsigned char* smem) {
    const Params& p = pin; unsigned char* const ws_ = opaque_ws(pin.ws); float* const out_ = opaque_out(pin.out); const int tid = opaque_v(threadIdx.x), lane = tid & 63, wave = opaque_s(tid >> 6);
    const bf16_t* __restrict__ A = (const bf16_t*)(ws_ + offA); const bf16_t* __restrict__ Bt = (const bf16_t*)(ws_ + offB);
    const int wm = wave >> 1, wn = wave & 1;
    const int lr = lane & 15, g = lane >> 4;
    const int ntm = NTOK / 128;
    const int ntiles = ntm * ntn, nk = K >> 6;
    for (int tile = blockIdx.x; tile < ntiles; tile += gridDim.x) {
        const int tm = tile % ntm, tn = tile / ntm;
        const int m0 = tm * 128, n0 = tn * 128;
        f32x4 acc[4][4];
#pragma unroll
        for (int mi = 0; mi < 4; ++mi)
#pragma unroll
            for (int ni = 0; ni < 4; ++ni) acc[mi][ni] = (f32x4){0.f, 0.f, 0.f, 0.f};
        const bf16_t* Ag = A + (size_t)m0 * K;
        const bf16_t* Bg = Bt + (size_t)n0 * K;
        const bf16_t* ag = Ag + (size_t)(wave * 32 + (lane >> 3)) * K + (((lane & 7) ^ (lane >> 3)) << 3);
        const bf16_t* bg = Bg + (size_t)(wave * 32 + (lane >> 3)) * K + (((lane & 7) ^ (lane >> 3)) << 3);
#pragma unroll
        for (int j = 0; j < 4; ++j) {
            __builtin_amdgcn_global_load_lds((const unsigned*)(ag + (size_t)j * 8 * K), (LAS unsigned*)(smem + (wave * 4 + j) * 1024), 16, 0, 0);
            __builtin_amdgcn_global_load_lds((const unsigned*)(bg + (size_t)j * 8 * K), (LAS unsigned*)(smem + 16384 + (wave * 4 + j) * 1024), 16, 0, 0);
        }
        asm volatile("s_waitcnt vmcnt(0)" ::: "memory");
        __syncthreads();
        for (int kt = 0; kt < nk; ++kt) {
            const unsigned char* cur = smem + (kt & 1) * 32768;
            unsigned char* nxt = smem + ((kt + 1) & 1) * 32768;
            if (kt + 1 < nk) {
                const int k0 = (kt + 1) << 6;
#pragma unroll
                for (int j = 0; j < 4; ++j) {
                    __builtin_amdgcn_global_load_lds((const unsigned*)(ag + (size_t)j * 8 * K + k0), (LAS unsigned*)(nxt + (wave * 4 + j) * 1024), 16, 0, 0);
                    __builtin_amdgcn_global_load_lds((const unsigned*)(bg + (size_t)j * 8 * K + k0), (LAS unsigned*)(nxt + 16384 + (wave * 4 + j) * 1024), 16, 0, 0);
                }
            }
#pragma unroll
            for (int kk = 0; kk < 2; ++kk) {
                bf16x8 af[4], bfr[4];
#pragma unroll
                for (int mi = 0; mi < 4; ++mi) {
                    const int row = wm * 64 + mi * 16 + lr;
                    af[mi] = *(const bf16x8*)(cur + row * 128 + (((kk * 4 + g) ^ (row & 7)) << 4));
                }
#pragma unroll
                for (int ni = 0; ni < 4; ++ni) {
                    const int row = wn * 64 + ni * 16 + lr;
                    bfr[ni] = *(const bf16x8*)(cur + 16384 + row * 128 + (((kk * 4 + g) ^ (row & 7)) << 4));
                }
#pragma unroll
                for (int mi = 0; mi < 4; ++mi)
#pragma unroll
                    for (int ni = 0; ni < 4; ++ni) acc[mi][ni] = mfma16(af[mi], bfr[ni], acc[mi][ni]);
            }
            asm volatile("s_waitcnt vmcnt(0)" ::: "memory");
            __syncthreads();
        }
        if (EPI == EPI_LN1 || EPI == EPI_LN2) {
            const int rb = m0 + wm * 64, cb = n0 + wn * 64;
            const int cnd = rb < NCTX ? 0 : 1 + ((rb - NCTX) >> 10);
            const float* gp = (const float*)(ws_ + OFF_MOD) + (size_t)(layer * 3 + cnd) * 6144 + (EPI == EPI_LN1 ? 2048 : 5120) + cb + lr;
            const float* xp = (const float*)(ws_ + OFF_X) + (size_t)(rb + 4 * g) * 1024 + cb + lr;
            float gt[4];
#pragma unroll
            for (int ni = 0; ni < 4; ++ni) gt[ni] = gp[ni * 16];
#pragma unroll
            for (int mh = 0; mh < 2; ++mh) {
                f32x4 xv[2][4];
#pragma unroll
                for (int m2 = 0; m2 < 2; ++m2)
#pragma unroll
                    for (int ni = 0; ni < 4; ++ni)
#pragma unroll
                        for (int i = 0; i < 4; ++i) xv[m2][ni][i] = xp[(size_t)((mh * 2 + m2) * 16 + i) * 1024 + ni * 16];
#pragma unroll
                for (int m2 = 0; m2 < 2; ++m2)
#pragma unroll
                    for (int ni = 0; ni < 4; ++ni)
#pragma unroll
                        for (int i = 0; i < 4; ++i) acc[mh * 2 + m2][ni][i] = ALPHA * xv[m2][ni][i] + gt[ni] * acc[mh * 2 + m2][ni][i];
                __builtin_amdgcn_sched_barrier(0);
            }
        }
        float* T = (float*)smem + wave * (64 * 65);
#pragma unroll
        for (int mi = 0; mi < 4; ++mi)
#pragma unroll
            for (int ni = 0; ni < 4; ++ni)
#pragma unroll
                for (int i = 0; i < 4; ++i) T[(mi * 16 + 4 * g + i) * 65 + ni * 16 + lr] = acc[mi][ni][i];
        const int rowbase = m0 + wm * 64, colbase = n0 + wn * 64;
        if (EPI == EPI_INPROJ) {
            epi_inproj(p, ws_, out_, layer, T, rowbase, colbase, lane);
        } else if (EPI == EPI_LN1) {
            epi_ln<1>(p, ws_, out_, layer, T, tm, tn, wn, rowbase, colbase, lane, tid);
        } else if (EPI == EPI_LN2) {
            epi_ln<2>(p, ws_, out_, layer, T, tm, tn, wn, rowbase, colbase, lane, tid);
        } else {
            bf16_t* U = (bf16_t*)(ws_ + OFF_U) + (size_t)rowbase * ldc + colbase + lane;
#pragma unroll 4
            for (int r = 0; r < 64; ++r) { const float v = fmaxf(T[r * 65 + lane], 0.f); U[(size_t)r * ldc] = f2bf(v * v); }
        }
        __syncthreads();
    }
}

template <int NMAP, int DV>
struct AttnSt { f32x4 O[NMAP][DV / 16]; float m[NMAP]; float l[NMAP]; };
template <int NMAP, int DV>
struct UnitFrags { bf16x8 k[NMAP][2][2]; bf16x8 v[DV / 16]; };

template <int NMAP, int DV>
struct TileGeom {
    static constexpr int KROW = NMAP * 128, KBYTES = 64 * KROW, VUNIT = DV * 64, TBYTES = KBYTES + 2 * VUNIT;
};
DI int kswz(int row) { return (row & 3) | (((row >> 3) & 3) << 2); }

template <int NMAP, int DV>
DI void stage_tile(unsigned char* buf, const bf16_t* kg, int kstride, const bf16_t* vg, int vunit, int wave, int lane) {
    typedef TileGeom<NMAP, DV> TG;
    if (NMAP == 2) {
#pragma unroll
        for (int j = 0; j < 4; ++j) {
            const int jj = wave * 4 + j, row = jj * 4 + (lane >> 4), lc = (lane & 15) ^ kswz(row);
            __builtin_amdgcn_global_load_lds((const unsigned*)(kg + (size_t)row * kstride + lc * 8), (LAS unsigned*)(buf + jj * 1024), 16, 0, 0);
        }
    } else {
#pragma unroll
        for (int j = 0; j < 2; ++j) {
            const int jj = wave * 2 + j, row = jj * 8 + (lane >> 3), lc = (lane & 7) ^ (kswz(row) >> 1);
            __builtin_amdgcn_global_load_lds((const unsigned*)(kg + (size_t)row * kstride + lc * 8), (LAS unsigned*)(buf + jj * 1024), 16, 0, 0);
        }
    }
    constexpr int VI = TG::VUNIT / 1024, PER = 2 * VI / 4;
#pragma unroll
    for (int j = 0; j < PER; ++j) {
        const int jj = wave * PER + j, unit = jj / VI, piece = jj % VI;
        __builtin_amdgcn_global_load_lds((const unsigned*)(vg + (size_t)unit * vunit + piece * 512 + lane * 8),
                                         (LAS unsigned*)(buf + TG::KBYTES + jj * 1024), 16, 0, 0);
    }
}

template <int NMAP, int DV>
DI void lds_unit(UnitFrags<NMAP, DV>& f, const unsigned char* buf, int rowbase, int voff, int lr, int g) {
    typedef TileGeom<NMAP, DV> TG;
#pragma unroll
    for (int b = 0; b < 2; ++b) {
        const int row = rowbase + (lr >> 2) * 8 + (lr & 3) + 4 * b, sw = kswz(row);
        if (NMAP == 2) {
#pragma unroll
            for (int m = 0; m < NMAP; ++m)
#pragma unroll
                for (int kk = 0; kk < 2; ++kk) f.k[m][b][kk] = *(const bf16x8*)(buf + row * 256 + (((m * 8 + kk * 4 + g) ^ sw) << 4));
        } else {
#pragma unroll
            for (int kk = 0; kk < 2; ++kk) f.k[0][b][kk] = *(const bf16x8*)(buf + row * 128 + (((kk * 4 + g) ^ (sw >> 1)) << 4));
        }
    }
#pragma unroll
    for (int vb = 0; vb < DV / 16; ++vb) f.v[vb] = *(const bf16x8*)(buf + TG::KBYTES + voff + (vb * 16 + lr) * 64);
}

template <int NMAP, int DV, class SrcFn, class CompFn>
DI void tile_pipeline(unsigned char* tiles, int nt, int wave, int lane, SrcFn src, CompFn comp) {
    typedef TileGeom<NMAP, DV> TG;
    {
        const bf16_t *kg, *vg; int ks, vu;
        src(0, kg, ks, vg, vu);
        stage_tile<NMAP, DV>(tiles, kg, ks, vg, vu, wave, lane);
    }
    asm volatile("s_waitcnt vmcnt(0)" ::: "memory");
    __syncthreads();
    for (int t = 0; t < nt; ++t) {
        unsigned char* cur = tiles + (t & 1) * TG::TBYTES;
        if (t + 1 < nt) {
            const bf16_t *kg, *vg; int ks, vu;
            src(t + 1, kg, ks, vg, vu);
            stage_tile<NMAP, DV>(tiles + ((t + 1) & 1) * TG::TBYTES, kg, ks, vg, vu, wave, lane);
        }
        comp(t, cur);
        asm volatile("s_waitcnt vmcnt(0)" ::: "memory");
        __syncthreads();
    }
}

template <int NMAP, int DV, bool HASBIAS>
DI void compute_unit(AttnSt<NMAP, DV>& st, const UnitFrags<NMAP, DV>& f, const bf16x8 (&qf)[NMAP][2], float sc, const float (&bias)[8]) {
    bf16x8 pk[NMAP];
#pragma unroll
    for (int m = 0; m < NMAP; ++m) {
        f32x4 sa = (f32x4){0.f, 0.f, 0.f, 0.f}, sb = sa;
        sa = mfma16(f.k[m][0][0], qf[m][0], sa); sa = mfma16(f.k[m][0][1], qf[m][1], sa);
        sb = mfma16(f.k[m][1][0], qf[m][0], sb); sb = mfma16(f.k[m][1][1], qf[m][1], sb);
        float s[8];
#pragma unroll
        for (int j = 0; j < 4; ++j) { s[j] = sa[j] * sc; s[4 + j] = sb[j] * sc; }
        if (HASBIAS) {
#pragma unroll
            for (int j = 0; j < 8; ++j) s[j] += bias[j];
        }
        float mx = fmaxf(fmaxf(fmaxf(s[0], s[1]), fmaxf(s[2], s[3])), fmaxf(fmaxf(s[4], s[5]), fmaxf(s[6], s[7])));
        mx = grp_max(mx);
        const float mnew = fmaxf(st.m[m], mx);
        const float alpha = fexp2(st.m[m] - mnew);
        float ps = 0.f;
#pragma unroll
        for (int j = 0; j < 8; ++j) { s[j] = fexp2(s[j] - mnew); ps += s[j]; }
        st.l[m] = st.l[m] * alpha + ps; st.m[m] = mnew;
#pragma unroll
        for (int vb = 0; vb < DV / 16; ++vb) st.O[m][vb] *= alpha;
        pk[m] = pack8(s[0], s[1], s[2], s[3], s[4], s[5], s[6], s[7]);
    }
#pragma unroll
    for (int vb = 0; vb < DV / 16; ++vb) {
#pragma unroll
        for (int m = 0; m < NMAP; ++m) st.O[m][vb] = mfma16(f.v[vb], pk[m], st.O[m][vb]);
    }
}

template <int NMAP, int DV>
DI void attn_init(AttnSt<NMAP, DV>& st) {
#pragma unroll
    for (int m = 0; m < NMAP; ++m) {
        st.m[m] = -INFINITY; st.l[m] = 0.f;
#pragma unroll
        for (int vb = 0; vb < DV / 16; ++vb) st.O[m][vb] = (f32x4){0.f, 0.f, 0.f, 0.f};
    }
}

template <bool LAT>
DI void item_diffattn(const Params& pin, int l, int seq, int h, int qt, unsigned char* smem, int wave, int lane) {
    const Params& p = pin; unsigned char* const ws_ = opaque_ws(pin.ws); float* const out_ = opaque_out(pin.out); lane = opaque_v(lane); wave = opaque_s(wave);
    const int lr = lane & 15, g = lane >> 4;
    const int nseq = LAT ? 1024 : 256;
    const int tok0 = LAT ? NCTX + seq * 1024 : seq * 256;
    const bf16_t* P = (const bf16_t*)(ws_ + OFF_P);
    const int q0 = qt * 64 + wave * 16;
    bf16x8 qf[2][2];
    {
        const bf16_t* qp = P + (size_t)(tok0 + q0 + lr) * NIN + h * 128 + 8 * g;
#pragma unroll
        for (int m = 0; m < 2; ++m)
#pragma unroll
            for (int kk = 0; kk < 2; ++kk) qf[m][kk] = *(const bf16x8*)(qp + m * 64 + kk * 32);
    }
    AttnSt<2, 128> st;
    attn_init<2, 128>(st);
    const float sc = 0.125f * LOG2E;
    const size_t hb = (size_t)((seq * 4 + l) * 4 + h);
    const bf16_t* kc = (const bf16_t*)(ws_ + OFF_CAK) + hb * 512 * 128;
    const bf16_t* vc = (const bf16_t*)(ws_ + OFF_CAVT) + hb * 128 * 512;
    const bf16_t* kn = P + (size_t)tok0 * NIN + 512 + h * 128;
    const bf16_t* vn = (const bf16_t*)(ws_ + OFF_PT_AV) + (size_t)tok0 * 512 + (size_t)(h * 128) * 32;
    const int ncache = LAT ? 8 : 0;
    __syncthreads();
    tile_pipeline<2, 128>(smem, ncache + nseq / 64, wave, lane,
        [&](int t, const bf16_t*& kg, int& ks, const bf16_t*& vg, int& vu) {
            if (t < ncache) { kg = kc + (size_t)t * 64 * 128; ks = 128; vg = vc + (size_t)(2 * t) * 128 * 32; vu = 128 * 32; }
            else { const int tt = t - ncache; kg = kn + (size_t)tt * 64 * NIN; ks = NIN; vg = vn + (size_t)(2 * tt) * 512 * 32; vu = 512 * 32; }
        },
        [&](int t, const unsigned char* buf) {
            const float nob[8] = {0.f, 0.f, 0.f, 0.f, 0.f, 0.f, 0.f, 0.f};
#pragma unroll 1
            for (int half = 0; half < 2; ++half) {
                UnitFrags<2, 128> f;
                lds_unit<2, 128>(f, buf, 32 * half, half * TileGeom<2, 128>::VUNIT + g * 16, lr, g);
                compute_unit<2, 128, false>(st, f, qf, sc, nob);
            }
        });
    const float inv0 = 1.f / grp_sum(st.l[0]), inv1 = 1.f / grp_sum(st.l[1]);
    const float* lamp = (const float*)(ws_ + OFF_LAM);
    const float lam = lamp[l * 2], lam_init = lamp[l * 2 + 1];
    const float c1 = lam * inv1;
    float ss = 0.f;
#pragma unroll
    for (int vb = 0; vb < 8; ++vb)
#pragma unroll
        for (int i = 0; i < 4; ++i) {
            const float o = st.O[0][vb][i] * inv0 - st.O[1][vb][i] * c1;
            st.O[0][vb][i] = o; ss += o * o;
        }
    ss = grp_sum(ss);
    const float r = rsqrtf(ss * (1.f / 128.f) + LN_EPS) * (1.f - lam_init);
    bf16_t* MIX = (bf16_t*)(ws_ + OFF_MIX) + (size_t)(tok0 + q0 + lr) * 1024 + h * 128;
    const float* gn = p.diff_norm_g + l * 128;
#pragma unroll
    for (int vb = 0; vb < 8; ++vb) {
        const int v = vb * 16 + 4 * g;
        const float4 g4 = *(const float4*)(gn + v);
        uint2 o; o.x = pack2(st.O[0][vb][0] * r * g4.x, st.O[0][vb][1] * r * g4.y);
        o.y = pack2(st.O[0][vb][2] * r * g4.z, st.O[0][vb][3] * r * g4.w);
        *(uint2*)(MIX + v) = o;
    }
}

DI void item_dense(const Params& pin, int seq, int h, int qt, unsigned char* smem, int wave, int lane) {
    const Params& p = pin; unsigned char* const ws_ = opaque_ws(pin.ws); float* const out_ = opaque_out(pin.out); lane = opaque_v(lane); wave = opaque_s(wave);
    const int lr = lane & 15, g = lane >> 4;
    const int tok0 = seq * 256;
    const bf16_t* P = (const bf16_t*)(ws_ + OFF_P);
    const int q0 = qt * 64 + wave * 16;
    bf16x8 qf[1][2];
    {
        const bf16_t* qp = P + (size_t)(tok0 + q0 + lr) * NIN + 1536 + h * 64 + 8 * g;
        qf[0][0] = *(const bf16x8*)(qp); qf[0][1] = *(const bf16x8*)(qp + 32);
    }
    AttnSt<1, 64> st;
    attn_init<1, 64>(st);
    const bf16_t* kn = P + (size_t)tok0 * NIN + 1792 + h * 64;
    const bf16_t* vn = (const bf16_t*)(ws_ + OFF_PT_BV) + (size_t)tok0 * 256 + (size_t)(h * 64) * 32;
    const float sc = 0.125f * LOG2E;
    __syncthreads();
    tile_pipeline<1, 64>(smem, 4, wave, lane,
        [&](int t, const bf16_t*& kg, int& ks, const bf16_t*& vg, int& vu) {
            kg = kn + (size_t)t * 64 * NIN; ks = NIN; vg = vn + (size_t)(2 * t) * 256 * 32; vu = 256 * 32;
        },
        [&](int t, const unsigned char* buf) {
            const float nob[8] = {0.f, 0.f, 0.f, 0.f, 0.f, 0.f, 0.f, 0.f};
#pragma unroll
            for (int half = 0; half < 2; ++half) {
                UnitFrags<1, 64> f;
                lds_unit<1, 64>(f, buf, 32 * half, half * TileGeom<1, 64>::VUNIT + g * 16, lr, g);
                compute_unit<1, 64, false>(st, f, qf, sc, nob);
            }
        });
    const float inv = 1.f / grp_sum(st.l[0]);
    bf16_t* MIX = (bf16_t*)(ws_ + OFF_MIX) + (size_t)(tok0 + q0 + lr) * 1024 + 512 + h * 64;
#pragma unroll
    for (int vb = 0; vb < 4; ++vb) {
        uint2 o; o.x = pack2(st.O[0][vb][0] * inv, st.O[0][vb][1] * inv); o.y = pack2(st.O[0][vb][2] * inv, st.O[0][vb][3] * inv);
        *(uint2*)(MIX + vb * 16 + 4 * g) = o;
    }
}

DI void item_na(const Params& pin, int l, int sb, int h, int r, unsigned char* smem, int wave, int lane) {
    const Params& p = pin; unsigned char* const ws_ = opaque_ws(pin.ws); float* const out_ = opaque_out(pin.out); lane = opaque_v(lane); wave = opaque_s(wave);
    const int lr = lane & 15, g = lane >> 4;
    const int tok0 = NCTX + sb * 1024;
    const bf16_t* P = (const bf16_t*)(ws_ + OFF_P);
    const int qc = wave * 16 + lr;
    const int q0 = r * 64 + wave * 16;
    bf16x8 qf[1][2];
    {
        const bf16_t* qp = P + (size_t)(tok0 + q0 + lr) * NIN + 1536 + h * 64 + 8 * g;
        qf[0][0] = *(const bf16x8*)(qp); qf[0][1] = *(const bf16x8*)(qp + 32);
    }
    AttnSt<1, 64> st;
    attn_init<1, 64>(st);
    const float sc = 0.125f * LOG2E;
    const size_t hb = (size_t)((sb * 4 + l) * 4 + h);
    const bf16_t* kc = (const bf16_t*)(ws_ + OFF_CBK) + hb * 512 * 64;
    const bf16_t* vc = (const bf16_t*)(ws_ + OFF_CBVT) + hb * 64 * 512;
    const bf16_t* kn = P + (size_t)tok0 * NIN + 1792 + h * 64;
    const bf16_t* vn = (const bf16_t*)(ws_ + OFF_PT_BV) + (size_t)tok0 * 256 + (size_t)(h * 64) * 32;
    const int kr0 = min(max(r - 4, 0), 8);
    const int bs = min(max(wave * 16 - 8, 0), 32);
    const int wstart = min(max(qc - 8, 0), 48);
    const float* rpb = p.nat_rpb + (size_t)(l * 4 + h) * 15 * 31;
    __syncthreads();
    tile_pipeline<1, 64>(smem, 16, wave, lane,
        [&](int t, const bf16_t*& kg, int& ks, const bf16_t*& vg, int& vu) {
            if (t < 8) { kg = kc + (size_t)t * 64 * 64; ks = 64; vg = vc + (size_t)(2 * t) * 64 * 32; vu = 64 * 32; }
            else { const int kr = kr0 + t - 8; kg = kn + (size_t)kr * 64 * NIN; ks = NIN; vg = vn + (size_t)(2 * kr) * 256 * 32; vu = 256 * 32; }
        },
        [&](int t, const unsigned char* buf) {
            if (t < 8) {
                const float nob[8] = {0.f, 0.f, 0.f, 0.f, 0.f, 0.f, 0.f, 0.f};
#pragma unroll
                for (int half = 0; half < 2; ++half) {
                    UnitFrags<1, 64> f;
                    lds_unit<1, 64>(f, buf, 32 * half, half * TileGeom<1, 64>::VUNIT + g * 16, lr, g);
                    compute_unit<1, 64, false>(st, f, qf, sc, nob);
                }
            } else {
                const int kr = kr0 + t - 8;
                const int nl = bs + 8 * g;
                UnitFrags<1, 64> f;
                lds_unit<1, 64>(f, buf, bs, (nl >> 5) * TileGeom<1, 64>::VUNIT + (nl & 31) * 2, lr, g);
                float bias[8];
                const float* rrow = rpb + (kr - r + 7) * 31;
#pragma unroll
                for (int j = 0; j < 8; ++j) {
                    const int kcol = bs + 8 * g + j;
                    const bool valid = (kcol >= wstart) && (kcol < wstart + 16);
                    const int dc = min(max(kcol - qc + 15, 0), 30);
                    bias[j] = valid ? rrow[dc] * LOG2E : -INFINITY;
                }
                compute_unit<1, 64, true>(st, f, qf, sc, bias);
            }
        });
    const float inv = 1.f / grp_sum(st.l[0]);
    bf16_t* MIX = (bf16_t*)(ws_ + OFF_MIX) + (size_t)(tok0 + q0 + lr) * 1024 + 512 + h * 64;
#pragma unroll
    for (int vb = 0; vb < 4; ++vb) {
        uint2 o; o.x = pack2(st.O[0][vb][0] * inv, st.O[0][vb][1] * inv); o.y = pack2(st.O[0][vb][2] * inv, st.O[0][vb][3] * inv);
        *(uint2*)(MIX + vb * 16 + 4 * g) = o;
    }
}

DI float wave_excl_sum(float v, int lane) {
    float x = v;
#pragma unroll
    for (int d = 1; d < 64; d <<= 1) { const float y = __shfl_up(x, d); if (lane >= d) x += y; }
    return x - v;
}
DI float wave_excl_max(float v, int lane, float init) {
    float x = v;
#pragma unroll
    for (int d = 1; d < 64; d <<= 1) { const float y = __shfl_up(x, d); if (lane >= d) x = fmaxf(x, y); }
    const float ex = __shfl_up(x, 1);
    return lane == 0 ? init : fmaxf(init, ex);
}
DI void mlstm_scan(const float* __restrict__ G, int h, int nseq, int dir, float* aA, float* MA, float* FA, float m0, int lane) {
    const int per = nseq >> 6;
    float run = 0.f;
    for (int e = 0; e < per; ++e) {
        const int idx = lane * per + e, pos = dir ? nseq - 1 - idx : idx;
        const float f = G[(size_t)pos * 16 + (dir ? 12 : 4) + h];
        const float lf = fminf(f, 0.f) - log1pf(expf(-fabsf(f)));
        run += lf; FA[pos] = run;
    }
    const float off = wave_excl_sum(run, lane);
    float rmax = -INFINITY;
    for (int e = 0; e < per; ++e) {
        const int idx = lane * per + e, pos = dir ? nseq - 1 - idx : idx;
        const float F = FA[pos] + off; FA[pos] = F;
        const float a = G[(size_t)pos * 16 + (dir ? 8 : 0) + h] - F;
        aA[pos] = a; rmax = fmaxf(rmax, a); MA[pos] = rmax;
    }
    const float pre = wave_excl_max(rmax, lane, m0);
    for (int e = 0; e < per; ++e) {
        const int idx = lane * per + e, pos = dir ? nseq - 1 - idx : idx;
        MA[pos] = fmaxf(MA[pos], pre);
    }
}

DI void mlstm_unit(f32x4 (&O)[4], float& den, int dir, int t, const bf16x8 (&qf)[2], const UnitFrags<1, 64>& f, const float* aA, float Mt, int key0, int g) {
    f32x4 sa = (f32x4){0.f, 0.f, 0.f, 0.f}, sb = sa;
    sa = mfma16(f.k[0][0][0], qf[0], sa); sa = mfma16(f.k[0][0][1], qf[1], sa);
    sb = mfma16(f.k[0][1][0], qf[0], sb); sb = mfma16(f.k[0][1][1], qf[1], sb);
    const float4 a0 = *(const float4*)(aA + key0 + 8 * g), a1 = *(const float4*)(aA + key0 + 8 * g + 4);
    const float av[8] = {a0.x, a0.y, a0.z, a0.w, a1.x, a1.y, a1.z, a1.w};
    float pv[8];
#pragma unroll
    for (int j = 0; j < 8; ++j) {
        const int key = key0 + 8 * g + j;
        const bool ok = dir ? (key >= t) : (key <= t);
        const float w = ok ? fexp2((av[j] - Mt) * LOG2E) : 0.f;
        const float sv = (j < 4) ? sa[j & 3] : sb[j & 3];
        pv[j] = sv * 0.125f * w;
        den += pv[j];
    }
    const bf16x8 pk = pack8(pv[0], pv[1], pv[2], pv[3], pv[4], pv[5], pv[6], pv[7]);
#pragma unroll
    for (int vb = 0; vb < 4; ++vb) O[vb] = mfma16(f.v[vb], pk, O[vb]);
}

template <bool LAT>
DI void item_mlstm(const Params& pin, int l, int seq, int h, int qt, unsigned char* smem, int wave, int lane) {
    const Params& p = pin; unsigned char* const ws_ = opaque_ws(pin.ws); float* const out_ = opaque_out(pin.out); lane = opaque_v(lane); wave = opaque_s(wave);
    const int lr = lane & 15, g = lane >> 4;
    const int nseq = LAT ? 1024 : 256;
    const int tok0 = LAT ? NCTX + seq * 1024 : seq * 256;
    float* aF = (float*)smem; float* MF = aF + 1024; float* FF = MF + 1024;
    float* aB = FF + 1024; float* MB = aB + 1024; float* FB = MB + 1024;
    unsigned char* tiles = smem + 24576;
    const float* G = (const float*)(ws_ + OFF_G) + (size_t)tok0 * 16;
    float m0f = 0.f, m0b = 0.f;
    const int sidx_f = ((seq * 4 + l) * 2 + 0) * 4 + h, sidx_b = ((seq * 4 + l) * 2 + 1) * 4 + h;
    if (LAT) { m0f = p.state_m[sidx_f]; m0b = p.state_m[sidx_b]; }
    __syncthreads();
    if (wave == 0) mlstm_scan(G, h, nseq, 0, aF, MF, FF, m0f, lane);
    if (wave == 1) mlstm_scan(G, h, nseq, 1, aB, MB, FB, m0b, lane);
    __syncthreads();
    const bf16_t* P = (const bf16_t*)(ws_ + OFF_P);
    const int q0 = qt * 64 + wave * 16;
    const int t = q0 + lr;
    bf16x8 qf[2];
    {
        const bf16_t* qp = P + (size_t)(tok0 + t) * NIN + 2304 + h * 64 + 8 * g;
        qf[0] = *(const bf16x8*)(qp); qf[1] = *(const bf16x8*)(qp + 32);
    }
    const bf16_t* kn = P + (size_t)tok0 * NIN + 2560 + h * 64;
    const bf16_t* vn = (const bf16_t*)(ws_ + OFF_PT_CV) + (size_t)tok0 * 256 + (size_t)(h * 64) * 32;
    const float Mf = MF[t], Mb = MB[t], Ff = FF[t], Fb = FB[t];
    f32x4 Of[4], Ob[4];
#pragma unroll
    for (int vb = 0; vb < 4; ++vb) { Of[vb] = (f32x4){0.f, 0.f, 0.f, 0.f}; Ob[vb] = Of[vb]; }
    float denf = 0.f, denb = 0.f;
    tile_pipeline<1, 64>(tiles, nseq / 64, wave, lane,
        [&](int tt, const bf16_t*& kg, int& ks, const bf16_t*& vg, int& vu) {
            kg = kn + (size_t)tt * 64 * NIN; ks = NIN; vg = vn + (size_t)(2 * tt) * 256 * 32; vu = 256 * 32;
        },
        [&](int tt, const unsigned char* buf) {
#pragma unroll
            for (int half = 0; half < 2; ++half) {
                const int key0 = tt * 64 + half * 32;
                const bool dof = key0 <= q0 + 15, dob = key0 + 31 >= q0;
                if (dof || dob) {
                    UnitFrags<1, 64> f;
                    lds_unit<1, 64>(f, buf, 32 * half, half * TileGeom<1, 64>::VUNIT + g * 16, lr, g);
                    if (dof) mlstm_unit(Of, denf, 0, t, qf, f, aF, Mf, key0, g);
                    if (dob) mlstm_unit(Ob, denb, 1, t, qf, f, aB, Mb, key0, g);
                }
            }
        });
    if (LAT) {
        const bf16_t* qp2 = P + (size_t)(tok0 + t) * NIN + 2304 + h * 64 + 4 * g;
#pragma unroll
        for (int dir = 0; dir < 2; ++dir) {
            const int sidx = dir ? sidx_b : sidx_f;
            const float e = fexp2(((dir ? m0b : m0f) - (dir ? Mb : Mf)) * LOG2E) * 0.125f;
            const bf16_t* c0t = (const bf16_t*)(ws_ + OFF_C0T) + (size_t)sidx * 4096 + lr * 64 + 4 * g;
            const float* n0 = p.state_n + (size_t)sidx * 64;
            float dacc = 0.f;
#pragma unroll
            for (int u2 = 0; u2 < 2; ++u2) {
                const bf16x4 qa = *(const bf16x4*)(qp2 + u2 * 32), qb = *(const bf16x4*)(qp2 + u2 * 32 + 16);
                const float4 na = *(const float4*)(n0 + u2 * 32 + 4 * g), nb = *(const float4*)(n0 + u2 * 32 + 16 + 4 * g);
                float pv[8];
#pragma unroll
                for (int j = 0; j < 4; ++j) { pv[j] = bf2f((unsigned short)qa[j]) * e; pv[4 + j] = bf2f((unsigned short)qb[j]) * e; }
                dacc += pv[0] * na.x + pv[1] * na.y + pv[2] * na.z + pv[3] * na.w + pv[4] * nb.x + pv[5] * nb.y + pv[6] * nb.z + pv[7] * nb.w;
                const bf16x8 pk = pack8(pv[0], pv[1], pv[2], pv[3], pv[4], pv[5], pv[6], pv[7]);
#pragma unroll
                for (int vb = 0; vb < 4; ++vb) {
                    const bf16_t* cp = c0t + (size_t)vb * 16 * 64 + u2 * 32;
                    const bf16x8 cf = cat4(*(const bf16x4*)(cp), *(const bf16x4*)(cp + 16));
                    if (dir) Ob[vb] = mfma16(cf, pk, Ob[vb]); else Of[vb] = mfma16(cf, pk, Of[vb]);
                }
            }
            if (dir) denb += dacc; else denf += dacc;
        }
    }
    denf = grp_sum(denf); denb = grp_sum(denb);
    const float rf = 1.f / fmaxf(fabsf(denf), expf(-(Ff + Mf)));
    const float rb = 1.f / fmaxf(fabsf(denb), expf(-(Fb + Mb)));
    float ss = 0.f;
#pragma unroll
    for (int vb = 0; vb < 4; ++vb)
#pragma unroll
        for (int i = 0; i < 4; ++i) { const float hs = Of[vb][i] * rf + Ob[vb][i] * rb; Of[vb][i] = hs; ss += hs * hs; }
    ss = grp_sum(ss);
    const float rn = rsqrtf(ss * (1.f / 64.f) + LN_EPS);
    const float* gn = p.mlstm_norm_g + (size_t)(l * 4 + h) * 64;
    const bf16_t* op = P + (size_t)(tok0 + t) * NIN + 3072 + h * 64;
    bf16_t* MIX = (bf16_t*)(ws_ + OFF_MIX) + (size_t)(tok0 + t) * 1024 + 768 + h * 64;
#pragma unroll
    for (int vb = 0; vb < 4; ++vb) {
        const int v = vb * 16 + 4 * g;
        const float4 g4 = *(const float4*)(gn + v);
        const bf16x4 o4 = *(const bf16x4*)(op + v);
        float sg[4];
#pragma unroll
        for (int i = 0; i < 4; ++i) sg[i] = 1.f / (1.f + __expf(-bf2f((unsigned short)o4[i])));
        uint2 o; o.x = pack2(Of[vb][0] * rn * g4.x * sg[0], Of[vb][1] * rn * g4.y * sg[1]);
        o.y = pack2(Of[vb][2] * rn * g4.z * sg[2], Of[vb][3] * rn * g4.w * sg[3]);
        *(uint2*)(MIX + v) = o;
    }
}

DI void item_mlstm_state(const Params& pin, int l, int b, int h, int dir, unsigned char* smem, int wave, int lane) {
    const Params& p = pin; unsigned char* const ws_ = opaque_ws(pin.ws); float* const out_ = opaque_out(pin.out); lane = opaque_v(lane); wave = opaque_s(wave);
    const int lr = lane & 15, g = lane >> 4;
    const int tok0 = b * 256;
    float* aA = (float*)smem; float* MA = aA + 1024; float* FA = MA + 1024;
    const float* G = (const float*)(ws_ + OFF_G) + (size_t)tok0 * 16;
    __syncthreads();
    if (wave == 0) mlstm_scan(G, h, 256, dir, aA, MA, FA, 0.f, lane);
    __syncthreads();
    const float Mfin = dir ? MA[0] : MA[255];
    const float Ffin = dir ? FA[0] : FA[255];
    const bf16_t* KT = (const bf16_t*)(ws_ + OFF_PT_CK) + (size_t)tok0 * 256 + (size_t)(h * 64 + wave * 16 + lr) * 32 + 8 * g;
    const bf16_t* VT = (const bf16_t*)(ws_ + OFF_PT_CV) + (size_t)tok0 * 256 + (size_t)(h * 64 + lr) * 32 + 8 * g;
    f32x4 C[4];
#pragma unroll
    for (int vb = 0; vb < 4; ++vb) C[vb] = (f32x4){0.f, 0.f, 0.f, 0.f};
    float nacc = 0.f;
    for (int u = 0; u < 8; ++u) {
        const int s0 = u * 32;
        const bf16x8 kf = *(const bf16x8*)(KT + (size_t)u * 256 * 32);
        const float4 a0 = *(const float4*)(aA + s0 + 8 * g), a1 = *(const float4*)(aA + s0 + 8 * g + 4);
        const float av[8] = {a0.x, a0.y, a0.z, a0.w, a1.x, a1.y, a1.z, a1.w};
        float kw[8];
#pragma unroll
        for (int j = 0; j < 8; ++j) { kw[j] = bf2f((unsigned short)kf[j]) * fexp2((av[j] - Mfin) * LOG2E); nacc += kw[j]; }
        const bf16x8 af = pack8(kw[0], kw[1], kw[2], kw[3], kw[4], kw[5], kw[6], kw[7]);
#pragma unroll
        for (int vb = 0; vb < 4; ++vb) {
            const bf16x8 vf = *(const bf16x8*)(VT + (size_t)u * 256 * 32 + vb * 16 * 32);
            C[vb] = mfma16(af, vf, C[vb]);
        }
    }
    const size_t sidx = (size_t)((b * 4 + l) * 2 + dir) * 4 + h;
    float* oc = out_ + O_NC + sidx * 4096;
#pragma unroll
    for (int vb = 0; vb < 4; ++vb)
#pragma unroll
        for (int i = 0; i < 4; ++i) oc[(wave * 16 + 4 * g + i) * 64 + vb * 16 + lr] = C[vb][i];
    nacc = grp_sum(nacc);
    if (g == 0) out_[O_NN + sidx * 64 + wave * 16 + lr] = nacc;
    if (wave == 0 && lane == 0) out_[O_NM + sidx] = Ffin + Mfin;
}

DI void mixer_phase(const Params& p, int l, unsigned char* smem) {
    const int tid_ = opaque_v(threadIdx.x); const int lane = tid_ & 63, wave = tid_ >> 6;
    for (int it = blockIdx.x; it < 1280; it += gridDim.x) {
        if (it < 128) { if (IM & 1) item_diffattn<true>(p, l, it >> 6, (it >> 4) & 3, it & 15, smem, wave, lane); }
        else if (it < 256) { const int i = it - 128; if (IM & 2) item_mlstm<true>(p, l, i >> 6, (i >> 4) & 3, i & 15, smem, wave, lane); }
        else if (it < 384) { const int i = it - 256; if (IM & 4) item_na(p, l, i >> 6, (i >> 4) & 3, i & 15, smem, wave, lane); }
        else if (it < 640) { const int i = it - 384; if (IM & 8) item_diffattn<false>(p, l, i >> 4, (i >> 2) & 3, i & 3, smem, wave, lane); }
        else if (it < 896) { const int i = it - 640; if (IM & 16) item_mlstm<false>(p, l, i >> 4, (i >> 2) & 3, i & 3, smem, wave, lane); }
        else if (it < 1152) { const int i = it - 896; if (IM & 32) item_dense(p, i >> 4, (i >> 2) & 3, i & 3, smem, wave, lane); }
        else { const int i = it - 1152; if (IM & 64) item_mlstm_state(p, l, i >> 3, (i >> 1) & 3, i & 1, smem, wave, lane); }
    }
}

#define XB_TMO      128
#define XB_XCNT(j)  (256  + 64 * (j))
#define XB_XSUB(j)  (1280 + 64 * (j))
#define XB_XGEN(j)  (2304 + 64 * (j))
#define XB_TOP      3328
#define XB_TOPGEN   3392
#define XCD_BAR_WORDS 3456
#define XB_SPIN_CAP (1u << 18)

__device__ __forceinline__ unsigned xb_ld(unsigned* p)              { return __hip_atomic_load(p, __ATOMIC_RELAXED, __HIP_MEMORY_SCOPE_AGENT); }
__device__ __forceinline__ unsigned xb_add(unsigned* p, unsigned v) { return __hip_atomic_fetch_add(p, v, __ATOMIC_RELAXED, __HIP_MEMORY_SCOPE_AGENT); }
__device__ __forceinline__ unsigned xb_xcc_id() { return (unsigned)__builtin_amdgcn_s_getreg((3 << 11) | 20) & 0xFu; }
#define XB_SPIN(cond, bar) do { unsigned _sp = 0; while (cond) { __builtin_amdgcn_s_sleep(1); \
    if ((++_sp & 255u) == 0u) { if (xb_ld(&(bar)[XB_TMO])) break; if (_sp > XB_SPIN_CAP) { atomicAdd(&(bar)[XB_TMO], 1u); break; } } } } while (0)

struct XcdBarrier {
    unsigned* bar; unsigned x;
    volatile LAS unsigned* st;
};

__device__ __forceinline__ XcdBarrier xcd_barrier_post(unsigned* bar, volatile LAS unsigned* st) {
    XcdBarrier b; b.bar = bar; b.x = xb_xcc_id(); b.st = st;
    if (threadIdx.x == 0) (void)xb_add(&bar[XB_XCNT(b.x)], 1u);
    return b;
}
__device__ __forceinline__ void xcd_barrier_complete(unsigned* bar, unsigned x, unsigned& nloc, unsigned& nx) {
    const unsigned G = gridDim.x * gridDim.y * gridDim.z;
    unsigned sum, cnt, mine, sp = 0u;
    for (;;) {
        sum = 0u; cnt = 0u; mine = 0u;
#pragma unroll
        for (unsigned j = 0; j < 16; ++j) { const unsigned c = xb_ld(&bar[XB_XCNT(j)]); sum += c; cnt += (c > 0u) ? 1u : 0u; mine = (j == x) ? c : mine; }
        if (sum == G) break;
        __builtin_amdgcn_s_sleep(1);
        if ((++sp & 255u) == 0u) { if (xb_ld(&bar[XB_TMO])) break; if (sp > XB_SPIN_CAP) { atomicAdd(&bar[XB_TMO], 1u); break; } }
    }
    nloc = mine > 0u ? mine : 1u; nx = cnt > 0u ? cnt : 1u;
}

__device__ __forceinline__ void xcd_barrier(const XcdBarrier& b) {
    asm volatile("s_waitcnt vmcnt(0)" ::: "memory");
    __syncthreads();
    if (threadIdx.x == 0) {
        unsigned* bar = b.bar;
        __builtin_amdgcn_s_waitcnt(0);
        unsigned nloc = b.st[0], nx = b.st[1];
        if (nloc == 0u) { xcd_barrier_complete(bar, b.x, nloc, nx); b.st[0] = nloc; b.st[1] = nx; }
        const unsigned old = xb_add(&bar[XB_XSUB(b.x)], 1u);
        const unsigned gen = old / nloc;
        if (old + 1u == (gen + 1u) * nloc) {
            __builtin_amdgcn_fence(__ATOMIC_RELEASE, "agent");
            asm volatile("s_waitcnt vmcnt(0)" ::: "memory");
            const unsigned og = xb_add(&bar[XB_TOP], 1u);
            const unsigned tg = og / nx;
            if (og + 1u == (tg + 1u) * nx) xb_add(&bar[XB_TOPGEN], 1u);
            else XB_SPIN(xb_ld(&bar[XB_TOPGEN]) == tg, bar);
            __builtin_amdgcn_fence(__ATOMIC_ACQUIRE, "agent");
            xb_add(&bar[XB_XGEN(b.x)], 1u);
            asm volatile("s_waitcnt vmcnt(0)" ::: "memory");
        } else {
            XB_SPIN(xb_ld(&bar[XB_XGEN(b.x)]) == gen, bar);
            __builtin_amdgcn_fence(__ATOMIC_ACQUIRE, "agent");
            asm volatile("s_waitcnt vmcnt(0)" ::: "memory");
        }
    }
    __syncthreads();
}


constexpr int N_PHASES = 2 + 5 * 4;

__global__ void __launch_bounds__(256, 2) fwd_kernel(Params p) {
    __shared__ __attribute__((aligned(16))) unsigned char smem[66560 + 16];
    if (threadIdx.x == 0) *(uint4*)(smem + 66560) = make_uint4(0u, 0u, 0u, 0u);
    __syncthreads();
    XcdBarrier xb = xcd_barrier_post((unsigned*)(p.ws + OFF_BAR), (volatile LAS unsigned*)(smem + 66560));
    for (int ph = p.ph_lo; ph < p.ph_hi; ++ph) {
        if (ph > p.ph_lo) {
            if (p.ph_hi > 1000) cg::this_grid().sync();
            xcd_barrier(xb);
        }
        const int l = ph < 2 ? 0 : (ph - 2) / 5, s = ph < 2 ? ph - 2 : (ph - 2) % 5;
        const int bit = 1 << (s + 2);
        const int reps = (DUPM & bit) ? 2 : 1;
        for (int rep = 0; rep < reps; ++rep) {
            if (rep) __syncthreads();
            if (s == -2) prep0(p, smem);
            else if (s == -1) prep1(p);
            else if (s == 0) gemm_phase<EPI_INPROJ>(p, l, OFF_H, OFF_WT_IN + (size_t)l * NINP * DM * 2, NINP / 128, 1024, 0, smem);
            else if (s == 1) mixer_phase(p, l, smem);
            else if (s == 2) gemm_phase<EPI_LN1>(p, l, OFF_MIX, OFF_WT_OUT + (size_t)l * DM * DM * 2, 8, 1024, 1024, smem);
            else if (s == 3) gemm_phase<EPI_RELU2>(p, l, OFF_H, OFF_WT_1 + (size_t)l * DFF * DM * 2, 32, 1024, 4096, smem);
            else gemm_phase<EPI_LN2>(p, l, OFF_U, OFF_WT_2 + (size_t)l * DM * DFF * 2, 8, 4096, 1024, smem);
        }
    }
}

extern "C" void kernel_launch(void* const* d_in, const int* in_sizes, int n_in, void* d_out, int out_size, void* d_ws, size_t ws_size,
                              hipStream_t stream) {
    static int grid = 0;
    if (grid == 0) {
        if (n_in != 26 || ws_size < WS_END) { fprintf(stderr, "kernel_launch: unexpected n_in %d / ws %zu (need %zu)\n", n_in, ws_size, (size_t)WS_END); grid = -1; return; }
        int dev = 0, cus = 0, per_cu = 0;
        hipGetDevice(&dev);
        hipDeviceGetAttribute(&cus, hipDeviceAttributeMultiprocessorCount, dev);
        hipOccupancyMaxActiveBlocksPerMultiprocessor(&per_cu, (const void*)fwd_kernel, 256, 0);
        if (per_cu < 1) per_cu = 1;
        if (per_cu > 2) per_cu = 2;
        grid = cus * per_cu;
        if (grid < 384) { fprintf(stderr, "kernel_launch: grid %d < 384 resident workgroups needed by the fused LayerNorm exchange\n", grid); grid = -1; return; }
    }
    if (grid < 0) return;
    Params p{};
    const float** pp = (const float**)&p;
    for (int i = 0; i < 26; ++i) pp[i] = (const float*)d_in[i];
    p.out = (float*)d_out; p.ws = (unsigned char*)d_ws;
    (void)hipMemsetAsync((unsigned char*)d_ws + OFF_BAR, 0, 16384, stream);
#if SINGLE_LAUNCH
    p.ph_lo = 0; p.ph_hi = N_PHASES;
    void* args[] = {&p};
    hipError_t e = hipLaunchCooperativeKernel((const void*)fwd_kernel, dim3(grid), dim3(256), args, 0, stream);
    if (e != hipSuccess) fprintf(stderr, "cooperative launch failed: %s (grid %d)\n", hipGetErrorString(e), grid);
#else
    for (int ph = 0; ph < N_PHASES; ++ph) {
        p.ph_lo = ph; p.ph_hi = ph + 1;
        void* args[] = {&p};
        hipError_t e = hipLaunchCooperativeKernel((const void*)fwd_kernel, dim3(grid), dim3(256), args, 0, stream);
        if (e != hipSuccess) { fprintf(stderr, "launch %d failed: %s (grid %d)\n", ph, hipGetErrorString(e), grid); break; }
    }
#endif
}
```

```cpp
#include <hip/hip_runtime.h>
#include <hip/hip_cooperative_groups.h>
#include <cstdio>
namespace cg = cooperative_groups;

#ifndef IM
#define IM 0xffff
#endif
#ifndef IM
#define IM 0xffff
#endif
#ifndef DUPM
#define DUPM 0
#endif
#ifndef PHM
#define PHM 0xffff
#endif
#ifndef SINGLE_LAUNCH
#define SINGLE_LAUNCH 1
#endif

#define LAS __attribute__((address_space(3)))
typedef unsigned short bf16_t;
typedef __attribute__((ext_vector_type(8))) short bf16x8;
typedef __attribute__((ext_vector_type(4))) short bf16x4;
typedef __attribute__((ext_vector_type(4))) float f32x4;
#define DI __device__ __forceinline__

constexpr int NTOK = 6144, NCTX = 4096, DM = 1024, NIN = 3344, NINP = 3456, DFF = 4096;
constexpr float ALPHA = 1.681792830507429f;
constexpr float LOG2E = 1.4426950408889634f;
constexpr float LN_EPS = 1e-5f;

constexpr size_t al256(size_t x) { return (x + 255) & ~(size_t)255; }
constexpr size_t OFF_WT_IN = 0;
constexpr size_t OFF_WT_OUT = OFF_WT_IN + al256((size_t)4 * NINP * DM * 2);
constexpr size_t OFF_WT_1 = OFF_WT_OUT + al256((size_t)4 * DM * DM * 2);
constexpr size_t OFF_WT_2 = OFF_WT_1 + al256((size_t)4 * DFF * DM * 2);
constexpr size_t OFF_MOD = OFF_WT_2 + al256((size_t)4 * DFF * DM * 2);
constexpr size_t OFF_X = OFF_MOD + al256((size_t)4 * 3 * 6144 * 4);
constexpr size_t OFF_H = OFF_X + al256((size_t)NTOK * DM * 4);
constexpr size_t OFF_P = OFF_H + al256((size_t)NTOK * DM * 2);
constexpr size_t OFF_PT_AV = OFF_P + al256((size_t)NTOK * NIN * 2);
constexpr size_t OFF_PT_BV = OFF_PT_AV + al256((size_t)NTOK * 512 * 2);
constexpr size_t OFF_PT_CV = OFF_PT_BV + al256((size_t)NTOK * 256 * 2);
constexpr size_t OFF_PT_CK = OFF_PT_CV + al256((size_t)NTOK * 256 * 2);
constexpr size_t OFF_G = OFF_PT_CK + al256((size_t)NTOK * 256 * 2);
constexpr size_t OFF_MIX = OFF_G + al256((size_t)NTOK * 16 * 4);
constexpr size_t OFF_Y = OFF_MIX + al256((size_t)NTOK * DM * 2);
constexpr size_t OFF_U = OFF_Y + al256((size_t)NTOK * DM * 4);
constexpr size_t OFF_CAK = OFF_U + al256((size_t)NTOK * DFF * 2);
constexpr size_t OFF_CAVT = OFF_CAK + al256((size_t)32 * 512 * 128 * 2);
constexpr size_t OFF_CBK = OFF_CAVT + al256((size_t)32 * 512 * 128 * 2);
constexpr size_t OFF_CBVT = OFF_CBK + al256((size_t)32 * 512 * 64 * 2);
constexpr size_t OFF_C0T = OFF_CBVT + al256((size_t)32 * 512 * 64 * 2);
constexpr size_t OFF_ROPE = OFF_C0T + al256((size_t)64 * 64 * 64 * 2);
constexpr size_t OFF_LAM = OFF_ROPE + al256((size_t)2 * 1024 * 4);
constexpr size_t OFF_BAR = OFF_LAM + 256;
constexpr size_t OFF_LNCNT = OFF_BAR + 13824;
constexpr size_t OFF_MIXCTR = OFF_BAR + 15360;
constexpr size_t OFF_STATS = OFF_BAR + 16384;
constexpr size_t WS_END = OFF_STATS + (size_t)NTOK * 16 * 8;

constexpr size_t O_YP = 0, O_YS = 4194304, O_AK = 6291456, O_AV = 14680064, O_BK = 23068672, O_BV = 27262976,
                 O_NC = 31457280, O_NN = 33554432, O_NM = 33587200;

struct Params {
    const float* x_prompt; const float* x_sample; const float* cache_a_k; const float* cache_a_v;
    const float* cache_b_k; const float* cache_b_v; const float* state_c; const float* state_n;
    const float* state_m; const float* c; const float* c_ctx; const float* w_in; const float* gate_bias;
    const float* diff_lambda; const float* diff_norm_g; const float* nat_rpb; const float* mlstm_norm_g;
    const float* w_out; const float* ada_w; const float* ada_b; const float* ln1_g; const float* ln1_b;
    const float* ln2_g; const float* ln2_b; const float* w_mlp1; const float* w_mlp2;
    float* out; unsigned char* ws; int ph_lo; int ph_hi;
};

DI int opaque_v(int x) { asm volatile("" : "+v"(x)); return x; }
DI int opaque_s(int x) { x = __builtin_amdgcn_readfirstlane(x); asm volatile("" : "+s"(x)); return x; }
DI size_t opaque_zero() { size_t z = 0; asm volatile("" : "+s"(z)); return z; }
DI unsigned char* opaque_ws(unsigned char* w) { return w + opaque_zero(); }
DI float* opaque_out(float* w) { return w + opaque_zero(); }
DI unsigned short f2bf(float x) { unsigned u = __float_as_uint(x); u += 0x7fffu + ((u >> 16) & 1u); return (unsigned short)(u >> 16); }
DI float bf2f(unsigned short h) { return __uint_as_float(((unsigned)h) << 16); }
DI unsigned pack2(float a, float b) { return (unsigned)f2bf(a) | ((unsigned)f2bf(b) << 16); }
DI f32x4 mfma16(bf16x8 a, bf16x8 b, f32x4 c) { return __builtin_amdgcn_mfma_f32_16x16x32_bf16(a, b, c, 0, 0, 0); }
DI float fexp2(float x) { return __builtin_amdgcn_exp2f(x); }
DI bf16x8 pack8(float a0, float a1, float a2, float a3, float a4, float a5, float a6, float a7) {
    uint4 u; u.x = pack2(a0, a1); u.y = pack2(a2, a3); u.z = pack2(a4, a5); u.w = pack2(a6, a7);
    return __builtin_bit_cast(bf16x8, u);
}
DI bf16x8 cat4(bf16x4 a, bf16x4 b) { return __builtin_shufflevector(a, b, 0, 1, 2, 3, 4, 5, 6, 7); }
DI float wave_sum(float v) {
#pragma unroll
    for (int o = 32; o > 0; o >>= 1) v += __shfl_xor(v, o);
    return v;
}
DI float grp_sum(float v) { v += __shfl_xor(v, 16); v += __shfl_xor(v, 32); return v; }
DI float grp_max(float v) { v = fmaxf(v, __shfl_xor(v, 16)); v = fmaxf(v, __shfl_xor(v, 32)); return v; }

DI void transpose_job(const float* __restrict__ src, bf16_t* __restrict__ dst, int R, int C, int Cpad, int nmat, float* tile, bool blocked = false) {
    const int tid = threadIdx.x;
    const int rt = R >> 6, ct = Cpad >> 6, per = rt * ct, total = per * nmat;
    for (int it = blockIdx.x; it < total; it += gridDim.x) {
        const int mat = it / per, rem = it - mat * per;
        const int r0 = (rem / ct) << 6, c0 = (rem % ct) << 6;
        const float* s = src + (size_t)mat * R * C;
        bf16_t* d = dst + (size_t)mat * Cpad * R;
#pragma unroll
        for (int i = 0; i < 4; ++i) {
            const int r = (tid >> 4) + 16 * i, c = (tid & 15) * 4;
            float4 v = make_float4(0.f, 0.f, 0.f, 0.f);
            if (c0 + c < C) v = *(const float4*)(s + (size_t)(r0 + r) * C + c0 + c);
            tile[r * 65 + c + 0] = v.x; tile[r * 65 + c + 1] = v.y; tile[r * 65 + c + 2] = v.z; tile[r * 65 + c + 3] = v.w;
        }
        __syncthreads();
        {
            const int c = tid >> 2, rs = (tid & 3) * 16;
            uint4 o0, o1;
            o0.x = pack2(tile[(rs + 0) * 65 + c], tile[(rs + 1) * 65 + c]);
            o0.y = pack2(tile[(rs + 2) * 65 + c], tile[(rs + 3) * 65 + c]);
            o0.z = pack2(tile[(rs + 4) * 65 + c], tile[(rs + 5) * 65 + c]);
            o0.w = pack2(tile[(rs + 6) * 65 + c], tile[(rs + 7) * 65 + c]);
            o1.x = pack2(tile[(rs + 8) * 65 + c], tile[(rs + 9) * 65 + c]);
            o1.y = pack2(tile[(rs + 10) * 65 + c], tile[(rs + 11) * 65 + c]);
            o1.z = pack2(tile[(rs + 12) * 65 + c], tile[(rs + 13) * 65 + c]);
            o1.w = pack2(tile[(rs + 14) * 65 + c], tile[(rs + 15) * 65 + c]);
            uint4* dp = blocked ? (uint4*)(d + ((size_t)((r0 + rs) >> 5) * Cpad + (c0 + c)) * 32 + ((r0 + rs) & 31))
                                : (uint4*)(d + (size_t)(c0 + c) * R + r0 + rs);
            dp[0] = o0; dp[1] = o1;
        }
        __syncthreads();
    }
}

DI void convert_job(const float* __restrict__ src, bf16_t* __restrict__ dst, size_t n) {
    for (size_t i = ((size_t)blockIdx.x * 256 + threadIdx.x) * 8; i < n; i += (size_t)gridDim.x * 256 * 8) {
        const float4 a = *(const float4*)(src + i), b = *(const float4*)(src + i + 4);
        uint4 o; o.x = pack2(a.x, a.y); o.y = pack2(a.z, a.w); o.z = pack2(b.x, b.y); o.w = pack2(b.z, b.w);
        *(uint4*)(dst + i) = o;
    }
}

DI void prep0(const Params& pin, unsigned char* smem) {
    const Params& p = pin; unsigned char* const ws_ = opaque_ws(pin.ws); float* const out_ = opaque_out(pin.out); const int tid = opaque_v(threadIdx.x);
    {
        float* sl = (float*)smem; float* red = (float*)(smem + 12288);
        for (int i = tid; i < 3072; i += 256) {
            const int cnd = i >> 10, k = i & 1023;
            const float v = (cnd == 0) ? p.c_ctx[k] : p.c[(cnd - 1) * 1024 + k];
            sl[i] = v / (1.f + __expf(-v));
        }
        __syncthreads();
        float* mod = (float*)(ws_ + OFF_MOD);
        const int kg = tid >> 4, cl = tid & 15;
        for (int it = blockIdx.x; it < 384; it += gridDim.x) {
            const int l = it / 96, j0 = (it % 96) * 64;
            const float* w = p.ada_w + (size_t)l * 1024 * 6144 + j0 + cl * 4;
            float4 a0 = make_float4(0, 0, 0, 0), a1 = a0, a2 = a0;
#pragma unroll 8
            for (int kk = 0; kk < 64; ++kk) {
                const int k = kg * 64 + kk;
                const float4 wv = *(const float4*)(w + (size_t)k * 6144);
                const float s0 = sl[k], s1 = sl[1024 + k], s2 = sl[2048 + k];
                a0.x += s0 * wv.x; a0.y += s0 * wv.y; a0.z += s0 * wv.z; a0.w += s0 * wv.w;
                a1.x += s1 * wv.x; a1.y += s1 * wv.y; a1.z += s1 * wv.z; a1.w += s1 * wv.w;
                a2.x += s2 * wv.x; a2.y += s2 * wv.y; a2.z += s2 * wv.z; a2.w += s2 * wv.w;
            }
            __syncthreads();
            float* r = red + kg * 192 + cl * 4;
            r[0] = a0.x; r[1] = a0.y; r[2] = a0.z; r[3] = a0.w;
            r[64] = a1.x; r[65] = a1.y; r[66] = a1.z; r[67] = a1.w;
            r[128] = a2.x; r[129] = a2.y; r[130] = a2.z; r[131] = a2.w;
            __syncthreads();
            if (tid < 192) {
                const int cnd = tid >> 6, col = tid & 63;
                float s = 0.f;
#pragma unroll
                for (int q = 0; q < 16; ++q) s += red[q * 192 + tid];
                mod[(l * 3 + cnd) * 6144 + j0 + col] = s + p.ada_b[l * 6144 + j0 + col];
            }
        }
        __syncthreads();
    }
    if (blockIdx.x == gridDim.x - 1) {
        float* rope = (float*)(ws_ + OFF_ROPE);
        for (int i = tid; i < 1024; i += 256) {
            const int pos = i >> 4, j = i & 15;
            const float freq = powf(10000.f, -(float)j / 16.f);
            float s, c; sincosf((float)pos * freq, &s, &c);
            rope[i] = c; rope[1024 + i] = s;
        }
        if (tid < 4) {
            const float* lp = p.diff_lambda + tid * 256;
            float s1 = 0.f, s2 = 0.f;
            for (int i = 0; i < 64; ++i) { s1 += lp[i] * lp[64 + i]; s2 += lp[128 + i] * lp[192 + i]; }
            const float li = 0.8f - 0.6f * expf(-0.3f * (float)tid);
            float* lam = (float*)(ws_ + OFF_LAM);
            lam[tid * 2] = expf(s1) - expf(s2) + li; lam[tid * 2 + 1] = li;
        }
    }
    float* tile = (float*)smem;
    transpose_job(p.w_in, (bf16_t*)(ws_ + OFF_WT_IN), 1024, NIN, NINP, 4, tile);
    transpose_job(p.w_out, (bf16_t*)(ws_ + OFF_WT_OUT), 1024, 1024, 1024, 4, tile);
    transpose_job(p.w_mlp1, (bf16_t*)(ws_ + OFF_WT_1), 1024, 4096, 4096, 4, tile);
    transpose_job(p.w_mlp2, (bf16_t*)(ws_ + OFF_WT_2), 4096, 1024, 1024, 4, tile);
    transpose_job(p.cache_a_v, (bf16_t*)(ws_ + OFF_CAVT), 512, 128, 128, 32, tile, true);
    transpose_job(p.cache_b_v, (bf16_t*)(ws_ + OFF_CBVT), 512, 64, 64, 32, tile, true);
    transpose_job(p.state_c, (bf16_t*)(ws_ + OFF_C0T), 64, 64, 64, 64, tile);
    convert_job(p.cache_a_k, (bf16_t*)(ws_ + OFF_CAK), (size_t)32 * 512 * 128);
    convert_job(p.cache_b_k, (bf16_t*)(ws_ + OFF_CBK), (size_t)32 * 512 * 64);
}

DI void prep1(const Params& pin) {
    const Params& p = pin; unsigned char* const ws_ = opaque_ws(pin.ws); float* const out_ = opaque_out(pin.out); const int tid_ = opaque_v(threadIdx.x); const int lane = tid_ & 63, wave = tid_ >> 6;
    const float* mod = (const float*)(ws_ + OFF_MOD);
    float* X = (float*)(ws_ + OFF_X);
    bf16_t* H = (bf16_t*)(ws_ + OFF_H);
    for (int row = blockIdx.x * 4 + wave; row < NTOK; row += gridDim.x * 4) {
        const float* src = row < NCTX ? p.x_prompt + (size_t)row * 1024 : p.x_sample + (size_t)(row - NCTX) * 1024;
        const int cnd = row < NCTX ? 0 : 1 + ((row - NCTX) >> 10);
        const float* md = mod + (size_t)cnd * 6144;
#pragma unroll
        for (int j = 0; j < 4; ++j) {
            const int c = lane * 4 + 256 * j;
            const float4 v = *(const float4*)(src + c);
            *(float4*)(X + (size_t)row * 1024 + c) = v;
            const float4 sh = *(const float4*)(md + c), sc = *(const float4*)(md + 1024 + c);
            uint2 o; o.x = pack2(v.x * (1.f + sc.x) + sh.x, v.y * (1.f + sc.y) + sh.y);
            o.y = pack2(v.z * (1.f + sc.z) + sh.z, v.w * (1.f + sc.w) + sh.w);
            *(uint2*)(H + (size_t)row * 1024 + c) = o;
        }
    }
}

enum { EPI_INPROJ = 0, EPI_LN1 = 1, EPI_RELU2 = 2, EPI_LN2 = 3 };

DI void epi_inproj(const Params& p, unsigned char* ws_, float* out_, int layer, const float* T, int rowbase, int colbase, int lane) {
    if (colbase >= NIN) return;
    bf16_t* P = (bf16_t*)(ws_ + OFF_P);
    const bool latent = rowbase >= NCTX;
    const int seq_tok0 = latent ? (NCTX + ((rowbase - NCTX) & ~1023)) : (rowbase & ~255);
    const int nseq = latent ? 1024 : 256;
    const int bctx = seq_tok0 >> 8;
    const int n0 = rowbase - seq_tok0;
    if (colbase >= 3328) {
        float* G = (float*)(ws_ + OFF_G);
        const float bias = p.gate_bias[layer * 16 + (lane & 15)];
        for (int rr = 0; rr < 16; ++rr) {
            const int r = rr * 4 + (lane >> 4);
            G[(size_t)(rowbase + r) * 16 + (lane & 15)] = T[r * 65 + (lane & 15)] + bias;
        }
        return;
    }
    bool toP = false, rope = false, toT = false, toO = false;
    size_t toff = 0, obase = 0; int tW = 0, tcr = 0, ohd = 64, ocr = 0;
    if (colbase < 1024) { toP = true; rope = latent; if (colbase >= 512) { toO = !latent; obase = O_AK; ohd = 128; ocr = colbase - 512; } }
    else if (colbase < 1536) { toT = true; toff = OFF_PT_AV; tW = 512; tcr = colbase - 1024; toO = !latent; obase = O_AV; ohd = 128; ocr = tcr; }
    else if (colbase < 1792) { toP = true; }
    else if (colbase < 2048) { toP = true; toO = !latent; obase = O_BK; ohd = 64; ocr = colbase - 1792; }
    else if (colbase < 2304) { toT = true; toff = OFF_PT_BV; tW = 256; tcr = colbase - 2048; toO = !latent; obase = O_BV; ohd = 64; ocr = tcr; }
    else if (colbase < 2560) { toP = true; }
    else if (colbase < 2816) { toP = true; toT = true; toff = OFF_PT_CK; tW = 256; tcr = colbase - 2560; }
    else if (colbase < 3072) { toT = true; toff = OFF_PT_CV; tW = 256; tcr = colbase - 2816; }
    else { toP = true; }
    if (toO) {
        const int h = ocr / ohd, w = ocr - h * ohd + lane;
        float* O = out_ + obase + (((size_t)(bctx * 4 + layer) * 4 + h) * 256 + n0) * ohd + w;
#pragma unroll 4
        for (int r = 0; r < 64; ++r) O[(size_t)r * ohd] = T[r * 65 + lane];
    }
    if (toP) {
        bf16_t* Pp = P + (size_t)rowbase * NIN + colbase + lane;
        if (rope) {
            const float* rc = (const float*)(ws_ + OFF_ROPE);
            const float* rs = rc + 1024;
#pragma unroll 4
            for (int r = 0; r < 64; ++r) {
                const float v = T[r * 65 + lane], vp = T[r * 65 + (lane ^ 16)];
                const int t = n0 + r;
                const int pos = (lane < 32) ? (t >> 6) : (t & 63);
                const float c = rc[pos * 16 + (lane & 15)], sn = rs[pos * 16 + (lane & 15)];
                const float o = (lane & 16) ? (vp * sn + v * c) : (v * c - vp * sn);
                Pp[(size_t)r * NIN] = f2bf(o);
            }
        } else {
#pragma unroll 4
            for (int r = 0; r < 64; ++r) Pp[(size_t)r * NIN] = f2bf(T[r * 65 + lane]);
        }
    }
    if (toT) {
        const int n = n0 + lane;
        bf16_t* Tp = (bf16_t*)(ws_ + toff) + (size_t)seq_tok0 * tW + ((size_t)(n >> 5) * tW + tcr) * 32 + (n & 31);
#pragma unroll 4
        for (int c = 0; c < 64; ++c) Tp[(size_t)c * 32] = f2bf(T[lane * 65 + c]);
    }
}

template <int WHICH>
DI void epi_ln(const Params& p, unsigned char* ws_, float* out_, int l, float* T, int tm, int tn, int wn, int rowbase, int colbase, int lane, int tid) {
    const float* mod = (const float*)(ws_ + OFF_MOD);
    float* X = (float*)(ws_ + OFF_X);
    bf16_t* H = (bf16_t*)(ws_ + OFF_H);
    const int cnd = rowbase < NCTX ? 0 : 1 + ((rowbase - NCTX) >> 10);
    const float* md = mod + (size_t)(l * 3 + cnd) * 6144;
    const int col = colbase + lane;
    const bool last = (WHICH == 2 && l == 3);
    float s1 = 0.f, s2 = 0.f;
#pragma unroll 8
    for (int c = 0; c < 64; ++c) { const float v = T[lane * 65 + c]; s1 += v; s2 += v * v; }
    unsigned long long* stats = (unsigned long long*)(ws_ + OFF_STATS);
    __hip_atomic_store(stats + (size_t)(rowbase + lane) * 16 + tn * 2 + wn,
                       ((unsigned long long)__float_as_uint(s2) << 32) | (unsigned long long)__float_as_uint(s1), __ATOMIC_RELAXED, __HIP_MEMORY_SCOPE_AGENT);
    unsigned* cnt = (unsigned*)(ws_ + OFF_LNCNT) + (l * 2 + (WHICH - 1)) * 48 + tm;
    asm volatile("s_waitcnt vmcnt(0)" ::: "memory");
    __syncthreads();
    if (tid == 0) {
        (void)__hip_atomic_fetch_add(cnt, 1u, __ATOMIC_RELAXED, __HIP_MEMORY_SCOPE_AGENT);
        unsigned sp = 0;
        while (__hip_atomic_load(cnt, __ATOMIC_RELAXED, __HIP_MEMORY_SCOPE_AGENT) < 8u) { __builtin_amdgcn_s_sleep(1); if (++sp > (1u << 22)) break; }
    }
    __syncthreads();
    float t1 = 0.f, t2 = 0.f;
    {
        unsigned long long* sp8 = stats + (size_t)(rowbase + lane) * 16;
        unsigned long long a[16];
#pragma unroll
        for (int q = 0; q < 16; ++q) a[q] = __hip_atomic_load(sp8 + q, __ATOMIC_RELAXED, __HIP_MEMORY_SCOPE_AGENT);
#pragma unroll
        for (int q = 0; q < 16; ++q) { t1 += __uint_as_float((unsigned)a[q]); t2 += __uint_as_float((unsigned)(a[q] >> 32)); }
    }
    const float mu = t1 * (1.f / 1024.f);
    const float rstd = rsqrtf(fmaxf(t2 * (1.f / 1024.f) - mu * mu, 0.f) + LN_EPS);
    const float lng = (WHICH == 1 ? p.ln1_g : p.ln2_g)[l * 1024 + col], lnb = (WHICH == 1 ? p.ln1_b : p.ln2_b)[l * 1024 + col];
    if (last) {
        float* op = out_ + (size_t)rowbase * 1024 + col;
#pragma unroll 8
        for (int r = 0; r < 64; ++r) op[(size_t)r * 1024] = (T[r * 65 + lane] - __shfl(mu, r)) * __shfl(rstd, r) * lng + lnb;
    } else {
        const float* nmd = (WHICH == 1) ? md : mod + (size_t)((l + 1) * 3 + cnd) * 6144;
        const float sh = nmd[(WHICH == 1 ? 3072 : 0) + col], sc1p = 1.f + nmd[(WHICH == 1 ? 4096 : 1024) + col];
        float* xp = X + (size_t)rowbase * 1024 + col;
        bf16_t* hp = H + (size_t)rowbase * 1024 + col;
#pragma unroll 8
        for (int r = 0; r < 64; ++r) {
            const float o = (T[r * 65 + lane] - __shfl(mu, r)) * __shfl(rstd, r) * lng + lnb;
            xp[(size_t)r * 1024] = o;
            hp[(size_t)r * 1024] = f2bf(o * sc1p + sh);
        }
    }
}

template <int EPI>
DI void gemm_phase(const Params& pin, int layer, size_t offA, size_t offB, int ntn, int K, int ldc,
                   unsigned char* smem) {
    const Params& p = pin; unsigned char* const ws_ = opaque_ws(pin.ws); float* const out_ = opaque_out(pin.out); const int tid = opaque_v(threadIdx.x), lane = tid & 63, wave = opaque_s(tid >> 6);
    const bf16_t* __restrict__ A = (const bf16_t*)(ws_ + offA); const bf16_t* __restrict__ Bt = (const bf16_t*)(ws_ + offB);
    const int wm = wave >> 1, wn = wave & 1;
    const int lr = lane & 15, g = lane >> 4;
    const int ntm = NTOK / 128;
    const int ntiles = ntm * ntn, nk = K >> 6;
    for (int tile = blockIdx.x; tile < ntiles; tile += gridDim.x) {
        const int tm = tile % ntm, tn = tile / ntm;
        const int m0 = tm * 128, n0 = tn * 128;
        f32x4 acc[4][4];
#pragma unroll
        for (int mi = 0; mi < 4; ++mi)
#pragma unroll
            for (int ni = 0; ni < 4; ++ni) acc[mi][ni] = (f32x4){0.f, 0.f, 0.f, 0.f};
        const bf16_t* Ag = A + (size_t)m0 * K;
        const bf16_t* Bg = Bt + (size_t)n0 * K;
        const bf16_t* ag = Ag + (size_t)(wave * 32 + (lane >> 3)) * K + (((lane & 7) ^ (lane >> 3)) << 3);
        const bf16_t* bg = Bg + (size_t)(wave * 32 + (lane >> 3)) * K + (((lane & 7) ^ (lane >> 3)) << 3);
#pragma unroll
        for (int j = 0; j < 4; ++j) {
            __builtin_amdgcn_global_load_lds((const unsigned*)(ag + (size_t)j * 8 * K), (LAS unsigned*)(smem + (wave * 4 + j) * 1024), 16, 0, 0);
            __builtin_amdgcn_global_load_lds((const unsigned*)(bg + (size_t)j * 8 * K), (LAS unsigned*)(smem + 16384 + (wave * 4 + j) * 1024), 16, 0, 0);
        }
        asm volatile("s_waitcnt vmcnt(0)" ::: "memory");
        __syncthreads();
        for (int kt = 0; kt < nk; ++kt) {
            const unsigned char* cur = smem + (kt & 1) * 32768;
            unsigned char* nxt = smem + ((kt + 1) & 1) * 32768;
            if (kt + 1 < nk) {
                const int k0 = (kt + 1) << 6;
#pragma unroll
                for (int j = 0; j < 4; ++j) {
                    __builtin_amdgcn_global_load_lds((const unsigned*)(ag + (size_t)j * 8 * K + k0), (LAS unsigned*)(nxt + (wave * 4 + j) * 1024), 16, 0, 0);
                    __builtin_amdgcn_global_load_lds((const unsigned*)(bg + (size_t)j * 8 * K + k0), (LAS unsigned*)(nxt + 16384 + (wave * 4 + j) * 1024), 16, 0, 0);
                }
            }
#pragma unroll
            for (int kk = 0; kk < 2; ++kk) {
                bf16x8 af[4], bfr[4];
#pragma unroll
                for (int mi = 0; mi < 4; ++mi) {
                    const int row = wm * 64 + mi * 16 + lr;
                    af[mi] = *(const bf16x8*)(cur + row * 128 + (((kk * 4 + g) ^ (row & 7)) << 4));
                }
#pragma unroll
                for (int ni = 0; ni < 4; ++ni) {
                    const int row = wn * 64 + ni * 16 + lr;
                    bfr[ni] = *(const bf16x8*)(cur + 16384 + row * 128 + (((kk * 4 + g) ^ (row & 7)) << 4));
                }
#pragma unroll
                for (int mi = 0; mi < 4; ++mi)
#pragma unroll
                    for (int ni = 0; ni < 4; ++ni) acc[mi][ni] = mfma16(af[mi], bfr[ni], acc[mi][ni]);
            }
            asm volatile("s_waitcnt vmcnt(0)" ::: "memory");
            __syncthreads();
        }
        if (EPI == EPI_LN1 || EPI == EPI_LN2) {
            const int rb = m0 + wm * 64, cb = n0 + wn * 64;
            const int cnd = rb < NCTX ? 0 : 1 + ((rb - NCTX) >> 10);
            const float* gp = (const float*)(ws_ + OFF_MOD) + (size_t)(layer * 3 + cnd) * 6144 + (EPI == EPI_LN1 ? 2048 : 5120) + cb + lr;
            const float* xp = (const float*)(ws_ + OFF_X) + (size_t)(rb + 4 * g) * 1024 + cb + lr;
            float gt[4];
#pragma unroll
            for (int ni = 0; ni < 4; ++ni) gt[ni] = gp[ni * 16];
#pragma unroll
            for (int mh = 0; mh < 2; ++mh) {
                f32x4 xv[2][4];
#pragma unroll
                for (int m2 = 0; m2 < 2; ++m2)
#pragma unroll
                    for (int ni = 0; ni < 4; ++ni)
#pragma unroll
                        for (int i = 0; i < 4; ++i) xv[m2][ni][i] = xp[(size_t)((mh * 2 + m2) * 16 + i) * 1024 + ni * 16];
#pragma unroll
                for (int m2 = 0; m2 < 2; ++m2)
#pragma unroll
                    for (int ni = 0; ni < 4; ++ni)
#pragma unroll
                        for (int i = 0; i < 4; ++i) acc[mh * 2 + m2][ni][i] = ALPHA * xv[m2][ni][i] + gt[ni] * acc[mh * 2 + m2][ni][i];
                __builtin_amdgcn_sched_barrier(0);
            }
        }
        float* T = (float*)smem + wave * (64 * 65);
#pragma unroll
        for (int mi = 0; mi < 4; ++mi)
#pragma unroll
            for (int ni = 0; ni < 4; ++ni)
#pragma unroll
                for (int i = 0; i < 4; ++i) T[(mi * 16 + 4 * g + i) * 65 + ni * 16 + lr] = acc[mi][ni][i];
        const int rowbase = m0 + wm * 64, colbase = n0 + wn * 64;
        if (EPI == EPI_INPROJ) {
            epi_inproj(p, ws_, out_, layer, T, rowbase, colbase, lane);
        } else if (EPI == EPI_LN1) {
            epi_ln<1>(p, ws_, out_, layer, T, tm, tn, wn, rowbase, colbase, lane, tid);
        } else if (EPI == EPI_LN2) {
            epi_ln<2>(p, ws_, out_, layer, T, tm, tn, wn, rowbase, colbase, lane, tid);
        } else {
            bf16_t* U = (bf16_t*)(ws_ + OFF_U) + (size_t)rowbase * ldc + colbase + lane;
#pragma unroll 4
            for (int r = 0; r < 64; ++r) { const float v = fmaxf(T[r * 65 + lane], 0.f); U[(size_t)r * ldc] = f2bf(v * v); }
        }
        __syncthreads();
    }
}

template <int NMAP, int DV>
struct AttnSt { f32x4 O[NMAP][DV / 16]; float m[NMAP]; float l[NMAP]; };
template <int NMAP, int DV>
struct UnitFrags { bf16x8 k[NMAP][2][2]; bf16x8 v[DV / 16]; };

template <int NMAP, int DV>
struct TileGeom {
    static constexpr int KROW = NMAP * 128, KBYTES = 64 * KROW, VUNIT = DV * 64, TBYTES = KBYTES + 2 * VUNIT;
};
DI int kswz(int row) { return (row & 3) | (((row >> 3) & 3) << 2); }

template <int NMAP, int DV>
DI void stage_tile(unsigned char* buf, const bf16_t* kg, int kstride, const bf16_t* vg, int vunit, int wave, int lane) {
    typedef TileGeom<NMAP, DV> TG;
    if (NMAP == 2) {
#pragma unroll
        for (int j = 0; j < 4; ++j) {
            const int jj = wave * 4 + j, row = jj * 4 + (lane >> 4), lc = (lane & 15) ^ kswz(row);
            __builtin_amdgcn_global_load_lds((const unsigned*)(kg + (size_t)row * kstride + lc * 8), (LAS unsigned*)(buf + jj * 1024), 16, 0, 0);
        }
    } else {
#pragma unroll
        for (int j = 0; j < 2; ++j) {
            const int jj = wave * 2 + j, row = jj * 8 + (lane >> 3), lc = (lane & 7) ^ (kswz(row) >> 1);
            __builtin_amdgcn_global_load_lds((const unsigned*)(kg + (size_t)row * kstride + lc * 8), (LAS unsigned*)(buf + jj * 1024), 16, 0, 0);
        }
    }
    constexpr int VI = TG::VUNIT / 1024, PER = 2 * VI / 4;
#pragma unroll
    for (int j = 0; j < PER; ++j) {
        const int jj = wave * PER + j, unit = jj / VI, piece = jj % VI;
        __builtin_amdgcn_global_load_lds((const unsigned*)(vg + (size_t)unit * vunit + piece * 512 + lane * 8),
                                         (LAS unsigned*)(buf + TG::KBYTES + jj * 1024), 16, 0, 0);
    }
}

template <int NMAP, int DV>
DI void lds_unit(UnitFrags<NMAP, DV>& f, const unsigned char* buf, int rowbase, int voff, int lr, int g) {
    typedef TileGeom<NMAP, DV> TG;
#pragma unroll
    for (int b = 0; b < 2; ++b) {
        const int row = rowbase + (lr >> 2) * 8 + (lr & 3) + 4 * b, sw = kswz(row);
        if (NMAP == 2) {
#pragma unroll
            for (int m = 0; m < NMAP; ++m)
#pragma unroll
                for (int kk = 0; kk < 2; ++kk) f.k[m][b][kk] = *(const bf16x8*)(buf + row * 256 + (((m * 8 + kk * 4 + g) ^ sw) << 4));
        } else {
#pragma unroll
            for (int kk = 0; kk < 2; ++kk) f.k[0][b][kk] = *(const bf16x8*)(buf + row * 128 + (((kk * 4 + g) ^ (sw >> 1)) << 4));
        }
    }
#pragma unroll
    for (int vb = 0; vb < DV / 16; ++vb) f.v[vb] = *(const bf16x8*)(buf + TG::KBYTES + voff + (vb * 16 + lr) * 64);
}

template <int DV>
DI void lds_unit_sel(UnitFrags<1, DV>& f, const unsigned char* buf, int rowbase, int voff, int lr, int g, int msel) {
    typedef TileGeom<2, DV> TG;
#pragma unroll
    for (int b = 0; b < 2; ++b) {
        const int row = rowbase + (lr >> 2) * 8 + (lr & 3) + 4 * b, sw = kswz(row);
#pragma unroll
        for (int kk = 0; kk < 2; ++kk) f.k[0][b][kk] = *(const bf16x8*)(buf + row * 256 + (((msel * 8 + kk * 4 + g) ^ sw) << 4));
    }
#pragma unroll
    for (int vb = 0; vb < DV / 16; ++vb) f.v[vb] = *(const bf16x8*)(buf + TG::KBYTES + voff + (vb * 16 + lr) * 64);
}

template <int NMAP, int DV, class SrcFn, class CompFn>
DI void tile_pipeline(unsigned char* tiles, int nt, int wave, int lane, SrcFn src, CompFn comp) {
    typedef TileGeom<NMAP, DV> TG;
    {
        const bf16_t *kg, *vg; int ks, vu;
        src(0, kg, ks, vg, vu);
        stage_tile<NMAP, DV>(tiles, kg, ks, vg, vu, wave, lane);
    }
    asm volatile("s_waitcnt vmcnt(0)" ::: "memory");
    __syncthreads();
    for (int t = 0; t < nt; ++t) {
        unsigned char* cur = tiles + (t & 1) * TG::TBYTES;
        if (t + 1 < nt) {
            const bf16_t *kg, *vg; int ks, vu;
            src(t + 1, kg, ks, vg, vu);
            stage_tile<NMAP, DV>(tiles + ((t + 1) & 1) * TG::TBYTES, kg, ks, vg, vu, wave, lane);
        }
        comp(t, cur);
        asm volatile("s_waitcnt vmcnt(0)" ::: "memory");
        __syncthreads();
    }
}

template <int NMAP, int DV, bool HASBIAS>
DI void compute_unit(AttnSt<NMAP, DV>& st, const UnitFrags<NMAP, DV>& f, const bf16x8 (&qf)[NMAP][2], float sc, const float (&bias)[8]) {
    bf16x8 pk[NMAP];
#pragma unroll
    for (int m = 0; m < NMAP; ++m) {
        f32x4 sa = (f32x4){0.f, 0.f, 0.f, 0.f}, sb = sa;
        sa = mfma16(f.k[m][0][0], qf[m][0], sa); sa = mfma16(f.k[m][0][1], qf[m][1], sa);
        sb = mfma16(f.k[m][1][0], qf[m][0], sb); sb = mfma16(f.k[m][1][1], qf[m][1], sb);
        float s[8];
#pragma unroll
        for (int j = 0; j < 4; ++j) { s[j] = sa[j] * sc; s[4 + j] = sb[j] * sc; }
        if (HASBIAS) {
#pragma unroll
            for (int j = 0; j < 8; ++j) s[j] += bias[j];
        }
        float mx = fmaxf(fmaxf(fmaxf(s[0], s[1]), fmaxf(s[2], s[3])), fmaxf(fmaxf(s[4], s[5]), fmaxf(s[6], s[7])));
        mx = grp_max(mx);
        const float mnew = fmaxf(st.m[m], mx);
        const float alpha = fexp2(st.m[m] - mnew);
        float ps = 0.f;
#pragma unroll
        for (int j = 0; j < 8; ++j) { s[j] = fexp2(s[j] - mnew); ps += s[j]; }
        st.l[m] = st.l[m] * alpha + ps; st.m[m] = mnew;
#pragma unroll
        for (int vb = 0; vb < DV / 16; ++vb) st.O[m][vb] *= alpha;
        pk[m] = pack8(s[0], s[1], s[2], s[3], s[4], s[5], s[6], s[7]);
    }
#pragma unroll
    for (int vb = 0; vb < DV / 16; ++vb) {
#pragma unroll
        for (int m = 0; m < NMAP; ++m) st.O[m][vb] = mfma16(f.v[vb], pk[m], st.O[m][vb]);
    }
}

template <int NMAP, int DV>
DI void attn_init(AttnSt<NMAP, DV>& st) {
#pragma unroll
    for (int m = 0; m < NMAP; ++m) {
        st.m[m] = -INFINITY; st.l[m] = 0.f;
#pragma unroll
        for (int vb = 0; vb < DV / 16; ++vb) st.O[m][vb] = (f32x4){0.f, 0.f, 0.f, 0.f};
    }
}

template <bool LAT>
DI void item_diffattn(const Params& pin, int l, int seq, int h, int qt, unsigned char* smem, int wave, int lane) {
    const Params& p = pin; unsigned char* const ws_ = opaque_ws(pin.ws); float* const out_ = opaque_out(pin.out); lane = opaque_v(lane); wave = opaque_s(wave);
    const int lr = lane & 15, g = lane >> 4;
    const int nseq = LAT ? 1024 : 256;
    const int tok0 = LAT ? NCTX + seq * 1024 : seq * 256;
    const bf16_t* P = (const bf16_t*)(ws_ + OFF_P);
    const int q0 = qt * 64 + wave * 16;
    bf16x8 qf[2][2];
    {
        const bf16_t* qp = P + (size_t)(tok0 + q0 + lr) * NIN + h * 128 + 8 * g;
#pragma unroll
        for (int m = 0; m < 2; ++m)
#pragma unroll
            for (int kk = 0; kk < 2; ++kk) qf[m][kk] = *(const bf16x8*)(qp + m * 64 + kk * 32);
    }
    AttnSt<2, 128> st;
    attn_init<2, 128>(st);
    const float sc = 0.125f * LOG2E;
    const size_t hb = (size_t)((seq * 4 + l) * 4 + h);
    const bf16_t* kc = (const bf16_t*)(ws_ + OFF_CAK) + hb * 512 * 128;
    const bf16_t* vc = (const bf16_t*)(ws_ + OFF_CAVT) + hb * 128 * 512;
    const bf16_t* kn = P + (size_t)tok0 * NIN + 512 + h * 128;
    const bf16_t* vn = (const bf16_t*)(ws_ + OFF_PT_AV) + (size_t)tok0 * 512 + (size_t)(h * 128) * 32;
    const int ncache = LAT ? 8 : 0;
    __syncthreads();
    tile_pipeline<2, 128>(smem, ncache + nseq / 64, wave, lane,
        [&](int t, const bf16_t*& kg, int& ks, const bf16_t*& vg, int& vu) {
            if (t < ncache) { kg = kc + (size_t)t * 64 * 128; ks = 128; vg = vc + (size_t)(2 * t) * 128 * 32; vu = 128 * 32; }
            else { const int tt = t - ncache; kg = kn + (size_t)tt * 64 * NIN; ks = NIN; vg = vn + (size_t)(2 * tt) * 512 * 32; vu = 512 * 32; }
        },
        [&](int t, const unsigned char* buf) {
            const float nob[8] = {0.f, 0.f, 0.f, 0.f, 0.f, 0.f, 0.f, 0.f};
#pragma unroll 1
            for (int half = 0; half < 2; ++half) {
                UnitFrags<2, 128> f;
                lds_unit<2, 128>(f, buf, 32 * half, half * TileGeom<2, 128>::VUNIT + g * 16, lr, g);
                compute_unit<2, 128, false>(st, f, qf, sc, nob);
            }
        });
    const float inv0 = 1.f / grp_sum(st.l[0]), inv1 = 1.f / grp_sum(st.l[1]);
    const float* lamp = (const float*)(ws_ + OFF_LAM);
    const float lam = lamp[l * 2], lam_init = lamp[l * 2 + 1];
    const float c1 = lam * inv1;
    float ss = 0.f;
#pragma unroll
    for (int vb = 0; vb < 8; ++vb)
#pragma unroll
        for (int i = 0; i < 4; ++i) {
            const float o = st.O[0][vb][i] * inv0 - st.O[1][vb][i] * c1;
            st.O[0][vb][i] = o; ss += o * o;
        }
    ss = grp_sum(ss);
    const float r = rsqrtf(ss * (1.f / 128.f) + LN_EPS) * (1.f - lam_init);
    bf16_t* MIX = (bf16_t*)(ws_ + OFF_MIX) + (size_t)(tok0 + q0 + lr) * 1024 + h * 128;
    const float* gn = p.diff_norm_g + l * 128;
#pragma unroll
    for (int vb = 0; vb < 8; ++vb) {
        const int v = vb * 16 + 4 * g;
        const float4 g4 = *(const float4*)(gn + v);
        uint2 o; o.x = pack2(st.O[0][vb][0] * r * g4.x, st.O[0][vb][1] * r * g4.y);
        o.y = pack2(st.O[0][vb][2] * r * g4.z, st.O[0][vb][3] * r * g4.w);
        *(uint2*)(MIX + v) = o;
    }
}

DI void item_diffattn_lat(const Params& pin, int l, int seq, int h, int qt32, unsigned char* smem, int wave, int lane) {
    const Params& p = pin; unsigned char* const ws_ = opaque_ws(pin.ws); float* const out_ = opaque_out(pin.out); lane = opaque_v(lane); wave = opaque_s(wave);
    const int lr = lane & 15, g = lane >> 4;
    const int tok0 = NCTX + seq * 1024;
    const bf16_t* P = (const bf16_t*)(ws_ + OFF_P);
    const int msel = wave & 1;
    const int q0 = qt32 * 32 + (wave >> 1) * 16;
    bf16x8 qf[1][2];
    {
        const bf16_t* qp = P + (size_t)(tok0 + q0 + lr) * NIN + h * 128 + msel * 64 + 8 * g;
        qf[0][0] = *(const bf16x8*)(qp); qf[0][1] = *(const bf16x8*)(qp + 32);
    }
    AttnSt<1, 128> st;
    attn_init<1, 128>(st);
    const float sc = 0.125f * LOG2E;
    const size_t hb = (size_t)((seq * 4 + l) * 4 + h);
    const bf16_t* kc = (const bf16_t*)(ws_ + OFF_CAK) + hb * 512 * 128;
    const bf16_t* vc = (const bf16_t*)(ws_ + OFF_CAVT) + hb * 128 * 512;
    const bf16_t* kn = P + (size_t)tok0 * NIN + 512 + h * 128;
    const bf16_t* vn = (const bf16_t*)(ws_ + OFF_PT_AV) + (size_t)tok0 * 512 + (size_t)(h * 128) * 32;
    __syncthreads();
    tile_pipeline<2, 128>(smem, 24, wave, lane,
        [&](int t, const bf16_t*& kg, int& ks, const bf16_t*& vg, int& vu) {
            if (t < 8) { kg = kc + (size_t)t * 64 * 128; ks = 128; vg = vc + (size_t)(2 * t) * 128 * 32; vu = 128 * 32; }
            else { const int tt = t - 8; kg = kn + (size_t)tt * 64 * NIN; ks = NIN; vg = vn + (size_t)(2 * tt) * 512 * 32; vu = 512 * 32; }
        },
        [&](int t, const unsigned char* buf) {
            const float nob[8] = {0.f, 0.f, 0.f, 0.f, 0.f, 0.f, 0.f, 0.f};
#pragma unroll
            for (int half = 0; half < 2; ++half) {
                UnitFrags<1, 128> f;
                lds_unit_sel<128>(f, buf, 32 * half, half * TileGeom<2, 128>::VUNIT + g * 16, lr, g, msel);
                compute_unit<1, 128, false>(st, f, qf, sc, nob);
            }
        });
    const float* lamp = (const float*)(ws_ + OFF_LAM);
    const float lam = lamp[l * 2], lam_init = lamp[l * 2 + 1];
    const float inv = (msel ? lam : 1.f) / grp_sum(st.l[0]);
    float* xb = (float*)smem + (wave >> 1) * 32 * 64 + lane;
    if (msel) {
#pragma unroll
        for (int vb = 0; vb < 8; ++vb)
#pragma unroll
            for (int i = 0; i < 4; ++i) xb[(vb * 4 + i) * 64] = st.O[0][vb][i] * inv;
    }
    __syncthreads();
    if (msel) return;
    float ss = 0.f;
#pragma unroll
    for (int vb = 0; vb < 8; ++vb)
#pragma unroll
        for (int i = 0; i < 4; ++i) {
            const float o = st.O[0][vb][i] * inv - xb[(vb * 4 + i) * 64];
            st.O[0][vb][i] = o; ss += o * o;
        }
    ss = grp_sum(ss);
    const float r = rsqrtf(ss * (1.f / 128.f) + LN_EPS) * (1.f - lam_init);
    bf16_t* MIX = (bf16_t*)(ws_ + OFF_MIX) + (size_t)(tok0 + q0 + lr) * 1024 + h * 128;
    const float* gn = p.diff_norm_g + l * 128;
#pragma unroll
    for (int vb = 0; vb < 8; ++vb) {
        const int v = vb * 16 + 4 * g;
        const float4 g4 = *(const float4*)(gn + v);
        uint2 o; o.x = pack2(st.O[0][vb][0] * r * g4.x, st.O[0][vb][1] * r * g4.y);
        o.y = pack2(st.O[0][vb][2] * r * g4.z, st.O[0][vb][3] * r * g4.w);
        *(uint2*)(MIX + v) = o;
    }
}

DI void item_dense(const Params& pin, int seq, int h, int qt, unsigned char* smem, int wave, int lane) {
    const Params& p = pin; unsigned char* const ws_ = opaque_ws(pin.ws); float* const out_ = opaque_out(pin.out); lane = opaque_v(lane); wave = opaque_s(wave);
    const int lr = lane & 15, g = lane >> 4;
    const int tok0 = seq * 256;
    const bf16_t* P = (const bf16_t*)(ws_ + OFF_P);
    const int q0 = qt * 64 + wave * 16;
    bf16x8 qf[1][2];
    {
        const bf16_t* qp = P + (size_t)(tok0 + q0 + lr) * NIN + 1536 + h * 64 + 8 * g;
        qf[0][0] = *(const bf16x8*)(qp); qf[0][1] = *(const bf16x8*)(qp + 32);
    }
    AttnSt<1, 64> st;
    attn_init<1, 64>(st);
    const bf16_t* kn = P + (size_t)tok0 * NIN + 1792 + h * 64;
    const bf16_t* vn = (const bf16_t*)(ws_ + OFF_PT_BV) + (size_t)tok0 * 256 + (size_t)(h * 64) * 32;
    const float sc = 0.125f * LOG2E;
    __syncthreads();
    tile_pipeline<1, 64>(smem, 4, wave, lane,
        [&](int t, const bf16_t*& kg, int& ks, const bf16_t*& vg, int& vu) {
            kg = kn + (size_t)t * 64 * NIN; ks = NIN; vg = vn + (size_t)(2 * t) * 256 * 32; vu = 256 * 32;
        },
        [&](int t, const unsigned char* buf) {
            const float nob[8] = {0.f, 0.f, 0.f, 0.f, 0.f, 0.f, 0.f, 0.f};
#pragma unroll
            for (int half = 0; half < 2; ++half) {
                UnitFrags<1, 64> f;
                lds_unit<1, 64>(f, buf, 32 * half, half * TileGeom<1, 64>::VUNIT + g * 16, lr, g);
                compute_unit<1, 64, false>(st, f, qf, sc, nob);
            }
        });
    const float inv = 1.f / grp_sum(st.l[0]);
    bf16_t* MIX = (bf16_t*)(ws_ + OFF_MIX) + (size_t)(tok0 + q0 + lr) * 1024 + 512 + h * 64;
#pragma unroll
    for (int vb = 0; vb < 4; ++vb) {
        uint2 o; o.x = pack2(st.O[0][vb][0] * inv, st.O[0][vb][1] * inv); o.y = pack2(st.O[0][vb][2] * inv, st.O[0][vb][3] * inv);
        *(uint2*)(MIX + vb * 16 + 4 * g) = o;
    }
}

DI void item_na(const Params& pin, int l, int sb, int h, int r, unsigned char* smem, int wave, int lane) {
    const Params& p = pin; unsigned char* const ws_ = opaque_ws(pin.ws); float* const out_ = opaque_out(pin.out); lane = opaque_v(lane); wave = opaque_s(wave);
    const int lr = lane & 15, g = lane >> 4;
    const int tok0 = NCTX + sb * 1024;
    const bf16_t* P = (const bf16_t*)(ws_ + OFF_P);
    const int qc = wave * 16 + lr;
    const int q0 = r * 64 + wave * 16;
    bf16x8 qf[1][2];
    {
        const bf16_t* qp = P + (size_t)(tok0 + q0 + lr) * NIN + 1536 + h * 64 + 8 * g;
        qf[0][0] = *(const bf16x8*)(qp); qf[0][1] = *(const bf16x8*)(qp + 32);
    }
    AttnSt<1, 64> st;
    attn_init<1, 64>(st);
    const float sc = 0.125f * LOG2E;
    const size_t hb = (size_t)((sb * 4 + l) * 4 + h);
    const bf16_t* kc = (const bf16_t*)(ws_ + OFF_CBK) + hb * 512 * 64;
    const bf16_t* vc = (const bf16_t*)(ws_ + OFF_CBVT) + hb * 64 * 512;
    const bf16_t* kn = P + (size_t)tok0 * NIN + 1792 + h * 64;
    const bf16_t* vn = (const bf16_t*)(ws_ + OFF_PT_BV) + (size_t)tok0 * 256 + (size_t)(h * 64) * 32;
    const int kr0 = min(max(r - 4, 0), 8);
    const int bs = min(max(wave * 16 - 8, 0), 32);
    const int wstart = min(max(qc - 8, 0), 48);
    const float* rpb = p.nat_rpb + (size_t)(l * 4 + h) * 15 * 31;
    __syncthreads();
    tile_pipeline<1, 64>(smem, 16, wave, lane,
        [&](int t, const bf16_t*& kg, int& ks, const bf16_t*& vg, int& vu) {
            if (t < 8) { kg = kc + (size_t)t * 64 * 64; ks = 64; vg = vc + (size_t)(2 * t) * 64 * 32; vu = 64 * 32; }
            else { const int kr = kr0 + t - 8; kg = kn + (size_t)kr * 64 * NIN; ks = NIN; vg = vn + (size_t)(2 * kr) * 256 * 32; vu = 256 * 32; }
        },
        [&](int t, const unsigned char* buf) {
            if (t < 8) {
                const float nob[8] = {0.f, 0.f, 0.f, 0.f, 0.f, 0.f, 0.f, 0.f};
#pragma unroll
                for (int half = 0; half < 2; ++half) {
                    UnitFrags<1, 64> f;
                    lds_unit<1, 64>(f, buf, 32 * half, half * TileGeom<1, 64>::VUNIT + g * 16, lr, g);
                    compute_unit<1, 64, false>(st, f, qf, sc, nob);
                }
            } else {
                const int kr = kr0 + t - 8;
                const int nl = bs + 8 * g;
                UnitFrags<1, 64> f;
                lds_unit<1, 64>(f, buf, bs, (nl >> 5) * TileGeom<1, 64>::VUNIT + (nl & 31) * 2, lr, g);
                float bias[8];
                const float* rrow = rpb + (kr - r + 7) * 31;
#pragma unroll
                for (int j = 0; j < 8; ++j) {
                    const int kcol = bs + 8 * g + j;
                    const bool valid = (kcol >= wstart) && (kcol < wstart + 16);
                    const int dc = min(max(kcol - qc + 15, 0), 30);
                    bias[j] = valid ? rrow[dc] * LOG2E : -INFINITY;
                }
                compute_unit<1, 64, true>(st, f, qf, sc, bias);
            }
        });
    const float inv = 1.f / grp_sum(st.l[0]);
    bf16_t* MIX = (bf16_t*)(ws_ + OFF_MIX) + (size_t)(tok0 + q0 + lr) * 1024 + 512 + h * 64;
#pragma unroll
    for (int vb = 0; vb < 4; ++vb) {
        uint2 o; o.x = pack2(st.O[0][vb][0] * inv, st.O[0][vb][1] * inv); o.y = pack2(st.O[0][vb][2] * inv, st.O[0][vb][3] * inv);
        *(uint2*)(MIX + vb * 16 + 4 * g) = o;
    }
}

DI float wave_excl_sum(float v, int lane) {
    float x = v;
#pragma unroll
    for (int d = 1; d < 64; d <<= 1) { const float y = __shfl_up(x, d); if (lane >= d) x += y; }
    return x - v;
}
DI float wave_excl_max(float v, int lane, float init) {
    float x = v;
#pragma unroll
    for (int d = 1; d < 64; d <<= 1) { const float y = __shfl_up(x, d); if (lane >= d) x = fmaxf(x, y); }
    const float ex = __shfl_up(x, 1);
    return lane == 0 ? init : fmaxf(init, ex);
}
DI void mlstm_scan(const float* __restrict__ G, int h, int nseq, int dir, float* aA, float* MA, float* FA, float m0, int lane) {
    const int per = nseq >> 6;
    float run = 0.f;
    for (int e = 0; e < per; ++e) {
        const int idx = lane * per + e, pos = dir ? nseq - 1 - idx : idx;
        const float f = G[(size_t)pos * 16 + (dir ? 12 : 4) + h];
        const float lf = fminf(f, 0.f) - __logf(1.f + __expf(-fabsf(f)));
        run += lf; FA[pos] = run;
    }
    const float off = wave_excl_sum(run, lane);
    float rmax = -INFINITY;
    for (int e = 0; e < per; ++e) {
        const int idx = lane * per + e, pos = dir ? nseq - 1 - idx : idx;
        const float F = FA[pos] + off; FA[pos] = F;
        const float a = G[(size_t)pos * 16 + (dir ? 8 : 0) + h] - F;
        aA[pos] = a; rmax = fmaxf(rmax, a); MA[pos] = rmax;
    }
    const float pre = wave_excl_max(rmax, lane, m0);
    for (int e = 0; e < per; ++e) {
        const int idx = lane * per + e, pos = dir ? nseq - 1 - idx : idx;
        MA[pos] = fmaxf(MA[pos], pre);
    }
}

DI void mlstm_unit(f32x4 (&O)[4], float& den, int dir, int t, const bf16x8 (&qf)[2], const UnitFrags<1, 64>& f, const float* aA, float Mt, int key0, int g) {
    f32x4 sa = (f32x4){0.f, 0.f, 0.f, 0.f}, sb = sa;
    sa = mfma16(f.k[0][0][0], qf[0], sa); sa = mfma16(f.k[0][0][1], qf[1], sa);
    sb = mfma16(f.k[0][1][0], qf[0], sb); sb = mfma16(f.k[0][1][1], qf[1], sb);
    const float4 a0 = *(const float4*)(aA + key0 + 8 * g), a1 = *(const float4*)(aA + key0 + 8 * g + 4);
    const float av[8] = {a0.x, a0.y, a0.z, a0.w, a1.x, a1.y, a1.z, a1.w};
    float pv[8];
#pragma unroll
    for (int j = 0; j < 8; ++j) {
        const int key = key0 + 8 * g + j;
        const bool ok = dir ? (key >= t) : (key <= t);
        const float w = ok ? fexp2((av[j] - Mt) * LOG2E) : 0.f;
        const float sv = (j < 4) ? sa[j & 3] : sb[j & 3];
        pv[j] = sv * 0.125f * w;
        den += pv[j];
    }
    const bf16x8 pk = pack8(pv[0], pv[1], pv[2], pv[3], pv[4], pv[5], pv[6], pv[7]);
#pragma unroll
    for (int vb = 0; vb < 4; ++vb) O[vb] = mfma16(f.v[vb], pk, O[vb]);
}

template <bool LAT>
DI void item_mlstm(const Params& pin, int l, int seq, int h, int qt, unsigned char* smem, int wave, int lane) {
    const Params& p = pin; unsigned char* const ws_ = opaque_ws(pin.ws); float* const out_ = opaque_out(pin.out); lane = opaque_v(lane); wave = opaque_s(wave);
    const int lr = lane & 15, g = lane >> 4;
    const int nseq = LAT ? 1024 : 256;
    const int tok0 = LAT ? NCTX + seq * 1024 : seq * 256;
    float* aF = (float*)smem; float* MF = aF + 1024; float* FF = MF + 1024;
    float* aB = FF + 1024; float* MB = aB + 1024; float* FB = MB + 1024;
    unsigned char* tiles = smem + 24576;
    const float* G = (const float*)(ws_ + OFF_G) + (size_t)tok0 * 16;
    float m0f = 0.f, m0b = 0.f;
    const int sidx_f = ((seq * 4 + l) * 2 + 0) * 4 + h, sidx_b = ((seq * 4 + l) * 2 + 1) * 4 + h;
    if (LAT) { m0f = p.state_m[sidx_f]; m0b = p.state_m[sidx_b]; }
    __syncthreads();
    if (wave == 0) mlstm_scan(G, h, nseq, 0, aF, MF, FF, m0f, lane);
    if (wave == 1) mlstm_scan(G, h, nseq, 1, aB, MB, FB, m0b, lane);
    __syncthreads();
    const bf16_t* P = (const bf16_t*)(ws_ + OFF_P);
    const int q0 = qt * 64 + wave * 16;
    const int t = q0 + lr;
    bf16x8 qf[2];
    {
        const bf16_t* qp = P + (size_t)(tok0 + t) * NIN + 2304 + h * 64 + 8 * g;
        qf[0] = *(const bf16x8*)(qp); qf[1] = *(const bf16x8*)(qp + 32);
    }
    const bf16_t* kn = P + (size_t)tok0 * NIN + 2560 + h * 64;
    const bf16_t* vn = (const bf16_t*)(ws_ + OFF_PT_CV) + (size_t)tok0 * 256 + (size_t)(h * 64) * 32;
    const float Mf = MF[t], Mb = MB[t], Ff = FF[t], Fb = FB[t];
    f32x4 Of[4], Ob[4];
#pragma unroll
    for (int vb = 0; vb < 4; ++vb) { Of[vb] = (f32x4){0.f, 0.f, 0.f, 0.f}; Ob[vb] = Of[vb]; }
    float denf = 0.f, denb = 0.f;
    tile_pipeline<1, 64>(tiles, nseq / 64, wave, lane,
        [&](int tt, const bf16_t*& kg, int& ks, const bf16_t*& vg, int& vu) {
            kg = kn + (size_t)tt * 64 * NIN; ks = NIN; vg = vn + (size_t)(2 * tt) * 256 * 32; vu = 256 * 32;
        },
        [&](int tt, const unsigned char* buf) {
#pragma unroll
            for (int half = 0; half < 2; ++half) {
                const int key0 = tt * 64 + half * 32;
                const bool dof = key0 <= q0 + 15, dob = key0 + 31 >= q0;
                if (dof || dob) {
                    UnitFrags<1, 64> f;
                    lds_unit<1, 64>(f, buf, 32 * half, half * TileGeom<1, 64>::VUNIT + g * 16, lr, g);
                    if (dof) mlstm_unit(Of, denf, 0, t, qf, f, aF, Mf, key0, g);
                    if (dob) mlstm_unit(Ob, denb, 1, t, qf, f, aB, Mb, key0, g);
                }
            }
        });
    if (LAT) {
        const bf16_t* qp2 = P + (size_t)(tok0 + t) * NIN + 2304 + h * 64 + 4 * g;
#pragma unroll
        for (int dir = 0; dir < 2; ++dir) {
            const int sidx = dir ? sidx_b : sidx_f;
            const float e = fexp2(((dir ? m0b : m0f) - (dir ? Mb : Mf)) * LOG2E) * 0.125f;
            const bf16_t* c0t = (const bf16_t*)(ws_ + OFF_C0T) + (size_t)sidx * 4096 + lr * 64 + 4 * g;
            const float* n0 = p.state_n + (size_t)sidx * 64;
            float dacc = 0.f;
#pragma unroll
            for (int u2 = 0; u2 < 2; ++u2) {
                const bf16x4 qa = *(const bf16x4*)(qp2 + u2 * 32), qb = *(const bf16x4*)(qp2 + u2 * 32 + 16);
                const float4 na = *(const float4*)(n0 + u2 * 32 + 4 * g), nb = *(const float4*)(n0 + u2 * 32 + 16 + 4 * g);
                float pv[8];
#pragma unroll
                for (int j = 0; j < 4; ++j) { pv[j] = bf2f((unsigned short)qa[j]) * e; pv[4 + j] = bf2f((unsigned short)qb[j]) * e; }
                dacc += pv[0] * na.x + pv[1] * na.y + pv[2] * na.z + pv[3] * na.w + pv[4] * nb.x + pv[5] * nb.y + pv[6] * nb.z + pv[7] * nb.w;
                const bf16x8 pk = pack8(pv[0], pv[1], pv[2], pv[3], pv[4], pv[5], pv[6], pv[7]);
#pragma unroll
                for (int vb = 0; vb < 4; ++vb) {
                    const bf16_t* cp = c0t + (size_t)vb * 16 * 64 + u2 * 32;
                    const bf16x8 cf = cat4(*(const bf16x4*)(cp), *(const bf16x4*)(cp + 16));
                    if (dir) Ob[vb] = mfma16(cf, pk, Ob[vb]); else Of[vb] = mfma16(cf, pk, Of[vb]);
                }
            }
            if (dir) denb += dacc; else denf += dacc;
        }
    }
    denf = grp_sum(denf); denb = grp_sum(denb);
    const float rf = 1.f / fmaxf(fabsf(denf), expf(-(Ff + Mf)));
    const float rb = 1.f / fmaxf(fabsf(denb), expf(-(Fb + Mb)));
    float ss = 0.f;
#pragma unroll
    for (int vb = 0; vb < 4; ++vb)
#pragma unroll
        for (int i = 0; i < 4; ++i) { const float hs = Of[vb][i] * rf + Ob[vb][i] * rb; Of[vb][i] = hs; ss += hs * hs; }
    ss = grp_sum(ss);
    const float rn = rsqrtf(ss * (1.f / 64.f) + LN_EPS);
    const float* gn = p.mlstm_norm_g + (size_t)(l * 4 + h) * 64;
    const bf16_t* op = P + (size_t)(tok0 + t) * NIN + 3072 + h * 64;
    bf16_t* MIX = (bf16_t*)(ws_ + OFF_MIX) + (size_t)(tok0 + t) * 1024 + 768 + h * 64;
#pragma unroll
    for (int vb = 0; vb < 4; ++vb) {
        const int v = vb * 16 + 4 * g;
        const float4 g4 = *(const float4*)(gn + v);
        const bf16x4 o4 = *(const bf16x4*)(op + v);
        float sg[4];
#pragma unroll
        for (int i = 0; i < 4; ++i) sg[i] = 1.f / (1.f + __expf(-bf2f((unsigned short)o4[i])));
        uint2 o; o.x = pack2(Of[vb][0] * rn * g4.x * sg[0], Of[vb][1] * rn * g4.y * sg[1]);
        o.y = pack2(Of[vb][2] * rn * g4.z * sg[2], Of[vb][3] * rn * g4.w * sg[3]);
        *(uint2*)(MIX + v) = o;
    }
}

DI void item_mlstm_state(const Params& pin, int l, int b, int h, int dir, unsigned char* smem, int wave, int lane) {
    const Params& p = pin; unsigned char* const ws_ = opaque_ws(pin.ws); float* const out_ = opaque_out(pin.out); lane = opaque_v(lane); wave = opaque_s(wave);
    const int lr = lane & 15, g = lane >> 4;
    const int tok0 = b * 256;
    float* aA = (float*)smem; float* MA = aA + 1024; float* FA = MA + 1024;
    const float* G = (const float*)(ws_ + OFF_G) + (size_t)tok0 * 16;
    __syncthreads();
    if (wave == 0) mlstm_scan(G, h, 256, dir, aA, MA, FA, 0.f, lane);
    __syncthreads();
    const float Mfin = dir ? MA[0] : MA[255];
    const float Ffin = dir ? FA[0] : FA[255];
    const bf16_t* KT = (const bf16_t*)(ws_ + OFF_PT_CK) + (size_t)tok0 * 256 + (size_t)(h * 64 + wave * 16 + lr) * 32 + 8 * g;
    const bf16_t* VT = (const bf16_t*)(ws_ + OFF_PT_CV) + (size_t)tok0 * 256 + (size_t)(h * 64 + lr) * 32 + 8 * g;
    f32x4 C[4];
#pragma unroll
    for (int vb = 0; vb < 4; ++vb) C[vb] = (f32x4){0.f, 0.f, 0.f, 0.f};
    float nacc = 0.f;
#pragma unroll 4
    for (int u = 0; u < 8; ++u) {
        const int s0 = u * 32;
        const bf16x8 kf = *(const bf16x8*)(KT + (size_t)u * 256 * 32);
        const float4 a0 = *(const float4*)(aA + s0 + 8 * g), a1 = *(const float4*)(aA + s0 + 8 * g + 4);
        const float av[8] = {a0.x, a0.y, a0.z, a0.w, a1.x, a1.y, a1.z, a1.w};
        float kw[8];
#pragma unroll
        for (int j = 0; j < 8; ++j) { kw[j] = bf2f((unsigned short)kf[j]) * fexp2((av[j] - Mfin) * LOG2E); nacc += kw[j]; }
        const bf16x8 af = pack8(kw[0], kw[1], kw[2], kw[3], kw[4], kw[5], kw[6], kw[7]);
#pragma unroll
        for (int vb = 0; vb < 4; ++vb) {
            const bf16x8 vf = *(const bf16x8*)(VT + (size_t)u * 256 * 32 + vb * 16 * 32);
            C[vb] = mfma16(af, vf, C[vb]);
        }
    }
    const size_t sidx = (size_t)((b * 4 + l) * 2 + dir) * 4 + h;
    float* oc = out_ + O_NC + sidx * 4096;
#pragma unroll
    for (int vb = 0; vb < 4; ++vb)
#pragma unroll
        for (int i = 0; i < 4; ++i) oc[(wave * 16 + 4 * g + i) * 64 + vb * 16 + lr] = C[vb][i];
    nacc = grp_sum(nacc);
    if (g == 0) out_[O_NN + sidx * 64 + wave * 16 + lr] = nacc;
    if (wave == 0 && lane == 0) out_[O_NM + sidx] = Ffin + Mfin;
}

DI void mixer_phase(const Params& p, int l, unsigned char* smem) {
    const int tid_ = opaque_v(threadIdx.x); const int lane = tid_ & 63, wave = tid_ >> 6;
    unsigned* ctr = (unsigned*)(p.ws + OFF_MIXCTR) + l;
    volatile unsigned* slot = (volatile unsigned*)(smem + 66560 + 16);
    for (;;) {
        __syncthreads();
        if (tid_ == 0) *slot = __hip_atomic_fetch_add(ctr, 1u, __ATOMIC_RELAXED, __HIP_MEMORY_SCOPE_AGENT);
        __syncthreads();
        const int it = (int)*slot;
        if (it >= 1408) break;
        if (it < 256) { item_diffattn_lat(p, l, it >> 7, (it >> 5) & 3, it & 31, smem, wave, lane); }
        else if (it < 384) { const int i = it - 256; item_mlstm<true>(p, l, i >> 6, (i >> 4) & 3, i & 15, smem, wave, lane); }
        else if (it < 512) { const int i = it - 384; item_mlstm_state(p, l, i >> 3, (i >> 1) & 3, i & 1, smem, wave, lane); }
        else if (it < 640) { const int i = it - 512; item_na(p, l, i >> 6, (i >> 4) & 3, i & 15, smem, wave, lane); }
        else if (it < 896) { const int i = it - 640; item_diffattn<false>(p, l, i >> 4, (i >> 2) & 3, i & 3, smem, wave, lane); }
        else if (it < 1152) { const int i = it - 896; item_mlstm<false>(p, l, i >> 4, (i >> 2) & 3, i & 3, smem, wave, lane); }
        else { const int i = it - 1152; item_dense(p, i >> 4, (i >> 2) & 3, i & 3, smem, wave, lane); }
    }
}

#define XB_TMO      128
#define XB_XCNT(j)  (256  + 64 * (j))
#define XB_XSUB(j)  (1280 + 64 * (j))
#define XB_XGEN(j)  (2304 + 64 * (j))
#define XB_TOP      3328
#define XB_TOPGEN   3392
#define XCD_BAR_WORDS 3456
#define XB_SPIN_CAP (1u << 18)

__device__ __forceinline__ unsigned xb_ld(unsigned* p)              { return __hip_atomic_load(p, __ATOMIC_RELAXED, __HIP_MEMORY_SCOPE_AGENT); }
__device__ __forceinline__ unsigned xb_add(unsigned* p, unsigned v) { return __hip_atomic_fetch_add(p, v, __ATOMIC_RELAXED, __HIP_MEMORY_SCOPE_AGENT); }
__device__ __forceinline__ unsigned xb_xcc_id() { return (unsigned)__builtin_amdgcn_s_getreg((3 << 11) | 20) & 0xFu; }
#define XB_SPIN(cond, bar) do { unsigned _sp = 0; while (cond) { __builtin_amdgcn_s_sleep(1); \
    if ((++_sp & 255u) == 0u) { if (xb_ld(&(bar)[XB_TMO])) break; if (_sp > XB_SPIN_CAP) { atomicAdd(&(bar)[XB_TMO], 1u); break; } } } } while (0)

struct XcdBarrier {
    unsigned* bar; unsigned x;
    volatile LAS unsigned* st;
};

__device__ __forceinline__ XcdBarrier xcd_barrier_post(unsigned* bar, volatile LAS unsigned* st) {
    XcdBarrier b; b.bar = bar; b.x = xb_xcc_id(); b.st = st;
    if (threadIdx.x == 0) (void)xb_add(&bar[XB_XCNT(b.x)], 1u);
    return b;
}
__device__ __forceinline__ void xcd_barrier_complete(unsigned* bar, unsigned x, unsigned& nloc, unsigned& nx) {
    const unsigned G = gridDim.x * gridDim.y * gridDim.z;
    unsigned sum, cnt, mine, sp = 0u;
    for (;;) {
        sum = 0u; cnt = 0u; mine = 0u;
#pragma unroll
        for (unsigned j = 0; j < 16; ++j) { const unsigned c = xb_ld(&bar[XB_XCNT(j)]); sum += c; cnt += (c > 0u) ? 1u : 0u; mine = (j == x) ? c : mine; }
        if (sum == G) break;
        __builtin_amdgcn_s_sleep(1);
        if ((++sp & 255u) == 0u) { if (xb_ld(&bar[XB_TMO])) break; if (sp > XB_SPIN_CAP) { atomicAdd(&bar[XB_TMO], 1u); break; } }
    }
    nloc = mine > 0u ? mine : 1u; nx = cnt > 0u ? cnt : 1u;
}

__device__ __forceinline__ void xcd_barrier(const XcdBarrier& b) {
    asm volatile("s_waitcnt vmcnt(0)" ::: "memory");
    __syncthreads();
    if (threadIdx.x == 0) {
        unsigned* bar = b.bar;
        __builtin_amdgcn_s_waitcnt(0);
        unsigned nloc = b.st[0], nx = b.st[1];
        if (nloc == 0u) { xcd_barrier_complete(bar, b.x, nloc, nx); b.st[0] = nloc; b.st[1] = nx; }
        const unsigned old = xb_add(&bar[XB_XSUB(b.x)], 1u);
        const unsigned gen = old / nloc;
        if (old + 1u == (gen + 1u) * nloc) {
            __builtin_amdgcn_fence(__ATOMIC_RELEASE, "agent");
            asm volatile("s_waitcnt vmcnt(0)" ::: "memory");
            const unsigned og = xb_add(&bar[XB_TOP], 1u);
            const unsigned tg = og / nx;
            if (og + 1u == (tg + 1u) * nx) xb_add(&bar[XB_TOPGEN], 1u);
            else XB_SPIN(xb_ld(&bar[XB_TOPGEN]) == tg, bar);
            __builtin_amdgcn_fence(__ATOMIC_ACQUIRE, "agent");
            xb_add(&bar[XB_XGEN(b.x)], 1u);
            asm volatile("s_waitcnt vmcnt(0)" ::: "memory");
        } else {
            XB_SPIN(xb_ld(&bar[XB_XGEN(b.x)]) == gen, bar);
            __builtin_amdgcn_fence(__ATOMIC_ACQUIRE, "agent");
            asm volatile("s_waitcnt vmcnt(0)" ::: "memory");
        }
    }
    __syncthreads();
}


constexpr int N_PHASES = 2 + 5 * 4;

__global__ void __launch_bounds__(256, 2) fwd_kernel(Params p) {
    __shared__ __attribute__((aligned(16))) unsigned char smem[66560 + 32];
    if (threadIdx.x == 0) *(uint4*)(smem + 66560) = make_uint4(0u, 0u, 0u, 0u);
    __syncthreads();
    XcdBarrier xb = xcd_barrier_post((unsigned*)(p.ws + OFF_BAR), (volatile LAS unsigned*)(smem + 66560));
    for (int ph = p.ph_lo; ph < p.ph_hi; ++ph) {
        if (ph > p.ph_lo) {
            if (p.ph_hi > 1000) cg::this_grid().sync();
            xcd_barrier(xb);
        }
        const int l = ph < 2 ? 0 : (ph - 2) / 5, s = ph < 2 ? ph - 2 : (ph - 2) % 5;
        const int bit = 1 << (s + 2);
        const int reps = (DUPM & bit) ? 2 : 1;
        for (int rep = 0; rep < reps; ++rep) {
            if (rep) __syncthreads();
            if (s == -2) prep0(p, smem);
            else if (s == -1) prep1(p);
            else if (s == 0) gemm_phase<EPI_INPROJ>(p, l, OFF_H, OFF_WT_IN + (size_t)l * NINP * DM * 2, NINP / 128, 1024, 0, smem);
            else if (s == 1) mixer_phase(p, l, smem);
            else if (s == 2) gemm_phase<EPI_LN1>(p, l, OFF_MIX, OFF_WT_OUT + (size_t)l * DM * DM * 2, 8, 1024, 1024, smem);
            else if (s == 3) gemm_phase<EPI_RELU2>(p, l, OFF_H, OFF_WT_1 + (size_t)l * DFF * DM * 2, 32, 1024, 4096, smem);
            else gemm_phase<EPI_LN2>(p, l, OFF_U, OFF_WT_2 + (size_t)l * DM * DFF * 2, 8, 4096, 1024, smem);
        }
    }
}

extern "C" void kernel_launch(void* const* d_in, const int* in_sizes, int n_in, void* d_out, int out_size, void* d_ws, size_t ws_size,
                              hipStream_t stream) {
    static int grid = 0;
    if (grid == 0) {
        if (n_in != 26 || ws_size < WS_END) { fprintf(stderr, "kernel_launch: unexpected n_in %d / ws %zu (need %zu)\n", n_in, ws_size, (size_t)WS_END); grid = -1; return; }
        int dev = 0, cus = 0, per_cu = 0;
        hipGetDevice(&dev);
        hipDeviceGetAttribute(&cus, hipDeviceAttributeMultiprocessorCount, dev);
        hipOccupancyMaxActiveBlocksPerMultiprocessor(&per_cu, (const void*)fwd_kernel, 256, 0);
        if (per_cu < 1) per_cu = 1;
        if (per_cu > 2) per_cu = 2;
        grid = cus * per_cu;
        if (grid < 384) { fprintf(stderr, "kernel_launch: grid %d < 384 resident workgroups needed by the fused LayerNorm exchange\n", grid); grid = -1; return; }
    }
    if (grid < 0) return;
    Params p{};
    const float** pp = (const float**)&p;
    for (int i = 0; i < 26; ++i) pp[i] = (const float*)d_in[i];
    p.out = (float*)d_out; p.ws = (unsigned char*)d_ws;
    (void)hipMemsetAsync((unsigned char*)d_ws + OFF_BAR, 0, 16384, stream);
#if SINGLE_LAUNCH
    p.ph_lo = 0; p.ph_hi = N_PHASES;
    void* args[] = {&p};
    hipError_t e = hipLaunchCooperativeKernel((const void*)fwd_kernel, dim3(grid), dim3(256), args, 0, stream);
    if (e != hipSuccess) fprintf(stderr, "cooperative launch failed: %s (grid %d)\n", hipGetErrorString(e), grid);
#else
    for (int ph = 0; ph < N_PHASES; ++ph) {
        p.ph_lo = ph; p.ph_hi = ph + 1;
        void* args[] = {&p};
        hipError_t e = hipLaunchCooperativeKernel((const void*)fwd_kernel, dim3(grid), dim3(256), args, 0, stream);
        if (e != hipSuccess) { fprintf(stderr, "launch %d failed: %s (grid %d)\n", ph, hipGetErrorString(e), grid); break; }
    }
#endif
}
```

```cpp
#include <hip/hip_runtime.h>
#include <hip/hip_cooperative_groups.h>
#include <cstdio>
namespace cg = cooperative_groups;

#ifndef IM
#define IM 0xffff
#endif
#ifndef IM
#define IM 0xffff
#endif
#ifndef DUPM
#define DUPM 0
#endif
#ifndef PHM
#define PHM 0xffff
#endif
#ifndef SINGLE_LAUNCH
#define SINGLE_LAUNCH 1
#endif

#define LAS __attribute__((address_space(3)))
typedef unsigned short bf16_t;
typedef __attribute__((ext_vector_type(8))) short bf16x8;
typedef __attribute__((ext_vector_type(4))) short bf16x4;
typedef __attribute__((ext_vector_type(4))) float f32x4;
#define DI __device__ __forceinline__

constexpr int NTOK = 6144, NCTX = 4096, DM = 1024, NIN = 3344, NINP = 3456, DFF = 4096;
constexpr float ALPHA = 1.681792830507429f;
constexpr float LOG2E = 1.4426950408889634f;
constexpr float LN_EPS = 1e-5f;

constexpr size_t al256(size_t x) { return (x + 255) & ~(size_t)255; }
constexpr size_t OFF_WT_IN = 0;
constexpr size_t OFF_WT_OUT = OFF_WT_IN + al256((size_t)4 * NINP * DM * 2);
constexpr size_t OFF_WT_1 = OFF_WT_OUT + al256((size_t)4 * DM * DM * 2);
constexpr size_t OFF_WT_2 = OFF_WT_1 + al256((size_t)4 * DFF * DM * 2);
constexpr size_t OFF_MOD = OFF_WT_2 + al256((size_t)4 * DFF * DM * 2);
constexpr size_t OFF_X = OFF_MOD + al256((size_t)4 * 3 * 6144 * 4);
constexpr size_t OFF_H = OFF_X + al256((size_t)NTOK * DM * 4);
constexpr size_t OFF_P = OFF_H + al256((size_t)NTOK * DM * 2);
constexpr size_t OFF_PT_AV = OFF_P + al256((size_t)NTOK * NIN * 2);
constexpr size_t OFF_PT_BV = OFF_PT_AV + al256((size_t)NTOK * 512 * 2);
constexpr size_t OFF_PT_CV = OFF_PT_BV + al256((size_t)NTOK * 256 * 2);
constexpr size_t OFF_PT_CK = OFF_PT_CV + al256((size_t)NTOK * 256 * 2);
constexpr size_t OFF_G = OFF_PT_CK + al256((size_t)NTOK * 256 * 2);
constexpr size_t OFF_MIX = OFF_G + al256((size_t)NTOK * 16 * 4);
constexpr size_t OFF_Y = OFF_MIX + al256((size_t)NTOK * DM * 2);
constexpr size_t OFF_U = OFF_Y + al256((size_t)NTOK * DM * 4);
constexpr size_t OFF_CAK = OFF_U + al256((size_t)NTOK * DFF * 2);
constexpr size_t OFF_CAVT = OFF_CAK + al256((size_t)32 * 512 * 128 * 2);
constexpr size_t OFF_CBK = OFF_CAVT + al256((size_t)32 * 512 * 128 * 2);
constexpr size_t OFF_CBVT = OFF_CBK + al256((size_t)32 * 512 * 64 * 2);
constexpr size_t OFF_C0T = OFF_CBVT + al256((size_t)32 * 512 * 64 * 2);
constexpr size_t OFF_ROPE = OFF_C0T + al256((size_t)64 * 64 * 64 * 2);
constexpr size_t OFF_LAM = OFF_ROPE + al256((size_t)2 * 1024 * 4);
constexpr size_t OFF_BAR = OFF_LAM + 256;
constexpr size_t OFF_LNCNT = OFF_BAR + 13824;
constexpr size_t OFF_MIXCTR = OFF_BAR + 15360;
constexpr size_t OFF_STATS = OFF_BAR + 16384;
constexpr size_t WS_END = OFF_STATS + (size_t)NTOK * 16 * 8;

constexpr size_t O_YP = 0, O_YS = 4194304, O_AK = 6291456, O_AV = 14680064, O_BK = 23068672, O_BV = 27262976,
                 O_NC = 31457280, O_NN = 33554432, O_NM = 33587200;

struct Params {
    const float* x_prompt; const float* x_sample; const float* cache_a_k; const float* cache_a_v;
    const float* cache_b_k; const float* cache_b_v; const float* state_c; const float* state_n;
    const float* state_m; const float* c; const float* c_ctx; const float* w_in; const float* gate_bias;
    const float* diff_lambda; const float* diff_norm_g; const float* nat_rpb; const float* mlstm_norm_g;
    const float* w_out; const float* ada_w; const float* ada_b; const float* ln1_g; const float* ln1_b;
    const float* ln2_g; const float* ln2_b; const float* w_mlp1; const float* w_mlp2;
    float* out; unsigned char* ws; int ph_lo; int ph_hi;
};

DI int opaque_v(int x) { asm volatile("" : "+v"(x)); return x; }
DI int opaque_s(int x) { x = __builtin_amdgcn_readfirstlane(x); asm volatile("" : "+s"(x)); return x; }
DI size_t opaque_zero() { size_t z = 0; asm volatile("" : "+s"(z)); return z; }
DI unsigned char* opaque_ws(unsigned char* w) { return w + opaque_zero(); }
DI float* opaque_out(float* w) { return w + opaque_zero(); }
DI unsigned short f2bf(float x) { unsigned u = __float_as_uint(x); u += 0x7fffu + ((u >> 16) & 1u); return (unsigned short)(u >> 16); }
DI float bf2f(unsigned short h) { return __uint_as_float(((unsigned)h) << 16); }
DI unsigned pack2(float a, float b) { return (unsigned)f2bf(a) | ((unsigned)f2bf(b) << 16); }
DI f32x4 mfma16(bf16x8 a, bf16x8 b, f32x4 c) { return __builtin_amdgcn_mfma_f32_16x16x32_bf16(a, b, c, 0, 0, 0); }
DI float fexp2(float x) { return __builtin_amdgcn_exp2f(x); }
DI bf16x8 pack8(float a0, float a1, float a2, float a3, float a4, float a5, float a6, float a7) {
    uint4 u;
    asm volatile("v_cvt_pk_bf16_f32 %0, %4, %5\n\tv_cvt_pk_bf16_f32 %1, %6, %7\n\tv_cvt_pk_bf16_f32 %2, %8, %9\n\tv_cvt_pk_bf16_f32 %3, %10, %11\n\ts_nop 1"
                 : "=&v"(u.x), "=&v"(u.y), "=&v"(u.z), "=&v"(u.w)
                 : "v"(a0), "v"(a1), "v"(a2), "v"(a3), "v"(a4), "v"(a5), "v"(a6), "v"(a7));
    return __builtin_bit_cast(bf16x8, u);
}
DI bf16x8 cat4(bf16x4 a, bf16x4 b) { return __builtin_shufflevector(a, b, 0, 1, 2, 3, 4, 5, 6, 7); }
DI float wave_sum(float v) {
#pragma unroll
    for (int o = 32; o > 0; o >>= 1) v += __shfl_xor(v, o);
    return v;
}
DI float grp_sum(float v) { v += __shfl_xor(v, 16); v += __shfl_xor(v, 32); return v; }
DI float grp_max(float v) { v = fmaxf(v, __shfl_xor(v, 16)); v = fmaxf(v, __shfl_xor(v, 32)); return v; }

DI void transpose_job(const float* __restrict__ src, bf16_t* __restrict__ dst, int R, int C, int Cpad, int nmat, float* tile, bool blocked = false) {
    const int tid = threadIdx.x;
    const int rt = R >> 6, ct = Cpad >> 6, per = rt * ct, total = per * nmat;
    for (int it = blockIdx.x; it < total; it += gridDim.x) {
        const int mat = it / per, rem = it - mat * per;
        const int r0 = (rem / ct) << 6, c0 = (rem % ct) << 6;
        const float* s = src + (size_t)mat * R * C;
        bf16_t* d = dst + (size_t)mat * Cpad * R;
#pragma unroll
        for (int i = 0; i < 4; ++i) {
            const int r = (tid >> 4) + 16 * i, c = (tid & 15) * 4;
            float4 v = make_float4(0.f, 0.f, 0.f, 0.f);
            if (c0 + c < C) v = *(const float4*)(s + (size_t)(r0 + r) * C + c0 + c);
            tile[r * 65 + c + 0] = v.x; tile[r * 65 + c + 1] = v.y; tile[r * 65 + c + 2] = v.z; tile[r * 65 + c + 3] = v.w;
        }
        __syncthreads();
        {
            const int c = tid >> 2, rs = (tid & 3) * 16;
            uint4 o0, o1;
            o0.x = pack2(tile[(rs + 0) * 65 + c], tile[(rs + 1) * 65 + c]);
            o0.y = pack2(tile[(rs + 2) * 65 + c], tile[(rs + 3) * 65 + c]);
            o0.z = pack2(tile[(rs + 4) * 65 + c], tile[(rs + 5) * 65 + c]);
            o0.w = pack2(tile[(rs + 6) * 65 + c], tile[(rs + 7) * 65 + c]);
            o1.x = pack2(tile[(rs + 8) * 65 + c], tile[(rs + 9) * 65 + c]);
            o1.y = pack2(tile[(rs + 10) * 65 + c], tile[(rs + 11) * 65 + c]);
            o1.z = pack2(tile[(rs + 12) * 65 + c], tile[(rs + 13) * 65 + c]);
            o1.w = pack2(tile[(rs + 14) * 65 + c], tile[(rs + 15) * 65 + c]);
            uint4* dp = blocked ? (uint4*)(d + ((size_t)((r0 + rs) >> 5) * Cpad + (c0 + c)) * 32 + ((r0 + rs) & 31))
                                : (uint4*)(d + (size_t)(c0 + c) * R + r0 + rs);
            dp[0] = o0; dp[1] = o1;
        }
        __syncthreads();
    }
}

DI void convert_job(const float* __restrict__ src, bf16_t* __restrict__ dst, size_t n) {
    for (size_t i = ((size_t)blockIdx.x * 256 + threadIdx.x) * 8; i < n; i += (size_t)gridDim.x * 256 * 8) {
        const float4 a = *(const float4*)(src + i), b = *(const float4*)(src + i + 4);
        uint4 o; o.x = pack2(a.x, a.y); o.y = pack2(a.z, a.w); o.z = pack2(b.x, b.y); o.w = pack2(b.z, b.w);
        *(uint4*)(dst + i) = o;
    }
}

DI void prep0(const Params& pin, unsigned char* smem) {
    const Params& p = pin; unsigned char* const ws_ = opaque_ws(pin.ws); float* const out_ = opaque_out(pin.out); const int tid = opaque_v(threadIdx.x);
    {
        float* sl = (float*)smem; float* red = (float*)(smem + 12288);
        for (int i = tid; i < 3072; i += 256) {
            const int cnd = i >> 10, k = i & 1023;
            const float v = (cnd == 0) ? p.c_ctx[k] : p.c[(cnd - 1) * 1024 + k];
            sl[i] = v / (1.f + __expf(-v));
        }
        __syncthreads();
        float* mod = (float*)(ws_ + OFF_MOD);
        const int kg = tid >> 4, cl = tid & 15;
        for (int it = blockIdx.x; it < 384; it += gridDim.x) {
            const int l = it / 96, j0 = (it % 96) * 64;
            const float* w = p.ada_w + (size_t)l * 1024 * 6144 + j0 + cl * 4;
            float4 a0 = make_float4(0, 0, 0, 0), a1 = a0, a2 = a0;
#pragma unroll 8
            for (int kk = 0; kk < 64; ++kk) {
                const int k = kg * 64 + kk;
                const float4 wv = *(const float4*)(w + (size_t)k * 6144);
                const float s0 = sl[k], s1 = sl[1024 + k], s2 = sl[2048 + k];
                a0.x += s0 * wv.x; a0.y += s0 * wv.y; a0.z += s0 * wv.z; a0.w += s0 * wv.w;
                a1.x += s1 * wv.x; a1.y += s1 * wv.y; a1.z += s1 * wv.z; a1.w += s1 * wv.w;
                a2.x += s2 * wv.x; a2.y += s2 * wv.y; a2.z += s2 * wv.z; a2.w += s2 * wv.w;
            }
            __syncthreads();
            float* r = red + kg * 192 + cl * 4;
            r[0] = a0.x; r[1] = a0.y; r[2] = a0.z; r[3] = a0.w;
            r[64] = a1.x; r[65] = a1.y; r[66] = a1.z; r[67] = a1.w;
            r[128] = a2.x; r[129] = a2.y; r[130] = a2.z; r[131] = a2.w;
            __syncthreads();
            if (tid < 192) {
                const int cnd = tid >> 6, col = tid & 63;
                float s = 0.f;
#pragma unroll
                for (int q = 0; q < 16; ++q) s += red[q * 192 + tid];
                mod[(l * 3 + cnd) * 6144 + j0 + col] = s + p.ada_b[l * 6144 + j0 + col];
            }
        }
        __syncthreads();
    }
    if (blockIdx.x == gridDim.x - 1) {
        float* rope = (float*)(ws_ + OFF_ROPE);
        for (int i = tid; i < 1024; i += 256) {
            const int pos = i >> 4, j = i & 15;
            const float freq = powf(10000.f, -(float)j / 16.f);
            float s, c; sincosf((float)pos * freq, &s, &c);
            rope[i] = c; rope[1024 + i] = s;
        }
        if (tid < 4) {
            const float* lp = p.diff_lambda + tid * 256;
            float s1 = 0.f, s2 = 0.f;
            for (int i = 0; i < 64; ++i) { s1 += lp[i] * lp[64 + i]; s2 += lp[128 + i] * lp[192 + i]; }
            const float li = 0.8f - 0.6f * expf(-0.3f * (float)tid);
            float* lam = (float*)(ws_ + OFF_LAM);
            lam[tid * 2] = expf(s1) - expf(s2) + li; lam[tid * 2 + 1] = li;
        }
    }
    float* tile = (float*)smem;
    transpose_job(p.w_in, (bf16_t*)(ws_ + OFF_WT_IN), 1024, NIN, NINP, 4, tile);
    transpose_job(p.w_out, (bf16_t*)(ws_ + OFF_WT_OUT), 1024, 1024, 1024, 4, tile);
    transpose_job(p.w_mlp1, (bf16_t*)(ws_ + OFF_WT_1), 1024, 4096, 4096, 4, tile);
    transpose_job(p.w_mlp2, (bf16_t*)(ws_ + OFF_WT_2), 4096, 1024, 1024, 4, tile);
    transpose_job(p.cache_a_v, (bf16_t*)(ws_ + OFF_CAVT), 512, 128, 128, 32, tile, true);
    transpose_job(p.cache_b_v, (bf16_t*)(ws_ + OFF_CBVT), 512, 64, 64, 32, tile, true);
    transpose_job(p.state_c, (bf16_t*)(ws_ + OFF_C0T), 64, 64, 64, 64, tile);
    convert_job(p.cache_a_k, (bf16_t*)(ws_ + OFF_CAK), (size_t)32 * 512 * 128);
    convert_job(p.cache_b_k, (bf16_t*)(ws_ + OFF_CBK), (size_t)32 * 512 * 64);
}

DI void prep1(const Params& pin) {
    const Params& p = pin; unsigned char* const ws_ = opaque_ws(pin.ws); float* const out_ = opaque_out(pin.out); const int tid_ = opaque_v(threadIdx.x); const int lane = tid_ & 63, wave = tid_ >> 6;
    const float* mod = (const float*)(ws_ + OFF_MOD);
    float* X = (float*)(ws_ + OFF_X);
    bf16_t* H = (bf16_t*)(ws_ + OFF_H);
    for (int row = blockIdx.x * 4 + wave; row < NTOK; row += gridDim.x * 4) {
        const float* src = row < NCTX ? p.x_prompt + (size_t)row * 1024 : p.x_sample + (size_t)(row - NCTX) * 1024;
        const int cnd = row < NCTX ? 0 : 1 + ((row - NCTX) >> 10);
        const float* md = mod + (size_t)cnd * 6144;
#pragma unroll
        for (int j = 0; j < 4; ++j) {
            const int c = lane * 4 + 256 * j;
            const float4 v = *(const float4*)(src + c);
            *(float4*)(X + (size_t)row * 1024 + c) = v;
            const float4 sh = *(const float4*)(md + c), sc = *(const float4*)(md + 1024 + c);
            uint2 o; o.x = pack2(v.x * (1.f + sc.x) + sh.x, v.y * (1.f + sc.y) + sh.y);
            o.y = pack2(v.z * (1.f + sc.z) + sh.z, v.w * (1.f + sc.w) + sh.w);
            *(uint2*)(H + (size_t)row * 1024 + c) = o;
        }
    }
}

enum { EPI_INPROJ = 0, EPI_LN1 = 1, EPI_RELU2 = 2, EPI_LN2 = 3 };

DI void epi_inproj(const Params& p, unsigned char* ws_, float* out_, int layer, const float* T, int rowbase, int colbase, int lane) {
    if (colbase >= NIN) return;
    bf16_t* P = (bf16_t*)(ws_ + OFF_P);
    const bool latent = rowbase >= NCTX;
    const int seq_tok0 = latent ? (NCTX + ((rowbase - NCTX) & ~1023)) : (rowbase & ~255);
    const int nseq = latent ? 1024 : 256;
    const int bctx = seq_tok0 >> 8;
    const int n0 = rowbase - seq_tok0;
    if (colbase >= 3328) {
        float* G = (float*)(ws_ + OFF_G);
        const float bias = p.gate_bias[layer * 16 + (lane & 15)];
        for (int rr = 0; rr < 16; ++rr) {
            const int r = rr * 4 + (lane >> 4);
            G[(size_t)(rowbase + r) * 16 + (lane & 15)] = T[r * 65 + (lane & 15)] + bias;
        }
        return;
    }
    bool toP = false, rope = false, toT = false, toO = false;
    size_t toff = 0, obase = 0; int tW = 0, tcr = 0, ohd = 64, ocr = 0;
    if (colbase < 1024) { toP = true; rope = latent; if (colbase >= 512) { toO = !latent; obase = O_AK; ohd = 128; ocr = colbase - 512; } }
    else if (colbase < 1536) { toT = true; toff = OFF_PT_AV; tW = 512; tcr = colbase - 1024; toO = !latent; obase = O_AV; ohd = 128; ocr = tcr; }
    else if (colbase < 1792) { toP = true; }
    else if (colbase < 2048) { toP = true; toO = !latent; obase = O_BK; ohd = 64; ocr = colbase - 1792; }
    else if (colbase < 2304) { toT = true; toff = OFF_PT_BV; tW = 256; tcr = colbase - 2048; toO = !latent; obase = O_BV; ohd = 64; ocr = tcr; }
    else if (colbase < 2560) { toP = true; }
    else if (colbase < 2816) { toP = true; toT = true; toff = OFF_PT_CK; tW = 256; tcr = colbase - 2560; }
    else if (colbase < 3072) { toT = true; toff = OFF_PT_CV; tW = 256; tcr = colbase - 2816; }
    else { toP = true; }
    if (toO) {
        const int h = ocr / ohd, w = ocr - h * ohd + lane;
        float* O = out_ + obase + (((size_t)(bctx * 4 + layer) * 4 + h) * 256 + n0) * ohd + w;
#pragma unroll 4
        for (int r = 0; r < 64; ++r) O[(size_t)r * ohd] = T[r * 65 + lane];
    }
    if (toP) {
        bf16_t* Pp = P + (size_t)rowbase * NIN + colbase + lane;
        if (rope) {
            const float* rc = (const float*)(ws_ + OFF_ROPE);
            const float* rs = rc + 1024;
#pragma unroll 4
            for (int r = 0; r < 64; ++r) {
                const float v = T[r * 65 + lane], vp = T[r * 65 + (lane ^ 16)];
                const int t = n0 + r;
                const int pos = (lane < 32) ? (t >> 6) : (t & 63);
                const float c = rc[pos * 16 + (lane & 15)], sn = rs[pos * 16 + (lane & 15)];
                const float o = (lane & 16) ? (vp * sn + v * c) : (v * c - vp * sn);
                Pp[(size_t)r * NIN] = f2bf(o);
            }
        } else {
#pragma unroll 4
            for (int r = 0; r < 64; ++r) Pp[(size_t)r * NIN] = f2bf(T[r * 65 + lane]);
        }
    }
    if (toT) {
        const int n = n0 + lane;
        bf16_t* Tp = (bf16_t*)(ws_ + toff) + (size_t)seq_tok0 * tW + ((size_t)(n >> 5) * tW + tcr) * 32 + (n & 31);
#pragma unroll 4
        for (int c = 0; c < 64; ++c) Tp[(size_t)c * 32] = f2bf(T[lane * 65 + c]);
    }
}

template <int WHICH>
DI void epi_ln(const Params& p, unsigned char* ws_, float* out_, int l, float* T, int tm, int tn, int wn, int rowbase, int colbase, int lane, int tid) {
    const float* mod = (const float*)(ws_ + OFF_MOD);
    float* X = (float*)(ws_ + OFF_X);
    bf16_t* H = (bf16_t*)(ws_ + OFF_H);
    const int cnd = rowbase < NCTX ? 0 : 1 + ((rowbase - NCTX) >> 10);
    const float* md = mod + (size_t)(l * 3 + cnd) * 6144;
    const int col = colbase + lane;
    const bool last = (WHICH == 2 && l == 3);
    float s1 = 0.f, s2 = 0.f;
#pragma unroll 8
    for (int c = 0; c < 64; ++c) { const float v = T[lane * 65 + c]; s1 += v; s2 += v * v; }
    unsigned long long* stats = (unsigned long long*)(ws_ + OFF_STATS);
    __hip_atomic_store(stats + (size_t)(rowbase + lane) * 16 + tn * 2 + wn,
                       ((unsigned long long)__float_as_uint(s2) << 32) | (unsigned long long)__float_as_uint(s1), __ATOMIC_RELAXED, __HIP_MEMORY_SCOPE_AGENT);
    unsigned* cnt = (unsigned*)(ws_ + OFF_LNCNT) + (l * 2 + (WHICH - 1)) * 48 + tm;
    asm volatile("s_waitcnt vmcnt(0)" ::: "memory");
    __syncthreads();
    if (tid == 0) {
        (void)__hip_atomic_fetch_add(cnt, 1u, __ATOMIC_RELAXED, __HIP_MEMORY_SCOPE_AGENT);
        unsigned sp = 0;
        while (__hip_atomic_load(cnt, __ATOMIC_RELAXED, __HIP_MEMORY_SCOPE_AGENT) < 8u) { __builtin_amdgcn_s_sleep(1); if (++sp > (1u << 22)) break; }
    }
    __syncthreads();
    float t1 = 0.f, t2 = 0.f;
    {
        unsigned long long* sp8 = stats + (size_t)(rowbase + lane) * 16;
        unsigned long long a[16];
#pragma unroll
        for (int q = 0; q < 16; ++q) a[q] = __hip_atomic_load(sp8 + q, __ATOMIC_RELAXED, __HIP_MEMORY_SCOPE_AGENT);
#pragma unroll
        for (int q = 0; q < 16; ++q) { t1 += __uint_as_float((unsigned)a[q]); t2 += __uint_as_float((unsigned)(a[q] >> 32)); }
    }
    const float mu = t1 * (1.f / 1024.f);
    const float rstd = rsqrtf(fmaxf(t2 * (1.f / 1024.f) - mu * mu, 0.f) + LN_EPS);
    const float lng = (WHICH == 1 ? p.ln1_g : p.ln2_g)[l * 1024 + col], lnb = (WHICH == 1 ? p.ln1_b : p.ln2_b)[l * 1024 + col];
    if (last) {
        float* op = out_ + (size_t)rowbase * 1024 + col;
#pragma unroll 8
        for (int r = 0; r < 64; ++r) op[(size_t)r * 1024] = (T[r * 65 + lane] - __shfl(mu, r)) * __shfl(rstd, r) * lng + lnb;
    } else {
        const float* nmd = (WHICH == 1) ? md : mod + (size_t)((l + 1) * 3 + cnd) * 6144;
        const float sh = nmd[(WHICH == 1 ? 3072 : 0) + col], sc1p = 1.f + nmd[(WHICH == 1 ? 4096 : 1024) + col];
        float* xp = X + (size_t)rowbase * 1024 + col;
        bf16_t* hp = H + (size_t)rowbase * 1024 + col;
#pragma unroll 8
        for (int r = 0; r < 64; ++r) {
            const float o = (T[r * 65 + lane] - __shfl(mu, r)) * __shfl(rstd, r) * lng + lnb;
            xp[(size_t)r * 1024] = o;
            hp[(size_t)r * 1024] = f2bf(o * sc1p + sh);
        }
    }
}

template <int EPI>
DI void gemm_phase(const Params& pin, int layer, size_t offA, size_t offB, int ntn, int K, int ldc,
                   unsigned char* smem) {
    const Params& p = pin; unsigned char* const ws_ = opaque_ws(pin.ws); float* const out_ = opaque_out(pin.out); const int tid = opaque_v(threadIdx.x), lane = tid & 63, wave = opaque_s(tid >> 6);
    const bf16_t* __restrict__ A = (const bf16_t*)(ws_ + offA); const bf16_t* __restrict__ Bt = (const bf16_t*)(ws_ + offB);
    const int wm = wave >> 1, wn = wave & 1;
    const int lr = lane & 15, g = lane >> 4;
    const int ntm = NTOK / 128;
    const int ntiles = ntm * ntn, nk = K >> 6;
    for (int tile = blockIdx.x; tile < ntiles; tile += gridDim.x) {
        const int tm = tile % ntm, tn = tile / ntm;
        const int m0 = tm * 128, n0 = tn * 128;
        f32x4 acc[4][4];
#pragma unroll
        for (int mi = 0; mi < 4; ++mi)
#pragma unroll
            for (int ni = 0; ni < 4; ++ni) acc[mi][ni] = (f32x4){0.f, 0.f, 0.f, 0.f};
        const bf16_t* Ag = A + (size_t)m0 * K;
        const bf16_t* Bg = Bt + (size_t)n0 * K;
        const bf16_t* ag = Ag + (size_t)(wave * 32 + (lane >> 3)) * K + (((lane & 7) ^ (lane >> 3)) << 3);
        const bf16_t* bg = Bg + (size_t)(wave * 32 + (lane >> 3)) * K + (((lane & 7) ^ (lane >> 3)) << 3);
#pragma unroll
        for (int j = 0; j < 4; ++j) {
            __builtin_amdgcn_global_load_lds((const unsigned*)(ag + (size_t)j * 8 * K), (LAS unsigned*)(smem + (wave * 4 + j) * 1024), 16, 0, 0);
            __builtin_amdgcn_global_load_lds((const unsigned*)(bg + (size_t)j * 8 * K), (LAS unsigned*)(smem + 16384 + (wave * 4 + j) * 1024), 16, 0, 0);
        }
        asm volatile("s_waitcnt vmcnt(0)" ::: "memory");
        __syncthreads();
        for (int kt = 0; kt < nk; ++kt) {
            const unsigned char* cur = smem + (kt & 1) * 32768;
            unsigned char* nxt = smem + ((kt + 1) & 1) * 32768;
            if (kt + 1 < nk) {
                const int k0 = (kt + 1) << 6;
#pragma unroll
                for (int j = 0; j < 4; ++j) {
                    __builtin_amdgcn_global_load_lds((const unsigned*)(ag + (size_t)j * 8 * K + k0), (LAS unsigned*)(nxt + (wave * 4 + j) * 1024), 16, 0, 0);
                    __builtin_amdgcn_global_load_lds((const unsigned*)(bg + (size_t)j * 8 * K + k0), (LAS unsigned*)(nxt + 16384 + (wave * 4 + j) * 1024), 16, 0, 0);
                }
            }
#pragma unroll
            for (int kk = 0; kk < 2; ++kk) {
                bf16x8 af[4], bfr[4];
#pragma unroll
                for (int mi = 0; mi < 4; ++mi) {
                    const int row = wm * 64 + mi * 16 + lr;
                    af[mi] = *(const bf16x8*)(cur + row * 128 + (((kk * 4 + g) ^ (row & 7)) << 4));
                }
#pragma unroll
                for (int ni = 0; ni < 4; ++ni) {
                    const int row = wn * 64 + ni * 16 + lr;
                    bfr[ni] = *(const bf16x8*)(cur + 16384 + row * 128 + (((kk * 4 + g) ^ (row & 7)) << 4));
                }
#pragma unroll
                for (int mi = 0; mi < 4; ++mi)
#pragma unroll
                    for (int ni = 0; ni < 4; ++ni) acc[mi][ni] = mfma16(af[mi], bfr[ni], acc[mi][ni]);
            }
            asm volatile("s_waitcnt vmcnt(0)" ::: "memory");
            __syncthreads();
        }
        if (EPI == EPI_LN1 || EPI == EPI_LN2) {
            const int rb = m0 + wm * 64, cb = n0 + wn * 64;
            const int cnd = rb < NCTX ? 0 : 1 + ((rb - NCTX) >> 10);
            const float* gp = (const float*)(ws_ + OFF_MOD) + (size_t)(layer * 3 + cnd) * 6144 + (EPI == EPI_LN1 ? 2048 : 5120) + cb + lr;
            const float* xp = (const float*)(ws_ + OFF_X) + (size_t)(rb + 4 * g) * 1024 + cb + lr;
            float gt[4];
#pragma unroll
            for (int ni = 0; ni < 4; ++ni) gt[ni] = gp[ni * 16];
#pragma unroll
            for (int mh = 0; mh < 2; ++mh) {
                f32x4 xv[2][4];
#pragma unroll
                for (int m2 = 0; m2 < 2; ++m2)
#pragma unroll
                    for (int ni = 0; ni < 4; ++ni)
#pragma unroll
                        for (int i = 0; i < 4; ++i) xv[m2][ni][i] = xp[(size_t)((mh * 2 + m2) * 16 + i) * 1024 + ni * 16];
#pragma unroll
                for (int m2 = 0; m2 < 2; ++m2)
#pragma unroll
                    for (int ni = 0; ni < 4; ++ni)
#pragma unroll
                        for (int i = 0; i < 4; ++i) acc[mh * 2 + m2][ni][i] = ALPHA * xv[m2][ni][i] + gt[ni] * acc[mh * 2 + m2][ni][i];
                __builtin_amdgcn_sched_barrier(0);
            }
        }
        float* T = (float*)smem + wave * (64 * 65);
#pragma unroll
        for (int mi = 0; mi < 4; ++mi)
#pragma unroll
            for (int ni = 0; ni < 4; ++ni)
#pragma unroll
                for (int i = 0; i < 4; ++i) T[(mi * 16 + 4 * g + i) * 65 + ni * 16 + lr] = acc[mi][ni][i];
        const int rowbase = m0 + wm * 64, colbase = n0 + wn * 64;
        if (EPI == EPI_INPROJ) {
            epi_inproj(p, ws_, out_, layer, T, rowbase, colbase, lane);
        } else if (EPI == EPI_LN1) {
            epi_ln<1>(p, ws_, out_, layer, T, tm, tn, wn, rowbase, colbase, lane, tid);
        } else if (EPI == EPI_LN2) {
            epi_ln<2>(p, ws_, out_, layer, T, tm, tn, wn, rowbase, colbase, lane, tid);
        } else {
            bf16_t* U = (bf16_t*)(ws_ + OFF_U) + (size_t)rowbase * ldc + colbase + lane;
#pragma unroll 4
            for (int r = 0; r < 64; ++r) { const float v = fmaxf(T[r * 65 + lane], 0.f); U[(size_t)r * ldc] = f2bf(v * v); }
        }
        __syncthreads();
    }
}

template <int NMAP, int DV>
struct AttnSt { f32x4 O[NMAP][DV / 16]; float m[NMAP]; float l[NMAP]; };
template <int NMAP, int DV>
struct UnitFrags { bf16x8 k[NMAP][2][2]; bf16x8 v[DV / 16]; };

template <int NMAP, int DV>
struct TileGeom {
    static constexpr int KROW = NMAP * 128, KBYTES = 64 * KROW, VUNIT = DV * 64, TBYTES = KBYTES + 2 * VUNIT;
};
DI int kswz(int row) { return (row & 3) | (((row >> 3) & 3) << 2); }

template <int NMAP, int DV>
DI void stage_tile(unsigned char* buf, const bf16_t* kg, int kstride, const bf16_t* vg, int vunit, int wave, int lane) {
    typedef TileGeom<NMAP, DV> TG;
    if (NMAP == 2) {
#pragma unroll
        for (int j = 0; j < 4; ++j) {
            const int jj = wave * 4 + j, row = jj * 4 + (lane >> 4), lc = (lane & 15) ^ kswz(row);
            __builtin_amdgcn_global_load_lds((const unsigned*)(kg + (size_t)row * kstride + lc * 8), (LAS unsigned*)(buf + jj * 1024), 16, 0, 0);
        }
    } else {
#pragma unroll
        for (int j = 0; j < 2; ++j) {
            const int jj = wave * 2 + j, row = jj * 8 + (lane >> 3), lc = (lane & 7) ^ (kswz(row) >> 1);
            __builtin_amdgcn_global_load_lds((const unsigned*)(kg + (size_t)row * kstride + lc * 8), (LAS unsigned*)(buf + jj * 1024), 16, 0, 0);
        }
    }
    constexpr int VI = TG::VUNIT / 1024, PER = 2 * VI / 4;
#pragma unroll
    for (int j = 0; j < PER; ++j) {
        const int jj = wave * PER + j, unit = jj / VI, piece = jj % VI;
        __builtin_amdgcn_global_load_lds((const unsigned*)(vg + (size_t)unit * vunit + piece * 512 + lane * 8),
                                         (LAS unsigned*)(buf + TG::KBYTES + jj * 1024), 16, 0, 0);
    }
}

template <int NMAP, int DV>
DI void lds_unit(UnitFrags<NMAP, DV>& f, const unsigned char* buf, int rowbase, int voff, int lr, int g) {
    typedef TileGeom<NMAP, DV> TG;
#pragma unroll
    for (int b = 0; b < 2; ++b) {
        const int row = rowbase + (lr >> 2) * 8 + (lr & 3) + 4 * b, sw = kswz(row);
        if (NMAP == 2) {
#pragma unroll
            for (int m = 0; m < NMAP; ++m)
#pragma unroll
                for (int kk = 0; kk < 2; ++kk) f.k[m][b][kk] = *(const bf16x8*)(buf + row * 256 + (((m * 8 + kk * 4 + g) ^ sw) << 4));
        } else {
#pragma unroll
            for (int kk = 0; kk < 2; ++kk) f.k[0][b][kk] = *(const bf16x8*)(buf + row * 128 + (((kk * 4 + g) ^ (sw >> 1)) << 4));
        }
    }
#pragma unroll
    for (int vb = 0; vb < DV / 16; ++vb) f.v[vb] = *(const bf16x8*)(buf + TG::KBYTES + voff + (vb * 16 + lr) * 64);
}

template <int DV>
DI void lds_unit_sel(UnitFrags<1, DV>& f, const unsigned char* buf, int rowbase, int voff, int lr, int g, int msel) {
    typedef TileGeom<2, DV> TG;
#pragma unroll
    for (int b = 0; b < 2; ++b) {
        const int row = rowbase + (lr >> 2) * 8 + (lr & 3) + 4 * b, sw = kswz(row);
#pragma unroll
        for (int kk = 0; kk < 2; ++kk) f.k[0][b][kk] = *(const bf16x8*)(buf + row * 256 + (((msel * 8 + kk * 4 + g) ^ sw) << 4));
    }
#pragma unroll
    for (int vb = 0; vb < DV / 16; ++vb) f.v[vb] = *(const bf16x8*)(buf + TG::KBYTES + voff + (vb * 16 + lr) * 64);
}

template <int NMAP, int DV, class SrcFn, class CompFn>
DI void tile_pipeline(unsigned char* tiles, int nt, int wave, int lane, SrcFn src, CompFn comp) {
    typedef TileGeom<NMAP, DV> TG;
    {
        const bf16_t *kg, *vg; int ks, vu;
        src(0, kg, ks, vg, vu);
        stage_tile<NMAP, DV>(tiles, kg, ks, vg, vu, wave, lane);
    }
    asm volatile("s_waitcnt vmcnt(0)" ::: "memory");
    __syncthreads();
    for (int t = 0; t < nt; ++t) {
        unsigned char* cur = tiles + (t & 1) * TG::TBYTES;
        if (t + 1 < nt) {
            const bf16_t *kg, *vg; int ks, vu;
            src(t + 1, kg, ks, vg, vu);
            stage_tile<NMAP, DV>(tiles + ((t + 1) & 1) * TG::TBYTES, kg, ks, vg, vu, wave, lane);
        }
        comp(t, cur);
        asm volatile("s_waitcnt vmcnt(0)" ::: "memory");
        __syncthreads();
    }
}

template <int NMAP, int DV, bool HASBIAS>
DI void compute_unit(AttnSt<NMAP, DV>& st, const UnitFrags<NMAP, DV>& f, const bf16x8 (&qf)[NMAP][2], float sc, const float (&bias)[8]) {
    bf16x8 pk[NMAP];
#pragma unroll
    for (int m = 0; m < NMAP; ++m) {
        f32x4 sa = (f32x4){0.f, 0.f, 0.f, 0.f}, sb = sa;
        sa = mfma16(f.k[m][0][0], qf[m][0], sa); sa = mfma16(f.k[m][0][1], qf[m][1], sa);
        sb = mfma16(f.k[m][1][0], qf[m][0], sb); sb = mfma16(f.k[m][1][1], qf[m][1], sb);
        float s[8];
#pragma unroll
        for (int j = 0; j < 4; ++j) { s[j] = sa[j] * sc; s[4 + j] = sb[j] * sc; }
        if (HASBIAS) {
#pragma unroll
            for (int j = 0; j < 8; ++j) s[j] += bias[j];
        }
        float mx = fmaxf(fmaxf(fmaxf(s[0], s[1]), fmaxf(s[2], s[3])), fmaxf(fmaxf(s[4], s[5]), fmaxf(s[6], s[7])));
        mx = grp_max(mx);
        const float mnew = fmaxf(st.m[m], mx);
        const float alpha = fexp2(st.m[m] - mnew);
        float ps = 0.f;
#pragma unroll
        for (int j = 0; j < 8; ++j) { s[j] = fexp2(s[j] - mnew); ps += s[j]; }
        st.l[m] = st.l[m] * alpha + ps; st.m[m] = mnew;
        if (__builtin_amdgcn_ballot_w64(alpha != 1.f) != 0ull) {
#pragma unroll
            for (int vb = 0; vb < DV / 16; ++vb) st.O[m][vb] *= alpha;
        }
        pk[m] = pack8(s[0], s[1], s[2], s[3], s[4], s[5], s[6], s[7]);
    }
#pragma unroll
    for (int vb = 0; vb < DV / 16; ++vb) {
#pragma unroll
        for (int m = 0; m < NMAP; ++m) st.O[m][vb] = mfma16(f.v[vb], pk[m], st.O[m][vb]);
    }
}

template <int NMAP, int DV>
DI void attn_init(AttnSt<NMAP, DV>& st) {
#pragma unroll
    for (int m = 0; m < NMAP; ++m) {
        st.m[m] = -INFINITY; st.l[m] = 0.f;
#pragma unroll
        for (int vb = 0; vb < DV / 16; ++vb) st.O[m][vb] = (f32x4){0.f, 0.f, 0.f, 0.f};
    }
}

template <bool LAT>
DI void item_diffattn(const Params& pin, int l, int seq, int h, int qt, unsigned char* smem, int wave, int lane) {
    const Params& p = pin; unsigned char* const ws_ = opaque_ws(pin.ws); float* const out_ = opaque_out(pin.out); lane = opaque_v(lane); wave = opaque_s(wave);
    const int lr = lane & 15, g = lane >> 4;
    const int nseq = LAT ? 1024 : 256;
    const int tok0 = LAT ? NCTX + seq * 1024 : seq * 256;
    const bf16_t* P = (const bf16_t*)(ws_ + OFF_P);
    const int q0 = qt * 64 + wave * 16;
    bf16x8 qf[2][2];
    {
        const bf16_t* qp = P + (size_t)(tok0 + q0 + lr) * NIN + h * 128 + 8 * g;
#pragma unroll
        for (int m = 0; m < 2; ++m)
#pragma unroll
            for (int kk = 0; kk < 2; ++kk) qf[m][kk] = *(const bf16x8*)(qp + m * 64 + kk * 32);
    }
    AttnSt<2, 128> st;
    attn_init<2, 128>(st);
    const float sc = 0.125f * LOG2E;
    const size_t hb = (size_t)((seq * 4 + l) * 4 + h);
    const bf16_t* kc = (const bf16_t*)(ws_ + OFF_CAK) + hb * 512 * 128;
    const bf16_t* vc = (const bf16_t*)(ws_ + OFF_CAVT) + hb * 128 * 512;
    const bf16_t* kn = P + (size_t)tok0 * NIN + 512 + h * 128;
    const bf16_t* vn = (const bf16_t*)(ws_ + OFF_PT_AV) + (size_t)tok0 * 512 + (size_t)(h * 128) * 32;
    const int ncache = LAT ? 8 : 0;
    __syncthreads();
    tile_pipeline<2, 128>(smem, ncache + nseq / 64, wave, lane,
        [&](int t, const bf16_t*& kg, int& ks, const bf16_t*& vg, int& vu) {
            if (t < ncache) { kg = kc + (size_t)t * 64 * 128; ks = 128; vg = vc + (size_t)(2 * t) * 128 * 32; vu = 128 * 32; }
            else { const int tt = t - ncache; kg = kn + (size_t)tt * 64 * NIN; ks = NIN; vg = vn + (size_t)(2 * tt) * 512 * 32; vu = 512 * 32; }
        },
        [&](int t, const unsigned char* buf) {
            const float nob[8] = {0.f, 0.f, 0.f, 0.f, 0.f, 0.f, 0.f, 0.f};
#pragma unroll 1
            for (int half = 0; half < 2; ++half) {
                UnitFrags<2, 128> f;
                lds_unit<2, 128>(f, buf, 32 * half, half * TileGeom<2, 128>::VUNIT + g * 16, lr, g);
                compute_unit<2, 128, false>(st, f, qf, sc, nob);
            }
        });
    const float inv0 = 1.f / grp_sum(st.l[0]), inv1 = 1.f / grp_sum(st.l[1]);
    const float* lamp = (const float*)(ws_ + OFF_LAM);
    const float lam = lamp[l * 2], lam_init = lamp[l * 2 + 1];
    const float c1 = lam * inv1;
    float ss = 0.f;
#pragma unroll
    for (int vb = 0; vb < 8; ++vb)
#pragma unroll
        for (int i = 0; i < 4; ++i) {
            const float o = st.O[0][vb][i] * inv0 - st.O[1][vb][i] * c1;
            st.O[0][vb][i] = o; ss += o * o;
        }
    ss = grp_sum(ss);
    const float r = rsqrtf(ss * (1.f / 128.f) + LN_EPS) * (1.f - lam_init);
    bf16_t* MIX = (bf16_t*)(ws_ + OFF_MIX) + (size_t)(tok0 + q0 + lr) * 1024 + h * 128;
    const float* gn = p.diff_norm_g + l * 128;
#pragma unroll
    for (int vb = 0; vb < 8; ++vb) {
        const int v = vb * 16 + 4 * g;
        const float4 g4 = *(const float4*)(gn + v);
        uint2 o; o.x = pack2(st.O[0][vb][0] * r * g4.x, st.O[0][vb][1] * r * g4.y);
        o.y = pack2(st.O[0][vb][2] * r * g4.z, st.O[0][vb][3] * r * g4.w);
        *(uint2*)(MIX + v) = o;
    }
}

DI void item_diffattn_lat(const Params& pin, int l, int seq, int h, int qt32, unsigned char* smem, int wave, int lane) {
    const Params& p = pin; unsigned char* const ws_ = opaque_ws(pin.ws); float* const out_ = opaque_out(pin.out); lane = opaque_v(lane); wave = opaque_s(wave);
    const int lr = lane & 15, g = lane >> 4;
    const int tok0 = NCTX + seq * 1024;
    const bf16_t* P = (const bf16_t*)(ws_ + OFF_P);
    const int msel = wave & 1;
    const int q0 = qt32 * 32 + (wave >> 1) * 16;
    bf16x8 qf[1][2];
    {
        const bf16_t* qp = P + (size_t)(tok0 + q0 + lr) * NIN + h * 128 + msel * 64 + 8 * g;
        qf[0][0] = *(const bf16x8*)(qp); qf[0][1] = *(const bf16x8*)(qp + 32);
    }
    AttnSt<1, 128> st;
    attn_init<1, 128>(st);
    const float sc = 0.125f * LOG2E;
    const size_t hb = (size_t)((seq * 4 + l) * 4 + h);
    const bf16_t* kc = (const bf16_t*)(ws_ + OFF_CAK) + hb * 512 * 128;
    const bf16_t* vc = (const bf16_t*)(ws_ + OFF_CAVT) + hb * 128 * 512;
    const bf16_t* kn = P + (size_t)tok0 * NIN + 512 + h * 128;
    const bf16_t* vn = (const bf16_t*)(ws_ + OFF_PT_AV) + (size_t)tok0 * 512 + (size_t)(h * 128) * 32;
    __syncthreads();
    tile_pipeline<2, 128>(smem, 24, wave, lane,
        [&](int t, const bf16_t*& kg, int& ks, const bf16_t*& vg, int& vu) {
            if (t < 8) { kg = kc + (size_t)t * 64 * 128; ks = 128; vg = vc + (size_t)(2 * t) * 128 * 32; vu = 128 * 32; }
            else { const int tt = t - 8; kg = kn + (size_t)tt * 64 * NIN; ks = NIN; vg = vn + (size_t)(2 * tt) * 512 * 32; vu = 512 * 32; }
        },
        [&](int t, const unsigned char* buf) {
            const float nob[8] = {0.f, 0.f, 0.f, 0.f, 0.f, 0.f, 0.f, 0.f};
#pragma unroll
            for (int half = 0; half < 2; ++half) {
                UnitFrags<1, 128> f;
                lds_unit_sel<128>(f, buf, 32 * half, half * TileGeom<2, 128>::VUNIT + g * 16, lr, g, msel);
                compute_unit<1, 128, false>(st, f, qf, sc, nob);
            }
        });
    const float* lamp = (const float*)(ws_ + OFF_LAM);
    const float lam = lamp[l * 2], lam_init = lamp[l * 2 + 1];
    const float inv = (msel ? lam : 1.f) / grp_sum(st.l[0]);
    float* xb = (float*)smem + (wave >> 1) * 32 * 64 + lane;
    if (msel) {
#pragma unroll
        for (int vb = 0; vb < 8; ++vb)
#pragma unroll
            for (int i = 0; i < 4; ++i) xb[(vb * 4 + i) * 64] = st.O[0][vb][i] * inv;
    }
    __syncthreads();
    if (msel) return;
    float ss = 0.f;
#pragma unroll
    for (int vb = 0; vb < 8; ++vb)
#pragma unroll
        for (int i = 0; i < 4; ++i) {
            const float o = st.O[0][vb][i] * inv - xb[(vb * 4 + i) * 64];
            st.O[0][vb][i] = o; ss += o * o;
        }
    ss = grp_sum(ss);
    const float r = rsqrtf(ss * (1.f / 128.f) + LN_EPS) * (1.f - lam_init);
    bf16_t* MIX = (bf16_t*)(ws_ + OFF_MIX) + (size_t)(tok0 + q0 + lr) * 1024 + h * 128;
    const float* gn = p.diff_norm_g + l * 128;
#pragma unroll
    for (int vb = 0; vb < 8; ++vb) {
        const int v = vb * 16 + 4 * g;
        const float4 g4 = *(const float4*)(gn + v);
        uint2 o; o.x = pack2(st.O[0][vb][0] * r * g4.x, st.O[0][vb][1] * r * g4.y);
        o.y = pack2(st.O[0][vb][2] * r * g4.z, st.O[0][vb][3] * r * g4.w);
        *(uint2*)(MIX + v) = o;
    }
}

DI void item_dense(const Params& pin, int seq, int h, int qt, unsigned char* smem, int wave, int lane) {
    const Params& p = pin; unsigned char* const ws_ = opaque_ws(pin.ws); float* const out_ = opaque_out(pin.out); lane = opaque_v(lane); wave = opaque_s(wave);
    const int lr = lane & 15, g = lane >> 4;
    const int tok0 = seq * 256;
    const bf16_t* P = (const bf16_t*)(ws_ + OFF_P);
    const int q0 = qt * 64 + wave * 16;
    bf16x8 qf[1][2];
    {
        const bf16_t* qp = P + (size_t)(tok0 + q0 + lr) * NIN + 1536 + h * 64 + 8 * g;
        qf[0][0] = *(const bf16x8*)(qp); qf[0][1] = *(const bf16x8*)(qp + 32);
    }
    AttnSt<1, 64> st;
    attn_init<1, 64>(st);
    const bf16_t* kn = P + (size_t)tok0 * NIN + 1792 + h * 64;
    const bf16_t* vn = (const bf16_t*)(ws_ + OFF_PT_BV) + (size_t)tok0 * 256 + (size_t)(h * 64) * 32;
    const float sc = 0.125f * LOG2E;
    __syncthreads();
    tile_pipeline<1, 64>(smem, 4, wave, lane,
        [&](int t, const bf16_t*& kg, int& ks, const bf16_t*& vg, int& vu) {
            kg = kn + (size_t)t * 64 * NIN; ks = NIN; vg = vn + (size_t)(2 * t) * 256 * 32; vu = 256 * 32;
        },
        [&](int t, const unsigned char* buf) {
            const float nob[8] = {0.f, 0.f, 0.f, 0.f, 0.f, 0.f, 0.f, 0.f};
#pragma unroll
            for (int half = 0; half < 2; ++half) {
                UnitFrags<1, 64> f;
                lds_unit<1, 64>(f, buf, 32 * half, half * TileGeom<1, 64>::VUNIT + g * 16, lr, g);
                compute_unit<1, 64, false>(st, f, qf, sc, nob);
            }
        });
    const float inv = 1.f / grp_sum(st.l[0]);
    bf16_t* MIX = (bf16_t*)(ws_ + OFF_MIX) + (size_t)(tok0 + q0 + lr) * 1024 + 512 + h * 64;
#pragma unroll
    for (int vb = 0; vb < 4; ++vb) {
        uint2 o; o.x = pack2(st.O[0][vb][0] * inv, st.O[0][vb][1] * inv); o.y = pack2(st.O[0][vb][2] * inv, st.O[0][vb][3] * inv);
        *(uint2*)(MIX + vb * 16 + 4 * g) = o;
    }
}

DI void item_na(const Params& pin, int l, int sb, int h, int r, unsigned char* smem, int wave, int lane) {
    const Params& p = pin; unsigned char* const ws_ = opaque_ws(pin.ws); float* const out_ = opaque_out(pin.out); lane = opaque_v(lane); wave = opaque_s(wave);
    const int lr = lane & 15, g = lane >> 4;
    const int tok0 = NCTX + sb * 1024;
    const bf16_t* P = (const bf16_t*)(ws_ + OFF_P);
    const int qc = wave * 16 + lr;
    const int q0 = r * 64 + wave * 16;
    bf16x8 qf[1][2];
    {
        const bf16_t* qp = P + (size_t)(tok0 + q0 + lr) * NIN + 1536 + h * 64 + 8 * g;
        qf[0][0] = *(const bf16x8*)(qp); qf[0][1] = *(const bf16x8*)(qp + 32);
    }
    AttnSt<1, 64> st;
    attn_init<1, 64>(st);
    const float sc = 0.125f * LOG2E;
    const size_t hb = (size_t)((sb * 4 + l) * 4 + h);
    const bf16_t* kc = (const bf16_t*)(ws_ + OFF_CBK) + hb * 512 * 64;
    const bf16_t* vc = (const bf16_t*)(ws_ + OFF_CBVT) + hb * 64 * 512;
    const bf16_t* kn = P + (size_t)tok0 * NIN + 1792 + h * 64;
    const bf16_t* vn = (const bf16_t*)(ws_ + OFF_PT_BV) + (size_t)tok0 * 256 + (size_t)(h * 64) * 32;
    const int kr0 = min(max(r - 4, 0), 8);
    const int bs = min(max(wave * 16 - 8, 0), 32);
    const int wstart = min(max(qc - 8, 0), 48);
    const float* rpb = p.nat_rpb + (size_t)(l * 4 + h) * 15 * 31;
    __syncthreads();
    tile_pipeline<1, 64>(smem, 16, wave, lane,
        [&](int t, const bf16_t*& kg, int& ks, const bf16_t*& vg, int& vu) {
            if (t < 8) { kg = kc + (size_t)t * 64 * 64; ks = 64; vg = vc + (size_t)(2 * t) * 64 * 32; vu = 64 * 32; }
            else { const int kr = kr0 + t - 8; kg = kn + (size_t)kr * 64 * NIN; ks = NIN; vg = vn + (size_t)(2 * kr) * 256 * 32; vu = 256 * 32; }
        },
        [&](int t, const unsigned char* buf) {
            if (t < 8) {
                const float nob[8] = {0.f, 0.f, 0.f, 0.f, 0.f, 0.f, 0.f, 0.f};
#pragma unroll
                for (int half = 0; half < 2; ++half) {
                    UnitFrags<1, 64> f;
                    lds_unit<1, 64>(f, buf, 32 * half, half * TileGeom<1, 64>::VUNIT + g * 16, lr, g);
                    compute_unit<1, 64, false>(st, f, qf, sc, nob);
                }
            } else {
                const int kr = kr0 + t - 8;
                const int nl = bs + 8 * g;
                UnitFrags<1, 64> f;
                lds_unit<1, 64>(f, buf, bs, (nl >> 5) * TileGeom<1, 64>::VUNIT + (nl & 31) * 2, lr, g);
                float bias[8];
                const float* rrow = rpb + (kr - r + 7) * 31;
#pragma unroll
                for (int j = 0; j < 8; ++j) {
                    const int kcol = bs + 8 * g + j;
                    const bool valid = (kcol >= wstart) && (kcol < wstart + 16);
                    const int dc = min(max(kcol - qc + 15, 0), 30);
                    bias[j] = valid ? rrow[dc] * LOG2E : -INFINITY;
                }
                compute_unit<1, 64, true>(st, f, qf, sc, bias);
            }
        });
    const float inv = 1.f / grp_sum(st.l[0]);
    bf16_t* MIX = (bf16_t*)(ws_ + OFF_MIX) + (size_t)(tok0 + q0 + lr) * 1024 + 512 + h * 64;
#pragma unroll
    for (int vb = 0; vb < 4; ++vb) {
        uint2 o; o.x = pack2(st.O[0][vb][0] * inv, st.O[0][vb][1] * inv); o.y = pack2(st.O[0][vb][2] * inv, st.O[0][vb][3] * inv);
        *(uint2*)(MIX + vb * 16 + 4 * g) = o;
    }
}

DI float wave_excl_sum(float v, int lane) {
    float x = v;
#pragma unroll
    for (int d = 1; d < 64; d <<= 1) { const float y = __shfl_up(x, d); if (lane >= d) x += y; }
    return x - v;
}
DI float wave_excl_max(float v, int lane, float init) {
    float x = v;
#pragma unroll
    for (int d = 1; d < 64; d <<= 1) { const float y = __shfl_up(x, d); if (lane >= d) x = fmaxf(x, y); }
    const float ex = __shfl_up(x, 1);
    return lane == 0 ? init : fmaxf(init, ex);
}
DI void mlstm_scan(const float* __restrict__ G, int h, int nseq, int dir, float* aA, float* MA, float* FA, float m0, int lane) {
    const int per = nseq >> 6;
    float run = 0.f;
    for (int e = 0; e < per; ++e) {
        const int idx = lane * per + e, pos = dir ? nseq - 1 - idx : idx;
        const float f = G[(size_t)pos * 16 + (dir ? 12 : 4) + h];
        const float lf = fminf(f, 0.f) - __logf(1.f + __expf(-fabsf(f)));
        run += lf; FA[pos] = run;
    }
    const float off = wave_excl_sum(run, lane);
    float rmax = -INFINITY;
    for (int e = 0; e < per; ++e) {
        const int idx = lane * per + e, pos = dir ? nseq - 1 - idx : idx;
        const float F = FA[pos] + off; FA[pos] = F;
        const float a = G[(size_t)pos * 16 + (dir ? 8 : 0) + h] - F;
        aA[pos] = a; rmax = fmaxf(rmax, a); MA[pos] = rmax;
    }
    const float pre = wave_excl_max(rmax, lane, m0);
    for (int e = 0; e < per; ++e) {
        const int idx = lane * per + e, pos = dir ? nseq - 1 - idx : idx;
        MA[pos] = fmaxf(MA[pos], pre);
    }
}

DI void mlstm_unit(f32x4 (&O)[4], float& den, int dir, int t, const bf16x8 (&qf)[2], const UnitFrags<1, 64>& f, const float* aA, float Mt, int key0, int g) {
    f32x4 sa = (f32x4){0.f, 0.f, 0.f, 0.f}, sb = sa;
    sa = mfma16(f.k[0][0][0], qf[0], sa); sa = mfma16(f.k[0][0][1], qf[1], sa);
    sb = mfma16(f.k[0][1][0], qf[0], sb); sb = mfma16(f.k[0][1][1], qf[1], sb);
    const float4 a0 = *(const float4*)(aA + key0 + 8 * g), a1 = *(const float4*)(aA + key0 + 8 * g + 4);
    const float av[8] = {a0.x, a0.y, a0.z, a0.w, a1.x, a1.y, a1.z, a1.w};
    float pv[8];
#pragma unroll
    for (int j = 0; j < 8; ++j) {
        const int key = key0 + 8 * g + j;
        const bool ok = dir ? (key >= t) : (key <= t);
        const float w = ok ? fexp2((av[j] - Mt) * LOG2E) : 0.f;
        const float sv = (j < 4) ? sa[j & 3] : sb[j & 3];
        pv[j] = sv * 0.125f * w;
        den += pv[j];
    }
    const bf16x8 pk = pack8(pv[0], pv[1], pv[2], pv[3], pv[4], pv[5], pv[6], pv[7]);
#pragma unroll
    for (int vb = 0; vb < 4; ++vb) O[vb] = mfma16(f.v[vb], pk, O[vb]);
}

template <bool LAT>
DI void item_mlstm(const Params& pin, int l, int seq, int h, int qt, unsigned char* smem, int wave, int lane) {
    const Params& p = pin; unsigned char* const ws_ = opaque_ws(pin.ws); float* const out_ = opaque_out(pin.out); lane = opaque_v(lane); wave = opaque_s(wave);
    const int lr = lane & 15, g = lane >> 4;
    const int nseq = LAT ? 1024 : 256;
    const int tok0 = LAT ? NCTX + seq * 1024 : seq * 256;
    float* aF = (float*)smem; float* MF = aF + 1024; float* FF = MF + 1024;
    float* aB = FF + 1024; float* MB = aB + 1024; float* FB = MB + 1024;
    unsigned char* tiles = smem + 24576;
    const float* G = (const float*)(ws_ + OFF_G) + (size_t)tok0 * 16;
    float m0f = 0.f, m0b = 0.f;
    const int sidx_f = ((seq * 4 + l) * 2 + 0) * 4 + h, sidx_b = ((seq * 4 + l) * 2 + 1) * 4 + h;
    if (LAT) { m0f = p.state_m[sidx_f]; m0b = p.state_m[sidx_b]; }
    __syncthreads();
    if (wave == 0) mlstm_scan(G, h, nseq, 0, aF, MF, FF, m0f, lane);
    if (wave == 1) mlstm_scan(G, h, nseq, 1, aB, MB, FB, m0b, lane);
    __syncthreads();
    const bf16_t* P = (const bf16_t*)(ws_ + OFF_P);
    const int q0 = qt * 64 + wave * 16;
    const int t = q0 + lr;
    bf16x8 qf[2];
    {
        const bf16_t* qp = P + (size_t)(tok0 + t) * NIN + 2304 + h * 64 + 8 * g;
        qf[0] = *(const bf16x8*)(qp); qf[1] = *(const bf16x8*)(qp + 32);
    }
    const bf16_t* kn = P + (size_t)tok0 * NIN + 2560 + h * 64;
    const bf16_t* vn = (const bf16_t*)(ws_ + OFF_PT_CV) + (size_t)tok0 * 256 + (size_t)(h * 64) * 32;
    const float Mf = MF[t], Mb = MB[t], Ff = FF[t], Fb = FB[t];
    f32x4 Of[4], Ob[4];
#pragma unroll
    for (int vb = 0; vb < 4; ++vb) { Of[vb] = (f32x4){0.f, 0.f, 0.f, 0.f}; Ob[vb] = Of[vb]; }
    float denf = 0.f, denb = 0.f;
    tile_pipeline<1, 64>(tiles, nseq / 64, wave, lane,
        [&](int tt, const bf16_t*& kg, int& ks, const bf16_t*& vg, int& vu) {
            kg = kn + (size_t)tt * 64 * NIN; ks = NIN; vg = vn + (size_t)(2 * tt) * 256 * 32; vu = 256 * 32;
        },
        [&](int tt, const unsigned char* buf) {
#pragma unroll
            for (int half = 0; half < 2; ++half) {
                const int key0 = tt * 64 + half * 32;
                const bool dof = key0 <= q0 + 15, dob = key0 + 31 >= q0;
                if (dof || dob) {
                    UnitFrags<1, 64> f;
                    lds_unit<1, 64>(f, buf, 32 * half, half * TileGeom<1, 64>::VUNIT + g * 16, lr, g);
                    if (dof) mlstm_unit(Of, denf, 0, t, qf, f, aF, Mf, key0, g);
                    if (dob) mlstm_unit(Ob, denb, 1, t, qf, f, aB, Mb, key0, g);
                }
            }
        });
    if (LAT) {
        const bf16_t* qp2 = P + (size_t)(tok0 + t) * NIN + 2304 + h * 64 + 4 * g;
#pragma unroll
        for (int dir = 0; dir < 2; ++dir) {
            const int sidx = dir ? sidx_b : sidx_f;
            const float e = fexp2(((dir ? m0b : m0f) - (dir ? Mb : Mf)) * LOG2E) * 0.125f;
            const bf16_t* c0t = (const bf16_t*)(ws_ + OFF_C0T) + (size_t)sidx * 4096 + lr * 64 + 4 * g;
            const float* n0 = p.state_n + (size_t)sidx * 64;
            float dacc = 0.f;
#pragma unroll
            for (int u2 = 0; u2 < 2; ++u2) {
                const bf16x4 qa = *(const bf16x4*)(qp2 + u2 * 32), qb = *(const bf16x4*)(qp2 + u2 * 32 + 16);
                const float4 na = *(const float4*)(n0 + u2 * 32 + 4 * g), nb = *(const float4*)(n0 + u2 * 32 + 16 + 4 * g);
                float pv[8];
#pragma unroll
                for (int j = 0; j < 4; ++j) { pv[j] = bf2f((unsigned short)qa[j]) * e; pv[4 + j] = bf2f((unsigned short)qb[j]) * e; }
                dacc += pv[0] * na.x + pv[1] * na.y + pv[2] * na.z + pv[3] * na.w + pv[4] * nb.x + pv[5] * nb.y + pv[6] * nb.z + pv[7] * nb.w;
                const bf16x8 pk = pack8(pv[0], pv[1], pv[2], pv[3], pv[4], pv[5], pv[6], pv[7]);
#pragma unroll
                for (int vb = 0; vb < 4; ++vb) {
                    const bf16_t* cp = c0t + (size_t)vb * 16 * 64 + u2 * 32;
                    const bf16x8 cf = cat4(*(const bf16x4*)(cp), *(const bf16x4*)(cp + 16));
                    if (dir) Ob[vb] = mfma16(cf, pk, Ob[vb]); else Of[vb] = mfma16(cf, pk, Of[vb]);
                }
            }
            if (dir) denb += dacc; else denf += dacc;
        }
    }
    denf = grp_sum(denf); denb = grp_sum(denb);
    const float rf = 1.f / fmaxf(fabsf(denf), expf(-(Ff + Mf)));
    const float rb = 1.f / fmaxf(fabsf(denb), expf(-(Fb + Mb)));
    float ss = 0.f;
#pragma unroll
    for (int vb = 0; vb < 4; ++vb)
#pragma unroll
        for (int i = 0; i < 4; ++i) { const float hs = Of[vb][i] * rf + Ob[vb][i] * rb; Of[vb][i] = hs; ss += hs * hs; }
    ss = grp_sum(ss);
    const float rn = rsqrtf(ss * (1.f / 64.f) + LN_EPS);
    const float* gn = p.mlstm_norm_g + (size_t)(l * 4 + h) * 64;
    const bf16_t* op = P + (size_t)(tok0 + t) * NIN + 3072 + h * 64;
    bf16_t* MIX = (bf16_t*)(ws_ + OFF_MIX) + (size_t)(tok0 + t) * 1024 + 768 + h * 64;
#pragma unroll
    for (int vb = 0; vb < 4; ++vb) {
        const int v = vb * 16 + 4 * g;
        const float4 g4 = *(const float4*)(gn + v);
        const bf16x4 o4 = *(const bf16x4*)(op + v);
        float sg[4];
#pragma unroll
        for (int i = 0; i < 4; ++i) sg[i] = 1.f / (1.f + __expf(-bf2f((unsigned short)o4[i])));
        uint2 o; o.x = pack2(Of[vb][0] * rn * g4.x * sg[0], Of[vb][1] * rn * g4.y * sg[1]);
        o.y = pack2(Of[vb][2] * rn * g4.z * sg[2], Of[vb][3] * rn * g4.w * sg[3]);
        *(uint2*)(MIX + v) = o;
    }
}

DI void item_mlstm_state(const Params& pin, int l, int b, int h, int dir, unsigned char* smem, int wave, int lane) {
    const Params& p = pin; unsigned char* const ws_ = opaque_ws(pin.ws); float* const out_ = opaque_out(pin.out); lane = opaque_v(lane); wave = opaque_s(wave);
    const int lr = lane & 15, g = lane >> 4;
    const int tok0 = b * 256;
    float* aA = (float*)smem; float* MA = aA + 1024; float* FA = MA + 1024;
    const float* G = (const float*)(ws_ + OFF_G) + (size_t)tok0 * 16;
    __syncthreads();
    if (wave == 0) mlstm_scan(G, h, 256, dir, aA, MA, FA, 0.f, lane);
    __syncthreads();
    const float Mfin = dir ? MA[0] : MA[255];
    const float Ffin = dir ? FA[0] : FA[255];
    const bf16_t* KT = (const bf16_t*)(ws_ + OFF_PT_CK) + (size_t)tok0 * 256 + (size_t)(h * 64 + wave * 16 + lr) * 32 + 8 * g;
    const bf16_t* VT = (const bf16_t*)(ws_ + OFF_PT_CV) + (size_t)tok0 * 256 + (size_t)(h * 64 + lr) * 32 + 8 * g;
    f32x4 C[4];
#pragma unroll
    for (int vb = 0; vb < 4; ++vb) C[vb] = (f32x4){0.f, 0.f, 0.f, 0.f};
    float nacc = 0.f;
#pragma unroll 4
    for (int u = 0; u < 8; ++u) {
        const int s0 = u * 32;
        const bf16x8 kf = *(const bf16x8*)(KT + (size_t)u * 256 * 32);
        const float4 a0 = *(const float4*)(aA + s0 + 8 * g), a1 = *(const float4*)(aA + s0 + 8 * g + 4);
        const float av[8] = {a0.x, a0.y, a0.z, a0.w, a1.x, a1.y, a1.z, a1.w};
        float kw[8];
#pragma unroll
        for (int j = 0; j < 8; ++j) { kw[j] = bf2f((unsigned short)kf[j]) * fexp2((av[j] - Mfin) * LOG2E); nacc += kw[j]; }
        const bf16x8 af = pack8(kw[0], kw[1], kw[2], kw[3], kw[4], kw[5], kw[6], kw[7]);
#pragma unroll
        for (int vb = 0; vb < 4; ++vb) {
            const bf16x8 vf = *(const bf16x8*)(VT + (size_t)u * 256 * 32 + vb * 16 * 32);
            C[vb] = mfma16(af, vf, C[vb]);
        }
    }
    const size_t sidx = (size_t)((b * 4 + l) * 2 + dir) * 4 + h;
    float* oc = out_ + O_NC + sidx * 4096;
#pragma unroll
    for (int vb = 0; vb < 4; ++vb)
#pragma unroll
        for (int i = 0; i < 4; ++i) oc[(wave * 16 + 4 * g + i) * 64 + vb * 16 + lr] = C[vb][i];
    nacc = grp_sum(nacc);
    if (g == 0) out_[O_NN + sidx * 64 + wave * 16 + lr] = nacc;
    if (wave == 0 && lane == 0) out_[O_NM + sidx] = Ffin + Mfin;
}

DI void mixer_phase(const Params& p, int l, unsigned char* smem) {
    const int tid_ = opaque_v(threadIdx.x); const int lane = tid_ & 63, wave = tid_ >> 6;
    unsigned* ctr = (unsigned*)(p.ws + OFF_MIXCTR) + l;
    volatile unsigned* slot = (volatile unsigned*)(smem + 66560 + 16);
    for (;;) {
        __syncthreads();
        if (tid_ == 0) *slot = __hip_atomic_fetch_add(ctr, 1u, __ATOMIC_RELAXED, __HIP_MEMORY_SCOPE_AGENT);
        __syncthreads();
        const int it = (int)*slot;
        if (it >= 1408) break;
        if (it < 256) { item_diffattn_lat(p, l, it >> 7, (it >> 5) & 3, it & 31, smem, wave, lane); }
        else if (it < 384) { const int i = it - 256; item_mlstm<true>(p, l, i >> 6, (i >> 4) & 3, i & 15, smem, wave, lane); }
        else if (it < 512) { const int i = it - 384; item_mlstm_state(p, l, i >> 3, (i >> 1) & 3, i & 1, smem, wave, lane); }
        else if (it < 640) { const int i = it - 512; item_na(p, l, i >> 6, (i >> 4) & 3, i & 15, smem, wave, lane); }
        else if (it < 896) { const int i = it - 640; item_diffattn<false>(p, l, i >> 4, (i >> 2) & 3, i & 3, smem, wave, lane); }
        else if (it < 1152) { const int i = it - 896; item_mlstm<false>(p, l, i >> 4, (i >> 2) & 3, i & 3, smem, wave, lane); }
        else { const int i = it - 1152; item_dense(p, i >> 4, (i >> 2) & 3, i & 3, smem, wave, lane); }
    }
}

#define XB_TMO      128
#define XB_XCNT(j)  (256  + 64 * (j))
#define XB_XSUB(j)  (1280 + 64 * (j))
#define XB_XGEN(j)  (2304 + 64 * (j))
#define XB_TOP      3328
#define XB_TOPGEN   3392
#define XCD_BAR_WORDS 3456
#define XB_SPIN_CAP (1u << 18)

__device__ __forceinline__ unsigned xb_ld(unsigned* p)              { return __hip_atomic_load(p, __ATOMIC_RELAXED, __HIP_MEMORY_SCOPE_AGENT); }
__device__ __forceinline__ unsigned xb_add(unsigned* p, unsigned v) { return __hip_atomic_fetch_add(p, v, __ATOMIC_RELAXED, __HIP_MEMORY_SCOPE_AGENT); }
__device__ __forceinline__ unsigned xb_xcc_id() { return (unsigned)__builtin_amdgcn_s_getreg((3 << 11) | 20) & 0xFu; }
#define XB_SPIN(cond, bar) do { unsigned _sp = 0; while (cond) { __builtin_amdgcn_s_sleep(1); \
    if ((++_sp & 255u) == 0u) { if (xb_ld(&(bar)[XB_TMO])) break; if (_sp > XB_SPIN_CAP) { atomicAdd(&(bar)[XB_TMO], 1u); break; } } } } while (0)

struct XcdBarrier {
    unsigned* bar; unsigned x;
    volatile LAS unsigned* st;
};

__device__ __forceinline__ XcdBarrier xcd_barrier_post(unsigned* bar, volatile LAS unsigned* st) {
    XcdBarrier b; b.bar = bar; b.x = xb_xcc_id(); b.st = st;
    if (threadIdx.x == 0) (void)xb_add(&bar[XB_XCNT(b.x)], 1u);
    return b;
}
__device__ __forceinline__ void xcd_barrier_complete(unsigned* bar, unsigned x, unsigned& nloc, unsigned& nx) {
    const unsigned G = gridDim.x * gridDim.y * gridDim.z;
    unsigned sum, cnt, mine, sp = 0u;
    for (;;) {
        sum = 0u; cnt = 0u; mine = 0u;
#pragma unroll
        for (unsigned j = 0; j < 16; ++j) { const unsigned c = xb_ld(&bar[XB_XCNT(j)]); sum += c; cnt += (c > 0u) ? 1u : 0u; mine = (j == x) ? c : mine; }
        if (sum == G) break;
        __builtin_amdgcn_s_sleep(1);
        if ((++sp & 255u) == 0u) { if (xb_ld(&bar[XB_TMO])) break; if (sp > XB_SPIN_CAP) { atomicAdd(&bar[XB_TMO], 1u); break; } }
    }
    nloc = mine > 0u ? mine : 1u; nx = cnt > 0u ? cnt : 1u;
}

__device__ __forceinline__ void xcd_barrier(const XcdBarrier& b) {
    asm volatile("s_waitcnt vmcnt(0)" ::: "memory");
    __syncthreads();
    if (threadIdx.x == 0) {
        unsigned* bar = b.bar;
        __builtin_amdgcn_s_waitcnt(0);
        unsigned nloc = b.st[0], nx = b.st[1];
        if (nloc == 0u) { xcd_barrier_complete(bar, b.x, nloc, nx); b.st[0] = nloc; b.st[1] = nx; }
        const unsigned old = xb_add(&bar[XB_XSUB(b.x)], 1u);
        const unsigned gen = old / nloc;
        if (old + 1u == (gen + 1u) * nloc) {
            __builtin_amdgcn_fence(__ATOMIC_RELEASE, "agent");
            asm volatile("s_waitcnt vmcnt(0)" ::: "memory");
            const unsigned og = xb_add(&bar[XB_TOP], 1u);
            const unsigned tg = og / nx;
            if (og + 1u == (tg + 1u) * nx) xb_add(&bar[XB_TOPGEN], 1u);
            else XB_SPIN(xb_ld(&bar[XB_TOPGEN]) == tg, bar);
            __builtin_amdgcn_fence(__ATOMIC_ACQUIRE, "agent");
            xb_add(&bar[XB_XGEN(b.x)], 1u);
            asm volatile("s_waitcnt vmcnt(0)" ::: "memory");
        } else {
            XB_SPIN(xb_ld(&bar[XB_XGEN(b.x)]) == gen, bar);
            __builtin_amdgcn_fence(__ATOMIC_ACQUIRE, "agent");
            asm volatile("s_waitcnt vmcnt(0)" ::: "memory");
        }
    }
    __syncthreads();
}


constexpr int N_PHASES = 2 + 5 * 4;

__global__ void __launch_bounds__(256, 2) fwd_kernel(Params p) {
    __shared__ __attribute__((aligned(16))) unsigned char smem[66560 + 32];
    if (threadIdx.x == 0) *(uint4*)(smem + 66560) = make_uint4(0u, 0u, 0u, 0u);
    __syncthreads();
    XcdBarrier xb = xcd_barrier_post((unsigned*)(p.ws + OFF_BAR), (volatile LAS unsigned*)(smem + 66560));
    for (int ph = p.ph_lo; ph < p.ph_hi; ++ph) {
        if (ph > p.ph_lo) {
            if (p.ph_hi > 1000) cg::this_grid().sync();
            xcd_barrier(xb);
        }
        const int l = ph < 2 ? 0 : (ph - 2) / 5, s = ph < 2 ? ph - 2 : (ph - 2) % 5;
        const int bit = 1 << (s + 2);
        const int reps = (DUPM & bit) ? 2 : 1;
        for (int rep = 0; rep < reps; ++rep) {
            if (rep) __syncthreads();
            if (s == -2) prep0(p, smem);
            else if (s == -1) prep1(p);
            else if (s == 0) gemm_phase<EPI_INPROJ>(p, l, OFF_H, OFF_WT_IN + (size_t)l * NINP * DM * 2, NINP / 128, 1024, 0, smem);
            else if (s == 1) mixer_phase(p, l, smem);
            else if (s == 2) gemm_phase<EPI_LN1>(p, l, OFF_MIX, OFF_WT_OUT + (size_t)l * DM * DM * 2, 8, 1024, 1024, smem);
            else if (s == 3) gemm_phase<EPI_RELU2>(p, l, OFF_H, OFF_WT_1 + (size_t)l * DFF * DM * 2, 32, 1024, 4096, smem);
            else gemm_phase<EPI_LN2>(p, l, OFF_U, OFF_WT_2 + (size_t)l * DM * DFF * 2, 8, 4096, 1024, smem);
        }
    }
}

extern "C" void kernel_launch(void* const* d_in, const int* in_sizes, int n_in, void* d_out, int out_size, void* d_ws, size_t ws_size,
                              hipStream_t stream) {
    static int grid = 0;
    if (grid == 0) {
        if (n_in != 26 || ws_size < WS_END) { fprintf(stderr, "kernel_launch: unexpected n_in %d / ws %zu (need %zu)\n", n_in, ws_size, (size_t)WS_END); grid = -1; return; }
        int dev = 0, cus = 0, per_cu = 0;
        hipGetDevice(&dev);
        hipDeviceGetAttribute(&cus, hipDeviceAttributeMultiprocessorCount, dev);
        hipOccupancyMaxActiveBlocksPerMultiprocessor(&per_cu, (const void*)fwd_kernel, 256, 0);
        if (per_cu < 1) per_cu = 1;
        if (per_cu > 2) per_cu = 2;
        grid = cus * per_cu;
        if (grid < 384) { fprintf(stderr, "kernel_launch: grid %d < 384 resident workgroups needed by the fused LayerNorm exchange\n", grid); grid = -1; return; }
    }
    if (grid < 0) return;
    Params p{};
    const float** pp = (const float**)&p;
    for (int i = 0; i < 26; ++i) pp[i] = (const float*)d_in[i];
    p.out = (float*)d_out; p.ws = (unsigned char*)d_ws;
    (void)hipMemsetAsync((unsigned char*)d_ws + OFF_BAR, 0, 16384, stream);
#if SINGLE_LAUNCH
    p.ph_lo = 0; p.ph_hi = N_PHASES;
    void* args[] = {&p};
    hipError_t e = hipLaunchCooperativeKernel((const void*)fwd_kernel, dim3(grid), dim3(256), args, 0, stream);
    if (e != hipSuccess) fprintf(stderr, "cooperative launch failed: %s (grid %d)\n", hipGetErrorString(e), grid);
#else
    for (int ph = 0; ph < N_PHASES; ++ph) {
        p.ph_lo = ph; p.ph_hi = ph + 1;
        void* args[] = {&p};
        hipError_t e = hipLaunchCooperativeKernel((const void*)fwd_kernel, dim3(grid), dim3(256), args, 0, stream);
        if (e != hipSuccess) { fprintf(stderr, "launch %d failed: %s (grid %d)\n", ph, hipGetErrorString(e), grid); break; }
    }
#endif
}
```

```cpp
#include <hip/hip_runtime.h>
#include <hip/hip_cooperative_groups.h>
#include <cstdio>
namespace cg = cooperative_groups;

#ifndef IM
#define IM 0xffff
#endif
#ifndef IM
#define IM 0xffff
#endif
#ifndef DUPM
#define DUPM 0
#endif
#ifndef PHM
#define PHM 0xffff
#endif
#ifndef SINGLE_LAUNCH
#define SINGLE_LAUNCH 1
#endif

#define LAS __attribute__((address_space(3)))
typedef unsigned short bf16_t;
typedef __attribute__((ext_vector_type(8))) short bf16x8;
typedef __attribute__((ext_vector_type(4))) short bf16x4;
typedef __attribute__((ext_vector_type(4))) float f32x4;
#define DI __device__ __forceinline__

constexpr int NTOK = 6144, NCTX = 4096, DM = 1024, NIN = 3344, NINP = 3456, DFF = 4096;
constexpr float ALPHA = 1.681792830507429f;
constexpr float LOG2E = 1.4426950408889634f;
constexpr float LN_EPS = 1e-5f;

constexpr size_t al256(size_t x) { return (x + 255) & ~(size_t)255; }
constexpr size_t OFF_WT_IN = 0;
constexpr size_t OFF_WT_OUT = OFF_WT_IN + al256((size_t)4 * NINP * DM * 2);
constexpr size_t OFF_WT_1 = OFF_WT_OUT + al256((size_t)4 * DM * DM * 2);
constexpr size_t OFF_WT_2 = OFF_WT_1 + al256((size_t)4 * DFF * DM * 2);
constexpr size_t OFF_MOD = OFF_WT_2 + al256((size_t)4 * DFF * DM * 2);
constexpr size_t OFF_X = OFF_MOD + al256((size_t)4 * 3 * 6144 * 4);
constexpr size_t OFF_H = OFF_X + al256((size_t)NTOK * DM * 4);
constexpr size_t OFF_P = OFF_H + al256((size_t)NTOK * DM * 2);
constexpr size_t OFF_PT_AV = OFF_P + al256((size_t)NTOK * NIN * 2);
constexpr size_t OFF_PT_BV = OFF_PT_AV + al256((size_t)NTOK * 512 * 2);
constexpr size_t OFF_PT_CV = OFF_PT_BV + al256((size_t)NTOK * 256 * 2);
constexpr size_t OFF_PT_CK = OFF_PT_CV + al256((size_t)NTOK * 256 * 2);
constexpr size_t OFF_G = OFF_PT_CK + al256((size_t)NTOK * 256 * 2);
constexpr size_t OFF_MIX = OFF_G + al256((size_t)NTOK * 16 * 4);
constexpr size_t OFF_Y = OFF_MIX + al256((size_t)NTOK * DM * 2);
constexpr size_t OFF_U = OFF_Y + al256((size_t)NTOK * DM * 4);
constexpr size_t OFF_CAK = OFF_U + al256((size_t)NTOK * DFF * 2);
constexpr size_t OFF_CAVT = OFF_CAK + al256((size_t)32 * 512 * 128 * 2);
constexpr size_t OFF_CBK = OFF_CAVT + al256((size_t)32 * 512 * 128 * 2);
constexpr size_t OFF_CBVT = OFF_CBK + al256((size_t)32 * 512 * 64 * 2);
constexpr size_t OFF_C0T = OFF_CBVT + al256((size_t)32 * 512 * 64 * 2);
constexpr size_t OFF_ROPE = OFF_C0T + al256((size_t)64 * 64 * 64 * 2);
constexpr size_t OFF_LAM = OFF_ROPE + al256((size_t)2 * 1024 * 4);
constexpr size_t OFF_BAR = OFF_LAM + 256;
constexpr size_t OFF_LNCNT = OFF_BAR + 13824;
constexpr size_t OFF_MIXCTR = OFF_BAR + 15360;
constexpr size_t OFF_STATS = OFF_BAR + 16384;
constexpr size_t WS_END = OFF_STATS + (size_t)NTOK * 16 * 8;

constexpr size_t O_YP = 0, O_YS = 4194304, O_AK = 6291456, O_AV = 14680064, O_BK = 23068672, O_BV = 27262976,
                 O_NC = 31457280, O_NN = 33554432, O_NM = 33587200;

struct Params {
    const float* x_prompt; const float* x_sample; const float* cache_a_k; const float* cache_a_v;
    const float* cache_b_k; const float* cache_b_v; const float* state_c; const float* state_n;
    const float* state_m; const float* c; const float* c_ctx; const float* w_in; const float* gate_bias;
    const float* diff_lambda; const float* diff_norm_g; const float* nat_rpb; const float* mlstm_norm_g;
    const float* w_out; const float* ada_w; const float* ada_b; const float* ln1_g; const float* ln1_b;
    const float* ln2_g; const float* ln2_b; const float* w_mlp1; const float* w_mlp2;
    float* out; unsigned char* ws; int ph_lo; int ph_hi;
};

#define VBID ((int)(blockIdx.x * 2 + __builtin_amdgcn_readfirstlane(threadIdx.x >> 8)))
#define VGRID ((int)(gridDim.x * 2))
#define VTID ((int)(threadIdx.x & 255))
constexpr int HALF_LDS = 73728;
constexpr int LDS_BYTES = 2 * HALF_LDS;
DI int opaque_v(int x) { asm volatile("" : "+v"(x)); return x; }
DI int opaque_s(int x) { x = __builtin_amdgcn_readfirstlane(x); asm volatile("" : "+s"(x)); return x; }
DI size_t opaque_zero() { size_t z = 0; asm volatile("" : "+s"(z)); return z; }
DI unsigned char* opaque_ws(unsigned char* w) { return w + opaque_zero(); }
DI float* opaque_out(float* w) { return w + opaque_zero(); }
DI unsigned short f2bf(float x) { unsigned u = __float_as_uint(x); u += 0x7fffu + ((u >> 16) & 1u); return (unsigned short)(u >> 16); }
DI float bf2f(unsigned short h) { return __uint_as_float(((unsigned)h) << 16); }
DI unsigned pack2(float a, float b) { return (unsigned)f2bf(a) | ((unsigned)f2bf(b) << 16); }
DI f32x4 mfma16(bf16x8 a, bf16x8 b, f32x4 c) { return __builtin_amdgcn_mfma_f32_16x16x32_bf16(a, b, c, 0, 0, 0); }
DI float fexp2(float x) { return __builtin_amdgcn_exp2f(x); }
DI bf16x8 pack8(float a0, float a1, float a2, float a3, float a4, float a5, float a6, float a7) {
    uint4 u;
    asm volatile("s_nop 1\n\tv_cvt_pk_bf16_f32 %0, %4, %5\n\tv_cvt_pk_bf16_f32 %1, %6, %7\n\tv_cvt_pk_bf16_f32 %2, %8, %9\n\tv_cvt_pk_bf16_f32 %3, %10, %11\n\ts_nop 1"
                 : "=&v"(u.x), "=&v"(u.y), "=&v"(u.z), "=&v"(u.w)
                 : "v"(a0), "v"(a1), "v"(a2), "v"(a3), "v"(a4), "v"(a5), "v"(a6), "v"(a7));
    return __builtin_bit_cast(bf16x8, u);
}
DI bf16x8 cat4(bf16x4 a, bf16x4 b) { return __builtin_shufflevector(a, b, 0, 1, 2, 3, 4, 5, 6, 7); }
DI float wave_sum(float v) {
#pragma unroll
    for (int o = 32; o > 0; o >>= 1) v += __shfl_xor(v, o);
    return v;
}
DI float grp_sum(float v) { v += __shfl_xor(v, 16); v += __shfl_xor(v, 32); return v; }
DI float grp_max(float v) { v = fmaxf(v, __shfl_xor(v, 16)); v = fmaxf(v, __shfl_xor(v, 32)); return v; }

DI void transpose_job(const float* __restrict__ src, bf16_t* __restrict__ dst, int R, int C, int Cpad, int nmat, float* tile, bool blocked = false) {
    const int tid = VTID;
    const int rt = R >> 6, ct = Cpad >> 6, per = rt * ct, total = per * nmat;
    for (int it = VBID; it < total; it += VGRID) {
        const int mat = it / per, rem = it - mat * per;
        const int r0 = (rem / ct) << 6, c0 = (rem % ct) << 6;
        const float* s = src + (size_t)mat * R * C;
        bf16_t* d = dst + (size_t)mat * Cpad * R;
#pragma unroll
        for (int i = 0; i < 4; ++i) {
            const int r = (tid >> 4) + 16 * i, c = (tid & 15) * 4;
            float4 v = make_float4(0.f, 0.f, 0.f, 0.f);
            if (c0 + c < C) v = *(const float4*)(s + (size_t)(r0 + r) * C + c0 + c);
            tile[r * 65 + c + 0] = v.x; tile[r * 65 + c + 1] = v.y; tile[r * 65 + c + 2] = v.z; tile[r * 65 + c + 3] = v.w;
        }
        __syncthreads();
        {
            const int c = tid >> 2, rs = (tid & 3) * 16;
            uint4 o0, o1;
            o0.x = pack2(tile[(rs + 0) * 65 + c], tile[(rs + 1) * 65 + c]);
            o0.y = pack2(tile[(rs + 2) * 65 + c], tile[(rs + 3) * 65 + c]);
            o0.z = pack2(tile[(rs + 4) * 65 + c], tile[(rs + 5) * 65 + c]);
            o0.w = pack2(tile[(rs + 6) * 65 + c], tile[(rs + 7) * 65 + c]);
            o1.x = pack2(tile[(rs + 8) * 65 + c], tile[(rs + 9) * 65 + c]);
            o1.y = pack2(tile[(rs + 10) * 65 + c], tile[(rs + 11) * 65 + c]);
            o1.z = pack2(tile[(rs + 12) * 65 + c], tile[(rs + 13) * 65 + c]);
            o1.w = pack2(tile[(rs + 14) * 65 + c], tile[(rs + 15) * 65 + c]);
            uint4* dp = blocked ? (uint4*)(d + ((size_t)((r0 + rs) >> 5) * Cpad + (c0 + c)) * 32 + ((r0 + rs) & 31))
                                : (uint4*)(d + (size_t)(c0 + c) * R + r0 + rs);
            dp[0] = o0; dp[1] = o1;
        }
        __syncthreads();
    }
}

DI void convert_job(const float* __restrict__ src, bf16_t* __restrict__ dst, size_t n) {
    for (size_t i = ((size_t)VBID * 256 + VTID) * 8; i < n; i += (size_t)VGRID * 256 * 8) {
        const float4 a = *(const float4*)(src + i), b = *(const float4*)(src + i + 4);
        uint4 o; o.x = pack2(a.x, a.y); o.y = pack2(a.z, a.w); o.z = pack2(b.x, b.y); o.w = pack2(b.z, b.w);
        *(uint4*)(dst + i) = o;
    }
}

DI void prep0(const Params& pin, unsigned char* smem) {
    const Params& p = pin; unsigned char* const ws_ = opaque_ws(pin.ws); float* const out_ = opaque_out(pin.out); const int tid = opaque_v(VTID);
    {
        float* sl = (float*)smem; float* red = (float*)(smem + 12288);
        for (int i = tid; i < 3072; i += 256) {
            const int cnd = i >> 10, k = i & 1023;
            const float v = (cnd == 0) ? p.c_ctx[k] : p.c[(cnd - 1) * 1024 + k];
            sl[i] = v / (1.f + __expf(-v));
        }
        __syncthreads();
        float* mod = (float*)(ws_ + OFF_MOD);
        const int kg = tid >> 4, cl = tid & 15;
        for (int it = VBID; it < 384; it += VGRID) {
            const int l = it / 96, j0 = (it % 96) * 64;
            const float* w = p.ada_w + (size_t)l * 1024 * 6144 + j0 + cl * 4;
            float4 a0 = make_float4(0, 0, 0, 0), a1 = a0, a2 = a0;
#pragma unroll 8
            for (int kk = 0; kk < 64; ++kk) {
                const int k = kg * 64 + kk;
                const float4 wv = *(const float4*)(w + (size_t)k * 6144);
                const float s0 = sl[k], s1 = sl[1024 + k], s2 = sl[2048 + k];
                a0.x += s0 * wv.x; a0.y += s0 * wv.y; a0.z += s0 * wv.z; a0.w += s0 * wv.w;
                a1.x += s1 * wv.x; a1.y += s1 * wv.y; a1.z += s1 * wv.z; a1.w += s1 * wv.w;
                a2.x += s2 * wv.x; a2.y += s2 * wv.y; a2.z += s2 * wv.z; a2.w += s2 * wv.w;
            }
            __syncthreads();
            float* r = red + kg * 192 + cl * 4;
            r[0] = a0.x; r[1] = a0.y; r[2] = a0.z; r[3] = a0.w;
            r[64] = a1.x; r[65] = a1.y; r[66] = a1.z; r[67] = a1.w;
            r[128] = a2.x; r[129] = a2.y; r[130] = a2.z; r[131] = a2.w;
            __syncthreads();
            if (tid < 192) {
                const int cnd = tid >> 6, col = tid & 63;
                float s = 0.f;
#pragma unroll
                for (int q = 0; q < 16; ++q) s += red[q * 192 + tid];
                mod[(l * 3 + cnd) * 6144 + j0 + col] = s + p.ada_b[l * 6144 + j0 + col];
            }
        }
        __syncthreads();
    }
    if (VBID == VGRID - 1) {
        float* rope = (float*)(ws_ + OFF_ROPE);
        for (int i = tid; i < 1024; i += 256) {
            const int pos = i >> 4, j = i & 15;
            const float freq = powf(10000.f, -(float)j / 16.f);
            float s, c; sincosf((float)pos * freq, &s, &c);
            rope[i] = c; rope[1024 + i] = s;
        }
        if (tid < 4) {
            const float* lp = p.diff_lambda + tid * 256;
            float s1 = 0.f, s2 = 0.f;
            for (int i = 0; i < 64; ++i) { s1 += lp[i] * lp[64 + i]; s2 += lp[128 + i] * lp[192 + i]; }
            const float li = 0.8f - 0.6f * expf(-0.3f * (float)tid);
            float* lam = (float*)(ws_ + OFF_LAM);
            lam[tid * 2] = expf(s1) - expf(s2) + li; lam[tid * 2 + 1] = li;
        }
    }
    float* tile = (float*)smem;
    transpose_job(p.w_in, (bf16_t*)(ws_ + OFF_WT_IN), 1024, NIN, NINP, 4, tile);
    transpose_job(p.w_out, (bf16_t*)(ws_ + OFF_WT_OUT), 1024, 1024, 1024, 4, tile);
    transpose_job(p.w_mlp1, (bf16_t*)(ws_ + OFF_WT_1), 1024, 4096, 4096, 4, tile);
    transpose_job(p.w_mlp2, (bf16_t*)(ws_ + OFF_WT_2), 4096, 1024, 1024, 4, tile);
    transpose_job(p.cache_a_v, (bf16_t*)(ws_ + OFF_CAVT), 512, 128, 128, 32, tile, true);
    transpose_job(p.cache_b_v, (bf16_t*)(ws_ + OFF_CBVT), 512, 64, 64, 32, tile, true);
    transpose_job(p.state_c, (bf16_t*)(ws_ + OFF_C0T), 64, 64, 64, 64, tile);
    convert_job(p.cache_a_k, (bf16_t*)(ws_ + OFF_CAK), (size_t)32 * 512 * 128);
    convert_job(p.cache_b_k, (bf16_t*)(ws_ + OFF_CBK), (size_t)32 * 512 * 64);
}

DI void prep1(const Params& pin) {
    const Params& p = pin; unsigned char* const ws_ = opaque_ws(pin.ws); float* const out_ = opaque_out(pin.out); const int tid_ = opaque_v(threadIdx.x); const int lane = tid_ & 63, wave = tid_ >> 6;
    const float* mod = (const float*)(ws_ + OFF_MOD);
    float* X = (float*)(ws_ + OFF_X);
    bf16_t* H = (bf16_t*)(ws_ + OFF_H);
    for (int row = blockIdx.x * 8 + wave; row < NTOK; row += gridDim.x * 8) {
        const float* src = row < NCTX ? p.x_prompt + (size_t)row * 1024 : p.x_sample + (size_t)(row - NCTX) * 1024;
        const int cnd = row < NCTX ? 0 : 1 + ((row - NCTX) >> 10);
        const float* md = mod + (size_t)cnd * 6144;
#pragma unroll
        for (int j = 0; j < 4; ++j) {
            const int c = lane * 4 + 256 * j;
            const float4 v = *(const float4*)(src + c);
            *(float4*)(X + (size_t)row * 1024 + c) = v;
            const float4 sh = *(const float4*)(md + c), sc = *(const float4*)(md + 1024 + c);
            uint2 o; o.x = pack2(v.x * (1.f + sc.x) + sh.x, v.y * (1.f + sc.y) + sh.y);
            o.y = pack2(v.z * (1.f + sc.z) + sh.z, v.w * (1.f + sc.w) + sh.w);
            *(uint2*)(H + (size_t)row * 1024 + c) = o;
        }
    }
}

enum { EPI_INPROJ = 0, EPI_LN1 = 1, EPI_RELU2 = 2, EPI_LN2 = 3 };

DI void epi_inproj(const Params& p, unsigned char* ws_, float* out_, int layer, const float* T, int rowbase, int colbase, int lane) {
    if (colbase >= NIN) return;
    bf16_t* P = (bf16_t*)(ws_ + OFF_P);
    const bool latent = rowbase >= NCTX;
    const int seq_tok0 = latent ? (NCTX + ((rowbase - NCTX) & ~1023)) : (rowbase & ~255);
    const int nseq = latent ? 1024 : 256;
    const int bctx = seq_tok0 >> 8;
    const int n0 = rowbase - seq_tok0;
    if (colbase >= 3328) {
        float* G = (float*)(ws_ + OFF_G);
        const float bias = p.gate_bias[layer * 16 + (lane & 15)];
        for (int rr = 0; rr < 16; ++rr) {
            const int r = rr * 4 + (lane >> 4);
            G[(size_t)(rowbase + r) * 16 + (lane & 15)] = T[r * 65 + (lane & 15)] + bias;
        }
        return;
    }
    bool toP = false, rope = false, toT = false, toO = false;
    size_t toff = 0, obase = 0; int tW = 0, tcr = 0, ohd = 64, ocr = 0;
    if (colbase < 1024) { toP = true; rope = latent; if (colbase >= 512) { toO = !latent; obase = O_AK; ohd = 128; ocr = colbase - 512; } }
    else if (colbase < 1536) { toT = true; toff = OFF_PT_AV; tW = 512; tcr = colbase - 1024; toO = !latent; obase = O_AV; ohd = 128; ocr = tcr; }
    else if (colbase < 1792) { toP = true; }
    else if (colbase < 2048) { toP = true; toO = !latent; obase = O_BK; ohd = 64; ocr = colbase - 1792; }
    else if (colbase < 2304) { toT = true; toff = OFF_PT_BV; tW = 256; tcr = colbase - 2048; toO = !latent; obase = O_BV; ohd = 64; ocr = tcr; }
    else if (colbase < 2560) { toP = true; }
    else if (colbase < 2816) { toP = true; toT = true; toff = OFF_PT_CK; tW = 256; tcr = colbase - 2560; }
    else if (colbase < 3072) { toT = true; toff = OFF_PT_CV; tW = 256; tcr = colbase - 2816; }
    else { toP = true; }
    if (toO) {
        const int h = ocr / ohd, w = ocr - h * ohd + lane;
        float* O = out_ + obase + (((size_t)(bctx * 4 + layer) * 4 + h) * 256 + n0) * ohd + w;
#pragma unroll 4
        for (int r = 0; r < 64; ++r) O[(size_t)r * ohd] = T[r * 65 + lane];
    }
    if (toP) {
        bf16_t* Pp = P + (size_t)rowbase * NIN + colbase + lane;
        if (rope) {
            const float* rc = (const float*)(ws_ + OFF_ROPE);
            const float* rs = rc + 1024;
#pragma unroll 4
            for (int r = 0; r < 64; ++r) {
                const float v = T[r * 65 + lane], vp = T[r * 65 + (lane ^ 16)];
                const int t = n0 + r;
                const int pos = (lane < 32) ? (t >> 6) : (t & 63);
                const float c = rc[pos * 16 + (lane & 15)], sn = rs[pos * 16 + (lane & 15)];
                const float o = (lane & 16) ? (vp * sn + v * c) : (v * c - vp * sn);
                Pp[(size_t)r * NIN] = f2bf(o);
            }
        } else {
#pragma unroll 4
            for (int r = 0; r < 64; ++r) Pp[(size_t)r * NIN] = f2bf(T[r * 65 + lane]);
        }
    }
    if (toT) {
        const int n = n0 + lane;
        bf16_t* Tp = (bf16_t*)(ws_ + toff) + (size_t)seq_tok0 * tW + ((size_t)(n >> 5) * tW + tcr) * 32 + (n & 31);
#pragma unroll 4
        for (int c = 0; c < 64; ++c) Tp[(size_t)c * 32] = f2bf(T[lane * 65 + c]);
    }
}

template <int WHICH>
DI void epi_ln(const Params& p, unsigned char* ws_, float* out_, int l, float* T, int tm, int tn, int wn, int rowbase, int colbase, int lane, int tid) {
    const float* mod = (const float*)(ws_ + OFF_MOD);
    float* X = (float*)(ws_ + OFF_X);
    bf16_t* H = (bf16_t*)(ws_ + OFF_H);
    const int cnd = rowbase < NCTX ? 0 : 1 + ((rowbase - NCTX) >> 10);
    const float* md = mod + (size_t)(l * 3 + cnd) * 6144;
    const int col = colbase + lane;
    const bool last = (WHICH == 2 && l == 3);
    float s1 = 0.f, s2 = 0.f;
#pragma unroll 8
    for (int c = 0; c < 64; ++c) { const float v = T[lane * 65 + c]; s1 += v; s2 += v * v; }
    unsigned long long* stats = (unsigned long long*)(ws_ + OFF_STATS);
    __hip_atomic_store(stats + (size_t)(rowbase + lane) * 16 + tn * 2 + wn,
                       ((unsigned long long)__float_as_uint(s2) << 32) | (unsigned long long)__float_as_uint(s1), __ATOMIC_RELAXED, __HIP_MEMORY_SCOPE_AGENT);
    unsigned* cnt = (unsigned*)(ws_ + OFF_LNCNT) + (l * 2 + (WHICH - 1)) * 48 + tm;
    asm volatile("s_waitcnt vmcnt(0)" ::: "memory");
    __syncthreads();
    if (tid == 0) {
        (void)__hip_atomic_fetch_add(cnt, 1u, __ATOMIC_RELAXED, __HIP_MEMORY_SCOPE_AGENT);
        unsigned sp = 0;
        while (__hip_atomic_load(cnt, __ATOMIC_RELAXED, __HIP_MEMORY_SCOPE_AGENT) < 8u) { __builtin_amdgcn_s_sleep(1); if (++sp > (1u << 22)) break; }
    }
    __syncthreads();
    float t1 = 0.f, t2 = 0.f;
    {
        unsigned long long* sp8 = stats + (size_t)(rowbase + lane) * 16;
        unsigned long long a[16];
#pragma unroll
        for (int q = 0; q < 16; ++q) a[q] = __hip_atomic_load(sp8 + q, __ATOMIC_RELAXED, __HIP_MEMORY_SCOPE_AGENT);
#pragma unroll
        for (int q = 0; q < 16; ++q) { t1 += __uint_as_float((unsigned)a[q]); t2 += __uint_as_float((unsigned)(a[q] >> 32)); }
    }
    const float mu = t1 * (1.f / 1024.f);
    const float rstd = rsqrtf(fmaxf(t2 * (1.f / 1024.f) - mu * mu, 0.f) + LN_EPS);
    const float lng = (WHICH == 1 ? p.ln1_g : p.ln2_g)[l * 1024 + col], lnb = (WHICH == 1 ? p.ln1_b : p.ln2_b)[l * 1024 + col];
    if (last) {
        float* op = out_ + (size_t)rowbase * 1024 + col;
#pragma unroll 8
        for (int r = 0; r < 64; ++r) op[(size_t)r * 1024] = (T[r * 65 + lane] - __shfl(mu, r)) * __shfl(rstd, r) * lng + lnb;
    } else {
        const float* nmd = (WHICH == 1) ? md : mod + (size_t)((l + 1) * 3 + cnd) * 6144;
        const float sh = nmd[(WHICH == 1 ? 3072 : 0) + col], sc1p = 1.f + nmd[(WHICH == 1 ? 4096 : 1024) + col];
        float* xp = X + (size_t)rowbase * 1024 + col;
        bf16_t* hp = H + (size_t)rowbase * 1024 + col;
#pragma unroll 8
        for (int r = 0; r < 64; ++r) {
            const float o = (T[r * 65 + lane] - __shfl(mu, r)) * __shfl(rstd, r) * lng + lnb;
            xp[(size_t)r * 1024] = o;
            hp[(size_t)r * 1024] = f2bf(o * sc1p + sh);
        }
    }
}

template <int EPI>
DI void gemm_phase(const Params& pin, int layer, size_t offA, size_t offB, int ntn, int K, int ldc,
                   unsigned char* smem) {
    const Params& p = pin; unsigned char* const ws_ = opaque_ws(pin.ws); float* const out_ = opaque_out(pin.out); const int tid = opaque_v(threadIdx.x), lane = tid & 63, wave = opaque_s(tid >> 6);
    const bf16_t* __restrict__ A = (const bf16_t*)(ws_ + offA); const bf16_t* __restrict__ Bt = (const bf16_t*)(ws_ + offB);
    const int wm = wave >> 1, wn = wave & 1;
    const int lr = lane & 15, g = lane >> 4;
    const int ntm = NTOK / 256;
    const int ntiles = ntm * ntn, nk = K >> 6;
    constexpr int STAGE = 49152;
    for (int tile = blockIdx.x; tile < ntiles; tile += gridDim.x) {
        const int tm = tile % ntm, tn = tile / ntm;
        const int m0 = tm * 256, n0 = tn * 128;
        f32x4 acc[4][4];
#pragma unroll
        for (int mi = 0; mi < 4; ++mi)
#pragma unroll
            for (int ni = 0; ni < 4; ++ni) acc[mi][ni] = (f32x4){0.f, 0.f, 0.f, 0.f};
        const bf16_t* Ag = A + (size_t)m0 * K;
        const bf16_t* Bg = Bt + (size_t)n0 * K;
        const bf16_t* ag = Ag + (size_t)(wave * 32 + (lane >> 3)) * K + (((lane & 7) ^ (lane >> 3)) << 3);
        const bf16_t* bg = Bg + (size_t)(wave * 16 + (lane >> 3)) * K + (((lane & 7) ^ (lane >> 3)) << 3);
#pragma unroll
        for (int st = 0; st < 2; ++st) {
            unsigned char* dst = smem + st * STAGE;
#pragma unroll
            for (int j = 0; j < 4; ++j)
                __builtin_amdgcn_global_load_lds((const unsigned*)(ag + (size_t)j * 8 * K + st * 64), (LAS unsigned*)(dst + (wave * 4 + j) * 1024), 16, 0, 0);
#pragma unroll
            for (int j = 0; j < 2; ++j)
                __builtin_amdgcn_global_load_lds((const unsigned*)(bg + (size_t)j * 8 * K + st * 64), (LAS unsigned*)(dst + 32768 + (wave * 2 + j) * 1024), 16, 0, 0);
        }
        for (int kt = 0; kt < nk; ++kt) {
            if (kt + 1 < nk) asm volatile("s_waitcnt vmcnt(6)" ::: "memory");
            else asm volatile("s_waitcnt vmcnt(0)" ::: "memory");
            asm volatile("s_waitcnt lgkmcnt(0)" ::: "memory");
            __builtin_amdgcn_s_barrier();
            if (kt + 2 < nk) {
                unsigned char* dst = smem + ((kt + 2) % 3) * STAGE;
                const int k0 = (kt + 2) << 6;
#pragma unroll
                for (int j = 0; j < 4; ++j)
                    __builtin_amdgcn_global_load_lds((const unsigned*)(ag + (size_t)j * 8 * K + k0), (LAS unsigned*)(dst + (wave * 4 + j) * 1024), 16, 0, 0);
#pragma unroll
                for (int j = 0; j < 2; ++j)
                    __builtin_amdgcn_global_load_lds((const unsigned*)(bg + (size_t)j * 8 * K + k0), (LAS unsigned*)(dst + 32768 + (wave * 2 + j) * 1024), 16, 0, 0);
            }
            const unsigned char* cur = smem + (kt % 3) * STAGE;
#pragma unroll
            for (int kk = 0; kk < 2; ++kk) {
                bf16x8 af[4], bfr[4];
#pragma unroll
                for (int mi = 0; mi < 4; ++mi) {
                    const int row = wm * 64 + mi * 16 + lr;
                    af[mi] = *(const bf16x8*)(cur + row * 128 + (((kk * 4 + g) ^ (row & 7)) << 4));
                }
#pragma unroll
                for (int ni = 0; ni < 4; ++ni) {
                    const int row = wn * 64 + ni * 16 + lr;
                    bfr[ni] = *(const bf16x8*)(cur + 32768 + row * 128 + (((kk * 4 + g) ^ (row & 7)) << 4));
                }
#pragma unroll
                for (int mi = 0; mi < 4; ++mi)
#pragma unroll
                    for (int ni = 0; ni < 4; ++ni) acc[mi][ni] = mfma16(af[mi], bfr[ni], acc[mi][ni]);
            }
        }
        asm volatile("s_waitcnt lgkmcnt(0)" ::: "memory");
        __builtin_amdgcn_s_barrier();
        if (EPI == EPI_LN1 || EPI == EPI_LN2) {
            const int rb = m0 + wm * 64, cb = n0 + wn * 64;
            const int cnd = rb < NCTX ? 0 : 1 + ((rb - NCTX) >> 10);
            const float* gp = (const float*)(ws_ + OFF_MOD) + (size_t)(layer * 3 + cnd) * 6144 + (EPI == EPI_LN1 ? 2048 : 5120) + cb + lr;
            const float* xp = (const float*)(ws_ + OFF_X) + (size_t)(rb + 4 * g) * 1024 + cb + lr;
            float gt[4];
#pragma unroll
            for (int ni = 0; ni < 4; ++ni) gt[ni] = gp[ni * 16];
#pragma unroll
            for (int mh = 0; mh < 2; ++mh) {
                f32x4 xv[2][4];
#pragma unroll
                for (int m2 = 0; m2 < 2; ++m2)
#pragma unroll
                    for (int ni = 0; ni < 4; ++ni)
#pragma unroll
                        for (int i = 0; i < 4; ++i) xv[m2][ni][i] = xp[(size_t)((mh * 2 + m2) * 16 + i) * 1024 + ni * 16];
#pragma unroll
                for (int m2 = 0; m2 < 2; ++m2)
#pragma unroll
                    for (int ni = 0; ni < 4; ++ni)
#pragma unroll
                        for (int i = 0; i < 4; ++i) acc[mh * 2 + m2][ni][i] = ALPHA * xv[m2][ni][i] + gt[ni] * acc[mh * 2 + m2][ni][i];
                __builtin_amdgcn_sched_barrier(0);
            }
        }
        float* T = (float*)smem + wave * (64 * 65);
#pragma unroll
        for (int mi = 0; mi < 4; ++mi)
#pragma unroll
            for (int ni = 0; ni < 4; ++ni)
#pragma unroll
                for (int i = 0; i < 4; ++i) T[(mi * 16 + 4 * g + i) * 65 + ni * 16 + lr] = acc[mi][ni][i];
        const int rowbase = m0 + wm * 64, colbase = n0 + wn * 64;
        if (EPI == EPI_INPROJ) {
            epi_inproj(p, ws_, out_, layer, T, rowbase, colbase, lane);
        } else if (EPI == EPI_LN1) {
            epi_ln<1>(p, ws_, out_, layer, T, tm, tn, wn, rowbase, colbase, lane, tid);
        } else if (EPI == EPI_LN2) {
            epi_ln<2>(p, ws_, out_, layer, T, tm, tn, wn, rowbase, colbase, lane, tid);
        } else {
            bf16_t* U = (bf16_t*)(ws_ + OFF_U) + (size_t)rowbase * ldc + colbase + lane;
#pragma unroll 4
            for (int r = 0; r < 64; ++r) { const float v = fmaxf(T[r * 65 + lane], 0.f); U[(size_t)r * ldc] = f2bf(v * v); }
        }
        __syncthreads();
    }
}

template <int NMAP, int DV>
struct AttnSt { f32x4 O[NMAP][DV / 16]; float m[NMAP]; float l[NMAP]; };
template <int NMAP, int DV>
struct UnitFrags { bf16x8 k[NMAP][2][2]; bf16x8 v[DV / 16]; };

template <int NMAP, int DV>
struct TileGeom {
    static constexpr int KROW = NMAP * 128, KBYTES = 64 * KROW, VUNIT = DV * 64, TBYTES = KBYTES + 2 * VUNIT;
};
DI int kswz(int row) { return (row & 3) | (((row >> 3) & 3) << 2); }

template <int NMAP, int DV>
DI void stage_tile(unsigned char* buf, const bf16_t* kg, int kstride, const bf16_t* vg, int vunit, int wave, int lane) {
    typedef TileGeom<NMAP, DV> TG;
    if (NMAP == 2) {
#pragma unroll
        for (int j = 0; j < 4; ++j) {
            const int jj = wave * 4 + j, row = jj * 4 + (lane >> 4), lc = (lane & 15) ^ kswz(row);
            __builtin_amdgcn_global_load_lds((const unsigned*)(kg + (size_t)row * kstride + lc * 8), (LAS unsigned*)(buf + jj * 1024), 16, 0, 0);
        }
    } else {
#pragma unroll
        for (int j = 0; j < 2; ++j) {
            const int jj = wave * 2 + j, row = jj * 8 + (lane >> 3), lc = (lane & 7) ^ (kswz(row) >> 1);
            __builtin_amdgcn_global_load_lds((const unsigned*)(kg + (size_t)row * kstride + lc * 8), (LAS unsigned*)(buf + jj * 1024), 16, 0, 0);
        }
    }
    constexpr int VI = TG::VUNIT / 1024, PER = 2 * VI / 4;
#pragma unroll
    for (int j = 0; j < PER; ++j) {
        const int jj = wave * PER + j, unit = jj / VI, piece = jj % VI;
        __builtin_amdgcn_global_load_lds((const unsigned*)(vg + (size_t)unit * vunit + piece * 512 + lane * 8),
                                         (LAS unsigned*)(buf + TG::KBYTES + jj * 1024), 16, 0, 0);
    }
}

template <int NMAP, int DV>
DI void lds_unit(UnitFrags<NMAP, DV>& f, const unsigned char* buf, int rowbase, int voff, int lr, int g) {
    typedef TileGeom<NMAP, DV> TG;
#pragma unroll
    for (int b = 0; b < 2; ++b) {
        const int row = rowbase + (lr >> 2) * 8 + (lr & 3) + 4 * b, sw = kswz(row);
        if (NMAP == 2) {
#pragma unroll
            for (int m = 0; m < NMAP; ++m)
#pragma unroll
                for (int kk = 0; kk < 2; ++kk) f.k[m][b][kk] = *(const bf16x8*)(buf + row * 256 + (((m * 8 + kk * 4 + g) ^ sw) << 4));
        } else {
#pragma unroll
            for (int kk = 0; kk < 2; ++kk) f.k[0][b][kk] = *(const bf16x8*)(buf + row * 128 + (((kk * 4 + g) ^ (sw >> 1)) << 4));
        }
    }
#pragma unroll
    for (int vb = 0; vb < DV / 16; ++vb) f.v[vb] = *(const bf16x8*)(buf + TG::KBYTES + voff + (vb * 16 + lr) * 64);
}

template <int DV>
DI void lds_unit_sel(UnitFrags<1, DV>& f, const unsigned char* buf, int rowbase, int voff, int lr, int g, int msel) {
    typedef TileGeom<2, DV> TG;
#pragma unroll
    for (int b = 0; b < 2; ++b) {
        const int row = rowbase + (lr >> 2) * 8 + (lr & 3) + 4 * b, sw = kswz(row);
#pragma unroll
        for (int kk = 0; kk < 2; ++kk) f.k[0][b][kk] = *(const bf16x8*)(buf + row * 256 + (((msel * 8 + kk * 4 + g) ^ sw) << 4));
    }
#pragma unroll
    for (int vb = 0; vb < DV / 16; ++vb) f.v[vb] = *(const bf16x8*)(buf + TG::KBYTES + voff + (vb * 16 + lr) * 64);
}

template <int NMAP, int DV, class SrcFn, class CompFn>
DI void tile_pipeline(unsigned char* tiles, int nt, int wave, int lane, SrcFn src, CompFn comp) {
    typedef TileGeom<NMAP, DV> TG;
    {
        const bf16_t *kg, *vg; int ks, vu;
        src(0, kg, ks, vg, vu);
        stage_tile<NMAP, DV>(tiles, kg, ks, vg, vu, wave, lane);
    }
    asm volatile("s_waitcnt vmcnt(0)" ::: "memory");
    __syncthreads();
    for (int t = 0; t < nt; ++t) {
        unsigned char* cur = tiles + (t & 1) * TG::TBYTES;
        if (t + 1 < nt) {
            const bf16_t *kg, *vg; int ks, vu;
            src(t + 1, kg, ks, vg, vu);
            stage_tile<NMAP, DV>(tiles + ((t + 1) & 1) * TG::TBYTES, kg, ks, vg, vu, wave, lane);
        }
        comp(t, cur);
        asm volatile("s_waitcnt vmcnt(0)" ::: "memory");
        __syncthreads();
    }
}

template <int NMAP, int DV, bool HASBIAS>
DI void compute_unit(AttnSt<NMAP, DV>& st, const UnitFrags<NMAP, DV>& f, const bf16x8 (&qf)[NMAP][2], float sc, const float (&bias)[8]) {
    bf16x8 pk[NMAP];
#pragma unroll
    for (int m = 0; m < NMAP; ++m) {
        f32x4 sa = (f32x4){0.f, 0.f, 0.f, 0.f}, sb = sa;
        sa = mfma16(f.k[m][0][0], qf[m][0], sa); sa = mfma16(f.k[m][0][1], qf[m][1], sa);
        sb = mfma16(f.k[m][1][0], qf[m][0], sb); sb = mfma16(f.k[m][1][1], qf[m][1], sb);
        float s[8];
#pragma unroll
        for (int j = 0; j < 4; ++j) { s[j] = sa[j] * sc; s[4 + j] = sb[j] * sc; }
        if (HASBIAS) {
#pragma unroll
            for (int j = 0; j < 8; ++j) s[j] += bias[j];
        }
        float mx = fmaxf(fmaxf(fmaxf(s[0], s[1]), fmaxf(s[2], s[3])), fmaxf(fmaxf(s[4], s[5]), fmaxf(s[6], s[7])));
        mx = grp_max(mx);
        const float mnew = fmaxf(st.m[m], mx);
        const float alpha = fexp2(st.m[m] - mnew);
        float ps = 0.f;
#pragma unroll
        for (int j = 0; j < 8; ++j) { s[j] = fexp2(s[j] - mnew); ps += s[j]; }
        st.l[m] = st.l[m] * alpha + ps; st.m[m] = mnew;
        if (__builtin_amdgcn_ballot_w64(alpha != 1.f) != 0ull) {
#pragma unroll
            for (int vb = 0; vb < DV / 16; ++vb) st.O[m][vb] *= alpha;
        }
        pk[m] = pack8(s[0], s[1], s[2], s[3], s[4], s[5], s[6], s[7]);
    }
#pragma unroll
    for (int vb = 0; vb < DV / 16; ++vb) {
#pragma unroll
        for (int m = 0; m < NMAP; ++m) st.O[m][vb] = mfma16(f.v[vb], pk[m], st.O[m][vb]);
    }
}

template <int NMAP, int DV>
DI void attn_init(AttnSt<NMAP, DV>& st) {
#pragma unroll
    for (int m = 0; m < NMAP; ++m) {
        st.m[m] = -INFINITY; st.l[m] = 0.f;
#pragma unroll
        for (int vb = 0; vb < DV / 16; ++vb) st.O[m][vb] = (f32x4){0.f, 0.f, 0.f, 0.f};
    }
}

template <bool LAT>
DI void item_diffattn(const Params& pin, int l, int seq, int h, int qt, unsigned char* smem, int wave, int lane) {
    const Params& p = pin; unsigned char* const ws_ = opaque_ws(pin.ws); float* const out_ = opaque_out(pin.out); lane = opaque_v(lane); wave = opaque_s(wave);
    const int lr = lane & 15, g = lane >> 4;
    const int nseq = LAT ? 1024 : 256;
    const int tok0 = LAT ? NCTX + seq * 1024 : seq * 256;
    const bf16_t* P = (const bf16_t*)(ws_ + OFF_P);
    const int q0 = qt * 64 + wave * 16;
    bf16x8 qf[2][2];
    {
        const bf16_t* qp = P + (size_t)(tok0 + q0 + lr) * NIN + h * 128 + 8 * g;
#pragma unroll
        for (int m = 0; m < 2; ++m)
#pragma unroll
            for (int kk = 0; kk < 2; ++kk) qf[m][kk] = *(const bf16x8*)(qp + m * 64 + kk * 32);
    }
    AttnSt<2, 128> st;
    attn_init<2, 128>(st);
    const float sc = 0.125f * LOG2E;
    const size_t hb = (size_t)((seq * 4 + l) * 4 + h);
    const bf16_t* kc = (const bf16_t*)(ws_ + OFF_CAK) + hb * 512 * 128;
    const bf16_t* vc = (const bf16_t*)(ws_ + OFF_CAVT) + hb * 128 * 512;
    const bf16_t* kn = P + (size_t)tok0 * NIN + 512 + h * 128;
    const bf16_t* vn = (const bf16_t*)(ws_ + OFF_PT_AV) + (size_t)tok0 * 512 + (size_t)(h * 128) * 32;
    const int ncache = LAT ? 8 : 0;
    __syncthreads();
    tile_pipeline<2, 128>(smem, ncache + nseq / 64, wave, lane,
        [&](int t, const bf16_t*& kg, int& ks, const bf16_t*& vg, int& vu) {
            if (t < ncache) { kg = kc + (size_t)t * 64 * 128; ks = 128; vg = vc + (size_t)(2 * t) * 128 * 32; vu = 128 * 32; }
            else { const int tt = t - ncache; kg = kn + (size_t)tt * 64 * NIN; ks = NIN; vg = vn + (size_t)(2 * tt) * 512 * 32; vu = 512 * 32; }
        },
        [&](int t, const unsigned char* buf) {
            const float nob[8] = {0.f, 0.f, 0.f, 0.f, 0.f, 0.f, 0.f, 0.f};
#pragma unroll 1
            for (int half = 0; half < 2; ++half) {
                UnitFrags<2, 128> f;
                lds_unit<2, 128>(f, buf, 32 * half, half * TileGeom<2, 128>::VUNIT + g * 16, lr, g);
                compute_unit<2, 128, false>(st, f, qf, sc, nob);
            }
        });
    const float inv0 = 1.f / grp_sum(st.l[0]), inv1 = 1.f / grp_sum(st.l[1]);
    const float* lamp = (const float*)(ws_ + OFF_LAM);
    const float lam = lamp[l * 2], lam_init = lamp[l * 2 + 1];
    const float c1 = lam * inv1;
    float ss = 0.f;
#pragma unroll
    for (int vb = 0; vb < 8; ++vb)
#pragma unroll
        for (int i = 0; i < 4; ++i) {
            const float o = st.O[0][vb][i] * inv0 - st.O[1][vb][i] * c1;
            st.O[0][vb][i] = o; ss += o * o;
        }
    ss = grp_sum(ss);
    const float r = rsqrtf(ss * (1.f / 128.f) + LN_EPS) * (1.f - lam_init);
    bf16_t* MIX = (bf16_t*)(ws_ + OFF_MIX) + (size_t)(tok0 + q0 + lr) * 1024 + h * 128;
    const float* gn = p.diff_norm_g + l * 128;
#pragma unroll
    for (int vb = 0; vb < 8; ++vb) {
        const int v = vb * 16 + 4 * g;
        const float4 g4 = *(const float4*)(gn + v);
        uint2 o; o.x = pack2(st.O[0][vb][0] * r * g4.x, st.O[0][vb][1] * r * g4.y);
        o.y = pack2(st.O[0][vb][2] * r * g4.z, st.O[0][vb][3] * r * g4.w);
        *(uint2*)(MIX + v) = o;
    }
}

DI void item_diffattn_lat(const Params& pin, int l, int seq, int h, int qt32, unsigned char* smem, int wave, int lane) {
    const Params& p = pin; unsigned char* const ws_ = opaque_ws(pin.ws); float* const out_ = opaque_out(pin.out); lane = opaque_v(lane); wave = opaque_s(wave);
    const int lr = lane & 15, g = lane >> 4;
    const int tok0 = NCTX + seq * 1024;
    const bf16_t* P = (const bf16_t*)(ws_ + OFF_P);
    const int msel = wave & 1;
    const int q0 = qt32 * 32 + (wave >> 1) * 16;
    bf16x8 qf[1][2];
    {
        const bf16_t* qp = P + (size_t)(tok0 + q0 + lr) * NIN + h * 128 + msel * 64 + 8 * g;
        qf[0][0] = *(const bf16x8*)(qp); qf[0][1] = *(const bf16x8*)(qp + 32);
    }
    AttnSt<1, 128> st;
    attn_init<1, 128>(st);
    const float sc = 0.125f * LOG2E;
    const size_t hb = (size_t)((seq * 4 + l) * 4 + h);
    const bf16_t* kc = (const bf16_t*)(ws_ + OFF_CAK) + hb * 512 * 128;
    const bf16_t* vc = (const bf16_t*)(ws_ + OFF_CAVT) + hb * 128 * 512;
    const bf16_t* kn = P + (size_t)tok0 * NIN + 512 + h * 128;
    const bf16_t* vn = (const bf16_t*)(ws_ + OFF_PT_AV) + (size_t)tok0 * 512 + (size_t)(h * 128) * 32;
    __syncthreads();
    tile_pipeline<2, 128>(smem, 24, wave, lane,
        [&](int t, const bf16_t*& kg, int& ks, const bf16_t*& vg, int& vu) {
            if (t < 8) { kg = kc + (size_t)t * 64 * 128; ks = 128; vg = vc + (size_t)(2 * t) * 128 * 32; vu = 128 * 32; }
            else { const int tt = t - 8; kg = kn + (size_t)tt * 64 * NIN; ks = NIN; vg = vn + (size_t)(2 * tt) * 512 * 32; vu = 512 * 32; }
        },
        [&](int t, const unsigned char* buf) {
            const float nob[8] = {0.f, 0.f, 0.f, 0.f, 0.f, 0.f, 0.f, 0.f};
#pragma unroll
            for (int half = 0; half < 2; ++half) {
                UnitFrags<1, 128> f;
                lds_unit_sel<128>(f, buf, 32 * half, half * TileGeom<2, 128>::VUNIT + g * 16, lr, g, msel);
                compute_unit<1, 128, false>(st, f, qf, sc, nob);
            }
        });
    const float* lamp = (const float*)(ws_ + OFF_LAM);
    const float lam = lamp[l * 2], lam_init = lamp[l * 2 + 1];
    const float inv = (msel ? lam : 1.f) / grp_sum(st.l[0]);
    float* xb = (float*)smem + (wave >> 1) * 32 * 64 + lane;
    if (msel) {
#pragma unroll
        for (int vb = 0; vb < 8; ++vb)
#pragma unroll
            for (int i = 0; i < 4; ++i) xb[(vb * 4 + i) * 64] = st.O[0][vb][i] * inv;
    }
    __syncthreads();
    if (msel) return;
    float ss = 0.f;
#pragma unroll
    for (int vb = 0; vb < 8; ++vb)
#pragma unroll
        for (int i = 0; i < 4; ++i) {
            const float o = st.O[0][vb][i] * inv - xb[(vb * 4 + i) * 64];
            st.O[0][vb][i] = o; ss += o * o;
        }
    ss = grp_sum(ss);
    const float r = rsqrtf(ss * (1.f / 128.f) + LN_EPS) * (1.f - lam_init);
    bf16_t* MIX = (bf16_t*)(ws_ + OFF_MIX) + (size_t)(tok0 + q0 + lr) * 1024 + h * 128;
    const float* gn = p.diff_norm_g + l * 128;
#pragma unroll
    for (int vb = 0; vb < 8; ++vb) {
        const int v = vb * 16 + 4 * g;
        const float4 g4 = *(const float4*)(gn + v);
        uint2 o; o.x = pack2(st.O[0][vb][0] * r * g4.x, st.O[0][vb][1] * r * g4.y);
        o.y = pack2(st.O[0][vb][2] * r * g4.z, st.O[0][vb][3] * r * g4.w);
        *(uint2*)(MIX + v) = o;
    }
}

DI void item_dense(const Params& pin, int seq, int h, int qt, unsigned char* smem, int wave, int lane) {
    const Params& p = pin; unsigned char* const ws_ = opaque_ws(pin.ws); float* const out_ = opaque_out(pin.out); lane = opaque_v(lane); wave = opaque_s(wave);
    const int lr = lane & 15, g = lane >> 4;
    const int tok0 = seq * 256;
    const bf16_t* P = (const bf16_t*)(ws_ + OFF_P);
    const int q0 = qt * 64 + wave * 16;
    bf16x8 qf[1][2];
    {
        const bf16_t* qp = P + (size_t)(tok0 + q0 + lr) * NIN + 1536 + h * 64 + 8 * g;
        qf[0][0] = *(const bf16x8*)(qp); qf[0][1] = *(const bf16x8*)(qp + 32);
    }
    AttnSt<1, 64> st;
    attn_init<1, 64>(st);
    const bf16_t* kn = P + (size_t)tok0 * NIN + 1792 + h * 64;
    const bf16_t* vn = (const bf16_t*)(ws_ + OFF_PT_BV) + (size_t)tok0 * 256 + (size_t)(h * 64) * 32;
    const float sc = 0.125f * LOG2E;
    __syncthreads();
    tile_pipeline<1, 64>(smem, 4, wave, lane,
        [&](int t, const bf16_t*& kg, int& ks, const bf16_t*& vg, int& vu) {
            kg = kn + (size_t)t * 64 * NIN; ks = NIN; vg = vn + (size_t)(2 * t) * 256 * 32; vu = 256 * 32;
        },
        [&](int t, const unsigned char* buf) {
            const float nob[8] = {0.f, 0.f, 0.f, 0.f, 0.f, 0.f, 0.f, 0.f};
#pragma unroll
            for (int half = 0; half < 2; ++half) {
                UnitFrags<1, 64> f;
                lds_unit<1, 64>(f, buf, 32 * half, half * TileGeom<1, 64>::VUNIT + g * 16, lr, g);
                compute_unit<1, 64, false>(st, f, qf, sc, nob);
            }
        });
    const float inv = 1.f / grp_sum(st.l[0]);
    bf16_t* MIX = (bf16_t*)(ws_ + OFF_MIX) + (size_t)(tok0 + q0 + lr) * 1024 + 512 + h * 64;
#pragma unroll
    for (int vb = 0; vb < 4; ++vb) {
        uint2 o; o.x = pack2(st.O[0][vb][0] * inv, st.O[0][vb][1] * inv); o.y = pack2(st.O[0][vb][2] * inv, st.O[0][vb][3] * inv);
        *(uint2*)(MIX + vb * 16 + 4 * g) = o;
    }
}

DI void item_na(const Params& pin, int l, int sb, int h, int r, unsigned char* smem, int wave, int lane) {
    const Params& p = pin; unsigned char* const ws_ = opaque_ws(pin.ws); float* const out_ = opaque_out(pin.out); lane = opaque_v(lane); wave = opaque_s(wave);
    const int lr = lane & 15, g = lane >> 4;
    const int tok0 = NCTX + sb * 1024;
    const bf16_t* P = (const bf16_t*)(ws_ + OFF_P);
    const int qc = wave * 16 + lr;
    const int q0 = r * 64 + wave * 16;
    bf16x8 qf[1][2];
    {
        const bf16_t* qp = P + (size_t)(tok0 + q0 + lr) * NIN + 1536 + h * 64 + 8 * g;
        qf[0][0] = *(const bf16x8*)(qp); qf[0][1] = *(const bf16x8*)(qp + 32);
    }
    AttnSt<1, 64> st;
    attn_init<1, 64>(st);
    const float sc = 0.125f * LOG2E;
    const size_t hb = (size_t)((sb * 4 + l) * 4 + h);
    const bf16_t* kc = (const bf16_t*)(ws_ + OFF_CBK) + hb * 512 * 64;
    const bf16_t* vc = (const bf16_t*)(ws_ + OFF_CBVT) + hb * 64 * 512;
    const bf16_t* kn = P + (size_t)tok0 * NIN + 1792 + h * 64;
    const bf16_t* vn = (const bf16_t*)(ws_ + OFF_PT_BV) + (size_t)tok0 * 256 + (size_t)(h * 64) * 32;
    const int kr0 = min(max(r - 4, 0), 8);
    const int bs = min(max(wave * 16 - 8, 0), 32);
    const int wstart = min(max(qc - 8, 0), 48);
    const float* rpb = p.nat_rpb + (size_t)(l * 4 + h) * 15 * 31;
    __syncthreads();
    tile_pipeline<1, 64>(smem, 16, wave, lane,
        [&](int t, const bf16_t*& kg, int& ks, const bf16_t*& vg, int& vu) {
            if (t < 8) { kg = kc + (size_t)t * 64 * 64; ks = 64; vg = vc + (size_t)(2 * t) * 64 * 32; vu = 64 * 32; }
            else { const int kr = kr0 + t - 8; kg = kn + (size_t)kr * 64 * NIN; ks = NIN; vg = vn + (size_t)(2 * kr) * 256 * 32; vu = 256 * 32; }
        },
        [&](int t, const unsigned char* buf) {
            if (t < 8) {
                const float nob[8] = {0.f, 0.f, 0.f, 0.f, 0.f, 0.f, 0.f, 0.f};
#pragma unroll
                for (int half = 0; half < 2; ++half) {
                    UnitFrags<1, 64> f;
                    lds_unit<1, 64>(f, buf, 32 * half, half * TileGeom<1, 64>::VUNIT + g * 16, lr, g);
                    compute_unit<1, 64, false>(st, f, qf, sc, nob);
                }
            } else {
                const int kr = kr0 + t - 8;
                const int nl = bs + 8 * g;
                UnitFrags<1, 64> f;
                lds_unit<1, 64>(f, buf, bs, (nl >> 5) * TileGeom<1, 64>::VUNIT + (nl & 31) * 2, lr, g);
                float bias[8];
                const float* rrow = rpb + (kr - r + 7) * 31;
#pragma unroll
                for (int j = 0; j < 8; ++j) {
                    const int kcol = bs + 8 * g + j;
                    const bool valid = (kcol >= wstart) && (kcol < wstart + 16);
                    const int dc = min(max(kcol - qc + 15, 0), 30);
                    bias[j] = valid ? rrow[dc] * LOG2E : -INFINITY;
                }
                compute_unit<1, 64, true>(st, f, qf, sc, bias);
            }
        });
    const float inv = 1.f / grp_sum(st.l[0]);
    bf16_t* MIX = (bf16_t*)(ws_ + OFF_MIX) + (size_t)(tok0 + q0 + lr) * 1024 + 512 + h * 64;
#pragma unroll
    for (int vb = 0; vb < 4; ++vb) {
        uint2 o; o.x = pack2(st.O[0][vb][0] * inv, st.O[0][vb][1] * inv); o.y = pack2(st.O[0][vb][2] * inv, st.O[0][vb][3] * inv);
        *(uint2*)(MIX + vb * 16 + 4 * g) = o;
    }
}

DI float wave_excl_sum(float v, int lane) {
    float x = v;
#pragma unroll
    for (int d = 1; d < 64; d <<= 1) { const float y = __shfl_up(x, d); if (lane >= d) x += y; }
    return x - v;
}
DI float wave_excl_max(float v, int lane, float init) {
    float x = v;
#pragma unroll
    for (int d = 1; d < 64; d <<= 1) { const float y = __shfl_up(x, d); if (lane >= d) x = fmaxf(x, y); }
    const float ex = __shfl_up(x, 1);
    return lane == 0 ? init : fmaxf(init, ex);
}
DI void mlstm_scan(const float* __restrict__ G, int h, int nseq, int dir, float* aA, float* MA, float* FA, float m0, int lane) {
    const int per = nseq >> 6;
    float run = 0.f;
    for (int e = 0; e < per; ++e) {
        const int idx = lane * per + e, pos = dir ? nseq - 1 - idx : idx;
        const float f = G[(size_t)pos * 16 + (dir ? 12 : 4) + h];
        const float lf = fminf(f, 0.f) - __logf(1.f + __expf(-fabsf(f)));
        run += lf; FA[pos] = run;
    }
    const float off = wave_excl_sum(run, lane);
    float rmax = -INFINITY;
    for (int e = 0; e < per; ++e) {
        const int idx = lane * per + e, pos = dir ? nseq - 1 - idx : idx;
        const float F = FA[pos] + off; FA[pos] = F;
        const float a = G[(size_t)pos * 16 + (dir ? 8 : 0) + h] - F;
        aA[pos] = a; rmax = fmaxf(rmax, a); MA[pos] = rmax;
    }
    const float pre = wave_excl_max(rmax, lane, m0);
    for (int e = 0; e < per; ++e) {
        const int idx = lane * per + e, pos = dir ? nseq - 1 - idx : idx;
        MA[pos] = fmaxf(MA[pos], pre);
    }
}

DI void mlstm_unit(f32x4 (&O)[4], float& den, int dir, int t, const bf16x8 (&qf)[2], const UnitFrags<1, 64>& f, const float* aA, float Mt, int key0, int g) {
    f32x4 sa = (f32x4){0.f, 0.f, 0.f, 0.f}, sb = sa;
    sa = mfma16(f.k[0][0][0], qf[0], sa); sa = mfma16(f.k[0][0][1], qf[1], sa);
    sb = mfma16(f.k[0][1][0], qf[0], sb); sb = mfma16(f.k[0][1][1], qf[1], sb);
    const float4 a0 = *(const float4*)(aA + key0 + 8 * g), a1 = *(const float4*)(aA + key0 + 8 * g + 4);
    const float av[8] = {a0.x, a0.y, a0.z, a0.w, a1.x, a1.y, a1.z, a1.w};
    float pv[8];
#pragma unroll
    for (int j = 0; j < 8; ++j) {
        const int key = key0 + 8 * g + j;
        const bool ok = dir ? (key >= t) : (key <= t);
        const float w = ok ? fexp2((av[j] - Mt) * LOG2E) : 0.f;
        const float sv = (j < 4) ? sa[j & 3] : sb[j & 3];
        pv[j] = sv * 0.125f * w;
        den += pv[j];
    }
    const bf16x8 pk = pack8(pv[0], pv[1], pv[2], pv[3], pv[4], pv[5], pv[6], pv[7]);
#pragma unroll
    for (int vb = 0; vb < 4; ++vb) O[vb] = mfma16(f.v[vb], pk, O[vb]);
}

template <bool LAT>
DI void item_mlstm(const Params& pin, int l, int seq, int h, int qt, unsigned char* smem, int wave, int lane) {
    const Params& p = pin; unsigned char* const ws_ = opaque_ws(pin.ws); float* const out_ = opaque_out(pin.out); lane = opaque_v(lane); wave = opaque_s(wave);
    const int lr = lane & 15, g = lane >> 4;
    const int nseq = LAT ? 1024 : 256;
    const int tok0 = LAT ? NCTX + seq * 1024 : seq * 256;
    float* aF = (float*)smem; float* MF = aF + 1024; float* FF = MF + 1024;
    float* aB = FF + 1024; float* MB = aB + 1024; float* FB = MB + 1024;
    unsigned char* tiles = smem + 24576;
    const float* G = (const float*)(ws_ + OFF_G) + (size_t)tok0 * 16;
    float m0f = 0.f, m0b = 0.f;
    const int sidx_f = ((seq * 4 + l) * 2 + 0) * 4 + h, sidx_b = ((seq * 4 + l) * 2 + 1) * 4 + h;
    if (LAT) { m0f = p.state_m[sidx_f]; m0b = p.state_m[sidx_b]; }
    __syncthreads();
    if (wave == 0) mlstm_scan(G, h, nseq, 0, aF, MF, FF, m0f, lane);
    if (wave == 1) mlstm_scan(G, h, nseq, 1, aB, MB, FB, m0b, lane);
    __syncthreads();
    const bf16_t* P = (const bf16_t*)(ws_ + OFF_P);
    const int q0 = qt * 64 + wave * 16;
    const int t = q0 + lr;
    bf16x8 qf[2];
    {
        const bf16_t* qp = P + (size_t)(tok0 + t) * NIN + 2304 + h * 64 + 8 * g;
        qf[0] = *(const bf16x8*)(qp); qf[1] = *(const bf16x8*)(qp + 32);
    }
    const bf16_t* kn = P + (size_t)tok0 * NIN + 2560 + h * 64;
    const bf16_t* vn = (const bf16_t*)(ws_ + OFF_PT_CV) + (size_t)tok0 * 256 + (size_t)(h * 64) * 32;
    const float Mf = MF[t], Mb = MB[t], Ff = FF[t], Fb = FB[t];
    f32x4 Of[4], Ob[4];
#pragma unroll
    for (int vb = 0; vb < 4; ++vb) { Of[vb] = (f32x4){0.f, 0.f, 0.f, 0.f}; Ob[vb] = Of[vb]; }
    float denf = 0.f, denb = 0.f;
    tile_pipeline<1, 64>(tiles, nseq / 64, wave, lane,
        [&](int tt, const bf16_t*& kg, int& ks, const bf16_t*& vg, int& vu) {
            kg = kn + (size_t)tt * 64 * NIN; ks = NIN; vg = vn + (size_t)(2 * tt) * 256 * 32; vu = 256 * 32;
        },
        [&](int tt, const unsigned char* buf) {
#pragma unroll
            for (int half = 0; half < 2; ++half) {
                const int key0 = tt * 64 + half * 32;
                const bool dof = key0 <= q0 + 15, dob = key0 + 31 >= q0;
                if (dof || dob) {
                    UnitFrags<1, 64> f;
                    lds_unit<1, 64>(f, buf, 32 * half, half * TileGeom<1, 64>::VUNIT + g * 16, lr, g);
                    if (dof) mlstm_unit(Of, denf, 0, t, qf, f, aF, Mf, key0, g);
                    if (dob) mlstm_unit(Ob, denb, 1, t, qf, f, aB, Mb, key0, g);
                }
            }
        });
    if (LAT) {
        const bf16_t* qp2 = P + (size_t)(tok0 + t) * NIN + 2304 + h * 64 + 4 * g;
#pragma unroll
        for (int dir = 0; dir < 2; ++dir) {
            const int sidx = dir ? sidx_b : sidx_f;
            const float e = fexp2(((dir ? m0b : m0f) - (dir ? Mb : Mf)) * LOG2E) * 0.125f;
            const bf16_t* c0t = (const bf16_t*)(ws_ + OFF_C0T) + (size_t)sidx * 4096 + lr * 64 + 4 * g;
            const float* n0 = p.state_n + (size_t)sidx * 64;
            float dacc = 0.f;
#pragma unroll
            for (int u2 = 0; u2 < 2; ++u2) {
                const bf16x4 qa = *(const bf16x4*)(qp2 + u2 * 32), qb = *(const bf16x4*)(qp2 + u2 * 32 + 16);
                const float4 na = *(const float4*)(n0 + u2 * 32 + 4 * g), nb = *(const float4*)(n0 + u2 * 32 + 16 + 4 * g);
                float pv[8];
#pragma unroll
                for (int j = 0; j < 4; ++j) { pv[j] = bf2f((unsigned short)qa[j]) * e; pv[4 + j] = bf2f((unsigned short)qb[j]) * e; }
                dacc += pv[0] * na.x + pv[1] * na.y + pv[2] * na.z + pv[3] * na.w + pv[4] * nb.x + pv[5] * nb.y + pv[6] * nb.z + pv[7] * nb.w;
                const bf16x8 pk = pack8(pv[0], pv[1], pv[2], pv[3], pv[4], pv[5], pv[6], pv[7]);
#pragma unroll
                for (int vb = 0; vb < 4; ++vb) {
                    const bf16_t* cp = c0t + (size_t)vb * 16 * 64 + u2 * 32;
                    const bf16x8 cf = cat4(*(const bf16x4*)(cp), *(const bf16x4*)(cp + 16));
                    if (dir) Ob[vb] = mfma16(cf, pk, Ob[vb]); else Of[vb] = mfma16(cf, pk, Of[vb]);
                }
            }
            if (dir) denb += dacc; else denf += dacc;
        }
    }
    denf = grp_sum(denf); denb = grp_sum(denb);
    const float rf = 1.f / fmaxf(fabsf(denf), expf(-(Ff + Mf)));
    const float rb = 1.f / fmaxf(fabsf(denb), expf(-(Fb + Mb)));
    float ss = 0.f;
#pragma unroll
    for (int vb = 0; vb < 4; ++vb)
#pragma unroll
        for (int i = 0; i < 4; ++i) { const float hs = Of[vb][i] * rf + Ob[vb][i] * rb; Of[vb][i] = hs; ss += hs * hs; }
    ss = grp_sum(ss);
    const float rn = rsqrtf(ss * (1.f / 64.f) + LN_EPS);
    const float* gn = p.mlstm_norm_g + (size_t)(l * 4 + h) * 64;
    const bf16_t* op = P + (size_t)(tok0 + t) * NIN + 3072 + h * 64;
    bf16_t* MIX = (bf16_t*)(ws_ + OFF_MIX) + (size_t)(tok0 + t) * 1024 + 768 + h * 64;
#pragma unroll
    for (int vb = 0; vb < 4; ++vb) {
        const int v = vb * 16 + 4 * g;
        const float4 g4 = *(const float4*)(gn + v);
        const bf16x4 o4 = *(const bf16x4*)(op + v);
        float sg[4];
#pragma unroll
        for (int i = 0; i < 4; ++i) sg[i] = 1.f / (1.f + __expf(-bf2f((unsigned short)o4[i])));
        uint2 o; o.x = pack2(Of[vb][0] * rn * g4.x * sg[0], Of[vb][1] * rn * g4.y * sg[1]);
        o.y = pack2(Of[vb][2] * rn * g4.z * sg[2], Of[vb][3] * rn * g4.w * sg[3]);
        *(uint2*)(MIX + v) = o;
    }
}

DI void item_mlstm_state(const Params& pin, int l, int b, int h, int dir, unsigned char* smem, int wave, int lane) {
    const Params& p = pin; unsigned char* const ws_ = opaque_ws(pin.ws); float* const out_ = opaque_out(pin.out); lane = opaque_v(lane); wave = opaque_s(wave);
    const int lr = lane & 15, g = lane >> 4;
    const int tok0 = b * 256;
    float* aA = (float*)smem; float* MA = aA + 1024; float* FA = MA + 1024;
    const float* G = (const float*)(ws_ + OFF_G) + (size_t)tok0 * 16;
    __syncthreads();
    if (wave == 0) mlstm_scan(G, h, 256, dir, aA, MA, FA, 0.f, lane);
    __syncthreads();
    const float Mfin = dir ? MA[0] : MA[255];
    const float Ffin = dir ? FA[0] : FA[255];
    const bf16_t* KT = (const bf16_t*)(ws_ + OFF_PT_CK) + (size_t)tok0 * 256 + (size_t)(h * 64 + wave * 16 + lr) * 32 + 8 * g;
    const bf16_t* VT = (const bf16_t*)(ws_ + OFF_PT_CV) + (size_t)tok0 * 256 + (size_t)(h * 64 + lr) * 32 + 8 * g;
    f32x4 C[4];
#pragma unroll
    for (int vb = 0; vb < 4; ++vb) C[vb] = (f32x4){0.f, 0.f, 0.f, 0.f};
    float nacc = 0.f;
#pragma unroll 4
    for (int u = 0; u < 8; ++u) {
        const int s0 = u * 32;
        const bf16x8 kf = *(const bf16x8*)(KT + (size_t)u * 256 * 32);
        const float4 a0 = *(const float4*)(aA + s0 + 8 * g), a1 = *(const float4*)(aA + s0 + 8 * g + 4);
        const float av[8] = {a0.x, a0.y, a0.z, a0.w, a1.x, a1.y, a1.z, a1.w};
        float kw[8];
#pragma unroll
        for (int j = 0; j < 8; ++j) { kw[j] = bf2f((unsigned short)kf[j]) * fexp2((av[j] - Mfin) * LOG2E); nacc += kw[j]; }
        const bf16x8 af = pack8(kw[0], kw[1], kw[2], kw[3], kw[4], kw[5], kw[6], kw[7]);
#pragma unroll
        for (int vb = 0; vb < 4; ++vb) {
            const bf16x8 vf = *(const bf16x8*)(VT + (size_t)u * 256 * 32 + vb * 16 * 32);
            C[vb] = mfma16(af, vf, C[vb]);
        }
    }
    const size_t sidx = (size_t)((b * 4 + l) * 2 + dir) * 4 + h;
    float* oc = out_ + O_NC + sidx * 4096;
#pragma unroll
    for (int vb = 0; vb < 4; ++vb)
#pragma unroll
        for (int i = 0; i < 4; ++i) oc[(wave * 16 + 4 * g + i) * 64 + vb * 16 + lr] = C[vb][i];
    nacc = grp_sum(nacc);
    if (g == 0) out_[O_NN + sidx * 64 + wave * 16 + lr] = nacc;
    if (wave == 0 && lane == 0) out_[O_NM + sidx] = Ffin + Mfin;
}

DI void mixer_phase(const Params& p, int l, unsigned char* smem) {
    const int tid_ = opaque_v(threadIdx.x); const int lane = tid_ & 63, wave = (tid_ >> 6) & 3;
    const int half = __builtin_amdgcn_readfirstlane(tid_ >> 8);
    unsigned char* sm = smem + half * HALF_LDS;
    unsigned* ctr = (unsigned*)(p.ws + OFF_MIXCTR) + l;
    volatile unsigned* slot = (volatile unsigned*)(smem + LDS_BYTES + 16);
    for (;;) {
        __syncthreads();
        if (tid_ == 0) *slot = __hip_atomic_fetch_add(ctr, 1u, __ATOMIC_RELAXED, __HIP_MEMORY_SCOPE_AGENT);
        __syncthreads();
        const int it = __builtin_amdgcn_readfirstlane(2 * (int)*slot + half);
        if (it >= 1408) break;
        if (it < 256) { item_diffattn_lat(p, l, it >> 7, (it >> 5) & 3, it & 31, sm, wave, lane); }
        else if (it < 384) { const int i = it - 256; item_mlstm<true>(p, l, i >> 6, (i >> 4) & 3, i & 15, sm, wave, lane); }
        else if (it < 512) { const int i = it - 384; item_mlstm_state(p, l, i >> 3, (i >> 1) & 3, i & 1, sm, wave, lane); }
        else if (it < 640) { const int i = it - 512; item_na(p, l, i >> 6, (i >> 4) & 3, i & 15, sm, wave, lane); }
        else if (it < 896) { const int i = it - 640; item_diffattn<false>(p, l, i >> 4, (i >> 2) & 3, i & 3, sm, wave, lane); }
        else if (it < 1152) { const int i = it - 896; item_mlstm<false>(p, l, i >> 4, (i >> 2) & 3, i & 3, sm, wave, lane); }
        else { const int i = it - 1152; item_dense(p, i >> 4, (i >> 2) & 3, i & 3, sm, wave, lane); }
    }
}

#define XB_TMO      128
#define XB_XCNT(j)  (256  + 64 * (j))
#define XB_XSUB(j)  (1280 + 64 * (j))
#define XB_XGEN(j)  (2304 + 64 * (j))
#define XB_TOP      3328
#define XB_TOPGEN   3392
#define XCD_BAR_WORDS 3456
#define XB_SPIN_CAP (1u << 18)

__device__ __forceinline__ unsigned xb_ld(unsigned* p)              { return __hip_atomic_load(p, __ATOMIC_RELAXED, __HIP_MEMORY_SCOPE_AGENT); }
__device__ __forceinline__ unsigned xb_add(unsigned* p, unsigned v) { return __hip_atomic_fetch_add(p, v, __ATOMIC_RELAXED, __HIP_MEMORY_SCOPE_AGENT); }
__device__ __forceinline__ unsigned xb_xcc_id() { return (unsigned)__builtin_amdgcn_s_getreg((3 << 11) | 20) & 0xFu; }
#define XB_SPIN(cond, bar) do { unsigned _sp = 0; while (cond) { __builtin_amdgcn_s_sleep(1); \
    if ((++_sp & 255u) == 0u) { if (xb_ld(&(bar)[XB_TMO])) break; if (_sp > XB_SPIN_CAP) { atomicAdd(&(bar)[XB_TMO], 1u); break; } } } } while (0)

struct XcdBarrier {
    unsigned* bar; unsigned x;
    volatile LAS unsigned* st;
};

__device__ __forceinline__ XcdBarrier xcd_barrier_post(unsigned* bar, volatile LAS unsigned* st) {
    XcdBarrier b; b.bar = bar; b.x = xb_xcc_id(); b.st = st;
    if (threadIdx.x == 0) (void)xb_add(&bar[XB_XCNT(b.x)], 1u);
    return b;
}
__device__ __forceinline__ void xcd_barrier_complete(unsigned* bar, unsigned x, unsigned& nloc, unsigned& nx) {
    const unsigned G = gridDim.x * gridDim.y * gridDim.z;
    unsigned sum, cnt, mine, sp = 0u;
    for (;;) {
        sum = 0u; cnt = 0u; mine = 0u;
#pragma unroll
        for (unsigned j = 0; j < 16; ++j) { const unsigned c = xb_ld(&bar[XB_XCNT(j)]); sum += c; cnt += (c > 0u) ? 1u : 0u; mine = (j == x) ? c : mine; }
        if (sum == G) break;
        __builtin_amdgcn_s_sleep(1);
        if ((++sp & 255u) == 0u) { if (xb_ld(&bar[XB_TMO])) break; if (sp > XB_SPIN_CAP) { atomicAdd(&bar[XB_TMO], 1u); break; } }
    }
    nloc = mine > 0u ? mine : 1u; nx = cnt > 0u ? cnt : 1u;
}

__device__ __forceinline__ void xcd_barrier(const XcdBarrier& b) {
    asm volatile("s_waitcnt vmcnt(0)" ::: "memory");
    __syncthreads();
    if (threadIdx.x == 0) {
        unsigned* bar = b.bar;
        __builtin_amdgcn_s_waitcnt(0);
        unsigned nloc = b.st[0], nx = b.st[1];
        if (nloc == 0u) { xcd_barrier_complete(bar, b.x, nloc, nx); b.st[0] = nloc; b.st[1] = nx; }
        const unsigned old = xb_add(&bar[XB_XSUB(b.x)], 1u);
        const unsigned gen = old / nloc;
        if (old + 1u == (gen + 1u) * nloc) {
            __builtin_amdgcn_fence(__ATOMIC_RELEASE, "agent");
            asm volatile("s_waitcnt vmcnt(0)" ::: "memory");
            const unsigned og = xb_add(&bar[XB_TOP], 1u);
            const unsigned tg = og / nx;
            if (og + 1u == (tg + 1u) * nx) xb_add(&bar[XB_TOPGEN], 1u);
            else XB_SPIN(xb_ld(&bar[XB_TOPGEN]) == tg, bar);
            __builtin_amdgcn_fence(__ATOMIC_ACQUIRE, "agent");
            xb_add(&bar[XB_XGEN(b.x)], 1u);
            asm volatile("s_waitcnt vmcnt(0)" ::: "memory");
        } else {
            XB_SPIN(xb_ld(&bar[XB_XGEN(b.x)]) == gen, bar);
            __builtin_amdgcn_fence(__ATOMIC_ACQUIRE, "agent");
            asm volatile("s_waitcnt vmcnt(0)" ::: "memory");
        }
    }
    __syncthreads();
}


constexpr int N_PHASES = 2 + 5 * 4;

__global__ void __launch_bounds__(512, 2) fwd_kernel(Params p) {
    __shared__ __attribute__((aligned(16))) unsigned char smem[LDS_BYTES + 32];
    if (threadIdx.x == 0) *(uint4*)(smem + LDS_BYTES) = make_uint4(0u, 0u, 0u, 0u);
    __syncthreads();
    XcdBarrier xb = xcd_barrier_post((unsigned*)(p.ws + OFF_BAR), (volatile LAS unsigned*)(smem + LDS_BYTES));
    for (int ph = p.ph_lo; ph < p.ph_hi; ++ph) {
        if (ph > p.ph_lo) {
            if (p.ph_hi > 1000) cg::this_grid().sync();
            xcd_barrier(xb);
        }
        const int l = ph < 2 ? 0 : (ph - 2) / 5, s = ph < 2 ? ph - 2 : (ph - 2) % 5;
        const int bit = 1 << (s + 2);
        const int reps = (DUPM & bit) ? 2 : 1;
        for (int rep = 0; rep < reps; ++rep) {
            if (rep) __syncthreads();
            if (s == -2) prep0(p, smem + __builtin_amdgcn_readfirstlane(threadIdx.x >> 8) * HALF_LDS);
            else if (s == -1) prep1(p);
            else if (s == 0) gemm_phase<EPI_INPROJ>(p, l, OFF_H, OFF_WT_IN + (size_t)l * NINP * DM * 2, NINP / 128, 1024, 0, smem);
            else if (s == 1) mixer_phase(p, l, smem);
            else if (s == 2) gemm_phase<EPI_LN1>(p, l, OFF_MIX, OFF_WT_OUT + (size_t)l * DM * DM * 2, 8, 1024, 1024, smem);
            else if (s == 3) gemm_phase<EPI_RELU2>(p, l, OFF_H, OFF_WT_1 + (size_t)l * DFF * DM * 2, 32, 1024, 4096, smem);
            else gemm_phase<EPI_LN2>(p, l, OFF_U, OFF_WT_2 + (size_t)l * DM * DFF * 2, 8, 4096, 1024, smem);
        }
    }
}

extern "C" void kernel_launch(void* const* d_in, const int* in_sizes, int n_in, void* d_out, int out_size, void* d_ws, size_t ws_size,
                              hipStream_t stream) {
    static int grid = 0;
    if (grid == 0) {
        if (n_in != 26 || ws_size < WS_END) { fprintf(stderr, "kernel_launch: unexpected n_in %d / ws %zu (need %zu)\n", n_in, ws_size, (size_t)WS_END); grid = -1; return; }
        int dev = 0, cus = 0, per_cu = 0;
        hipGetDevice(&dev);
        hipDeviceGetAttribute(&cus, hipDeviceAttributeMultiprocessorCount, dev);
        hipOccupancyMaxActiveBlocksPerMultiprocessor(&per_cu, (const void*)fwd_kernel, 512, 0);
        (void)per_cu;
        grid = cus;
        if (grid < 192) { fprintf(stderr, "kernel_launch: grid %d < 192 resident workgroups needed by the fused LayerNorm exchange\n", grid); grid = -1; return; }
    }
    if (grid < 0) return;
    Params p{};
    const float** pp = (const float**)&p;
    for (int i = 0; i < 26; ++i) pp[i] = (const float*)d_in[i];
    p.out = (float*)d_out; p.ws = (unsigned char*)d_ws;
    (void)hipMemsetAsync((unsigned char*)d_ws + OFF_BAR, 0, 16384, stream);
#if SINGLE_LAUNCH
    p.ph_lo = 0; p.ph_hi = N_PHASES;
    void* args[] = {&p};
    hipError_t e = hipLaunchCooperativeKernel((const void*)fwd_kernel, dim3(grid), dim3(512), args, 0, stream);
    if (e != hipSuccess) fprintf(stderr, "cooperative launch failed: %s (grid %d)\n", hipGetErrorString(e), grid);
#else
    for (int ph = 0; ph < N_PHASES; ++ph) {
        p.ph_lo = ph; p.ph_hi = ph + 1;
        void* args[] = {&p};
        hipError_t e = hipLaunchCooperativeKernel((const void*)fwd_kernel, dim3(grid), dim3(512), args, 0, stream);
        if (e != hipSuccess) { fprintf(stderr, "launch %d failed: %s (grid %d)\n", ph, hipGetErrorString(e), grid); break; }
    }
#endif
}
```

```cpp
#include <hip/hip_runtime.h>
#include <hip/hip_cooperative_groups.h>
#include <cstdio>
namespace cg = cooperative_groups;

#ifndef IM
#define IM 0xffff
#endif
#ifndef IM
#define IM 0xffff
#endif
#ifndef DUPM
#define DUPM 0
#endif
#ifndef PHM
#define PHM 0xffff
#endif
#ifndef SINGLE_LAUNCH
#define SINGLE_LAUNCH 1
#endif

#define LAS __attribute__((address_space(3)))
typedef unsigned short bf16_t;
typedef __attribute__((ext_vector_type(8))) short bf16x8;
typedef __attribute__((ext_vector_type(4))) short bf16x4;
typedef __attribute__((ext_vector_type(4))) float f32x4;
#define DI __device__ __forceinline__

constexpr int NTOK = 6144, NCTX = 4096, DM = 1024, NIN = 3344, NINP = 3456, DFF = 4096;
constexpr float ALPHA = 1.681792830507429f;
constexpr float LOG2E = 1.4426950408889634f;
constexpr float LN_EPS = 1e-5f;

constexpr size_t al256(size_t x) { return (x + 255) & ~(size_t)255; }
constexpr size_t OFF_WT_IN = 0;
constexpr size_t OFF_WT_OUT = OFF_WT_IN + al256((size_t)4 * NINP * DM * 2);
constexpr size_t OFF_WT_1 = OFF_WT_OUT + al256((size_t)4 * DM * DM * 2);
constexpr size_t OFF_WT_2 = OFF_WT_1 + al256((size_t)4 * DFF * DM * 2);
constexpr size_t OFF_MOD = OFF_WT_2 + al256((size_t)4 * DFF * DM * 2);
constexpr size_t OFF_X = OFF_MOD + al256((size_t)4 * 3 * 6144 * 4);
constexpr size_t OFF_H = OFF_X + al256((size_t)NTOK * DM * 4);
constexpr size_t OFF_P = OFF_H + al256((size_t)NTOK * DM * 2);
constexpr size_t OFF_PT_AV = OFF_P + al256((size_t)NTOK * NIN * 2);
constexpr size_t OFF_PT_BV = OFF_PT_AV + al256((size_t)NTOK * 512 * 2);
constexpr size_t OFF_PT_CV = OFF_PT_BV + al256((size_t)NTOK * 256 * 2);
constexpr size_t OFF_PT_CK = OFF_PT_CV + al256((size_t)NTOK * 256 * 2);
constexpr size_t OFF_G = OFF_PT_CK + al256((size_t)NTOK * 256 * 2);
constexpr size_t OFF_MIX = OFF_G + al256((size_t)NTOK * 16 * 4);
constexpr size_t OFF_Y = OFF_MIX + al256((size_t)NTOK * DM * 2);
constexpr size_t OFF_U = OFF_Y + al256((size_t)NTOK * DM * 4);
constexpr size_t OFF_CAK = OFF_U + al256((size_t)NTOK * DFF * 2);
constexpr size_t OFF_CAVT = OFF_CAK + al256((size_t)32 * 512 * 128 * 2);
constexpr size_t OFF_CBK = OFF_CAVT + al256((size_t)32 * 512 * 128 * 2);
constexpr size_t OFF_CBVT = OFF_CBK + al256((size_t)32 * 512 * 64 * 2);
constexpr size_t OFF_C0T = OFF_CBVT + al256((size_t)32 * 512 * 64 * 2);
constexpr size_t OFF_ROPE = OFF_C0T + al256((size_t)64 * 64 * 64 * 2);
constexpr size_t OFF_LAM = OFF_ROPE + al256((size_t)2 * 1024 * 4);
constexpr size_t OFF_BAR = OFF_LAM + 256;
constexpr size_t OFF_LNCNT = OFF_BAR + 13824;
constexpr size_t OFF_MIXCTR = OFF_BAR + 15360;
constexpr size_t OFF_STATS = OFF_BAR + 16384;
constexpr size_t WS_END = OFF_STATS + (size_t)NTOK * 16 * 8;

constexpr size_t O_YP = 0, O_YS = 4194304, O_AK = 6291456, O_AV = 14680064, O_BK = 23068672, O_BV = 27262976,
                 O_NC = 31457280, O_NN = 33554432, O_NM = 33587200;

struct Params {
    const float* x_prompt; const float* x_sample; const float* cache_a_k; const float* cache_a_v;
    const float* cache_b_k; const float* cache_b_v; const float* state_c; const float* state_n;
    const float* state_m; const float* c; const float* c_ctx; const float* w_in; const float* gate_bias;
    const float* diff_lambda; const float* diff_norm_g; const float* nat_rpb; const float* mlstm_norm_g;
    const float* w_out; const float* ada_w; const float* ada_b; const float* ln1_g; const float* ln1_b;
    const float* ln2_g; const float* ln2_b; const float* w_mlp1; const float* w_mlp2;
    float* out; unsigned char* ws; int ph_lo; int ph_hi;
};

#define VBID ((int)(blockIdx.x * 2 + __builtin_amdgcn_readfirstlane(threadIdx.x >> 8)))
#define VGRID ((int)(gridDim.x * 2))
#define VTID ((int)(threadIdx.x & 255))
constexpr int HALF_LDS = 73728;
constexpr int LDS_BYTES = 2 * HALF_LDS;
DI int opaque_v(int x) { asm volatile("" : "+v"(x)); return x; }
DI int opaque_s(int x) { x = __builtin_amdgcn_readfirstlane(x); asm volatile("" : "+s"(x)); return x; }
DI size_t opaque_zero() { size_t z = 0; asm volatile("" : "+s"(z)); return z; }
DI unsigned char* opaque_ws(unsigned char* w) { return w + opaque_zero(); }
DI float* opaque_out(float* w) { return w + opaque_zero(); }
DI unsigned short f2bf(float x) { unsigned u = __float_as_uint(x); u += 0x7fffu + ((u >> 16) & 1u); return (unsigned short)(u >> 16); }
DI float bf2f(unsigned short h) { return __uint_as_float(((unsigned)h) << 16); }
DI unsigned pack2(float a, float b) { return (unsigned)f2bf(a) | ((unsigned)f2bf(b) << 16); }
DI f32x4 mfma16(bf16x8 a, bf16x8 b, f32x4 c) { return __builtin_amdgcn_mfma_f32_16x16x32_bf16(a, b, c, 0, 0, 0); }
DI float fexp2(float x) { return __builtin_amdgcn_exp2f(x); }
DI bf16x8 pack8(float a0, float a1, float a2, float a3, float a4, float a5, float a6, float a7) {
    uint4 u;
    asm volatile("s_nop 1\n\tv_cvt_pk_bf16_f32 %0, %4, %5\n\tv_cvt_pk_bf16_f32 %1, %6, %7\n\tv_cvt_pk_bf16_f32 %2, %8, %9\n\tv_cvt_pk_bf16_f32 %3, %10, %11\n\ts_nop 1"
                 : "=&v"(u.x), "=&v"(u.y), "=&v"(u.z), "=&v"(u.w)
                 : "v"(a0), "v"(a1), "v"(a2), "v"(a3), "v"(a4), "v"(a5), "v"(a6), "v"(a7));
    return __builtin_bit_cast(bf16x8, u);
}
DI bf16x8 cat4(bf16x4 a, bf16x4 b) { return __builtin_shufflevector(a, b, 0, 1, 2, 3, 4, 5, 6, 7); }
DI float wave_sum(float v) {
#pragma unroll
    for (int o = 32; o > 0; o >>= 1) v += __shfl_xor(v, o);
    return v;
}
DI float grp_sum(float v) { v += __shfl_xor(v, 16); v += __shfl_xor(v, 32); return v; }
DI float grp_max(float v) { v = fmaxf(v, __shfl_xor(v, 16)); v = fmaxf(v, __shfl_xor(v, 32)); return v; }

DI void transpose_job(const float* __restrict__ src, bf16_t* __restrict__ dst, int R, int C, int Cpad, int nmat, float* tile, bool blocked = false) {
    const int tid = VTID;
    const int rt = R >> 6, ct = Cpad >> 6, per = rt * ct, total = per * nmat;
    for (int it = VBID; it < total; it += VGRID) {
        const int mat = it / per, rem = it - mat * per;
        const int r0 = (rem / ct) << 6, c0 = (rem % ct) << 6;
        const float* s = src + (size_t)mat * R * C;
        bf16_t* d = dst + (size_t)mat * Cpad * R;
#pragma unroll
        for (int i = 0; i < 4; ++i) {
            const int r = (tid >> 4) + 16 * i, c = (tid & 15) * 4;
            float4 v = make_float4(0.f, 0.f, 0.f, 0.f);
            if (c0 + c < C) v = *(const float4*)(s + (size_t)(r0 + r) * C + c0 + c);
            tile[r * 65 + c + 0] = v.x; tile[r * 65 + c + 1] = v.y; tile[r * 65 + c + 2] = v.z; tile[r * 65 + c + 3] = v.w;
        }
        __syncthreads();
        {
            const int c = tid >> 2, rs = (tid & 3) * 16;
            uint4 o0, o1;
            o0.x = pack2(tile[(rs + 0) * 65 + c], tile[(rs + 1) * 65 + c]);
            o0.y = pack2(tile[(rs + 2) * 65 + c], tile[(rs + 3) * 65 + c]);
            o0.z = pack2(tile[(rs + 4) * 65 + c], tile[(rs + 5) * 65 + c]);
            o0.w = pack2(tile[(rs + 6) * 65 + c], tile[(rs + 7) * 65 + c]);
            o1.x = pack2(tile[(rs + 8) * 65 + c], tile[(rs + 9) * 65 + c]);
            o1.y = pack2(tile[(rs + 10) * 65 + c], tile[(rs + 11) * 65 + c]);
            o1.z = pack2(tile[(rs + 12) * 65 + c], tile[(rs + 13) * 65 + c]);
            o1.w = pack2(tile[(rs + 14) * 65 + c], tile[(rs + 15) * 65 + c]);
            uint4* dp = blocked ? (uint4*)(d + ((size_t)((r0 + rs) >> 5) * Cpad + (c0 + c)) * 32 + ((r0 + rs) & 31))
                                : (uint4*)(d + (size_t)(c0 + c) * R + r0 + rs);
            dp[0] = o0; dp[1] = o1;
        }
        __syncthreads();
    }
}

DI void convert_job(const float* __restrict__ src, bf16_t* __restrict__ dst, size_t n) {
    for (size_t i = ((size_t)VBID * 256 + VTID) * 8; i < n; i += (size_t)VGRID * 256 * 8) {
        const float4 a = *(const float4*)(src + i), b = *(const float4*)(src + i + 4);
        uint4 o; o.x = pack2(a.x, a.y); o.y = pack2(a.z, a.w); o.z = pack2(b.x, b.y); o.w = pack2(b.z, b.w);
        *(uint4*)(dst + i) = o;
    }
}

DI void prep0(const Params& pin, unsigned char* smem) {
    const Params& p = pin; unsigned char* const ws_ = opaque_ws(pin.ws); float* const out_ = opaque_out(pin.out); const int tid = opaque_v(VTID);
    {
        float* sl = (float*)smem; float* red = (float*)(smem + 12288);
        for (int i = tid; i < 3072; i += 256) {
            const int cnd = i >> 10, k = i & 1023;
            const float v = (cnd == 0) ? p.c_ctx[k] : p.c[(cnd - 1) * 1024 + k];
            sl[i] = v / (1.f + __expf(-v));
        }
        __syncthreads();
        float* mod = (float*)(ws_ + OFF_MOD);
        const int kg = tid >> 4, cl = tid & 15;
        for (int it = VBID; it < 384; it += VGRID) {
            const int l = it / 96, j0 = (it % 96) * 64;
            const float* w = p.ada_w + (size_t)l * 1024 * 6144 + j0 + cl * 4;
            float4 a0 = make_float4(0, 0, 0, 0), a1 = a0, a2 = a0;
#pragma unroll 8
            for (int kk = 0; kk < 64; ++kk) {
                const int k = kg * 64 + kk;
                const float4 wv = *(const float4*)(w + (size_t)k * 6144);
                const float s0 = sl[k], s1 = sl[1024 + k], s2 = sl[2048 + k];
                a0.x += s0 * wv.x; a0.y += s0 * wv.y; a0.z += s0 * wv.z; a0.w += s0 * wv.w;
                a1.x += s1 * wv.x; a1.y += s1 * wv.y; a1.z += s1 * wv.z; a1.w += s1 * wv.w;
                a2.x += s2 * wv.x; a2.y += s2 * wv.y; a2.z += s2 * wv.z; a2.w += s2 * wv.w;
            }
            __syncthreads();
            float* r = red + kg * 192 + cl * 4;
            r[0] = a0.x; r[1] = a0.y; r[2] = a0.z; r[3] = a0.w;
            r[64] = a1.x; r[65] = a1.y; r[66] = a1.z; r[67] = a1.w;
            r[128] = a2.x; r[129] = a2.y; r[130] = a2.z; r[131] = a2.w;
            __syncthreads();
            if (tid < 192) {
                const int cnd = tid >> 6, col = tid & 63;
                float s = 0.f;
#pragma unroll
                for (int q = 0; q < 16; ++q) s += red[q * 192 + tid];
                mod[(l * 3 + cnd) * 6144 + j0 + col] = s + p.ada_b[l * 6144 + j0 + col];
            }
        }
        __syncthreads();
    }
    if (VBID == VGRID - 1) {
        float* rope = (float*)(ws_ + OFF_ROPE);
        for (int i = tid; i < 1024; i += 256) {
            const int pos = i >> 4, j = i & 15;
            const float freq = powf(10000.f, -(float)j / 16.f);
            float s, c; sincosf((float)pos * freq, &s, &c);
            rope[i] = c; rope[1024 + i] = s;
        }
        if (tid < 4) {
            const float* lp = p.diff_lambda + tid * 256;
            float s1 = 0.f, s2 = 0.f;
            for (int i = 0; i < 64; ++i) { s1 += lp[i] * lp[64 + i]; s2 += lp[128 + i] * lp[192 + i]; }
            const float li = 0.8f - 0.6f * expf(-0.3f * (float)tid);
            float* lam = (float*)(ws_ + OFF_LAM);
            lam[tid * 2] = expf(s1) - expf(s2) + li; lam[tid * 2 + 1] = li;
        }
    }
    float* tile = (float*)smem;
    transpose_job(p.w_in, (bf16_t*)(ws_ + OFF_WT_IN), 1024, NIN, NINP, 4, tile);
    transpose_job(p.w_out, (bf16_t*)(ws_ + OFF_WT_OUT), 1024, 1024, 1024, 4, tile);
    transpose_job(p.w_mlp1, (bf16_t*)(ws_ + OFF_WT_1), 1024, 4096, 4096, 4, tile);
    transpose_job(p.w_mlp2, (bf16_t*)(ws_ + OFF_WT_2), 4096, 1024, 1024, 4, tile);
    transpose_job(p.cache_a_v, (bf16_t*)(ws_ + OFF_CAVT), 512, 128, 128, 32, tile, true);
    transpose_job(p.cache_b_v, (bf16_t*)(ws_ + OFF_CBVT), 512, 64, 64, 32, tile, true);
    transpose_job(p.state_c, (bf16_t*)(ws_ + OFF_C0T), 64, 64, 64, 64, tile);
    convert_job(p.cache_a_k, (bf16_t*)(ws_ + OFF_CAK), (size_t)32 * 512 * 128);
    convert_job(p.cache_b_k, (bf16_t*)(ws_ + OFF_CBK), (size_t)32 * 512 * 64);
}

DI void prep1(const Params& pin) {
    const Params& p = pin; unsigned char* const ws_ = opaque_ws(pin.ws); float* const out_ = opaque_out(pin.out); const int tid_ = opaque_v(threadIdx.x); const int lane = tid_ & 63, wave = tid_ >> 6;
    const float* mod = (const float*)(ws_ + OFF_MOD);
    float* X = (float*)(ws_ + OFF_X);
    bf16_t* H = (bf16_t*)(ws_ + OFF_H);
    for (int row = blockIdx.x * 8 + wave; row < NTOK; row += gridDim.x * 8) {
        const float* src = row < NCTX ? p.x_prompt + (size_t)row * 1024 : p.x_sample + (size_t)(row - NCTX) * 1024;
        const int cnd = row < NCTX ? 0 : 1 + ((row - NCTX) >> 10);
        const float* md = mod + (size_t)cnd * 6144;
#pragma unroll
        for (int j = 0; j < 4; ++j) {
            const int c = lane * 4 + 256 * j;
            const float4 v = *(const float4*)(src + c);
            *(float4*)(X + (size_t)row * 1024 + c) = v;
            const float4 sh = *(const float4*)(md + c), sc = *(const float4*)(md + 1024 + c);
            uint2 o; o.x = pack2(v.x * (1.f + sc.x) + sh.x, v.y * (1.f + sc.y) + sh.y);
            o.y = pack2(v.z * (1.f + sc.z) + sh.z, v.w * (1.f + sc.w) + sh.w);
            *(uint2*)(H + (size_t)row * 1024 + c) = o;
        }
    }
}

enum { EPI_INPROJ = 0, EPI_LN1 = 1, EPI_RELU2 = 2, EPI_LN2 = 3 };

DI void epi_inproj(const Params& p, unsigned char* ws_, float* out_, int layer, const float* T, int rowbase, int colbase, int lane) {
    if (colbase >= NIN) return;
    bf16_t* P = (bf16_t*)(ws_ + OFF_P);
    const bool latent = rowbase >= NCTX;
    const int seq_tok0 = latent ? (NCTX + ((rowbase - NCTX) & ~1023)) : (rowbase & ~255);
    const int nseq = latent ? 1024 : 256;
    const int bctx = seq_tok0 >> 8;
    const int n0 = rowbase - seq_tok0;
    if (colbase >= 3328) {
        float* G = (float*)(ws_ + OFF_G);
        const float bias = p.gate_bias[layer * 16 + (lane & 15)];
        for (int rr = 0; rr < 16; ++rr) {
            const int r = rr * 4 + (lane >> 4);
            G[(size_t)(rowbase + r) * 16 + (lane & 15)] = T[r * 65 + (lane & 15)] + bias;
        }
        return;
    }
    bool toP = false, rope = false, toT = false, toO = false;
    size_t toff = 0, obase = 0; int tW = 0, tcr = 0, ohd = 64, ocr = 0;
    if (colbase < 1024) { toP = true; rope = latent; if (colbase >= 512) { toO = !latent; obase = O_AK; ohd = 128; ocr = colbase - 512; } }
    else if (colbase < 1536) { toT = true; toff = OFF_PT_AV; tW = 512; tcr = colbase - 1024; toO = !latent; obase = O_AV; ohd = 128; ocr = tcr; }
    else if (colbase < 1792) { toP = true; }
    else if (colbase < 2048) { toP = true; toO = !latent; obase = O_BK; ohd = 64; ocr = colbase - 1792; }
    else if (colbase < 2304) { toT = true; toff = OFF_PT_BV; tW = 256; tcr = colbase - 2048; toO = !latent; obase = O_BV; ohd = 64; ocr = tcr; }
    else if (colbase < 2560) { toP = true; }
    else if (colbase < 2816) { toP = true; toT = true; toff = OFF_PT_CK; tW = 256; tcr = colbase - 2560; }
    else if (colbase < 3072) { toT = true; toff = OFF_PT_CV; tW = 256; tcr = colbase - 2816; }
    else { toP = true; }
    if (toO) {
        const int h = ocr / ohd, w = ocr - h * ohd + lane;
        float* O = out_ + obase + (((size_t)(bctx * 4 + layer) * 4 + h) * 256 + n0) * ohd + w;
#pragma unroll 4
        for (int r = 0; r < 64; ++r) O[(size_t)r * ohd] = T[r * 65 + lane];
    }
    if (toP) {
        bf16_t* Pp = P + (size_t)rowbase * NIN + colbase + lane;
        if (rope) {
            const float* rc = (const float*)(ws_ + OFF_ROPE);
            const float* rs = rc + 1024;
#pragma unroll 4
            for (int r = 0; r < 64; ++r) {
                const float v = T[r * 65 + lane], vp = T[r * 65 + (lane ^ 16)];
                const int t = n0 + r;
                const int pos = (lane < 32) ? (t >> 6) : (t & 63);
                const float c = rc[pos * 16 + (lane & 15)], sn = rs[pos * 16 + (lane & 15)];
                const float o = (lane & 16) ? (vp * sn + v * c) : (v * c - vp * sn);
                Pp[(size_t)r * NIN] = f2bf(o);
            }
        } else {
#pragma unroll 4
            for (int r = 0; r < 64; ++r) Pp[(size_t)r * NIN] = f2bf(T[r * 65 + lane]);
        }
    }
    if (toT) {
        const int n = n0 + lane;
        bf16_t* Tp = (bf16_t*)(ws_ + toff) + (size_t)seq_tok0 * tW + ((size_t)(n >> 5) * tW + tcr) * 32 + (n & 31);
#pragma unroll 4
        for (int c = 0; c < 64; ++c) Tp[(size_t)c * 32] = f2bf(T[lane * 65 + c]);
    }
}

template <int WHICH>
DI void epi_ln(const Params& p, unsigned char* ws_, float* out_, int l, float* T, int tm, int tn, int wn, int rowbase, int colbase, int lane, int tid) {
    const float* mod = (const float*)(ws_ + OFF_MOD);
    float* X = (float*)(ws_ + OFF_X);
    bf16_t* H = (bf16_t*)(ws_ + OFF_H);
    const int cnd = rowbase < NCTX ? 0 : 1 + ((rowbase - NCTX) >> 10);
    const float* md = mod + (size_t)(l * 3 + cnd) * 6144;
    const int col = colbase + lane;
    const bool last = (WHICH == 2 && l == 3);
    float s1 = 0.f, s2 = 0.f;
#pragma unroll 8
    for (int c = 0; c < 64; ++c) { const float v = T[lane * 65 + c]; s1 += v; s2 += v * v; }
    unsigned long long* stats = (unsigned long long*)(ws_ + OFF_STATS);
    __hip_atomic_store(stats + (size_t)(rowbase + lane) * 16 + tn * 2 + wn,
                       ((unsigned long long)__float_as_uint(s2) << 32) | (unsigned long long)__float_as_uint(s1), __ATOMIC_RELAXED, __HIP_MEMORY_SCOPE_AGENT);
    unsigned* cnt = (unsigned*)(ws_ + OFF_LNCNT) + (l * 2 + (WHICH - 1)) * 48 + tm;
    asm volatile("s_waitcnt vmcnt(0)" ::: "memory");
    __syncthreads();
    if (tid == 0) {
        (void)__hip_atomic_fetch_add(cnt, 1u, __ATOMIC_RELAXED, __HIP_MEMORY_SCOPE_AGENT);
        unsigned sp = 0;
        while (__hip_atomic_load(cnt, __ATOMIC_RELAXED, __HIP_MEMORY_SCOPE_AGENT) < 8u) { __builtin_amdgcn_s_sleep(1); if (++sp > (1u << 22)) break; }
    }
    __syncthreads();
    float t1 = 0.f, t2 = 0.f;
    {
        unsigned long long* sp8 = stats + (size_t)(rowbase + lane) * 16;
        unsigned long long a[16];
#pragma unroll
        for (int q = 0; q < 16; ++q) a[q] = __hip_atomic_load(sp8 + q, __ATOMIC_RELAXED, __HIP_MEMORY_SCOPE_AGENT);
#pragma unroll
        for (int q = 0; q < 16; ++q) { t1 += __uint_as_float((unsigned)a[q]); t2 += __uint_as_float((unsigned)(a[q] >> 32)); }
    }
    const float mu = t1 * (1.f / 1024.f);
    const float rstd = rsqrtf(fmaxf(t2 * (1.f / 1024.f) - mu * mu, 0.f) + LN_EPS);
    const float lng = (WHICH == 1 ? p.ln1_g : p.ln2_g)[l * 1024 + col], lnb = (WHICH == 1 ? p.ln1_b : p.ln2_b)[l * 1024 + col];
    if (last) {
        float* op = out_ + (size_t)rowbase * 1024 + col;
#pragma unroll 8
        for (int r = 0; r < 64; ++r) op[(size_t)r * 1024] = (T[r * 65 + lane] - __shfl(mu, r)) * __shfl(rstd, r) * lng + lnb;
    } else {
        const float* nmd = (WHICH == 1) ? md : mod + (size_t)((l + 1) * 3 + cnd) * 6144;
        const float sh = nmd[(WHICH == 1 ? 3072 : 0) + col], sc1p = 1.f + nmd[(WHICH == 1 ? 4096 : 1024) + col];
        float* xp = X + (size_t)rowbase * 1024 + col;
        bf16_t* hp = H + (size_t)rowbase * 1024 + col;
#pragma unroll 8
        for (int r = 0; r < 64; ++r) {
            const float o = (T[r * 65 + lane] - __shfl(mu, r)) * __shfl(rstd, r) * lng + lnb;
            xp[(size_t)r * 1024] = o;
            hp[(size_t)r * 1024] = f2bf(o * sc1p + sh);
        }
    }
}

template <int EPI>
DI void gemm_phase(const Params& pin, int layer, size_t offA, size_t offB, int ntn, int K, int ldc,
                   unsigned char* smem) {
    const Params& p = pin; unsigned char* const ws_ = opaque_ws(pin.ws); float* const out_ = opaque_out(pin.out); const int tid = opaque_v(threadIdx.x), lane = tid & 63, wave = opaque_s(tid >> 6);
    const bf16_t* __restrict__ A = (const bf16_t*)(ws_ + offA); const bf16_t* __restrict__ Bt = (const bf16_t*)(ws_ + offB);
    const int wm = wave >> 1, wn = wave & 1;
    const int lr = lane & 15, g = lane >> 4;
    const int ntm = NTOK / 256;
    const int ntiles = ntm * ntn, nk = K >> 6;
    constexpr int STAGE = 49152;
    for (int tile = blockIdx.x; tile < ntiles; tile += gridDim.x) {
        const int tm = tile % ntm, tn = tile / ntm;
        const int m0 = tm * 256, n0 = tn * 128;
        f32x4 acc[4][4];
#pragma unroll
        for (int mi = 0; mi < 4; ++mi)
#pragma unroll
            for (int ni = 0; ni < 4; ++ni) acc[mi][ni] = (f32x4){0.f, 0.f, 0.f, 0.f};
        const bf16_t* Ag = A + (size_t)m0 * K;
        const bf16_t* Bg = Bt + (size_t)n0 * K;
        const bf16_t* ag = Ag + (size_t)(wave * 32 + (lane >> 3)) * K + (((lane & 7) ^ (lane >> 3)) << 3);
        const bf16_t* bg = Bg + (size_t)(wave * 16 + (lane >> 3)) * K + (((lane & 7) ^ (lane >> 3)) << 3);
        auto stage = [&](int t) {
            unsigned char* dst = smem + (t % 3) * STAGE;
            const int k0 = t << 6;
#pragma unroll
            for (int j = 0; j < 4; ++j)
                __builtin_amdgcn_global_load_lds((const unsigned*)(ag + (size_t)j * 8 * K + k0), (LAS unsigned*)(dst + (wave * 4 + j) * 1024), 16, 0, 0);
#pragma unroll
            for (int j = 0; j < 2; ++j)
                __builtin_amdgcn_global_load_lds((const unsigned*)(bg + (size_t)j * 8 * K + k0), (LAS unsigned*)(dst + 32768 + (wave * 2 + j) * 1024), 16, 0, 0);
        };
        auto read_half = [&](int t, int kk, bf16x8 (&af)[4], bf16x8 (&bfr)[4]) {
            const unsigned char* cur = smem + (t % 3) * STAGE;
#pragma unroll
            for (int mi = 0; mi < 4; ++mi) {
                const int row = wm * 64 + mi * 16 + lr;
                af[mi] = *(const bf16x8*)(cur + row * 128 + (((kk * 4 + g) ^ (row & 7)) << 4));
            }
#pragma unroll
            for (int ni = 0; ni < 4; ++ni) {
                const int row = wn * 64 + ni * 16 + lr;
                bfr[ni] = *(const bf16x8*)(cur + 32768 + row * 128 + (((kk * 4 + g) ^ (row & 7)) << 4));
            }
        };
        stage(0); stage(1); stage(2);
        bf16x8 a0[4], b0[4], a1[4], b1[4];
        asm volatile("s_waitcnt vmcnt(12)" ::: "memory");
        asm volatile("s_waitcnt lgkmcnt(0)" ::: "memory");
        __builtin_amdgcn_s_barrier();
        read_half(0, 0, a0, b0);
        for (int kt = 0; kt < nk; ++kt) {
            read_half(kt, 1, a1, b1);
#pragma unroll
            for (int mi = 0; mi < 4; ++mi)
#pragma unroll
                for (int ni = 0; ni < 4; ++ni) acc[mi][ni] = mfma16(a0[mi], b0[ni], acc[mi][ni]);
            __builtin_amdgcn_sched_barrier(0);
            if (kt + 2 < nk) asm volatile("s_waitcnt vmcnt(6)" ::: "memory");
            else asm volatile("s_waitcnt vmcnt(0)" ::: "memory");
            asm volatile("s_waitcnt lgkmcnt(0)" ::: "memory");
            __builtin_amdgcn_s_barrier();
            if (kt + 3 < nk) stage(kt + 3);
            if (kt + 1 < nk) read_half(kt + 1, 0, a0, b0);
#pragma unroll
            for (int mi = 0; mi < 4; ++mi)
#pragma unroll
                for (int ni = 0; ni < 4; ++ni) acc[mi][ni] = mfma16(a1[mi], b1[ni], acc[mi][ni]);
            __builtin_amdgcn_sched_barrier(0);
        }
        asm volatile("s_waitcnt lgkmcnt(0)" ::: "memory");
        __builtin_amdgcn_s_barrier();
        if (EPI == EPI_LN1 || EPI == EPI_LN2) {
            const int rb = m0 + wm * 64, cb = n0 + wn * 64;
            const int cnd = rb < NCTX ? 0 : 1 + ((rb - NCTX) >> 10);
            const float* gp = (const float*)(ws_ + OFF_MOD) + (size_t)(layer * 3 + cnd) * 6144 + (EPI == EPI_LN1 ? 2048 : 5120) + cb + lr;
            const float* xp = (const float*)(ws_ + OFF_X) + (size_t)(rb + 4 * g) * 1024 + cb + lr;
            float gt[4];
#pragma unroll
            for (int ni = 0; ni < 4; ++ni) gt[ni] = gp[ni * 16];
#pragma unroll
            for (int mh = 0; mh < 2; ++mh) {
                f32x4 xv[2][4];
#pragma unroll
                for (int m2 = 0; m2 < 2; ++m2)
#pragma unroll
                    for (int ni = 0; ni < 4; ++ni)
#pragma unroll
                        for (int i = 0; i < 4; ++i) xv[m2][ni][i] = xp[(size_t)((mh * 2 + m2) * 16 + i) * 1024 + ni * 16];
#pragma unroll
                for (int m2 = 0; m2 < 2; ++m2)
#pragma unroll
                    for (int ni = 0; ni < 4; ++ni)
#pragma unroll
                        for (int i = 0; i < 4; ++i) acc[mh * 2 + m2][ni][i] = ALPHA * xv[m2][ni][i] + gt[ni] * acc[mh * 2 + m2][ni][i];
                __builtin_amdgcn_sched_barrier(0);
            }
        }
        float* T = (float*)smem + wave * (64 * 65);
#pragma unroll
        for (int mi = 0; mi < 4; ++mi)
#pragma unroll
            for (int ni = 0; ni < 4; ++ni)
#pragma unroll
                for (int i = 0; i < 4; ++i) T[(mi * 16 + 4 * g + i) * 65 + ni * 16 + lr] = acc[mi][ni][i];
        const int rowbase = m0 + wm * 64, colbase = n0 + wn * 64;
        if (EPI == EPI_INPROJ) {
            epi_inproj(p, ws_, out_, layer, T, rowbase, colbase, lane);
        } else if (EPI == EPI_LN1) {
            epi_ln<1>(p, ws_, out_, layer, T, tm, tn, wn, rowbase, colbase, lane, tid);
        } else if (EPI == EPI_LN2) {
            epi_ln<2>(p, ws_, out_, layer, T, tm, tn, wn, rowbase, colbase, lane, tid);
        } else {
            bf16_t* U = (bf16_t*)(ws_ + OFF_U) + (size_t)rowbase * ldc + colbase + lane;
#pragma unroll 4
            for (int r = 0; r < 64; ++r) { const float v = fmaxf(T[r * 65 + lane], 0.f); U[(size_t)r * ldc] = f2bf(v * v); }
        }
        __syncthreads();
    }
}

template <int NMAP, int DV>
struct AttnSt { f32x4 O[NMAP][DV / 16]; float m[NMAP]; float l[NMAP]; };
template <int NMAP, int DV>
struct UnitFrags { bf16x8 k[NMAP][2][2]; bf16x8 v[DV / 16]; };

template <int NMAP, int DV>
struct TileGeom {
    static constexpr int KROW = NMAP * 128, KBYTES = 64 * KROW, VUNIT = DV * 64, TBYTES = KBYTES + 2 * VUNIT;
};
DI int kswz(int row) { return (row & 3) | (((row >> 3) & 3) << 2); }

template <int NMAP, int DV>
DI void stage_tile(unsigned char* buf, const bf16_t* kg, int kstride, const bf16_t* vg, int vunit, int wave, int lane) {
    typedef TileGeom<NMAP, DV> TG;
    if (NMAP == 2) {
#pragma unroll
        for (int j = 0; j < 4; ++j) {
            const int jj = wave * 4 + j, row = jj * 4 + (lane >> 4), lc = (lane & 15) ^ kswz(row);
            __builtin_amdgcn_global_load_lds((const unsigned*)(kg + (size_t)row * kstride + lc * 8), (LAS unsigned*)(buf + jj * 1024), 16, 0, 0);
        }
    } else {
#pragma unroll
        for (int j = 0; j < 2; ++j) {
            const int jj = wave * 2 + j, row = jj * 8 + (lane >> 3), lc = (lane & 7) ^ (kswz(row) >> 1);
            __builtin_amdgcn_global_load_lds((const unsigned*)(kg + (size_t)row * kstride + lc * 8), (LAS unsigned*)(buf + jj * 1024), 16, 0, 0);
        }
    }
    constexpr int VI = TG::VUNIT / 1024, PER = 2 * VI / 4;
#pragma unroll
    for (int j = 0; j < PER; ++j) {
        const int jj = wave * PER + j, unit = jj / VI, piece = jj % VI;
        __builtin_amdgcn_global_load_lds((const unsigned*)(vg + (size_t)unit * vunit + piece * 512 + lane * 8),
                                         (LAS unsigned*)(buf + TG::KBYTES + jj * 1024), 16, 0, 0);
    }
}

template <int NMAP, int DV>
DI void lds_unit(UnitFrags<NMAP, DV>& f, const unsigned char* buf, int rowbase, int voff, int lr, int g) {
    typedef TileGeom<NMAP, DV> TG;
#pragma unroll
    for (int b = 0; b < 2; ++b) {
        const int row = rowbase + (lr >> 2) * 8 + (lr & 3) + 4 * b, sw = kswz(row);
        if (NMAP == 2) {
#pragma unroll
            for (int m = 0; m < NMAP; ++m)
#pragma unroll
                for (int kk = 0; kk < 2; ++kk) f.k[m][b][kk] = *(const bf16x8*)(buf + row * 256 + (((m * 8 + kk * 4 + g) ^ sw) << 4));
        } else {
#pragma unroll
            for (int kk = 0; kk < 2; ++kk) f.k[0][b][kk] = *(const bf16x8*)(buf + row * 128 + (((kk * 4 + g) ^ (sw >> 1)) << 4));
        }
    }
#pragma unroll
    for (int vb = 0; vb < DV / 16; ++vb) f.v[vb] = *(const bf16x8*)(buf + TG::KBYTES + voff + (vb * 16 + lr) * 64);
}

template <int DV>
DI void lds_unit_sel(UnitFrags<1, DV>& f, const unsigned char* buf, int rowbase, int voff, int lr, int g, int msel) {
    typedef TileGeom<2, DV> TG;
#pragma unroll
    for (int b = 0; b < 2; ++b) {
        const int row = rowbase + (lr >> 2) * 8 + (lr & 3) + 4 * b, sw = kswz(row);
#pragma unroll
        for (int kk = 0; kk < 2; ++kk) f.k[0][b][kk] = *(const bf16x8*)(buf + row * 256 + (((msel * 8 + kk * 4 + g) ^ sw) << 4));
    }
#pragma unroll
    for (int vb = 0; vb < DV / 16; ++vb) f.v[vb] = *(const bf16x8*)(buf + TG::KBYTES + voff + (vb * 16 + lr) * 64);
}

template <int NMAP, int DV, class SrcFn, class CompFn>
DI void tile_pipeline(unsigned char* tiles, int nt, int wave, int lane, SrcFn src, CompFn comp) {
    typedef TileGeom<NMAP, DV> TG;
    {
        const bf16_t *kg, *vg; int ks, vu;
        src(0, kg, ks, vg, vu);
        stage_tile<NMAP, DV>(tiles, kg, ks, vg, vu, wave, lane);
    }
    asm volatile("s_waitcnt vmcnt(0)" ::: "memory");
    __syncthreads();
    for (int t = 0; t < nt; ++t) {
        unsigned char* cur = tiles + (t & 1) * TG::TBYTES;
        if (t + 1 < nt) {
            const bf16_t *kg, *vg; int ks, vu;
            src(t + 1, kg, ks, vg, vu);
            stage_tile<NMAP, DV>(tiles + ((t + 1) & 1) * TG::TBYTES, kg, ks, vg, vu, wave, lane);
        }
        comp(t, cur);
        asm volatile("s_waitcnt vmcnt(0)" ::: "memory");
        __syncthreads();
    }
}

template <int NMAP, int DV, bool HASBIAS>
DI void compute_unit(AttnSt<NMAP, DV>& st, const UnitFrags<NMAP, DV>& f, const bf16x8 (&qf)[NMAP][2], float sc, const float (&bias)[8]) {
    bf16x8 pk[NMAP];
#pragma unroll
    for (int m = 0; m < NMAP; ++m) {
        f32x4 sa = (f32x4){0.f, 0.f, 0.f, 0.f}, sb = sa;
        sa = mfma16(f.k[m][0][0], qf[m][0], sa); sa = mfma16(f.k[m][0][1], qf[m][1], sa);
        sb = mfma16(f.k[m][1][0], qf[m][0], sb); sb = mfma16(f.k[m][1][1], qf[m][1], sb);
        float s[8];
#pragma unroll
        for (int j = 0; j < 4; ++j) { s[j] = sa[j] * sc; s[4 + j] = sb[j] * sc; }
        if (HASBIAS) {
#pragma unroll
            for (int j = 0; j < 8; ++j) s[j] += bias[j];
        }
        float mx = fmaxf(fmaxf(fmaxf(s[0], s[1]), fmaxf(s[2], s[3])), fmaxf(fmaxf(s[4], s[5]), fmaxf(s[6], s[7])));
        mx = grp_max(mx);
        const float mnew = fmaxf(st.m[m], mx);
        const float alpha = fexp2(st.m[m] - mnew);
        float ps = 0.f;
#pragma unroll
        for (int j = 0; j < 8; ++j) { s[j] = fexp2(s[j] - mnew); ps += s[j]; }
        st.l[m] = st.l[m] * alpha + ps; st.m[m] = mnew;
        if (__builtin_amdgcn_ballot_w64(alpha != 1.f) != 0ull) {
#pragma unroll
            for (int vb = 0; vb < DV / 16; ++vb) st.O[m][vb] *= alpha;
        }
        pk[m] = pack8(s[0], s[1], s[2], s[3], s[4], s[5], s[6], s[7]);
    }
#pragma unroll
    for (int vb = 0; vb < DV / 16; ++vb) {
#pragma unroll
        for (int m = 0; m < NMAP; ++m) st.O[m][vb] = mfma16(f.v[vb], pk[m], st.O[m][vb]);
    }
}

template <int NMAP, int DV>
DI void attn_init(AttnSt<NMAP, DV>& st) {
#pragma unroll
    for (int m = 0; m < NMAP; ++m) {
        st.m[m] = -INFINITY; st.l[m] = 0.f;
#pragma unroll
        for (int vb = 0; vb < DV / 16; ++vb) st.O[m][vb] = (f32x4){0.f, 0.f, 0.f, 0.f};
    }
}

template <bool LAT>
DI void item_diffattn(const Params& pin, int l, int seq, int h, int qt, unsigned char* smem, int wave, int lane) {
    const Params& p = pin; unsigned char* const ws_ = opaque_ws(pin.ws); float* const out_ = opaque_out(pin.out); lane = opaque_v(lane); wave = opaque_s(wave);
    const int lr = lane & 15, g = lane >> 4;
    const int nseq = LAT ? 1024 : 256;
    const int tok0 = LAT ? NCTX + seq * 1024 : seq * 256;
    const bf16_t* P = (const bf16_t*)(ws_ + OFF_P);
    const int q0 = qt * 64 + wave * 16;
    bf16x8 qf[2][2];
    {
        const bf16_t* qp = P + (size_t)(tok0 + q0 + lr) * NIN + h * 128 + 8 * g;
#pragma unroll
        for (int m = 0; m < 2; ++m)
#pragma unroll
            for (int kk = 0; kk < 2; ++kk) qf[m][kk] = *(const bf16x8*)(qp + m * 64 + kk * 32);
    }
    AttnSt<2, 128> st;
    attn_init<2, 128>(st);
    const float sc = 0.125f * LOG2E;
    const size_t hb = (size_t)((seq * 4 + l) * 4 + h);
    const bf16_t* kc = (const bf16_t*)(ws_ + OFF_CAK) + hb * 512 * 128;
    const bf16_t* vc = (const bf16_t*)(ws_ + OFF_CAVT) + hb * 128 * 512;
    const bf16_t* kn = P + (size_t)tok0 * NIN + 512 + h * 128;
    const bf16_t* vn = (const bf16_t*)(ws_ + OFF_PT_AV) + (size_t)tok0 * 512 + (size_t)(h * 128) * 32;
    const int ncache = LAT ? 8 : 0;
    __syncthreads();
    tile_pipeline<2, 128>(smem, ncache + nseq / 64, wave, lane,
        [&](int t, const bf16_t*& kg, int& ks, const bf16_t*& vg, int& vu) {
            if (t < ncache) { kg = kc + (size_t)t * 64 * 128; ks = 128; vg = vc + (size_t)(2 * t) * 128 * 32; vu = 128 * 32; }
            else { const int tt = t - ncache; kg = kn + (size_t)tt * 64 * NIN; ks = NIN; vg = vn + (size_t)(2 * tt) * 512 * 32; vu = 512 * 32; }
        },
        [&](int t, const unsigned char* buf) {
            const float nob[8] = {0.f, 0.f, 0.f, 0.f, 0.f, 0.f, 0.f, 0.f};
#pragma unroll 1
            for (int half = 0; half < 2; ++half) {
                UnitFrags<2, 128> f;
                lds_unit<2, 128>(f, buf, 32 * half, half * TileGeom<2, 128>::VUNIT + g * 16, lr, g);
                compute_unit<2, 128, false>(st, f, qf, sc, nob);
            }
        });
    const float inv0 = 1.f / grp_sum(st.l[0]), inv1 = 1.f / grp_sum(st.l[1]);
    const float* lamp = (const float*)(ws_ + OFF_LAM);
    const float lam = lamp[l * 2], lam_init = lamp[l * 2 + 1];
    const float c1 = lam * inv1;
    float ss = 0.f;
#pragma unroll
    for (int vb = 0; vb < 8; ++vb)
#pragma unroll
        for (int i = 0; i < 4; ++i) {
            const float o = st.O[0][vb][i] * inv0 - st.O[1][vb][i] * c1;
            st.O[0][vb][i] = o; ss += o * o;
        }
    ss = grp_sum(ss);
    const float r = rsqrtf(ss * (1.f / 128.f) + LN_EPS) * (1.f - lam_init);
    bf16_t* MIX = (bf16_t*)(ws_ + OFF_MIX) + (size_t)(tok0 + q0 + lr) * 1024 + h * 128;
    const float* gn = p.diff_norm_g + l * 128;
#pragma unroll
    for (int vb = 0; vb < 8; ++vb) {
        const int v = vb * 16 + 4 * g;
        const float4 g4 = *(const float4*)(gn + v);
        uint2 o; o.x = pack2(st.O[0][vb][0] * r * g4.x, st.O[0][vb][1] * r * g4.y);
        o.y = pack2(st.O[0][vb][2] * r * g4.z, st.O[0][vb][3] * r * g4.w);
        *(uint2*)(MIX + v) = o;
    }
}

DI void item_diffattn_lat(const Params& pin, int l, int seq, int h, int qt32, unsigned char* smem, int wave, int lane) {
    const Params& p = pin; unsigned char* const ws_ = opaque_ws(pin.ws); float* const out_ = opaque_out(pin.out); lane = opaque_v(lane); wave = opaque_s(wave);
    const int lr = lane & 15, g = lane >> 4;
    const int tok0 = NCTX + seq * 1024;
    const bf16_t* P = (const bf16_t*)(ws_ + OFF_P);
    const int msel = wave & 1;
    const int q0 = qt32 * 32 + (wave >> 1) * 16;
    bf16x8 qf[1][2];
    {
        const bf16_t* qp = P + (size_t)(tok0 + q0 + lr) * NIN + h * 128 + msel * 64 + 8 * g;
        qf[0][0] = *(const bf16x8*)(qp); qf[0][1] = *(const bf16x8*)(qp + 32);
    }
    AttnSt<1, 128> st;
    attn_init<1, 128>(st);
    const float sc = 0.125f * LOG2E;
    const size_t hb = (size_t)((seq * 4 + l) * 4 + h);
    const bf16_t* kc = (const bf16_t*)(ws_ + OFF_CAK) + hb * 512 * 128;
    const bf16_t* vc = (const bf16_t*)(ws_ + OFF_CAVT) + hb * 128 * 512;
    const bf16_t* kn = P + (size_t)tok0 * NIN + 512 + h * 128;
    const bf16_t* vn = (const bf16_t*)(ws_ + OFF_PT_AV) + (size_t)tok0 * 512 + (size_t)(h * 128) * 32;
    __syncthreads();
    tile_pipeline<2, 128>(smem, 24, wave, lane,
        [&](int t, const bf16_t*& kg, int& ks, const bf16_t*& vg, int& vu) {
            if (t < 8) { kg = kc + (size_t)t * 64 * 128; ks = 128; vg = vc + (size_t)(2 * t) * 128 * 32; vu = 128 * 32; }
            else { const int tt = t - 8; kg = kn + (size_t)tt * 64 * NIN; ks = NIN; vg = vn + (size_t)(2 * tt) * 512 * 32; vu = 512 * 32; }
        },
        [&](int t, const unsigned char* buf) {
            const float nob[8] = {0.f, 0.f, 0.f, 0.f, 0.f, 0.f, 0.f, 0.f};
#pragma unroll
            for (int half = 0; half < 2; ++half) {
                UnitFrags<1, 128> f;
                lds_unit_sel<128>(f, buf, 32 * half, half * TileGeom<2, 128>::VUNIT + g * 16, lr, g, msel);
                compute_unit<1, 128, false>(st, f, qf, sc, nob);
            }
        });
    const float* lamp = (const float*)(ws_ + OFF_LAM);
    const float lam = lamp[l * 2], lam_init = lamp[l * 2 + 1];
    const float inv = (msel ? lam : 1.f) / grp_sum(st.l[0]);
    float* xb = (float*)smem + (wave >> 1) * 32 * 64 + lane;
    if (msel) {
#pragma unroll
        for (int vb = 0; vb < 8; ++vb)
#pragma unroll
            for (int i = 0; i < 4; ++i) xb[(vb * 4 + i) * 64] = st.O[0][vb][i] * inv;
    }
    __syncthreads();
    if (msel) return;
    float ss = 0.f;
#pragma unroll
    for (int vb = 0; vb < 8; ++vb)
#pragma unroll
        for (int i = 0; i < 4; ++i) {
            const float o = st.O[0][vb][i] * inv - xb[(vb * 4 + i) * 64];
            st.O[0][vb][i] = o; ss += o * o;
        }
    ss = grp_sum(ss);
    const float r = rsqrtf(ss * (1.f / 128.f) + LN_EPS) * (1.f - lam_init);
    bf16_t* MIX = (bf16_t*)(ws_ + OFF_MIX) + (size_t)(tok0 + q0 + lr) * 1024 + h * 128;
    const float* gn = p.diff_norm_g + l * 128;
#pragma unroll
    for (int vb = 0; vb < 8; ++vb) {
        const int v = vb * 16 + 4 * g;
        const float4 g4 = *(const float4*)(gn + v);
        uint2 o; o.x = pack2(st.O[0][vb][0] * r * g4.x, st.O[0][vb][1] * r * g4.y);
        o.y = pack2(st.O[0][vb][2] * r * g4.z, st.O[0][vb][3] * r * g4.w);
        *(uint2*)(MIX + v) = o;
    }
}

DI void item_dense(const Params& pin, int seq, int h, int qt, unsigned char* smem, int wave, int lane) {
    const Params& p = pin; unsigned char* const ws_ = opaque_ws(pin.ws); float* const out_ = opaque_out(pin.out); lane = opaque_v(lane); wave = opaque_s(wave);
    const int lr = lane & 15, g = lane >> 4;
    const int tok0 = seq * 256;
    const bf16_t* P = (const bf16_t*)(ws_ + OFF_P);
    const int q0 = qt * 64 + wave * 16;
    bf16x8 qf[1][2];
    {
        const bf16_t* qp = P + (size_t)(tok0 + q0 + lr) * NIN + 1536 + h * 64 + 8 * g;
        qf[0][0] = *(const bf16x8*)(qp); qf[0][1] = *(const bf16x8*)(qp + 32);
    }
    AttnSt<1, 64> st;
    attn_init<1, 64>(st);
    const bf16_t* kn = P + (size_t)tok0 * NIN + 1792 + h * 64;
    const bf16_t* vn = (const bf16_t*)(ws_ + OFF_PT_BV) + (size_t)tok0 * 256 + (size_t)(h * 64) * 32;
    const float sc = 0.125f * LOG2E;
    __syncthreads();
    tile_pipeline<1, 64>(smem, 4, wave, lane,
        [&](int t, const bf16_t*& kg, int& ks, const bf16_t*& vg, int& vu) {
            kg = kn + (size_t)t * 64 * NIN; ks = NIN; vg = vn + (size_t)(2 * t) * 256 * 32; vu = 256 * 32;
        },
        [&](int t, const unsigned char* buf) {
            const float nob[8] = {0.f, 0.f, 0.f, 0.f, 0.f, 0.f, 0.f, 0.f};
#pragma unroll
            for (int half = 0; half < 2; ++half) {
                UnitFrags<1, 64> f;
                lds_unit<1, 64>(f, buf, 32 * half, half * TileGeom<1, 64>::VUNIT + g * 16, lr, g);
                compute_unit<1, 64, false>(st, f, qf, sc, nob);
            }
        });
    const float inv = 1.f / grp_sum(st.l[0]);
    bf16_t* MIX = (bf16_t*)(ws_ + OFF_MIX) + (size_t)(tok0 + q0 + lr) * 1024 + 512 + h * 64;
#pragma unroll
    for (int vb = 0; vb < 4; ++vb) {
        uint2 o; o.x = pack2(st.O[0][vb][0] * inv, st.O[0][vb][1] * inv); o.y = pack2(st.O[0][vb][2] * inv, st.O[0][vb][3] * inv);
        *(uint2*)(MIX + vb * 16 + 4 * g) = o;
    }
}

DI void item_na(const Params& pin, int l, int sb, int h, int r, unsigned char* smem, int wave, int lane) {
    const Params& p = pin; unsigned char* const ws_ = opaque_ws(pin.ws); float* const out_ = opaque_out(pin.out); lane = opaque_v(lane); wave = opaque_s(wave);
    const int lr = lane & 15, g = lane >> 4;
    const int tok0 = NCTX + sb * 1024;
    const bf16_t* P = (const bf16_t*)(ws_ + OFF_P);
    const int qc = wave * 16 + lr;
    const int q0 = r * 64 + wave * 16;
    bf16x8 qf[1][2];
    {
        const bf16_t* qp = P + (size_t)(tok0 + q0 + lr) * NIN + 1536 + h * 64 + 8 * g;
        qf[0][0] = *(const bf16x8*)(qp); qf[0][1] = *(const bf16x8*)(qp + 32);
    }
    AttnSt<1, 64> st;
    attn_init<1, 64>(st);
    const float sc = 0.125f * LOG2E;
    const size_t hb = (size_t)((sb * 4 + l) * 4 + h);
    const bf16_t* kc = (const bf16_t*)(ws_ + OFF_CBK) + hb * 512 * 64;
    const bf16_t* vc = (const bf16_t*)(ws_ + OFF_CBVT) + hb * 64 * 512;
    const bf16_t* kn = P + (size_t)tok0 * NIN + 1792 + h * 64;
    const bf16_t* vn = (const bf16_t*)(ws_ + OFF_PT_BV) + (size_t)tok0 * 256 + (size_t)(h * 64) * 32;
    const int kr0 = min(max(r - 4, 0), 8);
    const int bs = min(max(wave * 16 - 8, 0), 32);
    const int wstart = min(max(qc - 8, 0), 48);
    const float* rpb = p.nat_rpb + (size_t)(l * 4 + h) * 15 * 31;
    __syncthreads();
    tile_pipeline<1, 64>(smem, 16, wave, lane,
        [&](int t, const bf16_t*& kg, int& ks, const bf16_t*& vg, int& vu) {
            if (t < 8) { kg = kc + (size_t)t * 64 * 64; ks = 64; vg = vc + (size_t)(2 * t) * 64 * 32; vu = 64 * 32; }
            else { const int kr = kr0 + t - 8; kg = kn + (size_t)kr * 64 * NIN; ks = NIN; vg = vn + (size_t)(2 * kr) * 256 * 32; vu = 256 * 32; }
        },
        [&](int t, const unsigned char* buf) {
            if (t < 8) {
                const float nob[8] = {0.f, 0.f, 0.f, 0.f, 0.f, 0.f, 0.f, 0.f};
#pragma unroll
                for (int half = 0; half < 2; ++half) {
                    UnitFrags<1, 64> f;
                    lds_unit<1, 64>(f, buf, 32 * half, half * TileGeom<1, 64>::VUNIT + g * 16, lr, g);
                    compute_unit<1, 64, false>(st, f, qf, sc, nob);
                }
            } else {
                const int kr = kr0 + t - 8;
                const int nl = bs + 8 * g;
                UnitFrags<1, 64> f;
                lds_unit<1, 64>(f, buf, bs, (nl >> 5) * TileGeom<1, 64>::VUNIT + (nl & 31) * 2, lr, g);
                float bias[8];
                const float* rrow = rpb + (kr - r + 7) * 31;
#pragma unroll
                for (int j = 0; j < 8; ++j) {
                    const int kcol = bs + 8 * g + j;
                    const bool valid = (kcol >= wstart) && (kcol < wstart + 16);
                    const int dc = min(max(kcol - qc + 15, 0), 30);
                    bias[j] = valid ? rrow[dc] * LOG2E : -INFINITY;
                }
                compute_unit<1, 64, true>(st, f, qf, sc, bias);
            }
        });
    const float inv = 1.f / grp_sum(st.l[0]);
    bf16_t* MIX = (bf16_t*)(ws_ + OFF_MIX) + (size_t)(tok0 + q0 + lr) * 1024 + 512 + h * 64;
#pragma unroll
    for (int vb = 0; vb < 4; ++vb) {
        uint2 o; o.x = pack2(st.O[0][vb][0] * inv, st.O[0][vb][1] * inv); o.y = pack2(st.O[0][vb][2] * inv, st.O[0][vb][3] * inv);
        *(uint2*)(MIX + vb * 16 + 4 * g) = o;
    }
}

DI float wave_excl_sum(float v, int lane) {
    float x = v;
#pragma unroll
    for (int d = 1; d < 64; d <<= 1) { const float y = __shfl_up(x, d); if (lane >= d) x += y; }
    return x - v;
}
DI float wave_excl_max(float v, int lane, float init) {
    float x = v;
#pragma unroll
    for (int d = 1; d < 64; d <<= 1) { const float y = __shfl_up(x, d); if (lane >= d) x = fmaxf(x, y); }
    const float ex = __shfl_up(x, 1);
    return lane == 0 ? init : fmaxf(init, ex);
}
DI void mlstm_scan(const float* __restrict__ G, int h, int nseq, int dir, float* aA, float* MA, float* FA, float m0, int lane) {
    const int per = nseq >> 6;
    float run = 0.f;
    for (int e = 0; e < per; ++e) {
        const int idx = lane * per + e, pos = dir ? nseq - 1 - idx : idx;
        const float f = G[(size_t)pos * 16 + (dir ? 12 : 4) + h];
        const float lf = fminf(f, 0.f) - __logf(1.f + __expf(-fabsf(f)));
        run += lf; FA[pos] = run;
    }
    const float off = wave_excl_sum(run, lane);
    float rmax = -INFINITY;
    for (int e = 0; e < per; ++e) {
        const int idx = lane * per + e, pos = dir ? nseq - 1 - idx : idx;
        const float F = FA[pos] + off; FA[pos] = F;
        const float a = G[(size_t)pos * 16 + (dir ? 8 : 0) + h] - F;
        aA[pos] = a; rmax = fmaxf(rmax, a); MA[pos] = rmax;
    }
    const float pre = wave_excl_max(rmax, lane, m0);
    for (int e = 0; e < per; ++e) {
        const int idx = lane * per + e, pos = dir ? nseq - 1 - idx : idx;
        MA[pos] = fmaxf(MA[pos], pre);
    }
}

DI void mlstm_unit(f32x4 (&O)[4], float& den, int dir, int t, const bf16x8 (&qf)[2], const UnitFrags<1, 64>& f, const float* aA, float Mt, int key0, int g) {
    f32x4 sa = (f32x4){0.f, 0.f, 0.f, 0.f}, sb = sa;
    sa = mfma16(f.k[0][0][0], qf[0], sa); sa = mfma16(f.k[0][0][1], qf[1], sa);
    sb = mfma16(f.k[0][1][0], qf[0], sb); sb = mfma16(f.k[0][1][1], qf[1], sb);
    const float4 a0 = *(const float4*)(aA + key0 + 8 * g), a1 = *(const float4*)(aA + key0 + 8 * g + 4);
    const float av[8] = {a0.x, a0.y, a0.z, a0.w, a1.x, a1.y, a1.z, a1.w};
    float pv[8];
#pragma unroll
    for (int j = 0; j < 8; ++j) {
        const int key = key0 + 8 * g + j;
        const bool ok = dir ? (key >= t) : (key <= t);
        const float w = ok ? fexp2((av[j] - Mt) * LOG2E) : 0.f;
        const float sv = (j < 4) ? sa[j & 3] : sb[j & 3];
        pv[j] = sv * 0.125f * w;
        den += pv[j];
    }
    const bf16x8 pk = pack8(pv[0], pv[1], pv[2], pv[3], pv[4], pv[5], pv[6], pv[7]);
#pragma unroll
    for (int vb = 0; vb < 4; ++vb) O[vb] = mfma16(f.v[vb], pk, O[vb]);
}

template <bool LAT>
DI void item_mlstm(const Params& pin, int l, int seq, int h, int qt, unsigned char* smem, int wave, int lane) {
    const Params& p = pin; unsigned char* const ws_ = opaque_ws(pin.ws); float* const out_ = opaque_out(pin.out); lane = opaque_v(lane); wave = opaque_s(wave);
    const int lr = lane & 15, g = lane >> 4;
    const int nseq = LAT ? 1024 : 256;
    const int tok0 = LAT ? NCTX + seq * 1024 : seq * 256;
    float* aF = (float*)smem; float* MF = aF + 1024; float* FF = MF + 1024;
    float* aB = FF + 1024; float* MB = aB + 1024; float* FB = MB + 1024;
    unsigned char* tiles = smem + 24576;
    const float* G = (const float*)(ws_ + OFF_G) + (size_t)tok0 * 16;
    float m0f = 0.f, m0b = 0.f;
    const int sidx_f = ((seq * 4 + l) * 2 + 0) * 4 + h, sidx_b = ((seq * 4 + l) * 2 + 1) * 4 + h;
    if (LAT) { m0f = p.state_m[sidx_f]; m0b = p.state_m[sidx_b]; }
    __syncthreads();
    if (wave == 0) mlstm_scan(G, h, nseq, 0, aF, MF, FF, m0f, lane);
    if (wave == 1) mlstm_scan(G, h, nseq, 1, aB, MB, FB, m0b, lane);
    __syncthreads();
    const bf16_t* P = (const bf16_t*)(ws_ + OFF_P);
    const int q0 = qt * 64 + wave * 16;
    const int t = q0 + lr;
    bf16x8 qf[2];
    {
        const bf16_t* qp = P + (size_t)(tok0 + t) * NIN + 2304 + h * 64 + 8 * g;
        qf[0] = *(const bf16x8*)(qp); qf[1] = *(const bf16x8*)(qp + 32);
    }
    const bf16_t* kn = P + (size_t)tok0 * NIN + 2560 + h * 64;
    const bf16_t* vn = (const bf16_t*)(ws_ + OFF_PT_CV) + (size_t)tok0 * 256 + (size_t)(h * 64) * 32;
    const float Mf = MF[t], Mb = MB[t], Ff = FF[t], Fb = FB[t];
    f32x4 Of[4], Ob[4];
#pragma unroll
    for (int vb = 0; vb < 4; ++vb) { Of[vb] = (f32x4){0.f, 0.f, 0.f, 0.f}; Ob[vb] = Of[vb]; }
    float denf = 0.f, denb = 0.f;
    tile_pipeline<1, 64>(tiles, nseq / 64, wave, lane,
        [&](int tt, const bf16_t*& kg, int& ks, const bf16_t*& vg, int& vu) {
            kg = kn + (size_t)tt * 64 * NIN; ks = NIN; vg = vn + (size_t)(2 * tt) * 256 * 32; vu = 256 * 32;
        },
        [&](int tt, const unsigned char* buf) {
#pragma unroll
            for (int half = 0; half < 2; ++half) {
                const int key0 = tt * 64 + half * 32;
                const bool dof = key0 <= q0 + 15, dob = key0 + 31 >= q0;
                if (dof || dob) {
                    UnitFrags<1, 64> f;
                    lds_unit<1, 64>(f, buf, 32 * half, half * TileGeom<1, 64>::VUNIT + g * 16, lr, g);
                    if (dof) mlstm_unit(Of, denf, 0, t, qf, f, aF, Mf, key0, g);
                    if (dob) mlstm_unit(Ob, denb, 1, t, qf, f, aB, Mb, key0, g);
                }
            }
        });
    if (LAT) {
        const bf16_t* qp2 = P + (size_t)(tok0 + t) * NIN + 2304 + h * 64 + 4 * g;
#pragma unroll
        for (int dir = 0; dir < 2; ++dir) {
            const int sidx = dir ? sidx_b : sidx_f;
            const float e = fexp2(((dir ? m0b : m0f) - (dir ? Mb : Mf)) * LOG2E) * 0.125f;
            const bf16_t* c0t = (const bf16_t*)(ws_ + OFF_C0T) + (size_t)sidx * 4096 + lr * 64 + 4 * g;
            const float* n0 = p.state_n + (size_t)sidx * 64;
            float dacc = 0.f;
#pragma unroll
            for (int u2 = 0; u2 < 2; ++u2) {
                const bf16x4 qa = *(const bf16x4*)(qp2 + u2 * 32), qb = *(const bf16x4*)(qp2 + u2 * 32 + 16);
                const float4 na = *(const float4*)(n0 + u2 * 32 + 4 * g), nb = *(const float4*)(n0 + u2 * 32 + 16 + 4 * g);
                float pv[8];
#pragma unroll
                for (int j = 0; j < 4; ++j) { pv[j] = bf2f((unsigned short)qa[j]) * e; pv[4 + j] = bf2f((unsigned short)qb[j]) * e; }
                dacc += pv[0] * na.x + pv[1] * na.y + pv[2] * na.z + pv[3] * na.w + pv[4] * nb.x + pv[5] * nb.y + pv[6] * nb.z + pv[7] * nb.w;
                const bf16x8 pk = pack8(pv[0], pv[1], pv[2], pv[3], pv[4], pv[5], pv[6], pv[7]);
#pragma unroll
                for (int vb = 0; vb < 4; ++vb) {
                    const bf16_t* cp = c0t + (size_t)vb * 16 * 64 + u2 * 32;
                    const bf16x8 cf = cat4(*(const bf16x4*)(cp), *(const bf16x4*)(cp + 16));
                    if (dir) Ob[vb] = mfma16(cf, pk, Ob[vb]); else Of[vb] = mfma16(cf, pk, Of[vb]);
                }
            }
            if (dir) denb += dacc; else denf += dacc;
        }
    }
    denf = grp_sum(denf); denb = grp_sum(denb);
    const float rf = 1.f / fmaxf(fabsf(denf), expf(-(Ff + Mf)));
    const float rb = 1.f / fmaxf(fabsf(denb), expf(-(Fb + Mb)));
    float ss = 0.f;
#pragma unroll
    for (int vb = 0; vb < 4; ++vb)
#pragma unroll
        for (int i = 0; i < 4; ++i) { const float hs = Of[vb][i] * rf + Ob[vb][i] * rb; Of[vb][i] = hs; ss += hs * hs; }
    ss = grp_sum(ss);
    const float rn = rsqrtf(ss * (1.f / 64.f) + LN_EPS);
    const float* gn = p.mlstm_norm_g + (size_t)(l * 4 + h) * 64;
    const bf16_t* op = P + (size_t)(tok0 + t) * NIN + 3072 + h * 64;
    bf16_t* MIX = (bf16_t*)(ws_ + OFF_MIX) + (size_t)(tok0 + t) * 1024 + 768 + h * 64;
#pragma unroll
    for (int vb = 0; vb < 4; ++vb) {
        const int v = vb * 16 + 4 * g;
        const float4 g4 = *(const float4*)(gn + v);
        const bf16x4 o4 = *(const bf16x4*)(op + v);
        float sg[4];
#pragma unroll
        for (int i = 0; i < 4; ++i) sg[i] = 1.f / (1.f + __expf(-bf2f((unsigned short)o4[i])));
        uint2 o; o.x = pack2(Of[vb][0] * rn * g4.x * sg[0], Of[vb][1] * rn * g4.y * sg[1]);
        o.y = pack2(Of[vb][2] * rn * g4.z * sg[2], Of[vb][3] * rn * g4.w * sg[3]);
        *(uint2*)(MIX + v) = o;
    }
}

DI void item_mlstm_state(const Params& pin, int l, int b, int h, int dir, unsigned char* smem, int wave, int lane) {
    const Params& p = pin; unsigned char* const ws_ = opaque_ws(pin.ws); float* const out_ = opaque_out(pin.out); lane = opaque_v(lane); wave = opaque_s(wave);
    const int lr = lane & 15, g = lane >> 4;
    const int tok0 = b * 256;
    float* aA = (float*)smem; float* MA = aA + 1024; float* FA = MA + 1024;
    const float* G = (const float*)(ws_ + OFF_G) + (size_t)tok0 * 16;
    __syncthreads();
    if (wave == 0) mlstm_scan(G, h, 256, dir, aA, MA, FA, 0.f, lane);
    __syncthreads();
    const float Mfin = dir ? MA[0] : MA[255];
    const float Ffin = dir ? FA[0] : FA[255];
    const bf16_t* KT = (const bf16_t*)(ws_ + OFF_PT_CK) + (size_t)tok0 * 256 + (size_t)(h * 64 + wave * 16 + lr) * 32 + 8 * g;
    const bf16_t* VT = (const bf16_t*)(ws_ + OFF_PT_CV) + (size_t)tok0 * 256 + (size_t)(h * 64 + lr) * 32 + 8 * g;
    f32x4 C[4];
#pragma unroll
    for (int vb = 0; vb < 4; ++vb) C[vb] = (f32x4){0.f, 0.f, 0.f, 0.f};
    float nacc = 0.f;
#pragma unroll 4
    for (int u = 0; u < 8; ++u) {
        const int s0 = u * 32;
        const bf16x8 kf = *(const bf16x8*)(KT + (size_t)u * 256 * 32);
        const float4 a0 = *(const float4*)(aA + s0 + 8 * g), a1 = *(const float4*)(aA + s0 + 8 * g + 4);
        const float av[8] = {a0.x, a0.y, a0.z, a0.w, a1.x, a1.y, a1.z, a1.w};
        float kw[8];
#pragma unroll
        for (int j = 0; j < 8; ++j) { kw[j] = bf2f((unsigned short)kf[j]) * fexp2((av[j] - Mfin) * LOG2E); nacc += kw[j]; }
        const bf16x8 af = pack8(kw[0], kw[1], kw[2], kw[3], kw[4], kw[5], kw[6], kw[7]);
#pragma unroll
        for (int vb = 0; vb < 4; ++vb) {
            const bf16x8 vf = *(const bf16x8*)(VT + (size_t)u * 256 * 32 + vb * 16 * 32);
            C[vb] = mfma16(af, vf, C[vb]);
        }
    }
    const size_t sidx = (size_t)((b * 4 + l) * 2 + dir) * 4 + h;
    float* oc = out_ + O_NC + sidx * 4096;
#pragma unroll
    for (int vb = 0; vb < 4; ++vb)
#pragma unroll
        for (int i = 0; i < 4; ++i) oc[(wave * 16 + 4 * g + i) * 64 + vb * 16 + lr] = C[vb][i];
    nacc = grp_sum(nacc);
    if (g == 0) out_[O_NN + sidx * 64 + wave * 16 + lr] = nacc;
    if (wave == 0 && lane == 0) out_[O_NM + sidx] = Ffin + Mfin;
}

DI void mixer_phase(const Params& p, int l, unsigned char* smem) {
    const int tid_ = opaque_v(threadIdx.x); const int lane = tid_ & 63, wave = (tid_ >> 6) & 3;
    const int half = __builtin_amdgcn_readfirstlane(tid_ >> 8);
    unsigned char* sm = smem + half * HALF_LDS;
    unsigned* ctr = (unsigned*)(p.ws + OFF_MIXCTR) + l;
    volatile unsigned* slot = (volatile unsigned*)(smem + LDS_BYTES + 16);
    for (;;) {
        __syncthreads();
        if (tid_ == 0) *slot = __hip_atomic_fetch_add(ctr, 1u, __ATOMIC_RELAXED, __HIP_MEMORY_SCOPE_AGENT);
        __syncthreads();
        const int it = __builtin_amdgcn_readfirstlane(2 * (int)*slot + half);
        if (it >= 1408) break;
        if (it < 256) { item_diffattn_lat(p, l, it >> 7, (it >> 5) & 3, it & 31, sm, wave, lane); }
        else if (it < 384) { const int i = it - 256; item_mlstm<true>(p, l, i >> 6, (i >> 4) & 3, i & 15, sm, wave, lane); }
        else if (it < 512) { const int i = it - 384; item_mlstm_state(p, l, i >> 3, (i >> 1) & 3, i & 1, sm, wave, lane); }
        else if (it < 640) { const int i = it - 512; item_na(p, l, i >> 6, (i >> 4) & 3, i & 15, sm, wave, lane); }
        else if (it < 896) { const int i = it - 640; item_diffattn<false>(p, l, i >> 4, (i >> 2) & 3, i & 3, sm, wave, lane); }
        else if (it < 1152) { const int i = it - 896; item_mlstm<false>(p, l, i >> 4, (i >> 2) & 3, i & 3, sm, wave, lane); }
        else { const int i = it - 1152; item_dense(p, i >> 4, (i >> 2) & 3, i & 3, sm, wave, lane); }
    }
}

#define XB_TMO      128
#define XB_XCNT(j)  (256  + 64 * (j))
#define XB_XSUB(j)  (1280 + 64 * (j))
#define XB_XGEN(j)  (2304 + 64 * (j))
#define XB_TOP      3328
#define XB_TOPGEN   3392
#define XCD_BAR_WORDS 3456
#define XB_SPIN_CAP (1u << 18)

__device__ __forceinline__ unsigned xb_ld(unsigned* p)              { return __hip_atomic_load(p, __ATOMIC_RELAXED, __HIP_MEMORY_SCOPE_AGENT); }
__device__ __forceinline__ unsigned xb_add(unsigned* p, unsigned v) { return __hip_atomic_fetch_add(p, v, __ATOMIC_RELAXED, __HIP_MEMORY_SCOPE_AGENT); }
__device__ __forceinline__ unsigned xb_xcc_id() { return (unsigned)__builtin_amdgcn_s_getreg((3 << 11) | 20) & 0xFu; }
#define XB_SPIN(cond, bar) do { unsigned _sp = 0; while (cond) { __builtin_amdgcn_s_sleep(1); \
    if ((++_sp & 255u) == 0u) { if (xb_ld(&(bar)[XB_TMO])) break; if (_sp > XB_SPIN_CAP) { atomicAdd(&(bar)[XB_TMO], 1u); break; } } } } while (0)

struct XcdBarrier {
    unsigned* bar; unsigned x;
    volatile LAS unsigned* st;
};

__device__ __forceinline__ XcdBarrier xcd_barrier_post(unsigned* bar, volatile LAS unsigned* st) {
    XcdBarrier b; b.bar = bar; b.x = xb_xcc_id(); b.st = st;
    if (threadIdx.x == 0) (void)xb_add(&bar[XB_XCNT(b.x)], 1u);
    return b;
}
__device__ __forceinline__ void xcd_barrier_complete(unsigned* bar, unsigned x, unsigned& nloc, unsigned& nx) {
    const unsigned G = gridDim.x * gridDim.y * gridDim.z;
    unsigned sum, cnt, mine, sp = 0u;
    for (;;) {
        sum = 0u; cnt = 0u; mine = 0u;
#pragma unroll
        for (unsigned j = 0; j < 16; ++j) { const unsigned c = xb_ld(&bar[XB_XCNT(j)]); sum += c; cnt += (c > 0u) ? 1u : 0u; mine = (j == x) ? c : mine; }
        if (sum == G) break;
        __builtin_amdgcn_s_sleep(1);
        if ((++sp & 255u) == 0u) { if (xb_ld(&bar[XB_TMO])) break; if (sp > XB_SPIN_CAP) { atomicAdd(&bar[XB_TMO], 1u); break; } }
    }
    nloc = mine > 0u ? mine : 1u; nx = cnt > 0u ? cnt : 1u;
}

__device__ __forceinline__ void xcd_barrier(const XcdBarrier& b) {
    asm volatile("s_waitcnt vmcnt(0)" ::: "memory");
    __syncthreads();
    if (threadIdx.x == 0) {
        unsigned* bar = b.bar;
        __builtin_amdgcn_s_waitcnt(0);
        unsigned nloc = b.st[0], nx = b.st[1];
        if (nloc == 0u) { xcd_barrier_complete(bar, b.x, nloc, nx); b.st[0] = nloc; b.st[1] = nx; }
        const unsigned old = xb_add(&bar[XB_XSUB(b.x)], 1u);
        const unsigned gen = old / nloc;
        if (old + 1u == (gen + 1u) * nloc) {
            __builtin_amdgcn_fence(__ATOMIC_RELEASE, "agent");
            asm volatile("s_waitcnt vmcnt(0)" ::: "memory");
            const unsigned og = xb_add(&bar[XB_TOP], 1u);
            const unsigned tg = og / nx;
            if (og + 1u == (tg + 1u) * nx) xb_add(&bar[XB_TOPGEN], 1u);
            else XB_SPIN(xb_ld(&bar[XB_TOPGEN]) == tg, bar);
            __builtin_amdgcn_fence(__ATOMIC_ACQUIRE, "agent");
            xb_add(&bar[XB_XGEN(b.x)], 1u);
            asm volatile("s_waitcnt vmcnt(0)" ::: "memory");
        } else {
            XB_SPIN(xb_ld(&bar[XB_XGEN(b.x)]) == gen, bar);
            __builtin_amdgcn_fence(__ATOMIC_ACQUIRE, "agent");
            asm volatile("s_waitcnt vmcnt(0)" ::: "memory");
        }
    }
    __syncthreads();
}


constexpr int N_PHASES = 2 + 5 * 4;

__global__ void __launch_bounds__(512, 2) fwd_kernel(Params p) {
    __shared__ __attribute__((aligned(16))) unsigned char smem[LDS_BYTES + 32];
    if (threadIdx.x == 0) *(uint4*)(smem + LDS_BYTES) = make_uint4(0u, 0u, 0u, 0u);
    __syncthreads();
    XcdBarrier xb = xcd_barrier_post((unsigned*)(p.ws + OFF_BAR), (volatile LAS unsigned*)(smem + LDS_BYTES));
    for (int ph = p.ph_lo; ph < p.ph_hi; ++ph) {
        if (ph > p.ph_lo) {
            if (p.ph_hi > 1000) cg::this_grid().sync();
            xcd_barrier(xb);
        }
        const int l = ph < 2 ? 0 : (ph - 2) / 5, s = ph < 2 ? ph - 2 : (ph - 2) % 5;
        const int bit = 1 << (s + 2);
        const int reps = (DUPM & bit) ? 2 : 1;
        for (int rep = 0; rep < reps; ++rep) {
            if (rep) __syncthreads();
            if (s == -2) prep0(p, smem + __builtin_amdgcn_readfirstlane(threadIdx.x >> 8) * HALF_LDS);
            else if (s == -1) prep1(p);
            else if (s == 0) gemm_phase<EPI_INPROJ>(p, l, OFF_H, OFF_WT_IN + (size_t)l * NINP * DM * 2, NINP / 128, 1024, 0, smem);
            else if (s == 1) mixer_phase(p, l, smem);
            else if (s == 2) gemm_phase<EPI_LN1>(p, l, OFF_MIX, OFF_WT_OUT + (size_t)l * DM * DM * 2, 8, 1024, 1024, smem);
            else if (s == 3) gemm_phase<EPI_RELU2>(p, l, OFF_H, OFF_WT_1 + (size_t)l * DFF * DM * 2, 32, 1024, 4096, smem);
            else gemm_phase<EPI_LN2>(p, l, OFF_U, OFF_WT_2 + (size_t)l * DM * DFF * 2, 8, 4096, 1024, smem);
        }
    }
}

extern "C" void kernel_launch(void* const* d_in, const int* in_sizes, int n_in, void* d_out, int out_size, void* d_ws, size_t ws_size,
                              hipStream_t stream) {
    static int grid = 0;
    if (grid == 0) {
        if (n_in != 26 || ws_size < WS_END) { fprintf(stderr, "kernel_launch: unexpected n_in %d / ws %zu (need %zu)\n", n_in, ws_size, (size_t)WS_END); grid = -1; return; }
        int dev = 0, cus = 0, per_cu = 0;
        hipGetDevice(&dev);
        hipDeviceGetAttribute(&cus, hipDeviceAttributeMultiprocessorCount, dev);
        hipOccupancyMaxActiveBlocksPerMultiprocessor(&per_cu, (const void*)fwd_kernel, 512, 0);
        (void)per_cu;
        grid = cus;
        if (grid < 192) { fprintf(stderr, "kernel_launch: grid %d < 192 resident workgroups needed by the fused LayerNorm exchange\n", grid); grid = -1; return; }
    }
    if (grid < 0) return;
    Params p{};
    const float** pp = (const float**)&p;
    for (int i = 0; i < 26; ++i) pp[i] = (const float*)d_in[i];
    p.out = (float*)d_out; p.ws = (unsigned char*)d_ws;
    (void)hipMemsetAsync((unsigned char*)d_ws + OFF_BAR, 0, 16384, stream);
#if SINGLE_LAUNCH
    p.ph_lo = 0; p.ph_hi = N_PHASES;
    void* args[] = {&p};
    hipError_t e = hipLaunchCooperativeKernel((const void*)fwd_kernel, dim3(grid), dim3(512), args, 0, stream);
    if (e != hipSuccess) fprintf(stderr, "cooperative launch failed: %s (grid %d)\n", hipGetErrorString(e), grid);
#else
    for (int ph = 0; ph < N_PHASES; ++ph) {
        p.ph_lo = ph; p.ph_hi = ph + 1;
        void* args[] = {&p};
        hipError_t e = hipLaunchCooperativeKernel((const void*)fwd_kernel, dim3(grid), dim3(512), args, 0, stream);
        if (e != hipSuccess) { fprintf(stderr, "launch %d failed: %s (grid %d)\n", ph, hipGetErrorString(e), grid); break; }
    }
#endif
}
```

```cpp
#include <hip/hip_runtime.h>
#include <hip/hip_cooperative_groups.h>
#include <cstdio>
namespace cg = cooperative_groups;

#ifndef IM
#define IM 0xffff
#endif
#ifndef IM
#define IM 0xffff
#endif
#ifndef DUPM
#define DUPM 0
#endif
#ifndef PHM
#define PHM 0xffff
#endif
#ifndef SINGLE_LAUNCH
#define SINGLE_LAUNCH 1
#endif

#define LAS __attribute__((address_space(3)))
typedef unsigned short bf16_t;
typedef __attribute__((ext_vector_type(8))) short bf16x8;
typedef __attribute__((ext_vector_type(4))) short bf16x4;
typedef __attribute__((ext_vector_type(4))) float f32x4;
#define DI __device__ __forceinline__

constexpr int NTOK = 6144, NCTX = 4096, DM = 1024, NIN = 3344, NINP = 3456, DFF = 4096;
constexpr float ALPHA = 1.681792830507429f;
constexpr float LOG2E = 1.4426950408889634f;
constexpr float LN_EPS = 1e-5f;

constexpr size_t al256(size_t x) { return (x + 255) & ~(size_t)255; }
constexpr size_t OFF_WT_IN = 0;
constexpr size_t OFF_WT_OUT = OFF_WT_IN + al256((size_t)4 * NINP * DM * 2);
constexpr size_t OFF_WT_1 = OFF_WT_OUT + al256((size_t)4 * DM * DM * 2);
constexpr size_t OFF_WT_2 = OFF_WT_1 + al256((size_t)4 * DFF * DM * 2);
constexpr size_t OFF_MOD = OFF_WT_2 + al256((size_t)4 * DFF * DM * 2);
constexpr size_t OFF_X = OFF_MOD + al256((size_t)4 * 3 * 6144 * 4);
constexpr size_t OFF_H = OFF_X + al256((size_t)NTOK * DM * 4);
constexpr size_t OFF_P = OFF_H + al256((size_t)NTOK * DM * 2);
constexpr size_t OFF_PT_AV = OFF_P + al256((size_t)NTOK * NIN * 2);
constexpr size_t OFF_PT_BV = OFF_PT_AV + al256((size_t)NTOK * 512 * 2);
constexpr size_t OFF_PT_CV = OFF_PT_BV + al256((size_t)NTOK * 256 * 2);
constexpr size_t OFF_PT_CK = OFF_PT_CV + al256((size_t)NTOK * 256 * 2);
constexpr size_t OFF_G = OFF_PT_CK + al256((size_t)NTOK * 256 * 2);
constexpr size_t OFF_MIX = OFF_G + al256((size_t)NTOK * 16 * 4);
constexpr size_t OFF_Y = OFF_MIX + al256((size_t)NTOK * DM * 2);
constexpr size_t OFF_U = OFF_Y + al256((size_t)NTOK * DM * 4);
constexpr size_t OFF_CAK = OFF_U + al256((size_t)NTOK * DFF * 2);
constexpr size_t OFF_CAVT = OFF_CAK + al256((size_t)32 * 512 * 128 * 2);
constexpr size_t OFF_CBK = OFF_CAVT + al256((size_t)32 * 512 * 128 * 2);
constexpr size_t OFF_CBVT = OFF_CBK + al256((size_t)32 * 512 * 64 * 2);
constexpr size_t OFF_C0T = OFF_CBVT + al256((size_t)32 * 512 * 64 * 2);
constexpr size_t OFF_ROPE = OFF_C0T + al256((size_t)64 * 64 * 64 * 2);
constexpr size_t OFF_LAM = OFF_ROPE + al256((size_t)2 * 1024 * 4);
constexpr size_t OFF_BAR = OFF_LAM + 256;
constexpr size_t OFF_LNCNT = OFF_BAR + 13824;
constexpr size_t OFF_MIXCTR = OFF_BAR + 15360;
constexpr size_t OFF_STATS = OFF_BAR + 16384;
constexpr size_t WS_END = OFF_STATS + (size_t)NTOK * 16 * 8;

constexpr size_t O_YP = 0, O_YS = 4194304, O_AK = 6291456, O_AV = 14680064, O_BK = 23068672, O_BV = 27262976,
                 O_NC = 31457280, O_NN = 33554432, O_NM = 33587200;

struct Params {
    const float* x_prompt; const float* x_sample; const float* cache_a_k; const float* cache_a_v;
    const float* cache_b_k; const float* cache_b_v; const float* state_c; const float* state_n;
    const float* state_m; const float* c; const float* c_ctx; const float* w_in; const float* gate_bias;
    const float* diff_lambda; const float* diff_norm_g; const float* nat_rpb; const float* mlstm_norm_g;
    const float* w_out; const float* ada_w; const float* ada_b; const float* ln1_g; const float* ln1_b;
    const float* ln2_g; const float* ln2_b; const float* w_mlp1; const float* w_mlp2;
    float* out; unsigned char* ws; int ph_lo; int ph_hi;
};

#define VBID ((int)(blockIdx.x * 2 + __builtin_amdgcn_readfirstlane(threadIdx.x >> 8)))
#define VGRID ((int)(gridDim.x * 2))
#define VTID ((int)(threadIdx.x & 255))
constexpr int HALF_LDS = 73728;
constexpr int LDS_BYTES = 2 * HALF_LDS;
DI int opaque_v(int x) { asm volatile("" : "+v"(x)); return x; }
DI int opaque_s(int x) { x = __builtin_amdgcn_readfirstlane(x); asm volatile("" : "+s"(x)); return x; }
DI size_t opaque_zero() { size_t z = 0; asm volatile("" : "+s"(z)); return z; }
DI unsigned char* opaque_ws(unsigned char* w) { return w + opaque_zero(); }
DI float* opaque_out(float* w) { return w + opaque_zero(); }
DI unsigned short f2bf(float x) { unsigned u = __float_as_uint(x); u += 0x7fffu + ((u >> 16) & 1u); return (unsigned short)(u >> 16); }
DI float bf2f(unsigned short h) { return __uint_as_float(((unsigned)h) << 16); }
DI unsigned pack2(float a, float b) { return (unsigned)f2bf(a) | ((unsigned)f2bf(b) << 16); }
DI f32x4 mfma16(bf16x8 a, bf16x8 b, f32x4 c) { return __builtin_amdgcn_mfma_f32_16x16x32_bf16(a, b, c, 0, 0, 0); }
DI float fexp2(float x) { return __builtin_amdgcn_exp2f(x); }
DI bf16x8 pack8(float a0, float a1, float a2, float a3, float a4, float a5, float a6, float a7) {
    uint4 u;
    asm volatile("s_nop 1\n\tv_cvt_pk_bf16_f32 %0, %4, %5\n\tv_cvt_pk_bf16_f32 %1, %6, %7\n\tv_cvt_pk_bf16_f32 %2, %8, %9\n\tv_cvt_pk_bf16_f32 %3, %10, %11\n\ts_nop 1"
                 : "=&v"(u.x), "=&v"(u.y), "=&v"(u.z), "=&v"(u.w)
                 : "v"(a0), "v"(a1), "v"(a2), "v"(a3), "v"(a4), "v"(a5), "v"(a6), "v"(a7));
    return __builtin_bit_cast(bf16x8, u);
}
DI bf16x8 cat4(bf16x4 a, bf16x4 b) { return __builtin_shufflevector(a, b, 0, 1, 2, 3, 4, 5, 6, 7); }
DI float wave_sum(float v) {
#pragma unroll
    for (int o = 32; o > 0; o >>= 1) v += __shfl_xor(v, o);
    return v;
}
DI float grp_sum(float v) { v += __shfl_xor(v, 16); v += __shfl_xor(v, 32); return v; }
DI float grp_max(float v) { v = fmaxf(v, __shfl_xor(v, 16)); v = fmaxf(v, __shfl_xor(v, 32)); return v; }

DI void transpose_job(const float* __restrict__ src, bf16_t* __restrict__ dst, int R, int C, int Cpad, int nmat, float* tile, bool blocked = false) {
    const int tid = VTID;
    const int rt = R >> 6, ct = Cpad >> 6, per = rt * ct, total = per * nmat;
    for (int it = VBID; it < total; it += VGRID) {
        const int mat = it / per, rem = it - mat * per;
        const int r0 = (rem / ct) << 6, c0 = (rem % ct) << 6;
        const float* s = src + (size_t)mat * R * C;
        bf16_t* d = dst + (size_t)mat * Cpad * R;
#pragma unroll
        for (int i = 0; i < 4; ++i) {
            const int r = (tid >> 4) + 16 * i, c = (tid & 15) * 4;
            float4 v = make_float4(0.f, 0.f, 0.f, 0.f);
            if (c0 + c < C) v = *(const float4*)(s + (size_t)(r0 + r) * C + c0 + c);
            tile[r * 65 + c + 0] = v.x; tile[r * 65 + c + 1] = v.y; tile[r * 65 + c + 2] = v.z; tile[r * 65 + c + 3] = v.w;
        }
        __syncthreads();
        {
            const int c = tid >> 2, rs = (tid & 3) * 16;
            uint4 o0, o1;
            o0.x = pack2(tile[(rs + 0) * 65 + c], tile[(rs + 1) * 65 + c]);
            o0.y = pack2(tile[(rs + 2) * 65 + c], tile[(rs + 3) * 65 + c]);
            o0.z = pack2(tile[(rs + 4) * 65 + c], tile[(rs + 5) * 65 + c]);
            o0.w = pack2(tile[(rs + 6) * 65 + c], tile[(rs + 7) * 65 + c]);
            o1.x = pack2(tile[(rs + 8) * 65 + c], tile[(rs + 9) * 65 + c]);
            o1.y = pack2(tile[(rs + 10) * 65 + c], tile[(rs + 11) * 65 + c]);
            o1.z = pack2(tile[(rs + 12) * 65 + c], tile[(rs + 13) * 65 + c]);
            o1.w = pack2(tile[(rs + 14) * 65 + c], tile[(rs + 15) * 65 + c]);
            uint4* dp = blocked ? (uint4*)(d + ((size_t)((r0 + rs) >> 5) * Cpad + (c0 + c)) * 32 + ((r0 + rs) & 31))
                                : (uint4*)(d + (size_t)(c0 + c) * R + r0 + rs);
            dp[0] = o0; dp[1] = o1;
        }
        __syncthreads();
    }
}

DI void convert_job(const float* __restrict__ src, bf16_t* __restrict__ dst, size_t n) {
    for (size_t i = ((size_t)VBID * 256 + VTID) * 8; i < n; i += (size_t)VGRID * 256 * 8) {
        const float4 a = *(const float4*)(src + i), b = *(const float4*)(src + i + 4);
        uint4 o; o.x = pack2(a.x, a.y); o.y = pack2(a.z, a.w); o.z = pack2(b.x, b.y); o.w = pack2(b.z, b.w);
        *(uint4*)(dst + i) = o;
    }
}

DI void prep0(const Params& pin, unsigned char* smem) {
    const Params& p = pin; unsigned char* const ws_ = opaque_ws(pin.ws); float* const out_ = opaque_out(pin.out); const int tid = opaque_v(VTID);
    {
        float* sl = (float*)smem; float* red = (float*)(smem + 12288);
        for (int i = tid; i < 3072; i += 256) {
            const int cnd = i >> 10, k = i & 1023;
            const float v = (cnd == 0) ? p.c_ctx[k] : p.c[(cnd - 1) * 1024 + k];
            sl[i] = v / (1.f + __expf(-v));
        }
        __syncthreads();
        float* mod = (float*)(ws_ + OFF_MOD);
        const int kg = tid >> 4, cl = tid & 15;
        for (int it = VBID; it < 384; it += VGRID) {
            const int l = it / 96, j0 = (it % 96) * 64;
            const float* w = p.ada_w + (size_t)l * 1024 * 6144 + j0 + cl * 4;
            float4 a0 = make_float4(0, 0, 0, 0), a1 = a0, a2 = a0;
#pragma unroll 8
            for (int kk = 0; kk < 64; ++kk) {
                const int k = kg * 64 + kk;
                const float4 wv = *(const float4*)(w + (size_t)k * 6144);
                const float s0 = sl[k], s1 = sl[1024 + k], s2 = sl[2048 + k];
                a0.x += s0 * wv.x; a0.y += s0 * wv.y; a0.z += s0 * wv.z; a0.w += s0 * wv.w;
                a1.x += s1 * wv.x; a1.y += s1 * wv.y; a1.z += s1 * wv.z; a1.w += s1 * wv.w;
                a2.x += s2 * wv.x; a2.y += s2 * wv.y; a2.z += s2 * wv.z; a2.w += s2 * wv.w;
            }
            __syncthreads();
            float* r = red + kg * 192 + cl * 4;
            r[0] = a0.x; r[1] = a0.y; r[2] = a0.z; r[3] = a0.w;
            r[64] = a1.x; r[65] = a1.y; r[66] = a1.z; r[67] = a1.w;
            r[128] = a2.x; r[129] = a2.y; r[130] = a2.z; r[131] = a2.w;
            __syncthreads();
            if (tid < 192) {
                const int cnd = tid >> 6, col = tid & 63;
                float s = 0.f;
#pragma unroll
                for (int q = 0; q < 16; ++q) s += red[q * 192 + tid];
                mod[(l * 3 + cnd) * 6144 + j0 + col] = s + p.ada_b[l * 6144 + j0 + col];
            }
        }
        __syncthreads();
    }
    if (VBID == VGRID - 1) {
        float* rope = (float*)(ws_ + OFF_ROPE);
        for (int i = tid; i < 1024; i += 256) {
            const int pos = i >> 4, j = i & 15;
            const float freq = powf(10000.f, -(float)j / 16.f);
            float s, c; sincosf((float)pos * freq, &s, &c);
            rope[i] = c; rope[1024 + i] = s;
        }
        if (tid < 4) {
            const float* lp = p.diff_lambda + tid * 256;
            float s1 = 0.f, s2 = 0.f;
            for (int i = 0; i < 64; ++i) { s1 += lp[i] * lp[64 + i]; s2 += lp[128 + i] * lp[192 + i]; }
            const float li = 0.8f - 0.6f * expf(-0.3f * (float)tid);
            float* lam = (float*)(ws_ + OFF_LAM);
            lam[tid * 2] = expf(s1) - expf(s2) + li; lam[tid * 2 + 1] = li;
        }
    }
    float* tile = (float*)smem;
    transpose_job(p.w_in, (bf16_t*)(ws_ + OFF_WT_IN), 1024, NIN, NINP, 4, tile);
    transpose_job(p.w_out, (bf16_t*)(ws_ + OFF_WT_OUT), 1024, 1024, 1024, 4, tile);
    transpose_job(p.w_mlp1, (bf16_t*)(ws_ + OFF_WT_1), 1024, 4096, 4096, 4, tile);
    transpose_job(p.w_mlp2, (bf16_t*)(ws_ + OFF_WT_2), 4096, 1024, 1024, 4, tile);
    transpose_job(p.cache_a_v, (bf16_t*)(ws_ + OFF_CAVT), 512, 128, 128, 32, tile, true);
    transpose_job(p.cache_b_v, (bf16_t*)(ws_ + OFF_CBVT), 512, 64, 64, 32, tile, true);
    transpose_job(p.state_c, (bf16_t*)(ws_ + OFF_C0T), 64, 64, 64, 64, tile);
    convert_job(p.cache_a_k, (bf16_t*)(ws_ + OFF_CAK), (size_t)32 * 512 * 128);
    convert_job(p.cache_b_k, (bf16_t*)(ws_ + OFF_CBK), (size_t)32 * 512 * 64);
}

DI void prep1(const Params& pin) {
    const Params& p = pin; unsigned char* const ws_ = opaque_ws(pin.ws); float* const out_ = opaque_out(pin.out); const int tid_ = opaque_v(threadIdx.x); const int lane = tid_ & 63, wave = tid_ >> 6;
    const float* mod = (const float*)(ws_ + OFF_MOD);
    float* X = (float*)(ws_ + OFF_X);
    bf16_t* H = (bf16_t*)(ws_ + OFF_H);
    for (int row = blockIdx.x * 8 + wave; row < NTOK; row += gridDim.x * 8) {
        const float* src = row < NCTX ? p.x_prompt + (size_t)row * 1024 : p.x_sample + (size_t)(row - NCTX) * 1024;
        const int cnd = row < NCTX ? 0 : 1 + ((row - NCTX) >> 10);
        const float* md = mod + (size_t)cnd * 6144;
#pragma unroll
        for (int j = 0; j < 4; ++j) {
            const int c = lane * 4 + 256 * j;
            const float4 v = *(const float4*)(src + c);
            *(float4*)(X + (size_t)row * 1024 + c) = v;
            const float4 sh = *(const float4*)(md + c), sc = *(const float4*)(md + 1024 + c);
            uint2 o; o.x = pack2(v.x * (1.f + sc.x) + sh.x, v.y * (1.f + sc.y) + sh.y);
            o.y = pack2(v.z * (1.f + sc.z) + sh.z, v.w * (1.f + sc.w) + sh.w);
            *(uint2*)(H + (size_t)row * 1024 + c) = o;
        }
    }
}

enum { EPI_INPROJ = 0, EPI_LN1 = 1, EPI_RELU2 = 2, EPI_LN2 = 3 };

DI void epi_inproj(const Params& p, unsigned char* ws_, float* out_, int layer, const float* T, int rowbase, int colbase, int lane) {
    if (colbase >= NIN) return;
    bf16_t* P = (bf16_t*)(ws_ + OFF_P);
    const bool latent = rowbase >= NCTX;
    const int seq_tok0 = latent ? (NCTX + ((rowbase - NCTX) & ~1023)) : (rowbase & ~255);
    const int nseq = latent ? 1024 : 256;
    const int bctx = seq_tok0 >> 8;
    const int n0 = rowbase - seq_tok0;
    if (colbase >= 3328) {
        float* G = (float*)(ws_ + OFF_G);
        const float bias = p.gate_bias[layer * 16 + (lane & 15)];
        for (int rr = 0; rr < 16; ++rr) {
            const int r = rr * 4 + (lane >> 4);
            G[(size_t)(rowbase + r) * 16 + (lane & 15)] = T[r * 65 + (lane & 15)] + bias;
        }
        return;
    }
    bool toP = false, rope = false, toT = false, toO = false;
    size_t toff = 0, obase = 0; int tW = 0, tcr = 0, ohd = 64, ocr = 0;
    if (colbase < 1024) { toP = true; rope = latent; if (colbase >= 512) { toO = !latent; obase = O_AK; ohd = 128; ocr = colbase - 512; } }
    else if (colbase < 1536) { toT = true; toff = OFF_PT_AV; tW = 512; tcr = colbase - 1024; toO = !latent; obase = O_AV; ohd = 128; ocr = tcr; }
    else if (colbase < 1792) { toP = true; }
    else if (colbase < 2048) { toP = true; toO = !latent; obase = O_BK; ohd = 64; ocr = colbase - 1792; }
    else if (colbase < 2304) { toT = true; toff = OFF_PT_BV; tW = 256; tcr = colbase - 2048; toO = !latent; obase = O_BV; ohd = 64; ocr = tcr; }
    else if (colbase < 2560) { toP = true; }
    else if (colbase < 2816) { toP = true; toT = true; toff = OFF_PT_CK; tW = 256; tcr = colbase - 2560; }
    else if (colbase < 3072) { toT = true; toff = OFF_PT_CV; tW = 256; tcr = colbase - 2816; }
    else { toP = true; }
    if (toO) {
        const int h = ocr / ohd, w = ocr - h * ohd + lane;
        float* O = out_ + obase + (((size_t)(bctx * 4 + layer) * 4 + h) * 256 + n0) * ohd + w;
#pragma unroll 4
        for (int r = 0; r < 64; ++r) O[(size_t)r * ohd] = T[r * 65 + lane];
    }
    if (toP) {
        bf16_t* Pp = P + (size_t)rowbase * NIN + colbase + lane;
        if (rope) {
            const float* rc = (const float*)(ws_ + OFF_ROPE);
            const float* rs = rc + 1024;
#pragma unroll 4
            for (int r = 0; r < 64; ++r) {
                const float v = T[r * 65 + lane], vp = T[r * 65 + (lane ^ 16)];
                const int t = n0 + r;
                const int pos = (lane < 32) ? (t >> 6) : (t & 63);
                const float c = rc[pos * 16 + (lane & 15)], sn = rs[pos * 16 + (lane & 15)];
                const float o = (lane & 16) ? (vp * sn + v * c) : (v * c - vp * sn);
                Pp[(size_t)r * NIN] = f2bf(o);
            }
        } else {
#pragma unroll 4
            for (int r = 0; r < 64; ++r) Pp[(size_t)r * NIN] = f2bf(T[r * 65 + lane]);
        }
    }
    if (toT) {
        const int n = n0 + lane;
        bf16_t* Tp = (bf16_t*)(ws_ + toff) + (size_t)seq_tok0 * tW + ((size_t)(n >> 5) * tW + tcr) * 32 + (n & 31);
#pragma unroll 4
        for (int c = 0; c < 64; ++c) Tp[(size_t)c * 32] = f2bf(T[lane * 65 + c]);
    }
}

template <int WHICH>
DI void epi_ln(const Params& p, unsigned char* ws_, float* out_, int l, float* T, int tm, int tn, int wn, int rowbase, int colbase, int lane, int tid) {
    const float* mod = (const float*)(ws_ + OFF_MOD);
    float* X = (float*)(ws_ + OFF_X);
    bf16_t* H = (bf16_t*)(ws_ + OFF_H);
    const int cnd = rowbase < NCTX ? 0 : 1 + ((rowbase - NCTX) >> 10);
    const float* md = mod + (size_t)(l * 3 + cnd) * 6144;
    const int col = colbase + lane;
    const bool last = (WHICH == 2 && l == 3);
    float s1 = 0.f, s2 = 0.f;
#pragma unroll 8
    for (int c = 0; c < 64; ++c) { const float v = T[lane * 65 + c]; s1 += v; s2 += v * v; }
    unsigned long long* stats = (unsigned long long*)(ws_ + OFF_STATS);
    __hip_atomic_store(stats + (size_t)(rowbase + lane) * 16 + tn * 2 + wn,
                       ((unsigned long long)__float_as_uint(s2) << 32) | (unsigned long long)__float_as_uint(s1), __ATOMIC_RELAXED, __HIP_MEMORY_SCOPE_AGENT);
    unsigned* cnt = (unsigned*)(ws_ + OFF_LNCNT) + (l * 2 + (WHICH - 1)) * 48 + tm;
    asm volatile("s_waitcnt vmcnt(0)" ::: "memory");
    __syncthreads();
    if (tid == 0) {
        (void)__hip_atomic_fetch_add(cnt, 1u, __ATOMIC_RELAXED, __HIP_MEMORY_SCOPE_AGENT);
        unsigned sp = 0;
        while (__hip_atomic_load(cnt, __ATOMIC_RELAXED, __HIP_MEMORY_SCOPE_AGENT) < 8u) { __builtin_amdgcn_s_sleep(1); if (++sp > (1u << 22)) break; }
    }
    __syncthreads();
    float t1 = 0.f, t2 = 0.f;
    {
        unsigned long long* sp8 = stats + (size_t)(rowbase + lane) * 16;
        unsigned long long a[16];
#pragma unroll
        for (int q = 0; q < 16; ++q) a[q] = __hip_atomic_load(sp8 + q, __ATOMIC_RELAXED, __HIP_MEMORY_SCOPE_AGENT);
#pragma unroll
        for (int q = 0; q < 16; ++q) { t1 += __uint_as_float((unsigned)a[q]); t2 += __uint_as_float((unsigned)(a[q] >> 32)); }
    }
    const float mu = t1 * (1.f / 1024.f);
    const float rstd = rsqrtf(fmaxf(t2 * (1.f / 1024.f) - mu * mu, 0.f) + LN_EPS);
    const float lng = (WHICH == 1 ? p.ln1_g : p.ln2_g)[l * 1024 + col], lnb = (WHICH == 1 ? p.ln1_b : p.ln2_b)[l * 1024 + col];
    if (last) {
        float* op = out_ + (size_t)rowbase * 1024 + col;
#pragma unroll 8
        for (int r = 0; r < 64; ++r) op[(size_t)r * 1024] = (T[r * 65 + lane] - __shfl(mu, r)) * __shfl(rstd, r) * lng + lnb;
    } else {
        const float* nmd = (WHICH == 1) ? md : mod + (size_t)((l + 1) * 3 + cnd) * 6144;
        const float sh = nmd[(WHICH == 1 ? 3072 : 0) + col], sc1p = 1.f + nmd[(WHICH == 1 ? 4096 : 1024) + col];
        float* xp = X + (size_t)rowbase * 1024 + col;
        bf16_t* hp = H + (size_t)rowbase * 1024 + col;
#pragma unroll 8
        for (int r = 0; r < 64; ++r) {
            const float o = (T[r * 65 + lane] - __shfl(mu, r)) * __shfl(rstd, r) * lng + lnb;
            xp[(size_t)r * 1024] = o;
            hp[(size_t)r * 1024] = f2bf(o * sc1p + sh);
        }
    }
}

template <int EPI>
DI void gemm_phase(const Params& pin, int layer, size_t offA, size_t offB, int ntn, int K, int ldc,
                   unsigned char* smem) {
    const Params& p = pin; unsigned char* const ws_ = opaque_ws(pin.ws); float* const out_ = opaque_out(pin.out); const int tid = opaque_v(threadIdx.x), lane = tid & 63, wave = opaque_s(tid >> 6);
    const bf16_t* __restrict__ A = (const bf16_t*)(ws_ + offA); const bf16_t* __restrict__ Bt = (const bf16_t*)(ws_ + offB);
    const int wm = wave >> 1, wn = wave & 1;
    const int lr = lane & 15, g = lane >> 4;
    const int ntm = NTOK / 256;
    const int ntiles = ntm * ntn, nk = K >> 6;
    constexpr int STAGE = 49152;
    for (int tile = blockIdx.x; tile < ntiles; tile += gridDim.x) {
        const int tm = tile % ntm, tn = tile / ntm;
        const int m0 = tm * 256, n0 = tn * 128;
        f32x4 acc[4][4];
#pragma unroll
        for (int mi = 0; mi < 4; ++mi)
#pragma unroll
            for (int ni = 0; ni < 4; ++ni) acc[mi][ni] = (f32x4){0.f, 0.f, 0.f, 0.f};
        const bf16_t* Ag = A + (size_t)m0 * K;
        const bf16_t* Bg = Bt + (size_t)n0 * K;
        const bf16_t* ag = Ag + (size_t)(wave * 32 + (lane >> 3)) * K + (((lane & 7) ^ (lane >> 3)) << 3);
        const bf16_t* bg = Bg + (size_t)(wave * 16 + (lane >> 3)) * K + (((lane & 7) ^ (lane >> 3)) << 3);
        auto stage = [&](int t) {
            unsigned char* dst = smem + (t % 3) * STAGE;
            const int k0 = t << 6;
#pragma unroll
            for (int j = 0; j < 4; ++j)
                __builtin_amdgcn_global_load_lds((const unsigned*)(ag + (size_t)j * 8 * K + k0), (LAS unsigned*)(dst + (wave * 4 + j) * 1024), 16, 0, 0);
#pragma unroll
            for (int j = 0; j < 2; ++j)
                __builtin_amdgcn_global_load_lds((const unsigned*)(bg + (size_t)j * 8 * K + k0), (LAS unsigned*)(dst + 32768 + (wave * 2 + j) * 1024), 16, 0, 0);
        };
        auto read_half = [&](int t, int kk, bf16x8 (&af)[4], bf16x8 (&bfr)[4]) {
            const unsigned char* cur = smem + (t % 3) * STAGE;
#pragma unroll
            for (int mi = 0; mi < 4; ++mi) {
                const int row = wm * 64 + mi * 16 + lr;
                af[mi] = *(const bf16x8*)(cur + row * 128 + (((kk * 4 + g) ^ (row & 7)) << 4));
            }
#pragma unroll
            for (int ni = 0; ni < 4; ++ni) {
                const int row = wn * 64 + ni * 16 + lr;
                bfr[ni] = *(const bf16x8*)(cur + 32768 + row * 128 + (((kk * 4 + g) ^ (row & 7)) << 4));
            }
        };
        stage(0); stage(1); stage(2);
        bf16x8 a0[4], b0[4], a1[4], b1[4];
        asm volatile("s_waitcnt vmcnt(12)" ::: "memory");
        asm volatile("s_waitcnt lgkmcnt(0)" ::: "memory");
        __builtin_amdgcn_s_barrier();
        read_half(0, 0, a0, b0);
        for (int kt = 0; kt < nk; ++kt) {
            read_half(kt, 1, a1, b1);
#pragma unroll
            for (int mi = 0; mi < 4; ++mi)
#pragma unroll
                for (int ni = 0; ni < 4; ++ni) acc[mi][ni] = mfma16(a0[mi], b0[ni], acc[mi][ni]);
            __builtin_amdgcn_sched_barrier(0);
            if (kt + 2 < nk) asm volatile("s_waitcnt vmcnt(6)" ::: "memory");
            else asm volatile("s_waitcnt vmcnt(0)" ::: "memory");
            asm volatile("s_waitcnt lgkmcnt(0)" ::: "memory");
            __builtin_amdgcn_s_barrier();
            if (kt + 1 < nk) read_half(kt + 1, 0, a0, b0);
            if (kt + 3 < nk) stage(kt + 3);
#pragma unroll
            for (int mi = 0; mi < 4; ++mi)
#pragma unroll
                for (int ni = 0; ni < 4; ++ni) acc[mi][ni] = mfma16(a1[mi], b1[ni], acc[mi][ni]);
            __builtin_amdgcn_sched_barrier(0);
        }
        asm volatile("s_waitcnt lgkmcnt(0)" ::: "memory");
        __builtin_amdgcn_s_barrier();
        if (EPI == EPI_LN1 || EPI == EPI_LN2) {
            const int rb = m0 + wm * 64, cb = n0 + wn * 64;
            const int cnd = rb < NCTX ? 0 : 1 + ((rb - NCTX) >> 10);
            const float* gp = (const float*)(ws_ + OFF_MOD) + (size_t)(layer * 3 + cnd) * 6144 + (EPI == EPI_LN1 ? 2048 : 5120) + cb + lr;
            const float* xp = (const float*)(ws_ + OFF_X) + (size_t)(rb + 4 * g) * 1024 + cb + lr;
            float gt[4];
#pragma unroll
            for (int ni = 0; ni < 4; ++ni) gt[ni] = gp[ni * 16];
#pragma unroll
            for (int mh = 0; mh < 2; ++mh) {
                f32x4 xv[2][4];
#pragma unroll
                for (int m2 = 0; m2 < 2; ++m2)
#pragma unroll
                    for (int ni = 0; ni < 4; ++ni)
#pragma unroll
                        for (int i = 0; i < 4; ++i) xv[m2][ni][i] = xp[(size_t)((mh * 2 + m2) * 16 + i) * 1024 + ni * 16];
#pragma unroll
                for (int m2 = 0; m2 < 2; ++m2)
#pragma unroll
                    for (int ni = 0; ni < 4; ++ni)
#pragma unroll
                        for (int i = 0; i < 4; ++i) acc[mh * 2 + m2][ni][i] = ALPHA * xv[m2][ni][i] + gt[ni] * acc[mh * 2 + m2][ni][i];
                __builtin_amdgcn_sched_barrier(0);
            }
        }
        float* T = (float*)smem + wave * (64 * 65);
#pragma unroll
        for (int mi = 0; mi < 4; ++mi)
#pragma unroll
            for (int ni = 0; ni < 4; ++ni)
#pragma unroll
                for (int i = 0; i < 4; ++i) T[(mi * 16 + 4 * g + i) * 65 + ni * 16 + lr] = acc[mi][ni][i];
        const int rowbase = m0 + wm * 64, colbase = n0 + wn * 64;
        if (EPI == EPI_INPROJ) {
            epi_inproj(p, ws_, out_, layer, T, rowbase, colbase, lane);
        } else if (EPI == EPI_LN1) {
            epi_ln<1>(p, ws_, out_, layer, T, tm, tn, wn, rowbase, colbase, lane, tid);
        } else if (EPI == EPI_LN2) {
            epi_ln<2>(p, ws_, out_, layer, T, tm, tn, wn, rowbase, colbase, lane, tid);
        } else {
            bf16_t* U = (bf16_t*)(ws_ + OFF_U) + (size_t)rowbase * ldc + colbase + lane;
#pragma unroll 4
            for (int r = 0; r < 64; ++r) { const float v = fmaxf(T[r * 65 + lane], 0.f); U[(size_t)r * ldc] = f2bf(v * v); }
        }
        __syncthreads();
    }
}

template <int NMAP, int DV>
struct AttnSt { f32x4 O[NMAP][DV / 16]; float m[NMAP]; float l[NMAP]; };
template <int NMAP, int DV>
struct UnitFrags { bf16x8 k[NMAP][2][2]; bf16x8 v[DV / 16]; };

template <int NMAP, int DV>
struct TileGeom {
    static constexpr int KROW = NMAP * 128, KBYTES = 64 * KROW, VUNIT = DV * 64, TBYTES = KBYTES + 2 * VUNIT;
};
DI int kswz(int row) { return (row & 3) | (((row >> 3) & 3) << 2); }

template <int NMAP, int DV>
DI void stage_tile(unsigned char* buf, const bf16_t* kg, int kstride, const bf16_t* vg, int vunit, int wave, int lane) {
    typedef TileGeom<NMAP, DV> TG;
    if (NMAP == 2) {
#pragma unroll
        for (int j = 0; j < 4; ++j) {
            const int jj = wave * 4 + j, row = jj * 4 + (lane >> 4), lc = (lane & 15) ^ kswz(row);
            __builtin_amdgcn_global_load_lds((const unsigned*)(kg + (size_t)row * kstride + lc * 8), (LAS unsigned*)(buf + jj * 1024), 16, 0, 0);
        }
    } else {
#pragma unroll
        for (int j = 0; j < 2; ++j) {
            const int jj = wave * 2 + j, row = jj * 8 + (lane >> 3), lc = (lane & 7) ^ (kswz(row) >> 1);
            __builtin_amdgcn_global_load_lds((const unsigned*)(kg + (size_t)row * kstride + lc * 8), (LAS unsigned*)(buf + jj * 1024), 16, 0, 0);
        }
    }
    constexpr int VI = TG::VUNIT / 1024, PER = 2 * VI / 4;
#pragma unroll
    for (int j = 0; j < PER; ++j) {
        const int jj = wave * PER + j, unit = jj / VI, piece = jj % VI;
        __builtin_amdgcn_global_load_lds((const unsigned*)(vg + (size_t)unit * vunit + piece * 512 + lane * 8),
                                         (LAS unsigned*)(buf + TG::KBYTES + jj * 1024), 16, 0, 0);
    }
}

template <int NMAP, int DV>
DI void lds_unit(UnitFrags<NMAP, DV>& f, const unsigned char* buf, int rowbase, int voff, int lr, int g) {
    typedef TileGeom<NMAP, DV> TG;
#pragma unroll
    for (int b = 0; b < 2; ++b) {
        const int row = rowbase + (lr >> 2) * 8 + (lr & 3) + 4 * b, sw = kswz(row);
        if (NMAP == 2) {
#pragma unroll
            for (int m = 0; m < NMAP; ++m)
#pragma unroll
                for (int kk = 0; kk < 2; ++kk) f.k[m][b][kk] = *(const bf16x8*)(buf + row * 256 + (((m * 8 + kk * 4 + g) ^ sw) << 4));
        } else {
#pragma unroll
            for (int kk = 0; kk < 2; ++kk) f.k[0][b][kk] = *(const bf16x8*)(buf + row * 128 + (((kk * 4 + g) ^ (sw >> 1)) << 4));
        }
    }
#pragma unroll
    for (int vb = 0; vb < DV / 16; ++vb) f.v[vb] = *(const bf16x8*)(buf + TG::KBYTES + voff + (vb * 16 + lr) * 64);
}

template <int DV>
DI void lds_unit_sel(UnitFrags<1, DV>& f, const unsigned char* buf, int rowbase, int voff, int lr, int g, int msel) {
    typedef TileGeom<2, DV> TG;
#pragma unroll
    for (int b = 0; b < 2; ++b) {
        const int row = rowbase + (lr >> 2) * 8 + (lr & 3) + 4 * b, sw = kswz(row);
#pragma unroll
        for (int kk = 0; kk < 2; ++kk) f.k[0][b][kk] = *(const bf16x8*)(buf + row * 256 + (((msel * 8 + kk * 4 + g) ^ sw) << 4));
    }
#pragma unroll
    for (int vb = 0; vb < DV / 16; ++vb) f.v[vb] = *(const bf16x8*)(buf + TG::KBYTES + voff + (vb * 16 + lr) * 64);
}

template <int NMAP, int DV, class SrcFn, class CompFn>
DI void tile_pipeline(unsigned char* tiles, int nt, int wave, int lane, SrcFn src, CompFn comp) {
    typedef TileGeom<NMAP, DV> TG;
    {
        const bf16_t *kg, *vg; int ks, vu;
        src(0, kg, ks, vg, vu);
        stage_tile<NMAP, DV>(tiles, kg, ks, vg, vu, wave, lane);
    }
    asm volatile("s_waitcnt vmcnt(0)" ::: "memory");
    __syncthreads();
    for (int t = 0; t < nt; ++t) {
        unsigned char* cur = tiles + (t & 1) * TG::TBYTES;
        if (t + 1 < nt) {
            const bf16_t *kg, *vg; int ks, vu;
            src(t + 1, kg, ks, vg, vu);
            stage_tile<NMAP, DV>(tiles + ((t + 1) & 1) * TG::TBYTES, kg, ks, vg, vu, wave, lane);
        }
        comp(t, cur);
        asm volatile("s_waitcnt vmcnt(0)" ::: "memory");
        __syncthreads();
    }
}

template <int NMAP, int DV, bool HASBIAS>
DI void compute_unit(AttnSt<NMAP, DV>& st, const UnitFrags<NMAP, DV>& f, const bf16x8 (&qf)[NMAP][2], float sc, const float (&bias)[8]) {
    bf16x8 pk[NMAP];
#pragma unroll
    for (int m = 0; m < NMAP; ++m) {
        f32x4 sa = (f32x4){0.f, 0.f, 0.f, 0.f}, sb = sa;
        sa = mfma16(f.k[m][0][0], qf[m][0], sa); sa = mfma16(f.k[m][0][1], qf[m][1], sa);
        sb = mfma16(f.k[m][1][0], qf[m][0], sb); sb = mfma16(f.k[m][1][1], qf[m][1], sb);
        float s[8];
#pragma unroll
        for (int j = 0; j < 4; ++j) { s[j] = sa[j] * sc; s[4 + j] = sb[j] * sc; }
        if (HASBIAS) {
#pragma unroll
            for (int j = 0; j < 8; ++j) s[j] += bias[j];
        }
        float mx = fmaxf(fmaxf(fmaxf(s[0], s[1]), fmaxf(s[2], s[3])), fmaxf(fmaxf(s[4], s[5]), fmaxf(s[6], s[7])));
        mx = grp_max(mx);
        const float mnew = fmaxf(st.m[m], mx);
        const float alpha = fexp2(st.m[m] - mnew);
        float ps = 0.f;
#pragma unroll
        for (int j = 0; j < 8; ++j) { s[j] = fexp2(s[j] - mnew); ps += s[j]; }
        st.l[m] = st.l[m] * alpha + ps; st.m[m] = mnew;
        if (__builtin_amdgcn_ballot_w64(alpha != 1.f) != 0ull) {
#pragma unroll
            for (int vb = 0; vb < DV / 16; ++vb) st.O[m][vb] *= alpha;
        }
        pk[m] = pack8(s[0], s[1], s[2], s[3], s[4], s[5], s[6], s[7]);
    }
#pragma unroll
    for (int vb = 0; vb < DV / 16; ++vb) {
#pragma unroll
        for (int m = 0; m < NMAP; ++m) st.O[m][vb] = mfma16(f.v[vb], pk[m], st.O[m][vb]);
    }
}

template <int NMAP, int DV>
DI void attn_init(AttnSt<NMAP, DV>& st) {
#pragma unroll
    for (int m = 0; m < NMAP; ++m) {
        st.m[m] = -INFINITY; st.l[m] = 0.f;
#pragma unroll
        for (int vb = 0; vb < DV / 16; ++vb) st.O[m][vb] = (f32x4){0.f, 0.f, 0.f, 0.f};
    }
}

template <bool LAT>
DI void item_diffattn(const Params& pin, int l, int seq, int h, int qt, unsigned char* smem, int wave, int lane) {
    const Params& p = pin; unsigned char* const ws_ = opaque_ws(pin.ws); float* const out_ = opaque_out(pin.out); lane = opaque_v(lane); wave = opaque_s(wave);
    const int lr = lane & 15, g = lane >> 4;
    const int nseq = LAT ? 1024 : 256;
    const int tok0 = LAT ? NCTX + seq * 1024 : seq * 256;
    const bf16_t* P = (const bf16_t*)(ws_ + OFF_P);
    const int q0 = qt * 64 + wave * 16;
    bf16x8 qf[2][2];
    {
        const bf16_t* qp = P + (size_t)(tok0 + q0 + lr) * NIN + h * 128 + 8 * g;
#pragma unroll
        for (int m = 0; m < 2; ++m)
#pragma unroll
            for (int kk = 0; kk < 2; ++kk) qf[m][kk] = *(const bf16x8*)(qp + m * 64 + kk * 32);
    }
    AttnSt<2, 128> st;
    attn_init<2, 128>(st);
    const float sc = 0.125f * LOG2E;
    const size_t hb = (size_t)((seq * 4 + l) * 4 + h);
    const bf16_t* kc = (const bf16_t*)(ws_ + OFF_CAK) + hb * 512 * 128;
    const bf16_t* vc = (const bf16_t*)(ws_ + OFF_CAVT) + hb * 128 * 512;
    const bf16_t* kn = P + (size_t)tok0 * NIN + 512 + h * 128;
    const bf16_t* vn = (const bf16_t*)(ws_ + OFF_PT_AV) + (size_t)tok0 * 512 + (size_t)(h * 128) * 32;
    const int ncache = LAT ? 8 : 0;
    __syncthreads();
    tile_pipeline<2, 128>(smem, ncache + nseq / 64, wave, lane,
        [&](int t, const bf16_t*& kg, int& ks, const bf16_t*& vg, int& vu) {
            if (t < ncache) { kg = kc + (size_t)t * 64 * 128; ks = 128; vg = vc + (size_t)(2 * t) * 128 * 32; vu = 128 * 32; }
            else { const int tt = t - ncache; kg = kn + (size_t)tt * 64 * NIN; ks = NIN; vg = vn + (size_t)(2 * tt) * 512 * 32; vu = 512 * 32; }
        },
        [&](int t, const unsigned char* buf) {
            const float nob[8] = {0.f, 0.f, 0.f, 0.f, 0.f, 0.f, 0.f, 0.f};
#pragma unroll 1
            for (int half = 0; half < 2; ++half) {
                UnitFrags<2, 128> f;
                lds_unit<2, 128>(f, buf, 32 * half, half * TileGeom<2, 128>::VUNIT + g * 16, lr, g);
                compute_unit<2, 128, false>(st, f, qf, sc, nob);
            }
        });
    const float inv0 = 1.f / grp_sum(st.l[0]), inv1 = 1.f / grp_sum(st.l[1]);
    const float* lamp = (const float*)(ws_ + OFF_LAM);
    const float lam = lamp[l * 2], lam_init = lamp[l * 2 + 1];
    const float c1 = lam * inv1;
    float ss = 0.f;
#pragma unroll
    for (int vb = 0; vb < 8; ++vb)
#pragma unroll
        for (int i = 0; i < 4; ++i) {
            const float o = st.O[0][vb][i] * inv0 - st.O[1][vb][i] * c1;
            st.O[0][vb][i] = o; ss += o * o;
        }
    ss = grp_sum(ss);
    const float r = rsqrtf(ss * (1.f / 128.f) + LN_EPS) * (1.f - lam_init);
    bf16_t* MIX = (bf16_t*)(ws_ + OFF_MIX) + (size_t)(tok0 + q0 + lr) * 1024 + h * 128;
    const float* gn = p.diff_norm_g + l * 128;
#pragma unroll
    for (int vb = 0; vb < 8; ++vb) {
        const int v = vb * 16 + 4 * g;
        const float4 g4 = *(const float4*)(gn + v);
        uint2 o; o.x = pack2(st.O[0][vb][0] * r * g4.x, st.O[0][vb][1] * r * g4.y);
        o.y = pack2(st.O[0][vb][2] * r * g4.z, st.O[0][vb][3] * r * g4.w);
        *(uint2*)(MIX + v) = o;
    }
}

DI void item_diffattn_lat(const Params& pin, int l, int seq, int h, int qt32, unsigned char* smem, int wave, int lane) {
    const Params& p = pin; unsigned char* const ws_ = opaque_ws(pin.ws); float* const out_ = opaque_out(pin.out); lane = opaque_v(lane); wave = opaque_s(wave);
    const int lr = lane & 15, g = lane >> 4;
    const int tok0 = NCTX + seq * 1024;
    const bf16_t* P = (const bf16_t*)(ws_ + OFF_P);
    const int msel = wave & 1;
    const int q0 = qt32 * 32 + (wave >> 1) * 16;
    bf16x8 qf[1][2];
    {
        const bf16_t* qp = P + (size_t)(tok0 + q0 + lr) * NIN + h * 128 + msel * 64 + 8 * g;
        qf[0][0] = *(const bf16x8*)(qp); qf[0][1] = *(const bf16x8*)(qp + 32);
    }
    AttnSt<1, 128> st;
    attn_init<1, 128>(st);
    const float sc = 0.125f * LOG2E;
    const size_t hb = (size_t)((seq * 4 + l) * 4 + h);
    const bf16_t* kc = (const bf16_t*)(ws_ + OFF_CAK) + hb * 512 * 128;
    const bf16_t* vc = (const bf16_t*)(ws_ + OFF_CAVT) + hb * 128 * 512;
    const bf16_t* kn = P + (size_t)tok0 * NIN + 512 + h * 128;
    const bf16_t* vn = (const bf16_t*)(ws_ + OFF_PT_AV) + (size_t)tok0 * 512 + (size_t)(h * 128) * 32;
    __syncthreads();
    tile_pipeline<2, 128>(smem, 24, wave, lane,
        [&](int t, const bf16_t*& kg, int& ks, const bf16_t*& vg, int& vu) {
            if (t < 8) { kg = kc + (size_t)t * 64 * 128; ks = 128; vg = vc + (size_t)(2 * t) * 128 * 32; vu = 128 * 32; }
            else { const int tt = t - 8; kg = kn + (size_t)tt * 64 * NIN; ks = NIN; vg = vn + (size_t)(2 * tt) * 512 * 32; vu = 512 * 32; }
        },
        [&](int t, const unsigned char* buf) {
            const float nob[8] = {0.f, 0.f, 0.f, 0.f, 0.f, 0.f, 0.f, 0.f};
#pragma unroll
            for (int half = 0; half < 2; ++half) {
                UnitFrags<1, 128> f;
                lds_unit_sel<128>(f, buf, 32 * half, half * TileGeom<2, 128>::VUNIT + g * 16, lr, g, msel);
                compute_unit<1, 128, false>(st, f, qf, sc, nob);
            }
        });
    const float* lamp = (const float*)(ws_ + OFF_LAM);
    const float lam = lamp[l * 2], lam_init = lamp[l * 2 + 1];
    const float inv = (msel ? lam : 1.f) / grp_sum(st.l[0]);
    float* xb = (float*)smem + (wave >> 1) * 32 * 64 + lane;
    if (msel) {
#pragma unroll
        for (int vb = 0; vb < 8; ++vb)
#pragma unroll
            for (int i = 0; i < 4; ++i) xb[(vb * 4 + i) * 64] = st.O[0][vb][i] * inv;
    }
    __syncthreads();
    if (msel) return;
    float ss = 0.f;
#pragma unroll
    for (int vb = 0; vb < 8; ++vb)
#pragma unroll
        for (int i = 0; i < 4; ++i) {
            const float o = st.O[0][vb][i] * inv - xb[(vb * 4 + i) * 64];
            st.O[0][vb][i] = o; ss += o * o;
        }
    ss = grp_sum(ss);
    const float r = rsqrtf(ss * (1.f / 128.f) + LN_EPS) * (1.f - lam_init);
    bf16_t* MIX = (bf16_t*)(ws_ + OFF_MIX) + (size_t)(tok0 + q0 + lr) * 1024 + h * 128;
    const float* gn = p.diff_norm_g + l * 128;
#pragma unroll
    for (int vb = 0; vb < 8; ++vb) {
        const int v = vb * 16 + 4 * g;
        const float4 g4 = *(const float4*)(gn + v);
        uint2 o; o.x = pack2(st.O[0][vb][0] * r * g4.x, st.O[0][vb][1] * r * g4.y);
        o.y = pack2(st.O[0][vb][2] * r * g4.z, st.O[0][vb][3] * r * g4.w);
        *(uint2*)(MIX + v) = o;
    }
}

DI void item_dense(const Params& pin, int seq, int h, int qt, unsigned char* smem, int wave, int lane) {
    const Params& p = pin; unsigned char* const ws_ = opaque_ws(pin.ws); float* const out_ = opaque_out(pin.out); lane = opaque_v(lane); wave = opaque_s(wave);
    const int lr = lane & 15, g = lane >> 4;
    const int tok0 = seq * 256;
    const bf16_t* P = (const bf16_t*)(ws_ + OFF_P);
    const int q0 = qt * 64 + wave * 16;
    bf16x8 qf[1][2];
    {
        const bf16_t* qp = P + (size_t)(tok0 + q0 + lr) * NIN + 1536 + h * 64 + 8 * g;
        qf[0][0] = *(const bf16x8*)(qp); qf[0][1] = *(const bf16x8*)(qp + 32);
    }
    AttnSt<1, 64> st;
    attn_init<1, 64>(st);
    const bf16_t* kn = P + (size_t)tok0 * NIN + 1792 + h * 64;
    const bf16_t* vn = (const bf16_t*)(ws_ + OFF_PT_BV) + (size_t)tok0 * 256 + (size_t)(h * 64) * 32;
    const float sc = 0.125f * LOG2E;
    __syncthreads();
    tile_pipeline<1, 64>(smem, 4, wave, lane,
        [&](int t, const bf16_t*& kg, int& ks, const bf16_t*& vg, int& vu) {
            kg = kn + (size_t)t * 64 * NIN; ks = NIN; vg = vn + (size_t)(2 * t) * 256 * 32; vu = 256 * 32;
        },
        [&](int t, const unsigned char* buf) {
            const float nob[8] = {0.f, 0.f, 0.f, 0.f, 0.f, 0.f, 0.f, 0.f};
#pragma unroll
            for (int half = 0; half < 2; ++half) {
                UnitFrags<1, 64> f;
                lds_unit<1, 64>(f, buf, 32 * half, half * TileGeom<1, 64>::VUNIT + g * 16, lr, g);
                compute_unit<1, 64, false>(st, f, qf, sc, nob);
            }
        });
    const float inv = 1.f / grp_sum(st.l[0]);
    bf16_t* MIX = (bf16_t*)(ws_ + OFF_MIX) + (size_t)(tok0 + q0 + lr) * 1024 + 512 + h * 64;
#pragma unroll
    for (int vb = 0; vb < 4; ++vb) {
        uint2 o; o.x = pack2(st.O[0][vb][0] * inv, st.O[0][vb][1] * inv); o.y = pack2(st.O[0][vb][2] * inv, st.O[0][vb][3] * inv);
        *(uint2*)(MIX + vb * 16 + 4 * g) = o;
    }
}

DI void item_na(const Params& pin, int l, int sb, int h, int r, unsigned char* smem, int wave, int lane) {
    const Params& p = pin; unsigned char* const ws_ = opaque_ws(pin.ws); float* const out_ = opaque_out(pin.out); lane = opaque_v(lane); wave = opaque_s(wave);
    const int lr = lane & 15, g = lane >> 4;
    const int tok0 = NCTX + sb * 1024;
    const bf16_t* P = (const bf16_t*)(ws_ + OFF_P);
    const int qc = wave * 16 + lr;
    const int q0 = r * 64 + wave * 16;
    bf16x8 qf[1][2];
    {
        const bf16_t* qp = P + (size_t)(tok0 + q0 + lr) * NIN + 1536 + h * 64 + 8 * g;
        qf[0][0] = *(const bf16x8*)(qp); qf[0][1] = *(const bf16x8*)(qp + 32);
    }
    AttnSt<1, 64> st;
    attn_init<1, 64>(st);
    const float sc = 0.125f * LOG2E;
    const size_t hb = (size_t)((sb * 4 + l) * 4 + h);
    const bf16_t* kc = (const bf16_t*)(ws_ + OFF_CBK) + hb * 512 * 64;
    const bf16_t* vc = (const bf16_t*)(ws_ + OFF_CBVT) + hb * 64 * 512;
    const bf16_t* kn = P + (size_t)tok0 * NIN + 1792 + h * 64;
    const bf16_t* vn = (const bf16_t*)(ws_ + OFF_PT_BV) + (size_t)tok0 * 256 + (size_t)(h * 64) * 32;
    const int kr0 = min(max(r - 4, 0), 8);
    const int bs = min(max(wave * 16 - 8, 0), 32);
    const int wstart = min(max(qc - 8, 0), 48);
    const float* rpb = p.nat_rpb + (size_t)(l * 4 + h) * 15 * 31;
    __syncthreads();
    tile_pipeline<1, 64>(smem, 16, wave, lane,
        [&](int t, const bf16_t*& kg, int& ks, const bf16_t*& vg, int& vu) {
            if (t < 8) { kg = kc + (size_t)t * 64 * 64; ks = 64; vg = vc + (size_t)(2 * t) * 64 * 32; vu = 64 * 32; }
            else { const int kr = kr0 + t - 8; kg = kn + (size_t)kr * 64 * NIN; ks = NIN; vg = vn + (size_t)(2 * kr) * 256 * 32; vu = 256 * 32; }
        },
        [&](int t, const unsigned char* buf) {
            if (t < 8) {
                const float nob[8] = {0.f, 0.f, 0.f, 0.f, 0.f, 0.f, 0.f, 0.f};
#pragma unroll
                for (int half = 0; half < 2; ++half) {
                    UnitFrags<1, 64> f;
                    lds_unit<1, 64>(f, buf, 32 * half, half * TileGeom<1, 64>::VUNIT + g * 16, lr, g);
                    compute_unit<1, 64, false>(st, f, qf, sc, nob);
                }
            } else {
                const int kr = kr0 + t - 8;
                const int nl = bs + 8 * g;
                UnitFrags<1, 64> f;
                lds_unit<1, 64>(f, buf, bs, (nl >> 5) * TileGeom<1, 64>::VUNIT + (nl & 31) * 2, lr, g);
                float bias[8];
                const float* rrow = rpb + (kr - r + 7) * 31;
#pragma unroll
                for (int j = 0; j < 8; ++j) {
                    const int kcol = bs + 8 * g + j;
                    const bool valid = (kcol >= wstart) && (kcol < wstart + 16);
                    const int dc = min(max(kcol - qc + 15, 0), 30);
                    bias[j] = valid ? rrow[dc] * LOG2E : -INFINITY;
                }
                compute_unit<1, 64, true>(st, f, qf, sc, bias);
            }
        });
    const float inv = 1.f / grp_sum(st.l[0]);
    bf16_t* MIX = (bf16_t*)(ws_ + OFF_MIX) + (size_t)(tok0 + q0 + lr) * 1024 + 512 + h * 64;
#pragma unroll
    for (int vb = 0; vb < 4; ++vb) {
        uint2 o; o.x = pack2(st.O[0][vb][0] * inv, st.O[0][vb][1] * inv); o.y = pack2(st.O[0][vb][2] * inv, st.O[0][vb][3] * inv);
        *(uint2*)(MIX + vb * 16 + 4 * g) = o;
    }
}

DI float wave_excl_sum(float v, int lane) {
    float x = v;
#pragma unroll
    for (int d = 1; d < 64; d <<= 1) { const float y = __shfl_up(x, d); if (lane >= d) x += y; }
    return x - v;
}
DI float wave_excl_max(float v, int lane, float init) {
    float x = v;
#pragma unroll
    for (int d = 1; d < 64; d <<= 1) { const float y = __shfl_up(x, d); if (lane >= d) x = fmaxf(x, y); }
    const float ex = __shfl_up(x, 1);
    return lane == 0 ? init : fmaxf(init, ex);
}
DI void mlstm_scan(const float* __restrict__ G, int h, int nseq, int dir, float* aA, float* MA, float* FA, float m0, int lane) {
    const int per = nseq >> 6;
    float run = 0.f;
    for (int e = 0; e < per; ++e) {
        const int idx = lane * per + e, pos = dir ? nseq - 1 - idx : idx;
        const float f = G[(size_t)pos * 16 + (dir ? 12 : 4) + h];
        const float lf = fminf(f, 0.f) - __logf(1.f + __expf(-fabsf(f)));
        run += lf; FA[pos] = run;
    }
    const float off = wave_excl_sum(run, lane);
    float rmax = -INFINITY;
    for (int e = 0; e < per; ++e) {
        const int idx = lane * per + e, pos = dir ? nseq - 1 - idx : idx;
        const float F = FA[pos] + off; FA[pos] = F;
        const float a = G[(size_t)pos * 16 + (dir ? 8 : 0) + h] - F;
        aA[pos] = a; rmax = fmaxf(rmax, a); MA[pos] = rmax;
    }
    const float pre = wave_excl_max(rmax, lane, m0);
    for (int e = 0; e < per; ++e) {
        const int idx = lane * per + e, pos = dir ? nseq - 1 - idx : idx;
        MA[pos] = fmaxf(MA[pos], pre);
    }
}

DI void mlstm_unit(f32x4 (&O)[4], float& den, int dir, int t, const bf16x8 (&qf)[2], const UnitFrags<1, 64>& f, const float* aA, float Mt, int key0, int g) {
    f32x4 sa = (f32x4){0.f, 0.f, 0.f, 0.f}, sb = sa;
    sa = mfma16(f.k[0][0][0], qf[0], sa); sa = mfma16(f.k[0][0][1], qf[1], sa);
    sb = mfma16(f.k[0][1][0], qf[0], sb); sb = mfma16(f.k[0][1][1], qf[1], sb);
    const float4 a0 = *(const float4*)(aA + key0 + 8 * g), a1 = *(const float4*)(aA + key0 + 8 * g + 4);
    const float av[8] = {a0.x, a0.y, a0.z, a0.w, a1.x, a1.y, a1.z, a1.w};
    float pv[8];
#pragma unroll
    for (int j = 0; j < 8; ++j) {
        const int key = key0 + 8 * g + j;
        const bool ok = dir ? (key >= t) : (key <= t);
        const float w = ok ? fexp2((av[j] - Mt) * LOG2E) : 0.f;
        const float sv = (j < 4) ? sa[j & 3] : sb[j & 3];
        pv[j] = sv * 0.125f * w;
        den += pv[j];
    }
    const bf16x8 pk = pack8(pv[0], pv[1], pv[2], pv[3], pv[4], pv[5], pv[6], pv[7]);
#pragma unroll
    for (int vb = 0; vb < 4; ++vb) O[vb] = mfma16(f.v[vb], pk, O[vb]);
}

template <bool LAT>
DI void item_mlstm(const Params& pin, int l, int seq, int h, int qt, unsigned char* smem, int wave, int lane) {
    const Params& p = pin; unsigned char* const ws_ = opaque_ws(pin.ws); float* const out_ = opaque_out(pin.out); lane = opaque_v(lane); wave = opaque_s(wave);
    const int lr = lane & 15, g = lane >> 4;
    const int nseq = LAT ? 1024 : 256;
    const int tok0 = LAT ? NCTX + seq * 1024 : seq * 256;
    float* aF = (float*)smem; float* MF = aF + 1024; float* FF = MF + 1024;
    float* aB = FF + 1024; float* MB = aB + 1024; float* FB = MB + 1024;
    unsigned char* tiles = smem + 24576;
    const float* G = (const float*)(ws_ + OFF_G) + (size_t)tok0 * 16;
    float m0f = 0.f, m0b = 0.f;
    const int sidx_f = ((seq * 4 + l) * 2 + 0) * 4 + h, sidx_b = ((seq * 4 + l) * 2 + 1) * 4 + h;
    if (LAT) { m0f = p.state_m[sidx_f]; m0b = p.state_m[sidx_b]; }
    __syncthreads();
    if (wave == 0) mlstm_scan(G, h, nseq, 0, aF, MF, FF, m0f, lane);
    if (wave == 1) mlstm_scan(G, h, nseq, 1, aB, MB, FB, m0b, lane);
    __syncthreads();
    const bf16_t* P = (const bf16_t*)(ws_ + OFF_P);
    const int q0 = qt * 64 + wave * 16;
    const int t = q0 + lr;
    bf16x8 qf[2];
    {
        const bf16_t* qp = P + (size_t)(tok0 + t) * NIN + 2304 + h * 64 + 8 * g;
        qf[0] = *(const bf16x8*)(qp); qf[1] = *(const bf16x8*)(qp + 32);
    }
    const bf16_t* kn = P + (size_t)tok0 * NIN + 2560 + h * 64;
    const bf16_t* vn = (const bf16_t*)(ws_ + OFF_PT_CV) + (size_t)tok0 * 256 + (size_t)(h * 64) * 32;
    const float Mf = MF[t], Mb = MB[t], Ff = FF[t], Fb = FB[t];
    f32x4 Of[4], Ob[4];
#pragma unroll
    for (int vb = 0; vb < 4; ++vb) { Of[vb] = (f32x4){0.f, 0.f, 0.f, 0.f}; Ob[vb] = Of[vb]; }
    float denf = 0.f, denb = 0.f;
    tile_pipeline<1, 64>(tiles, nseq / 64, wave, lane,
        [&](int tt, const bf16_t*& kg, int& ks, const bf16_t*& vg, int& vu) {
            kg = kn + (size_t)tt * 64 * NIN; ks = NIN; vg = vn + (size_t)(2 * tt) * 256 * 32; vu = 256 * 32;
        },
        [&](int tt, const unsigned char* buf) {
#pragma unroll
            for (int half = 0; half < 2; ++half) {
                const int key0 = tt * 64 + half * 32;
                const bool dof = key0 <= q0 + 15, dob = key0 + 31 >= q0;
                if (dof || dob) {
                    UnitFrags<1, 64> f;
                    lds_unit<1, 64>(f, buf, 32 * half, half * TileGeom<1, 64>::VUNIT + g * 16, lr, g);
                    if (dof) mlstm_unit(Of, denf, 0, t, qf, f, aF, Mf, key0, g);
                    if (dob) mlstm_unit(Ob, denb, 1, t, qf, f, aB, Mb, key0, g);
                }
            }
        });
    if (LAT) {
        const bf16_t* qp2 = P + (size_t)(tok0 + t) * NIN + 2304 + h * 64 + 4 * g;
#pragma unroll
        for (int dir = 0; dir < 2; ++dir) {
            const int sidx = dir ? sidx_b : sidx_f;
            const float e = fexp2(((dir ? m0b : m0f) - (dir ? Mb : Mf)) * LOG2E) * 0.125f;
            const bf16_t* c0t = (const bf16_t*)(ws_ + OFF_C0T) + (size_t)sidx * 4096 + lr * 64 + 4 * g;
            const float* n0 = p.state_n + (size_t)sidx * 64;
            float dacc = 0.f;
#pragma unroll
            for (int u2 = 0; u2 < 2; ++u2) {
                const bf16x4 qa = *(const bf16x4*)(qp2 + u2 * 32), qb = *(const bf16x4*)(qp2 + u2 * 32 + 16);
                const float4 na = *(const float4*)(n0 + u2 * 32 + 4 * g), nb = *(const float4*)(n0 + u2 * 32 + 16 + 4 * g);
                float pv[8];
#pragma unroll
                for (int j = 0; j < 4; ++j) { pv[j] = bf2f((unsigned short)qa[j]) * e; pv[4 + j] = bf2f((unsigned short)qb[j]) * e; }
                dacc += pv[0] * na.x + pv[1] * na.y + pv[2] * na.z + pv[3] * na.w + pv[4] * nb.x + pv[5] * nb.y + pv[6] * nb.z + pv[7] * nb.w;
                const bf16x8 pk = pack8(pv[0], pv[1], pv[2], pv[3], pv[4], pv[5], pv[6], pv[7]);
#pragma unroll
                for (int vb = 0; vb < 4; ++vb) {
                    const bf16_t* cp = c0t + (size_t)vb * 16 * 64 + u2 * 32;
                    const bf16x8 cf = cat4(*(const bf16x4*)(cp), *(const bf16x4*)(cp + 16));
                    if (dir) Ob[vb] = mfma16(cf, pk, Ob[vb]); else Of[vb] = mfma16(cf, pk, Of[vb]);
                }
            }
            if (dir) denb += dacc; else denf += dacc;
        }
    }
    denf = grp_sum(denf); denb = grp_sum(denb);
    const float rf = 1.f / fmaxf(fabsf(denf), expf(-(Ff + Mf)));
    const float rb = 1.f / fmaxf(fabsf(denb), expf(-(Fb + Mb)));
    float ss = 0.f;
#pragma unroll
    for (int vb = 0; vb < 4; ++vb)
#pragma unroll
        for (int i = 0; i < 4; ++i) { const float hs = Of[vb][i] * rf + Ob[vb][i] * rb; Of[vb][i] = hs; ss += hs * hs; }
    ss = grp_sum(ss);
    const float rn = rsqrtf(ss * (1.f / 64.f) + LN_EPS);
    const float* gn = p.mlstm_norm_g + (size_t)(l * 4 + h) * 64;
    const bf16_t* op = P + (size_t)(tok0 + t) * NIN + 3072 + h * 64;
    bf16_t* MIX = (bf16_t*)(ws_ + OFF_MIX) + (size_t)(tok0 + t) * 1024 + 768 + h * 64;
#pragma unroll
    for (int vb = 0; vb < 4; ++vb) {
        const int v = vb * 16 + 4 * g;
        const float4 g4 = *(const float4*)(gn + v);
        const bf16x4 o4 = *(const bf16x4*)(op + v);
        float sg[4];
#pragma unroll
        for (int i = 0; i < 4; ++i) sg[i] = 1.f / (1.f + __expf(-bf2f((unsigned short)o4[i])));
        uint2 o; o.x = pack2(Of[vb][0] * rn * g4.x * sg[0], Of[vb][1] * rn * g4.y * sg[1]);
        o.y = pack2(Of[vb][2] * rn * g4.z * sg[2], Of[vb][3] * rn * g4.w * sg[3]);
        *(uint2*)(MIX + v) = o;
    }
}

DI void item_mlstm_state(const Params& pin, int l, int b, int h, int dir, unsigned char* smem, int wave, int lane) {
    const Params& p = pin; unsigned char* const ws_ = opaque_ws(pin.ws); float* const out_ = opaque_out(pin.out); lane = opaque_v(lane); wave = opaque_s(wave);
    const int lr = lane & 15, g = lane >> 4;
    const int tok0 = b * 256;
    float* aA = (float*)smem; float* MA = aA + 1024; float* FA = MA + 1024;
    const float* G = (const float*)(ws_ + OFF_G) + (size_t)tok0 * 16;
    __syncthreads();
    if (wave == 0) mlstm_scan(G, h, 256, dir, aA, MA, FA, 0.f, lane);
    __syncthreads();
    const float Mfin = dir ? MA[0] : MA[255];
    const float Ffin = dir ? FA[0] : FA[255];
    const bf16_t* KT = (const bf16_t*)(ws_ + OFF_PT_CK) + (size_t)tok0 * 256 + (size_t)(h * 64 + wave * 16 + lr) * 32 + 8 * g;
    const bf16_t* VT = (const bf16_t*)(ws_ + OFF_PT_CV) + (size_t)tok0 * 256 + (size_t)(h * 64 + lr) * 32 + 8 * g;
    f32x4 C[4];
#pragma unroll
    for (int vb = 0; vb < 4; ++vb) C[vb] = (f32x4){0.f, 0.f, 0.f, 0.f};
    float nacc = 0.f;
#pragma unroll 4
    for (int u = 0; u < 8; ++u) {
        const int s0 = u * 32;
        const bf16x8 kf = *(const bf16x8*)(KT + (size_t)u * 256 * 32);
        const float4 a0 = *(const float4*)(aA + s0 + 8 * g), a1 = *(const float4*)(aA + s0 + 8 * g + 4);
        const float av[8] = {a0.x, a0.y, a0.z, a0.w, a1.x, a1.y, a1.z, a1.w};
        float kw[8];
#pragma unroll
        for (int j = 0; j < 8; ++j) { kw[j] = bf2f((unsigned short)kf[j]) * fexp2((av[j] - Mfin) * LOG2E); nacc += kw[j]; }
        const bf16x8 af = pack8(kw[0], kw[1], kw[2], kw[3], kw[4], kw[5], kw[6], kw[7]);
#pragma unroll
        for (int vb = 0; vb < 4; ++vb) {
            const bf16x8 vf = *(const bf16x8*)(VT + (size_t)u * 256 * 32 + vb * 16 * 32);
            C[vb] = mfma16(af, vf, C[vb]);
        }
    }
    const size_t sidx = (size_t)((b * 4 + l) * 2 + dir) * 4 + h;
    float* oc = out_ + O_NC + sidx * 4096;
#pragma unroll
    for (int vb = 0; vb < 4; ++vb)
#pragma unroll
        for (int i = 0; i < 4; ++i) oc[(wave * 16 + 4 * g + i) * 64 + vb * 16 + lr] = C[vb][i];
    nacc = grp_sum(nacc);
    if (g == 0) out_[O_NN + sidx * 64 + wave * 16 + lr] = nacc;
    if (wave == 0 && lane == 0) out_[O_NM + sidx] = Ffin + Mfin;
}

DI void mixer_phase(const Params& p, int l, unsigned char* smem) {
    const int tid_ = opaque_v(threadIdx.x); const int lane = tid_ & 63, wave = (tid_ >> 6) & 3;
    const int half = __builtin_amdgcn_readfirstlane(tid_ >> 8);
    unsigned char* sm = smem + half * HALF_LDS;
    unsigned* ctr = (unsigned*)(p.ws + OFF_MIXCTR) + l;
    volatile unsigned* slot = (volatile unsigned*)(smem + LDS_BYTES + 16);
    for (;;) {
        __syncthreads();
        if (tid_ == 0) *slot = __hip_atomic_fetch_add(ctr, 1u, __ATOMIC_RELAXED, __HIP_MEMORY_SCOPE_AGENT);
        __syncthreads();
        const int it = __builtin_amdgcn_readfirstlane(2 * (int)*slot + half);
        if (it >= 1408) break;
        if (it < 256) { item_diffattn_lat(p, l, it >> 7, (it >> 5) & 3, it & 31, sm, wave, lane); }
        else if (it < 384) { const int i = it - 256; item_mlstm<true>(p, l, i >> 6, (i >> 4) & 3, i & 15, sm, wave, lane); }
        else if (it < 512) { const int i = it - 384; item_mlstm_state(p, l, i >> 3, (i >> 1) & 3, i & 1, sm, wave, lane); }
        else if (it < 640) { const int i = it - 512; item_na(p, l, i >> 6, (i >> 4) & 3, i & 15, sm, wave, lane); }
        else if (it < 896) { const int i = it - 640; item_diffattn<false>(p, l, i >> 4, (i >> 2) & 3, i & 3, sm, wave, lane); }
        else if (it < 1152) { const int i = it - 896; item_mlstm<false>(p, l, i >> 4, (i >> 2) & 3, i & 3, sm, wave, lane); }
        else { const int i = it - 1152; item_dense(p, i >> 4, (i >> 2) & 3, i & 3, sm, wave, lane); }
    }
}

#define XB_TMO      128
#define XB_XCNT(j)  (256  + 64 * (j))
#define XB_XSUB(j)  (1280 + 64 * (j))
#define XB_XGEN(j)  (2304 + 64 * (j))
#define XB_TOP      3328
#define XB_TOPGEN   3392
#define XCD_BAR_WORDS 3456
#define XB_SPIN_CAP (1u << 18)

__device__ __forceinline__ unsigned xb_ld(unsigned* p)              { return __hip_atomic_load(p, __ATOMIC_RELAXED, __HIP_MEMORY_SCOPE_AGENT); }
__device__ __forceinline__ unsigned xb_add(unsigned* p, unsigned v) { return __hip_atomic_fetch_add(p, v, __ATOMIC_RELAXED, __HIP_MEMORY_SCOPE_AGENT); }
__device__ __forceinline__ unsigned xb_xcc_id() { return (unsigned)__builtin_amdgcn_s_getreg((3 << 11) | 20) & 0xFu; }
#define XB_SPIN(cond, bar) do { unsigned _sp = 0; while (cond) { __builtin_amdgcn_s_sleep(1); \
    if ((++_sp & 255u) == 0u) { if (xb_ld(&(bar)[XB_TMO])) break; if (_sp > XB_SPIN_CAP) { atomicAdd(&(bar)[XB_TMO], 1u); break; } } } } while (0)

struct XcdBarrier {
    unsigned* bar; unsigned x;
    volatile LAS unsigned* st;
};

__device__ __forceinline__ XcdBarrier xcd_barrier_post(unsigned* bar, volatile LAS unsigned* st) {
    XcdBarrier b; b.bar = bar; b.x = xb_xcc_id(); b.st = st;
    if (threadIdx.x == 0) (void)xb_add(&bar[XB_XCNT(b.x)], 1u);
    return b;
}
__device__ __forceinline__ void xcd_barrier_complete(unsigned* bar, unsigned x, unsigned& nloc, unsigned& nx) {
    const unsigned G = gridDim.x * gridDim.y * gridDim.z;
    unsigned sum, cnt, mine, sp = 0u;
    for (;;) {
        sum = 0u; cnt = 0u; mine = 0u;
#pragma unroll
        for (unsigned j = 0; j < 16; ++j) { const unsigned c = xb_ld(&bar[XB_XCNT(j)]); sum += c; cnt += (c > 0u) ? 1u : 0u; mine = (j == x) ? c : mine; }
        if (sum == G) break;
        __builtin_amdgcn_s_sleep(1);
        if ((++sp & 255u) == 0u) { if (xb_ld(&bar[XB_TMO])) break; if (sp > XB_SPIN_CAP) { atomicAdd(&bar[XB_TMO], 1u); break; } }
    }
    nloc = mine > 0u ? mine : 1u; nx = cnt > 0u ? cnt : 1u;
}

__device__ __forceinline__ void xcd_barrier(const XcdBarrier& b) {
    asm volatile("s_waitcnt vmcnt(0)" ::: "memory");
    __syncthreads();
    if (threadIdx.x == 0) {
        unsigned* bar = b.bar;
        __builtin_amdgcn_s_waitcnt(0);
        unsigned nloc = b.st[0], nx = b.st[1];
        if (nloc == 0u) { xcd_barrier_complete(bar, b.x, nloc, nx); b.st[0] = nloc; b.st[1] = nx; }
        const unsigned old = xb_add(&bar[XB_XSUB(b.x)], 1u);
        const unsigned gen = old / nloc;
        if (old + 1u == (gen + 1u) * nloc) {
            __builtin_amdgcn_fence(__ATOMIC_RELEASE, "agent");
            asm volatile("s_waitcnt vmcnt(0)" ::: "memory");
            const unsigned og = xb_add(&bar[XB_TOP], 1u);
            const unsigned tg = og / nx;
            if (og + 1u == (tg + 1u) * nx) xb_add(&bar[XB_TOPGEN], 1u);
            else XB_SPIN(xb_ld(&bar[XB_TOPGEN]) == tg, bar);
            __builtin_amdgcn_fence(__ATOMIC_ACQUIRE, "agent");
            xb_add(&bar[XB_XGEN(b.x)], 1u);
            asm volatile("s_waitcnt vmcnt(0)" ::: "memory");
        } else {
            XB_SPIN(xb_ld(&bar[XB_XGEN(b.x)]) == gen, bar);
            __builtin_amdgcn_fence(__ATOMIC_ACQUIRE, "agent");
            asm volatile("s_waitcnt vmcnt(0)" ::: "memory");
        }
    }
    __syncthreads();
}


constexpr int N_PHASES = 2 + 5 * 4;

__global__ void __launch_bounds__(512, 2) fwd_kernel(Params p) {
    __shared__ __attribute__((aligned(16))) unsigned char smem[LDS_BYTES + 32];
    if (threadIdx.x == 0) *(uint4*)(smem + LDS_BYTES) = make_uint4(0u, 0u, 0u, 0u);
    __syncthreads();
    XcdBarrier xb = xcd_barrier_post((unsigned*)(p.ws + OFF_BAR), (volatile LAS unsigned*)(smem + LDS_BYTES));
    for (int ph = p.ph_lo; ph < p.ph_hi; ++ph) {
        if (ph > p.ph_lo) {
            if (p.ph_hi > 1000) cg::this_grid().sync();
            xcd_barrier(xb);
        }
        const int l = ph < 2 ? 0 : (ph - 2) / 5, s = ph < 2 ? ph - 2 : (ph - 2) % 5;
        const int bit = 1 << (s + 2);
        const int reps = (DUPM & bit) ? 2 : 1;
        for (int rep = 0; rep < reps; ++rep) {
            if (rep) __syncthreads();
            if (s == -2) prep0(p, smem + __builtin_amdgcn_readfirstlane(threadIdx.x >> 8) * HALF_LDS);
            else if (s == -1) prep1(p);
            else if (s == 0) gemm_phase<EPI_INPROJ>(p, l, OFF_H, OFF_WT_IN + (size_t)l * NINP * DM * 2, NINP / 128, 1024, 0, smem);
            else if (s == 1) mixer_phase(p, l, smem);
            else if (s == 2) gemm_phase<EPI_LN1>(p, l, OFF_MIX, OFF_WT_OUT + (size_t)l * DM * DM * 2, 8, 1024, 1024, smem);
            else if (s == 3) gemm_phase<EPI_RELU2>(p, l, OFF_H, OFF_WT_1 + (size_t)l * DFF * DM * 2, 32, 1024, 4096, smem);
            else gemm_phase<EPI_LN2>(p, l, OFF_U, OFF_WT_2 + (size_t)l * DM * DFF * 2, 8, 4096, 1024, smem);
        }
    }
}

extern "C" void kernel_launch(void* const* d_in, const int* in_sizes, int n_in, void* d_out, int out_size, void* d_ws, size_t ws_size,
                              hipStream_t stream) {
    static int grid = 0;
    if (grid == 0) {
        if (n_in != 26 || ws_size < WS_END) { fprintf(stderr, "kernel_launch: unexpected n_in %d / ws %zu (need %zu)\n", n_in, ws_size, (size_t)WS_END); grid = -1; return; }
        int dev = 0, cus = 0, per_cu = 0;
        hipGetDevice(&dev);
        hipDeviceGetAttribute(&cus, hipDeviceAttributeMultiprocessorCount, dev);
        hipOccupancyMaxActiveBlocksPerMultiprocessor(&per_cu, (const void*)fwd_kernel, 512, 0);
        (void)per_cu;
        grid = cus;
        if (grid < 192) { fprintf(stderr, "kernel_launch: grid %d < 192 resident workgroups needed by the fused LayerNorm exchange\n", grid); grid = -1; return; }
    }
    if (grid < 0) return;
    Params p{};
    const float** pp = (const float**)&p;
    for (int i = 0; i < 26; ++i) pp[i] = (const float*)d_in[i];
    p.out = (float*)d_out; p.ws = (unsigned char*)d_ws;
    (void)hipMemsetAsync((unsigned char*)d_ws + OFF_BAR, 0, 16384, stream);
#if SINGLE_LAUNCH
    p.ph_lo = 0; p.ph_hi = N_PHASES;
    void* args[] = {&p};
    hipError_t e = hipLaunchCooperativeKernel((const void*)fwd_kernel, dim3(grid), dim3(512), args, 0, stream);
    if (e != hipSuccess) fprintf(stderr, "cooperative launch failed: %s (grid %d)\n", hipGetErrorString(e), grid);
#else
    for (int ph = 0; ph < N_PHASES; ++ph) {
        p.ph_lo = ph; p.ph_hi = ph + 1;
        void* args[] = {&p};
        hipError_t e = hipLaunchCooperativeKernel((const void*)fwd_kernel, dim3(grid), dim3(512), args, 0, stream);
        if (e != hipSuccess) { fprintf(stderr, "launch %d failed: %s (grid %d)\n", ph, hipGetErrorString(e), grid); break; }
    }
#endif
}
```

```cpp
#include <hip/hip_runtime.h>
#include <hip/hip_cooperative_groups.h>
#include <cstdio>
namespace cg = cooperative_groups;

#ifndef IM
#define IM 0xffff
#endif
#ifndef IM
#define IM 0xffff
#endif
#ifndef DUPM
#define DUPM 0
#endif
#ifndef PHM
#define PHM 0xffff
#endif
#ifndef SINGLE_LAUNCH
#define SINGLE_LAUNCH 1
#endif

#define LAS __attribute__((address_space(3)))
typedef unsigned short bf16_t;
typedef __attribute__((ext_vector_type(8))) short bf16x8;
typedef __attribute__((ext_vector_type(4))) short bf16x4;
typedef __attribute__((ext_vector_type(4))) float f32x4;
#define DI __device__ __forceinline__

constexpr int NTOK = 6144, NCTX = 4096, DM = 1024, NIN = 3344, NINP = 3456, DFF = 4096;
constexpr float ALPHA = 1.681792830507429f;
constexpr float LOG2E = 1.4426950408889634f;
constexpr float LN_EPS = 1e-5f;

constexpr size_t al256(size_t x) { return (x + 255) & ~(size_t)255; }
constexpr size_t OFF_WT_IN = 0;
constexpr size_t OFF_WT_OUT = OFF_WT_IN + al256((size_t)4 * NINP * DM * 2);
constexpr size_t OFF_WT_1 = OFF_WT_OUT + al256((size_t)4 * DM * DM * 2);
constexpr size_t OFF_WT_2 = OFF_WT_1 + al256((size_t)4 * DFF * DM * 2);
constexpr size_t OFF_MOD = OFF_WT_2 + al256((size_t)4 * DFF * DM * 2);
constexpr size_t OFF_X = OFF_MOD + al256((size_t)4 * 3 * 6144 * 4);
constexpr size_t OFF_H = OFF_X + al256((size_t)NTOK * DM * 4);
constexpr size_t OFF_P = OFF_H + al256((size_t)NTOK * DM * 2);
constexpr size_t OFF_PT_AV = OFF_P + al256((size_t)NTOK * NIN * 2);
constexpr size_t OFF_PT_BV = OFF_PT_AV + al256((size_t)NTOK * 512 * 2);
constexpr size_t OFF_PT_CV = OFF_PT_BV + al256((size_t)NTOK * 256 * 2);
constexpr size_t OFF_PT_CK = OFF_PT_CV + al256((size_t)NTOK * 256 * 2);
constexpr size_t OFF_G = OFF_PT_CK + al256((size_t)NTOK * 256 * 2);
constexpr size_t OFF_MIX = OFF_G + al256((size_t)NTOK * 16 * 4);
constexpr size_t OFF_Y = OFF_MIX + al256((size_t)NTOK * DM * 2);
constexpr size_t OFF_U = OFF_Y + al256((size_t)NTOK * DM * 4);
constexpr size_t OFF_CAK = OFF_U + al256((size_t)NTOK * DFF * 2);
constexpr size_t OFF_CAVT = OFF_CAK + al256((size_t)32 * 512 * 128 * 2);
constexpr size_t OFF_CBK = OFF_CAVT + al256((size_t)32 * 512 * 128 * 2);
constexpr size_t OFF_CBVT = OFF_CBK + al256((size_t)32 * 512 * 64 * 2);
constexpr size_t OFF_C0T = OFF_CBVT + al256((size_t)32 * 512 * 64 * 2);
constexpr size_t OFF_ROPE = OFF_C0T + al256((size_t)64 * 64 * 64 * 2);
constexpr size_t OFF_LAM = OFF_ROPE + al256((size_t)2 * 1024 * 4);
constexpr size_t OFF_BAR = OFF_LAM + 256;
constexpr size_t OFF_LNCNT = OFF_BAR + 13824;
constexpr size_t OFF_MIXCTR = OFF_BAR + 15360;
constexpr size_t OFF_STATS = OFF_BAR + 16384;
constexpr size_t WS_END = OFF_STATS + (size_t)NTOK * 16 * 8;

constexpr size_t O_YP = 0, O_YS = 4194304, O_AK = 6291456, O_AV = 14680064, O_BK = 23068672, O_BV = 27262976,
                 O_NC = 31457280, O_NN = 33554432, O_NM = 33587200;

struct Params {
    const float* x_prompt; const float* x_sample; const float* cache_a_k; const float* cache_a_v;
    const float* cache_b_k; const float* cache_b_v; const float* state_c; const float* state_n;
    const float* state_m; const float* c; const float* c_ctx; const float* w_in; const float* gate_bias;
    const float* diff_lambda; const float* diff_norm_g; const float* nat_rpb; const float* mlstm_norm_g;
    const float* w_out; const float* ada_w; const float* ada_b; const float* ln1_g; const float* ln1_b;
    const float* ln2_g; const float* ln2_b; const float* w_mlp1; const float* w_mlp2;
    float* out; unsigned char* ws; int ph_lo; int ph_hi;
};

#define VBID ((int)(blockIdx.x * 2 + __builtin_amdgcn_readfirstlane(threadIdx.x >> 8)))
#define VGRID ((int)(gridDim.x * 2))
#define VTID ((int)(threadIdx.x & 255))
constexpr int HALF_LDS = 73728;
constexpr int LDS_BYTES = 2 * HALF_LDS;
DI int opaque_v(int x) { asm volatile("" : "+v"(x)); return x; }
DI int opaque_s(int x) { x = __builtin_amdgcn_readfirstlane(x); asm volatile("" : "+s"(x)); return x; }
DI size_t opaque_zero() { size_t z = 0; asm volatile("" : "+s"(z)); return z; }
DI unsigned char* opaque_ws(unsigned char* w) { return w + opaque_zero(); }
DI float* opaque_out(float* w) { return w + opaque_zero(); }
DI unsigned short f2bf(float x) { unsigned u = __float_as_uint(x); u += 0x7fffu + ((u >> 16) & 1u); return (unsigned short)(u >> 16); }
DI float bf2f(unsigned short h) { return __uint_as_float(((unsigned)h) << 16); }
DI unsigned pack2(float a, float b) { return (unsigned)f2bf(a) | ((unsigned)f2bf(b) << 16); }
DI f32x4 mfma16(bf16x8 a, bf16x8 b, f32x4 c) { return __builtin_amdgcn_mfma_f32_16x16x32_bf16(a, b, c, 0, 0, 0); }
DI float fexp2(float x) { return __builtin_amdgcn_exp2f(x); }
DI bf16x8 pack8(float a0, float a1, float a2, float a3, float a4, float a5, float a6, float a7) {
    uint4 u;
    asm volatile("s_nop 1\n\tv_cvt_pk_bf16_f32 %0, %4, %5\n\tv_cvt_pk_bf16_f32 %1, %6, %7\n\tv_cvt_pk_bf16_f32 %2, %8, %9\n\tv_cvt_pk_bf16_f32 %3, %10, %11\n\ts_nop 1"
                 : "=&v"(u.x), "=&v"(u.y), "=&v"(u.z), "=&v"(u.w)
                 : "v"(a0), "v"(a1), "v"(a2), "v"(a3), "v"(a4), "v"(a5), "v"(a6), "v"(a7));
    return __builtin_bit_cast(bf16x8, u);
}
DI bf16x8 cat4(bf16x4 a, bf16x4 b) { return __builtin_shufflevector(a, b, 0, 1, 2, 3, 4, 5, 6, 7); }
DI float wave_sum(float v) {
#pragma unroll
    for (int o = 32; o > 0; o >>= 1) v += __shfl_xor(v, o);
    return v;
}
DI float grp_sum(float v) { v += __shfl_xor(v, 16); v += __shfl_xor(v, 32); return v; }
DI float grp_max(float v) { v = fmaxf(v, __shfl_xor(v, 16)); v = fmaxf(v, __shfl_xor(v, 32)); return v; }

DI void transpose_job(const float* __restrict__ src, bf16_t* __restrict__ dst, int R, int C, int Cpad, int nmat, float* tile, bool blocked = false,
                      int vb = -1, int vg = 0) {
    if (vb < 0) { vb = VBID; vg = VGRID; }
    const int tid = VTID;
    const int rt = R >> 6, ct = Cpad >> 6, per = rt * ct, total = per * nmat;
    for (int it = vb; it < total; it += vg) {
        const int mat = it / per, rem = it - mat * per;
        const int r0 = (rem / ct) << 6, c0 = (rem % ct) << 6;
        const float* s = src + (size_t)mat * R * C;
        bf16_t* d = dst + (size_t)mat * Cpad * R;
#pragma unroll
        for (int i = 0; i < 4; ++i) {
            const int r = (tid >> 4) + 16 * i, c = (tid & 15) * 4;
            float4 v = make_float4(0.f, 0.f, 0.f, 0.f);
            if (c0 + c < C) v = *(const float4*)(s + (size_t)(r0 + r) * C + c0 + c);
            tile[r * 65 + c + 0] = v.x; tile[r * 65 + c + 1] = v.y; tile[r * 65 + c + 2] = v.z; tile[r * 65 + c + 3] = v.w;
        }
        __syncthreads();
        {
            const int c = tid >> 2, rs = (tid & 3) * 16;
            uint4 o0, o1;
            o0.x = pack2(tile[(rs + 0) * 65 + c], tile[(rs + 1) * 65 + c]);
            o0.y = pack2(tile[(rs + 2) * 65 + c], tile[(rs + 3) * 65 + c]);
            o0.z = pack2(tile[(rs + 4) * 65 + c], tile[(rs + 5) * 65 + c]);
            o0.w = pack2(tile[(rs + 6) * 65 + c], tile[(rs + 7) * 65 + c]);
            o1.x = pack2(tile[(rs + 8) * 65 + c], tile[(rs + 9) * 65 + c]);
            o1.y = pack2(tile[(rs + 10) * 65 + c], tile[(rs + 11) * 65 + c]);
            o1.z = pack2(tile[(rs + 12) * 65 + c], tile[(rs + 13) * 65 + c]);
            o1.w = pack2(tile[(rs + 14) * 65 + c], tile[(rs + 15) * 65 + c]);
            uint4* dp = blocked ? (uint4*)(d + ((size_t)((r0 + rs) >> 5) * Cpad + (c0 + c)) * 32 + ((r0 + rs) & 31))
                                : (uint4*)(d + (size_t)(c0 + c) * R + r0 + rs);
            dp[0] = o0; dp[1] = o1;
        }
        __syncthreads();
    }
}

DI void convert_job(const float* __restrict__ src, bf16_t* __restrict__ dst, size_t n) {
    for (size_t i = ((size_t)VBID * 256 + VTID) * 8; i < n; i += (size_t)VGRID * 256 * 8) {
        const float4 a = *(const float4*)(src + i), b = *(const float4*)(src + i + 4);
        uint4 o; o.x = pack2(a.x, a.y); o.y = pack2(a.z, a.w); o.z = pack2(b.x, b.y); o.w = pack2(b.z, b.w);
        *(uint4*)(dst + i) = o;
    }
}

DI void prep0(const Params& pin, unsigned char* smem) {
    const Params& p = pin; unsigned char* const ws_ = opaque_ws(pin.ws); float* const out_ = opaque_out(pin.out); const int tid = opaque_v(VTID);
    {
        float* sl = (float*)smem; float* red = (float*)(smem + 12288);
        for (int i = tid; i < 3072; i += 256) {
            const int cnd = i >> 10, k = i & 1023;
            const float v = (cnd == 0) ? p.c_ctx[k] : p.c[(cnd - 1) * 1024 + k];
            sl[i] = v / (1.f + __expf(-v));
        }
        __syncthreads();
        float* mod = (float*)(ws_ + OFF_MOD);
        const int kg = tid >> 4, cl = tid & 15;
        for (int it = VBID; it < 384; it += VGRID) {
            const int l = it / 96, j0 = (it % 96) * 64;
            const float* w = p.ada_w + (size_t)l * 1024 * 6144 + j0 + cl * 4;
            float4 a0 = make_float4(0, 0, 0, 0), a1 = a0, a2 = a0;
#pragma unroll 8
            for (int kk = 0; kk < 64; ++kk) {
                const int k = kg * 64 + kk;
                const float4 wv = *(const float4*)(w + (size_t)k * 6144);
                const float s0 = sl[k], s1 = sl[1024 + k], s2 = sl[2048 + k];
                a0.x += s0 * wv.x; a0.y += s0 * wv.y; a0.z += s0 * wv.z; a0.w += s0 * wv.w;
                a1.x += s1 * wv.x; a1.y += s1 * wv.y; a1.z += s1 * wv.z; a1.w += s1 * wv.w;
                a2.x += s2 * wv.x; a2.y += s2 * wv.y; a2.z += s2 * wv.z; a2.w += s2 * wv.w;
            }
            __syncthreads();
            float* r = red + kg * 192 + cl * 4;
            r[0] = a0.x; r[1] = a0.y; r[2] = a0.z; r[3] = a0.w;
            r[64] = a1.x; r[65] = a1.y; r[66] = a1.z; r[67] = a1.w;
            r[128] = a2.x; r[129] = a2.y; r[130] = a2.z; r[131] = a2.w;
            __syncthreads();
            if (tid < 192) {
                const int cnd = tid >> 6, col = tid & 63;
                float s = 0.f;
#pragma unroll
                for (int q = 0; q < 16; ++q) s += red[q * 192 + tid];
                mod[(l * 3 + cnd) * 6144 + j0 + col] = s + p.ada_b[l * 6144 + j0 + col];
            }
        }
        __syncthreads();
    }
    if (VBID == VGRID - 1) {
        float* rope = (float*)(ws_ + OFF_ROPE);
        for (int i = tid; i < 1024; i += 256) {
            const int pos = i >> 4, j = i & 15;
            const float freq = powf(10000.f, -(float)j / 16.f);
            float s, c; sincosf((float)pos * freq, &s, &c);
            rope[i] = c; rope[1024 + i] = s;
        }
        if (tid < 4) {
            const float* lp = p.diff_lambda + tid * 256;
            float s1 = 0.f, s2 = 0.f;
            for (int i = 0; i < 64; ++i) { s1 += lp[i] * lp[64 + i]; s2 += lp[128 + i] * lp[192 + i]; }
            const float li = 0.8f - 0.6f * expf(-0.3f * (float)tid);
            float* lam = (float*)(ws_ + OFF_LAM);
            lam[tid * 2] = expf(s1) - expf(s2) + li; lam[tid * 2 + 1] = li;
        }
    }
    float* tile = (float*)smem;
    transpose_job(p.w_in, (bf16_t*)(ws_ + OFF_WT_IN), 1024, NIN, NINP, 1, tile);
    transpose_job(p.w_out, (bf16_t*)(ws_ + OFF_WT_OUT), 1024, 1024, 1024, 1, tile);
    transpose_job(p.w_mlp1, (bf16_t*)(ws_ + OFF_WT_1), 1024, 4096, 4096, 1, tile);
    transpose_job(p.w_mlp2, (bf16_t*)(ws_ + OFF_WT_2), 4096, 1024, 1024, 1, tile);
    transpose_job(p.cache_a_v, (bf16_t*)(ws_ + OFF_CAVT), 512, 128, 128, 32, tile, true);
    transpose_job(p.cache_b_v, (bf16_t*)(ws_ + OFF_CBVT), 512, 64, 64, 32, tile, true);
    transpose_job(p.state_c, (bf16_t*)(ws_ + OFF_C0T), 64, 64, 64, 64, tile);
    convert_job(p.cache_a_k, (bf16_t*)(ws_ + OFF_CAK), (size_t)32 * 512 * 128);
    convert_job(p.cache_b_k, (bf16_t*)(ws_ + OFF_CBK), (size_t)32 * 512 * 64);
}

DI void prep1(const Params& pin) {
    const Params& p = pin; unsigned char* const ws_ = opaque_ws(pin.ws); float* const out_ = opaque_out(pin.out); const int tid_ = opaque_v(threadIdx.x); const int lane = tid_ & 63, wave = tid_ >> 6;
    const float* mod = (const float*)(ws_ + OFF_MOD);
    float* X = (float*)(ws_ + OFF_X);
    bf16_t* H = (bf16_t*)(ws_ + OFF_H);
    for (int row = blockIdx.x * 8 + wave; row < NTOK; row += gridDim.x * 8) {
        const float* src = row < NCTX ? p.x_prompt + (size_t)row * 1024 : p.x_sample + (size_t)(row - NCTX) * 1024;
        const int cnd = row < NCTX ? 0 : 1 + ((row - NCTX) >> 10);
        const float* md = mod + (size_t)cnd * 6144;
#pragma unroll
        for (int j = 0; j < 4; ++j) {
            const int c = lane * 4 + 256 * j;
            const float4 v = *(const float4*)(src + c);
            *(float4*)(X + (size_t)row * 1024 + c) = v;
            const float4 sh = *(const float4*)(md + c), sc = *(const float4*)(md + 1024 + c);
            uint2 o; o.x = pack2(v.x * (1.f + sc.x) + sh.x, v.y * (1.f + sc.y) + sh.y);
            o.y = pack2(v.z * (1.f + sc.z) + sh.z, v.w * (1.f + sc.w) + sh.w);
            *(uint2*)(H + (size_t)row * 1024 + c) = o;
        }
    }
}

enum { EPI_INPROJ = 0, EPI_LN1 = 1, EPI_RELU2 = 2, EPI_LN2 = 3 };

DI void epi_inproj(const Params& p, unsigned char* ws_, float* out_, int layer, const float* T, int rowbase, int colbase, int lane) {
    if (colbase >= NIN) return;
    bf16_t* P = (bf16_t*)(ws_ + OFF_P);
    const bool latent = rowbase >= NCTX;
    const int seq_tok0 = latent ? (NCTX + ((rowbase - NCTX) & ~1023)) : (rowbase & ~255);
    const int nseq = latent ? 1024 : 256;
    const int bctx = seq_tok0 >> 8;
    const int n0 = rowbase - seq_tok0;
    if (colbase >= 3328) {
        float* G = (float*)(ws_ + OFF_G);
        const float bias = p.gate_bias[layer * 16 + (lane & 15)];
        for (int rr = 0; rr < 16; ++rr) {
            const int r = rr * 4 + (lane >> 4);
            G[(size_t)(rowbase + r) * 16 + (lane & 15)] = T[r * 65 + (lane & 15)] + bias;
        }
        return;
    }
    bool toP = false, rope = false, toT = false, toO = false;
    size_t toff = 0, obase = 0; int tW = 0, tcr = 0, ohd = 64, ocr = 0;
    if (colbase < 1024) { toP = true; rope = latent; if (colbase >= 512) { toO = !latent; obase = O_AK; ohd = 128; ocr = colbase - 512; } }
    else if (colbase < 1536) { toT = true; toff = OFF_PT_AV; tW = 512; tcr = colbase - 1024; toO = !latent; obase = O_AV; ohd = 128; ocr = tcr; }
    else if (colbase < 1792) { toP = true; }
    else if (colbase < 2048) { toP = true; toO = !latent; obase = O_BK; ohd = 64; ocr = colbase - 1792; }
    else if (colbase < 2304) { toT = true; toff = OFF_PT_BV; tW = 256; tcr = colbase - 2048; toO = !latent; obase = O_BV; ohd = 64; ocr = tcr; }
    else if (colbase < 2560) { toP = true; }
    else if (colbase < 2816) { toP = true; toT = true; toff = OFF_PT_CK; tW = 256; tcr = colbase - 2560; }
    else if (colbase < 3072) { toT = true; toff = OFF_PT_CV; tW = 256; tcr = colbase - 2816; }
    else { toP = true; }
    if (toO) {
        const int h = ocr / ohd, w = ocr - h * ohd + lane;
        float* O = out_ + obase + (((size_t)(bctx * 4 + layer) * 4 + h) * 256 + n0) * ohd + w;
#pragma unroll 4
        for (int r = 0; r < 64; ++r) O[(size_t)r * ohd] = T[r * 65 + lane];
    }
    if (toP) {
        bf16_t* Pp = P + (size_t)rowbase * NIN + colbase + lane;
        if (rope) {
            const float* rc = (const float*)(ws_ + OFF_ROPE);
            const float* rs = rc + 1024;
#pragma unroll 4
            for (int r = 0; r < 64; ++r) {
                const float v = T[r * 65 + lane], vp = T[r * 65 + (lane ^ 16)];
                const int t = n0 + r;
                const int pos = (lane < 32) ? (t >> 6) : (t & 63);
                const float c = rc[pos * 16 + (lane & 15)], sn = rs[pos * 16 + (lane & 15)];
                const float o = (lane & 16) ? (vp * sn + v * c) : (v * c - vp * sn);
                Pp[(size_t)r * NIN] = f2bf(o);
            }
        } else {
#pragma unroll 4
            for (int r = 0; r < 64; ++r) Pp[(size_t)r * NIN] = f2bf(T[r * 65 + lane]);
        }
    }
    if (toT) {
        const int n = n0 + lane;
        bf16_t* Tp = (bf16_t*)(ws_ + toff) + (size_t)seq_tok0 * tW + ((size_t)(n >> 5) * tW + tcr) * 32 + (n & 31);
#pragma unroll 4
        for (int c = 0; c < 64; ++c) Tp[(size_t)c * 32] = f2bf(T[lane * 65 + c]);
    }
}

template <int WHICH>
DI void epi_ln(const Params& p, unsigned char* ws_, float* out_, int l, float* T, int tm, int tn, int wn, int rowbase, int colbase, int lane, int tid) {
    const float* mod = (const float*)(ws_ + OFF_MOD);
    float* X = (float*)(ws_ + OFF_X);
    bf16_t* H = (bf16_t*)(ws_ + OFF_H);
    const int cnd = rowbase < NCTX ? 0 : 1 + ((rowbase - NCTX) >> 10);
    const float* md = mod + (size_t)(l * 3 + cnd) * 6144;
    const int col = colbase + lane;
    const bool last = (WHICH == 2 && l == 3);
    float s1 = 0.f, s2 = 0.f;
#pragma unroll 8
    for (int c = 0; c < 64; ++c) { const float v = T[lane * 65 + c]; s1 += v; s2 += v * v; }
    unsigned long long* stats = (unsigned long long*)(ws_ + OFF_STATS);
    __hip_atomic_store(stats + (size_t)(rowbase + lane) * 16 + tn * 2 + wn,
                       ((unsigned long long)__float_as_uint(s2) << 32) | (unsigned long long)__float_as_uint(s1), __ATOMIC_RELAXED, __HIP_MEMORY_SCOPE_AGENT);
    unsigned* cnt = (unsigned*)(ws_ + OFF_LNCNT) + (l * 2 + (WHICH - 1)) * 48 + tm;
    asm volatile("s_waitcnt vmcnt(0)" ::: "memory");
    __syncthreads();
    if (tid == 0) {
        (void)__hip_atomic_fetch_add(cnt, 1u, __ATOMIC_RELAXED, __HIP_MEMORY_SCOPE_AGENT);
        unsigned sp = 0;
        while (__hip_atomic_load(cnt, __ATOMIC_RELAXED, __HIP_MEMORY_SCOPE_AGENT) < 8u) { __builtin_amdgcn_s_sleep(1); if (++sp > (1u << 22)) break; }
    }
    __syncthreads();
    float t1 = 0.f, t2 = 0.f;
    {
        unsigned long long* sp8 = stats + (size_t)(rowbase + lane) * 16;
        unsigned long long a[16];
#pragma unroll
        for (int q = 0; q < 16; ++q) a[q] = __hip_atomic_load(sp8 + q, __ATOMIC_RELAXED, __HIP_MEMORY_SCOPE_AGENT);
#pragma unroll
        for (int q = 0; q < 16; ++q) { t1 += __uint_as_float((unsigned)a[q]); t2 += __uint_as_float((unsigned)(a[q] >> 32)); }
    }
    const float mu = t1 * (1.f / 1024.f);
    const float rstd = rsqrtf(fmaxf(t2 * (1.f / 1024.f) - mu * mu, 0.f) + LN_EPS);
    const float lng = (WHICH == 1 ? p.ln1_g : p.ln2_g)[l * 1024 + col], lnb = (WHICH == 1 ? p.ln1_b : p.ln2_b)[l * 1024 + col];
    if (last) {
        float* op = out_ + (size_t)rowbase * 1024 + col;
#pragma unroll 8
        for (int r = 0; r < 64; ++r) op[(size_t)r * 1024] = (T[r * 65 + lane] - __shfl(mu, r)) * __shfl(rstd, r) * lng + lnb;
    } else {
        const float* nmd = (WHICH == 1) ? md : mod + (size_t)((l + 1) * 3 + cnd) * 6144;
        const float sh = nmd[(WHICH == 1 ? 3072 : 0) + col], sc1p = 1.f + nmd[(WHICH == 1 ? 4096 : 1024) + col];
        float* xp = X + (size_t)rowbase * 1024 + col;
        bf16_t* hp = H + (size_t)rowbase * 1024 + col;
#pragma unroll 8
        for (int r = 0; r < 64; ++r) {
            const float o = (T[r * 65 + lane] - __shfl(mu, r)) * __shfl(rstd, r) * lng + lnb;
            xp[(size_t)r * 1024] = o;
            hp[(size_t)r * 1024] = f2bf(o * sc1p + sh);
        }
    }
}

template <int EPI>
DI void gemm_phase(const Params& pin, int layer, size_t offA, size_t offB, int ntn, int K, int ldc,
                   unsigned char* smem) {
    const Params& p = pin; unsigned char* const ws_ = opaque_ws(pin.ws); float* const out_ = opaque_out(pin.out); const int tid = opaque_v(threadIdx.x), lane = tid & 63, wave = opaque_s(tid >> 6);
    const bf16_t* __restrict__ A = (const bf16_t*)(ws_ + offA); const bf16_t* __restrict__ Bt = (const bf16_t*)(ws_ + offB);
    const int wm = wave >> 1, wn = wave & 1;
    const int lr = lane & 15, g = lane >> 4;
    const int ntm = NTOK / 256;
    const int ntiles = ntm * ntn, nk = K >> 6;
    constexpr int STAGE = 49152;
    for (int tile = blockIdx.x; tile < ntiles; tile += gridDim.x) {
        const int tm = tile % ntm, tn = tile / ntm;
        const int m0 = tm * 256, n0 = tn * 128;
        f32x4 acc[4][4];
#pragma unroll
        for (int mi = 0; mi < 4; ++mi)
#pragma unroll
            for (int ni = 0; ni < 4; ++ni) acc[mi][ni] = (f32x4){0.f, 0.f, 0.f, 0.f};
        const bf16_t* Ag = A + (size_t)m0 * K;
        const bf16_t* Bg = Bt + (size_t)n0 * K;
        const bf16_t* ag = Ag + (size_t)(wave * 32 + (lane >> 3)) * K + (((lane & 7) ^ (lane >> 3)) << 3);
        const bf16_t* bg = Bg + (size_t)(wave * 16 + (lane >> 3)) * K + (((lane & 7) ^ (lane >> 3)) << 3);
        auto stage = [&](int t) {
            unsigned char* dst = smem + (t % 3) * STAGE;
            const int k0 = t << 6;
#pragma unroll
            for (int j = 0; j < 4; ++j)
                __builtin_amdgcn_global_load_lds((const unsigned*)(ag + (size_t)j * 8 * K + k0), (LAS unsigned*)(dst + (wave * 4 + j) * 1024), 16, 0, 0);
#pragma unroll
            for (int j = 0; j < 2; ++j)
                __builtin_amdgcn_global_load_lds((const unsigned*)(bg + (size_t)j * 8 * K + k0), (LAS unsigned*)(dst + 32768 + (wave * 2 + j) * 1024), 16, 0, 0);
        };
        auto read_half = [&](int t, int kk, bf16x8 (&af)[4], bf16x8 (&bfr)[4]) {
            const unsigned char* cur = smem + (t % 3) * STAGE;
#pragma unroll
            for (int mi = 0; mi < 4; ++mi) {
                const int row = wm * 64 + mi * 16 + lr;
                af[mi] = *(const bf16x8*)(cur + row * 128 + (((kk * 4 + g) ^ (row & 7)) << 4));
            }
#pragma unroll
            for (int ni = 0; ni < 4; ++ni) {
                const int row = wn * 64 + ni * 16 + lr;
                bfr[ni] = *(const bf16x8*)(cur + 32768 + row * 128 + (((kk * 4 + g) ^ (row & 7)) << 4));
            }
        };
        stage(0); stage(1); stage(2);
        bf16x8 a0[4], b0[4], a1[4], b1[4];
        asm volatile("s_waitcnt vmcnt(12)" ::: "memory");
        asm volatile("s_waitcnt lgkmcnt(0)" ::: "memory");
        __builtin_amdgcn_s_barrier();
        read_half(0, 0, a0, b0);
        for (int kt = 0; kt < nk; ++kt) {
            read_half(kt, 1, a1, b1);
#pragma unroll
            for (int mi = 0; mi < 4; ++mi)
#pragma unroll
                for (int ni = 0; ni < 4; ++ni) acc[mi][ni] = mfma16(a0[mi], b0[ni], acc[mi][ni]);
            __builtin_amdgcn_sched_barrier(0);
            if (kt + 2 < nk) asm volatile("s_waitcnt vmcnt(6)" ::: "memory");
            else asm volatile("s_waitcnt vmcnt(0)" ::: "memory");
            asm volatile("s_waitcnt lgkmcnt(0)" ::: "memory");
            __builtin_amdgcn_s_barrier();
            if (kt + 1 < nk) read_half(kt + 1, 0, a0, b0);
            if (kt + 3 < nk) stage(kt + 3);
#pragma unroll
            for (int mi = 0; mi < 4; ++mi)
#pragma unroll
                for (int ni = 0; ni < 4; ++ni) acc[mi][ni] = mfma16(a1[mi], b1[ni], acc[mi][ni]);
            __builtin_amdgcn_sched_barrier(0);
        }
        asm volatile("s_waitcnt lgkmcnt(0)" ::: "memory");
        __builtin_amdgcn_s_barrier();
        if (EPI == EPI_LN1 || EPI == EPI_LN2) {
            const int rb = m0 + wm * 64, cb = n0 + wn * 64;
            const int cnd = rb < NCTX ? 0 : 1 + ((rb - NCTX) >> 10);
            const float* gp = (const float*)(ws_ + OFF_MOD) + (size_t)(layer * 3 + cnd) * 6144 + (EPI == EPI_LN1 ? 2048 : 5120) + cb + lr;
            const float* xp = (const float*)(ws_ + OFF_X) + (size_t)(rb + 4 * g) * 1024 + cb + lr;
            float gt[4];
#pragma unroll
            for (int ni = 0; ni < 4; ++ni) gt[ni] = gp[ni * 16];
#pragma unroll
            for (int mh = 0; mh < 2; ++mh) {
                f32x4 xv[2][4];
#pragma unroll
                for (int m2 = 0; m2 < 2; ++m2)
#pragma unroll
                    for (int ni = 0; ni < 4; ++ni)
#pragma unroll
                        for (int i = 0; i < 4; ++i) xv[m2][ni][i] = xp[(size_t)((mh * 2 + m2) * 16 + i) * 1024 + ni * 16];
#pragma unroll
                for (int m2 = 0; m2 < 2; ++m2)
#pragma unroll
                    for (int ni = 0; ni < 4; ++ni)
#pragma unroll
                        for (int i = 0; i < 4; ++i) acc[mh * 2 + m2][ni][i] = ALPHA * xv[m2][ni][i] + gt[ni] * acc[mh * 2 + m2][ni][i];
                __builtin_amdgcn_sched_barrier(0);
            }
        }
        float* T = (float*)smem + wave * (64 * 65);
#pragma unroll
        for (int mi = 0; mi < 4; ++mi)
#pragma unroll
            for (int ni = 0; ni < 4; ++ni)
#pragma unroll
                for (int i = 0; i < 4; ++i) T[(mi * 16 + 4 * g + i) * 65 + ni * 16 + lr] = acc[mi][ni][i];
        const int rowbase = m0 + wm * 64, colbase = n0 + wn * 64;
        if (EPI == EPI_INPROJ) {
            epi_inproj(p, ws_, out_, layer, T, rowbase, colbase, lane);
        } else if (EPI == EPI_LN1) {
            epi_ln<1>(p, ws_, out_, layer, T, tm, tn, wn, rowbase, colbase, lane, tid);
        } else if (EPI == EPI_LN2) {
            epi_ln<2>(p, ws_, out_, layer, T, tm, tn, wn, rowbase, colbase, lane, tid);
        } else {
            bf16_t* U = (bf16_t*)(ws_ + OFF_U) + (size_t)rowbase * ldc + colbase + lane;
#pragma unroll 4
            for (int r = 0; r < 64; ++r) { const float v = fmaxf(T[r * 65 + lane], 0.f); U[(size_t)r * ldc] = f2bf(v * v); }
        }
        __syncthreads();
    }
    if ((EPI == EPI_LN1 || EPI == EPI_LN2) && layer < 3 && (int)blockIdx.x >= ntiles) {
        const int half = __builtin_amdgcn_readfirstlane(threadIdx.x >> 8);
        const int vb = ((int)blockIdx.x - ntiles) * 2 + half, vg = ((int)gridDim.x - ntiles) * 2;
        float* tile = (float*)(smem + half * HALF_LDS);
        const int nl = layer + 1;
        if (EPI == EPI_LN1) {
            transpose_job(p.w_in + (size_t)nl * 1024 * NIN, (bf16_t*)(ws_ + OFF_WT_IN) + (size_t)nl * NINP * DM, 1024, NIN, NINP, 1, tile, false, vb, vg);
            transpose_job(p.w_out + (size_t)nl * 1024 * 1024, (bf16_t*)(ws_ + OFF_WT_OUT) + (size_t)nl * DM * DM, 1024, 1024, 1024, 1, tile, false, vb, vg);
        } else {
            transpose_job(p.w_mlp1 + (size_t)nl * 1024 * 4096, (bf16_t*)(ws_ + OFF_WT_1) + (size_t)nl * DFF * DM, 1024, 4096, 4096, 1, tile, false, vb, vg);
            transpose_job(p.w_mlp2 + (size_t)nl * 4096 * 1024, (bf16_t*)(ws_ + OFF_WT_2) + (size_t)nl * DM * DFF, 4096, 1024, 1024, 1, tile, false, vb, vg);
        }
    }
}

template <int NMAP, int DV>
struct AttnSt { f32x4 O[NMAP][DV / 16]; float m[NMAP]; float l[NMAP]; };
template <int NMAP, int DV>
struct UnitFrags { bf16x8 k[NMAP][2][2]; bf16x8 v[DV / 16]; };

template <int NMAP, int DV>
struct TileGeom {
    static constexpr int KROW = NMAP * 128, KBYTES = 64 * KROW, VUNIT = DV * 64, TBYTES = KBYTES + 2 * VUNIT;
};
DI int kswz(int row) { return (row & 3) | (((row >> 3) & 3) << 2); }

template <int NMAP, int DV>
DI void stage_tile(unsigned char* buf, const bf16_t* kg, int kstride, const bf16_t* vg, int vunit, int wave, int lane) {
    typedef TileGeom<NMAP, DV> TG;
    if (NMAP == 2) {
#pragma unroll
        for (int j = 0; j < 4; ++j) {
            const int jj = wave * 4 + j, row = jj * 4 + (lane >> 4), lc = (lane & 15) ^ kswz(row);
            __builtin_amdgcn_global_load_lds((const unsigned*)(kg + (size_t)row * kstride + lc * 8), (LAS unsigned*)(buf + jj * 1024), 16, 0, 0);
        }
    } else {
#pragma unroll
        for (int j = 0; j < 2; ++j) {
            const int jj = wave * 2 + j, row = jj * 8 + (lane >> 3), lc = (lane & 7) ^ (kswz(row) >> 1);
            __builtin_amdgcn_global_load_lds((const unsigned*)(kg + (size_t)row * kstride + lc * 8), (LAS unsigned*)(buf + jj * 1024), 16, 0, 0);
        }
    }
    constexpr int VI = TG::VUNIT / 1024, PER = 2 * VI / 4;
#pragma unroll
    for (int j = 0; j < PER; ++j) {
        const int jj = wave * PER + j, unit = jj / VI, piece = jj % VI;
        __builtin_amdgcn_global_load_lds((const unsigned*)(vg + (size_t)unit * vunit + piece * 512 + lane * 8),
                                         (LAS unsigned*)(buf + TG::KBYTES + jj * 1024), 16, 0, 0);
    }
}

template <int NMAP, int DV>
DI void lds_unit(UnitFrags<NMAP, DV>& f, const unsigned char* buf, int rowbase, int voff, int lr, int g) {
    typedef TileGeom<NMAP, DV> TG;
#pragma unroll
    for (int b = 0; b < 2; ++b) {
        const int row = rowbase + (lr >> 2) * 8 + (lr & 3) + 4 * b, sw = kswz(row);
        if (NMAP == 2) {
#pragma unroll
            for (int m = 0; m < NMAP; ++m)
#pragma unroll
                for (int kk = 0; kk < 2; ++kk) f.k[m][b][kk] = *(const bf16x8*)(buf + row * 256 + (((m * 8 + kk * 4 + g) ^ sw) << 4));
        } else {
#pragma unroll
            for (int kk = 0; kk < 2; ++kk) f.k[0][b][kk] = *(const bf16x8*)(buf + row * 128 + (((kk * 4 + g) ^ (sw >> 1)) << 4));
        }
    }
#pragma unroll
    for (int vb = 0; vb < DV / 16; ++vb) f.v[vb] = *(const bf16x8*)(buf + TG::KBYTES + voff + (vb * 16 + lr) * 64);
}

template <int DV>
DI void lds_unit_sel(UnitFrags<1, DV>& f, const unsigned char* buf, int rowbase, int voff, int lr, int g, int msel) {
    typedef TileGeom<2, DV> TG;
#pragma unroll
    for (int b = 0; b < 2; ++b) {
        const int row = rowbase + (lr >> 2) * 8 + (lr & 3) + 4 * b, sw = kswz(row);
#pragma unroll
        for (int kk = 0; kk < 2; ++kk) f.k[0][b][kk] = *(const bf16x8*)(buf + row * 256 + (((msel * 8 + kk * 4 + g) ^ sw) << 4));
    }
#pragma unroll
    for (int vb = 0; vb < DV / 16; ++vb) f.v[vb] = *(const bf16x8*)(buf + TG::KBYTES + voff + (vb * 16 + lr) * 64);
}

template <int NMAP, int DV, class SrcFn, class CompFn>
DI void tile_pipeline(unsigned char* tiles, int nt, int wave, int lane, SrcFn src, CompFn comp) {
    typedef TileGeom<NMAP, DV> TG;
    {
        const bf16_t *kg, *vg; int ks, vu;
        src(0, kg, ks, vg, vu);
        stage_tile<NMAP, DV>(tiles, kg, ks, vg, vu, wave, lane);
    }
    asm volatile("s_waitcnt vmcnt(0)" ::: "memory");
    __syncthreads();
    for (int t = 0; t < nt; ++t) {
        unsigned char* cur = tiles + (t & 1) * TG::TBYTES;
        if (t + 1 < nt) {
            const bf16_t *kg, *vg; int ks, vu;
            src(t + 1, kg, ks, vg, vu);
            stage_tile<NMAP, DV>(tiles + ((t + 1) & 1) * TG::TBYTES, kg, ks, vg, vu, wave, lane);
        }
        comp(t, cur);
        asm volatile("s_waitcnt vmcnt(0)" ::: "memory");
        __syncthreads();
    }
}

template <int NMAP, int DV, bool HASBIAS>
DI void compute_unit(AttnSt<NMAP, DV>& st, const UnitFrags<NMAP, DV>& f, const bf16x8 (&qf)[NMAP][2], float sc, const float (&bias)[8]) {
    bf16x8 pk[NMAP];
#pragma unroll
    for (int m = 0; m < NMAP; ++m) {
        f32x4 sa = (f32x4){0.f, 0.f, 0.f, 0.f}, sb = sa;
        sa = mfma16(f.k[m][0][0], qf[m][0], sa); sa = mfma16(f.k[m][0][1], qf[m][1], sa);
        sb = mfma16(f.k[m][1][0], qf[m][0], sb); sb = mfma16(f.k[m][1][1], qf[m][1], sb);
        float s[8];
#pragma unroll
        for (int j = 0; j < 4; ++j) { s[j] = sa[j] * sc; s[4 + j] = sb[j] * sc; }
        if (HASBIAS) {
#pragma unroll
            for (int j = 0; j < 8; ++j) s[j] += bias[j];
        }
        float mx = fmaxf(fmaxf(fmaxf(s[0], s[1]), fmaxf(s[2], s[3])), fmaxf(fmaxf(s[4], s[5]), fmaxf(s[6], s[7])));
        mx = grp_max(mx);
        const float mnew = fmaxf(st.m[m], mx);
        const float alpha = fexp2(st.m[m] - mnew);
        float ps = 0.f;
#pragma unroll
        for (int j = 0; j < 8; ++j) { s[j] = fexp2(s[j] - mnew); ps += s[j]; }
        st.l[m] = st.l[m] * alpha + ps; st.m[m] = mnew;
        if (__builtin_amdgcn_ballot_w64(alpha != 1.f) != 0ull) {
#pragma unroll
            for (int vb = 0; vb < DV / 16; ++vb) st.O[m][vb] *= alpha;
        }
        pk[m] = pack8(s[0], s[1], s[2], s[3], s[4], s[5], s[6], s[7]);
    }
#pragma unroll
    for (int vb = 0; vb < DV / 16; ++vb) {
#pragma unroll
        for (int m = 0; m < NMAP; ++m) st.O[m][vb] = mfma16(f.v[vb], pk[m], st.O[m][vb]);
    }
}

template <int NMAP, int DV>
DI void attn_init(AttnSt<NMAP, DV>& st) {
#pragma unroll
    for (int m = 0; m < NMAP; ++m) {
        st.m[m] = -INFINITY; st.l[m] = 0.f;
#pragma unroll
        for (int vb = 0; vb < DV / 16; ++vb) st.O[m][vb] = (f32x4){0.f, 0.f, 0.f, 0.f};
    }
}

template <bool LAT>
DI void item_diffattn(const Params& pin, int l, int seq, int h, int qt, unsigned char* smem, int wave, int lane) {
    const Params& p = pin; unsigned char* const ws_ = opaque_ws(pin.ws); float* const out_ = opaque_out(pin.out); lane = opaque_v(lane); wave = opaque_s(wave);
    const int lr = lane & 15, g = lane >> 4;
    const int nseq = LAT ? 1024 : 256;
    const int tok0 = LAT ? NCTX + seq * 1024 : seq * 256;
    const bf16_t* P = (const bf16_t*)(ws_ + OFF_P);
    const int q0 = qt * 64 + wave * 16;
    bf16x8 qf[2][2];
    {
        const bf16_t* qp = P + (size_t)(tok0 + q0 + lr) * NIN + h * 128 + 8 * g;
#pragma unroll
        for (int m = 0; m < 2; ++m)
#pragma unroll
            for (int kk = 0; kk < 2; ++kk) qf[m][kk] = *(const bf16x8*)(qp + m * 64 + kk * 32);
    }
    AttnSt<2, 128> st;
    attn_init<2, 128>(st);
    const float sc = 0.125f * LOG2E;
    const size_t hb = (size_t)((seq * 4 + l) * 4 + h);
    const bf16_t* kc = (const bf16_t*)(ws_ + OFF_CAK) + hb * 512 * 128;
    const bf16_t* vc = (const bf16_t*)(ws_ + OFF_CAVT) + hb * 128 * 512;
    const bf16_t* kn = P + (size_t)tok0 * NIN + 512 + h * 128;
    const bf16_t* vn = (const bf16_t*)(ws_ + OFF_PT_AV) + (size_t)tok0 * 512 + (size_t)(h * 128) * 32;
    const int ncache = LAT ? 8 : 0;
    __syncthreads();
    tile_pipeline<2, 128>(smem, ncache + nseq / 64, wave, lane,
        [&](int t, const bf16_t*& kg, int& ks, const bf16_t*& vg, int& vu) {
            if (t < ncache) { kg = kc + (size_t)t * 64 * 128; ks = 128; vg = vc + (size_t)(2 * t) * 128 * 32; vu = 128 * 32; }
            else { const int tt = t - ncache; kg = kn + (size_t)tt * 64 * NIN; ks = NIN; vg = vn + (size_t)(2 * tt) * 512 * 32; vu = 512 * 32; }
        },
        [&](int t, const unsigned char* buf) {
            const float nob[8] = {0.f, 0.f, 0.f, 0.f, 0.f, 0.f, 0.f, 0.f};
#pragma unroll 1
            for (int half = 0; half < 2; ++half) {
                UnitFrags<2, 128> f;
                lds_unit<2, 128>(f, buf, 32 * half, half * TileGeom<2, 128>::VUNIT + g * 16, lr, g);
                compute_unit<2, 128, false>(st, f, qf, sc, nob);
            }
        });
    const float inv0 = 1.f / grp_sum(st.l[0]), inv1 = 1.f / grp_sum(st.l[1]);
    const float* lamp = (const float*)(ws_ + OFF_LAM);
    const float lam = lamp[l * 2], lam_init = lamp[l * 2 + 1];
    const float c1 = lam * inv1;
    float ss = 0.f;
#pragma unroll
    for (int vb = 0; vb < 8; ++vb)
#pragma unroll
        for (int i = 0; i < 4; ++i) {
            const float o = st.O[0][vb][i] * inv0 - st.O[1][vb][i] * c1;
            st.O[0][vb][i] = o; ss += o * o;
        }
    ss = grp_sum(ss);
    const float r = rsqrtf(ss * (1.f / 128.f) + LN_EPS) * (1.f - lam_init);
    bf16_t* MIX = (bf16_t*)(ws_ + OFF_MIX) + (size_t)(tok0 + q0 + lr) * 1024 + h * 128;
    const float* gn = p.diff_norm_g + l * 128;
#pragma unroll
    for (int vb = 0; vb < 8; ++vb) {
        const int v = vb * 16 + 4 * g;
        const float4 g4 = *(const float4*)(gn + v);
        uint2 o; o.x = pack2(st.O[0][vb][0] * r * g4.x, st.O[0][vb][1] * r * g4.y);
        o.y = pack2(st.O[0][vb][2] * r * g4.z, st.O[0][vb][3] * r * g4.w);
        *(uint2*)(MIX + v) = o;
    }
}

DI void item_diffattn_lat(const Params& pin, int l, int seq, int h, int qt32, unsigned char* smem, int wave, int lane) {
    const Params& p = pin; unsigned char* const ws_ = opaque_ws(pin.ws); float* const out_ = opaque_out(pin.out); lane = opaque_v(lane); wave = opaque_s(wave);
    const int lr = lane & 15, g = lane >> 4;
    const int tok0 = NCTX + seq * 1024;
    const bf16_t* P = (const bf16_t*)(ws_ + OFF_P);
    const int msel = wave & 1;
    const int q0 = qt32 * 32 + (wave >> 1) * 16;
    bf16x8 qf[1][2];
    {
        const bf16_t* qp = P + (size_t)(tok0 + q0 + lr) * NIN + h * 128 + msel * 64 + 8 * g;
        qf[0][0] = *(const bf16x8*)(qp); qf[0][1] = *(const bf16x8*)(qp + 32);
    }
    AttnSt<1, 128> st;
    attn_init<1, 128>(st);
    const float sc = 0.125f * LOG2E;
    const size_t hb = (size_t)((seq * 4 + l) * 4 + h);
    const bf16_t* kc = (const bf16_t*)(ws_ + OFF_CAK) + hb * 512 * 128;
    const bf16_t* vc = (const bf16_t*)(ws_ + OFF_CAVT) + hb * 128 * 512;
    const bf16_t* kn = P + (size_t)tok0 * NIN + 512 + h * 128;
    const bf16_t* vn = (const bf16_t*)(ws_ + OFF_PT_AV) + (size_t)tok0 * 512 + (size_t)(h * 128) * 32;
    __syncthreads();
    tile_pipeline<2, 128>(smem, 24, wave, lane,
        [&](int t, const bf16_t*& kg, int& ks, const bf16_t*& vg, int& vu) {
            if (t < 8) { kg = kc + (size_t)t * 64 * 128; ks = 128; vg = vc + (size_t)(2 * t) * 128 * 32; vu = 128 * 32; }
            else { const int tt = t - 8; kg = kn + (size_t)tt * 64 * NIN; ks = NIN; vg = vn + (size_t)(2 * tt) * 512 * 32; vu = 512 * 32; }
        },
        [&](int t, const unsigned char* buf) {
            const float nob[8] = {0.f, 0.f, 0.f, 0.f, 0.f, 0.f, 0.f, 0.f};
#pragma unroll
            for (int half = 0; half < 2; ++half) {
                UnitFrags<1, 128> f;
                lds_unit_sel<128>(f, buf, 32 * half, half * TileGeom<2, 128>::VUNIT + g * 16, lr, g, msel);
                compute_unit<1, 128, false>(st, f, qf, sc, nob);
            }
        });
    const float* lamp = (const float*)(ws_ + OFF_LAM);
    const float lam = lamp[l * 2], lam_init = lamp[l * 2 + 1];
    const float inv = (msel ? lam : 1.f) / grp_sum(st.l[0]);
    float* xb = (float*)smem + (wave >> 1) * 32 * 64 + lane;
    if (msel) {
#pragma unroll
        for (int vb = 0; vb < 8; ++vb)
#pragma unroll
            for (int i = 0; i < 4; ++i) xb[(vb * 4 + i) * 64] = st.O[0][vb][i] * inv;
    }
    __syncthreads();
    if (msel) return;
    float ss = 0.f;
#pragma unroll
    for (int vb = 0; vb < 8; ++vb)
#pragma unroll
        for (int i = 0; i < 4; ++i) {
            const float o = st.O[0][vb][i] * inv - xb[(vb * 4 + i) * 64];
            st.O[0][vb][i] = o; ss += o * o;
        }
    ss = grp_sum(ss);
    const float r = rsqrtf(ss * (1.f / 128.f) + LN_EPS) * (1.f - lam_init);
    bf16_t* MIX = (bf16_t*)(ws_ + OFF_MIX) + (size_t)(tok0 + q0 + lr) * 1024 + h * 128;
    const float* gn = p.diff_norm_g + l * 128;
#pragma unroll
    for (int vb = 0; vb < 8; ++vb) {
        const int v = vb * 16 + 4 * g;
        const float4 g4 = *(const float4*)(gn + v);
        uint2 o; o.x = pack2(st.O[0][vb][0] * r * g4.x, st.O[0][vb][1] * r * g4.y);
        o.y = pack2(st.O[0][vb][2] * r * g4.z, st.O[0][vb][3] * r * g4.w);
        *(uint2*)(MIX + v) = o;
    }
}

DI void item_dense(const Params& pin, int seq, int h, int qt, unsigned char* smem, int wave, int lane) {
    const Params& p = pin; unsigned char* const ws_ = opaque_ws(pin.ws); float* const out_ = opaque_out(pin.out); lane = opaque_v(lane); wave = opaque_s(wave);
    const int lr = lane & 15, g = lane >> 4;
    const int tok0 = seq * 256;
    const bf16_t* P = (const bf16_t*)(ws_ + OFF_P);
    const int q0 = qt * 64 + wave * 16;
    bf16x8 qf[1][2];
    {
        const bf16_t* qp = P + (size_t)(tok0 + q0 + lr) * NIN + 1536 + h * 64 + 8 * g;
        qf[0][0] = *(const bf16x8*)(qp); qf[0][1] = *(const bf16x8*)(qp + 32);
    }
    AttnSt<1, 64> st;
    attn_init<1, 64>(st);
    const bf16_t* kn = P + (size_t)tok0 * NIN + 1792 + h * 64;
    const bf16_t* vn = (const bf16_t*)(ws_ + OFF_PT_BV) + (size_t)tok0 * 256 + (size_t)(h * 64) * 32;
    const float sc = 0.125f * LOG2E;
    __syncthreads();
    tile_pipeline<1, 64>(smem, 4, wave, lane,
        [&](int t, const bf16_t*& kg, int& ks, const bf16_t*& vg, int& vu) {
            kg = kn + (size_t)t * 64 * NIN; ks = NIN; vg = vn + (size_t)(2 * t) * 256 * 32; vu = 256 * 32;
        },
        [&](int t, const unsigned char* buf) {
            const float nob[8] = {0.f, 0.f, 0.f, 0.f, 0.f, 0.f, 0.f, 0.f};
#pragma unroll
            for (int half = 0; half < 2; ++half) {
                UnitFrags<1, 64> f;
                lds_unit<1, 64>(f, buf, 32 * half, half * TileGeom<1, 64>::VUNIT + g * 16, lr, g);
                compute_unit<1, 64, false>(st, f, qf, sc, nob);
            }
        });
    const float inv = 1.f / grp_sum(st.l[0]);
    bf16_t* MIX = (bf16_t*)(ws_ + OFF_MIX) + (size_t)(tok0 + q0 + lr) * 1024 + 512 + h * 64;
#pragma unroll
    for (int vb = 0; vb < 4; ++vb) {
        uint2 o; o.x = pack2(st.O[0][vb][0] * inv, st.O[0][vb][1] * inv); o.y = pack2(st.O[0][vb][2] * inv, st.O[0][vb][3] * inv);
        *(uint2*)(MIX + vb * 16 + 4 * g) = o;
    }
}

DI void item_na(const Params& pin, int l, int sb, int h, int r, unsigned char* smem, int wave, int lane) {
    const Params& p = pin; unsigned char* const ws_ = opaque_ws(pin.ws); float* const out_ = opaque_out(pin.out); lane = opaque_v(lane); wave = opaque_s(wave);
    const int lr = lane & 15, g = lane >> 4;
    const int tok0 = NCTX + sb * 1024;
    const bf16_t* P = (const bf16_t*)(ws_ + OFF_P);
    const int qc = wave * 16 + lr;
    const int q0 = r * 64 + wave * 16;
    bf16x8 qf[1][2];
    {
        const bf16_t* qp = P + (size_t)(tok0 + q0 + lr) * NIN + 1536 + h * 64 + 8 * g;
        qf[0][0] = *(const bf16x8*)(qp); qf[0][1] = *(const bf16x8*)(qp + 32);
    }
    AttnSt<1, 64> st;
    attn_init<1, 64>(st);
    const float sc = 0.125f * LOG2E;
    const size_t hb = (size_t)((sb * 4 + l) * 4 + h);
    const bf16_t* kc = (const bf16_t*)(ws_ + OFF_CBK) + hb * 512 * 64;
    const bf16_t* vc = (const bf16_t*)(ws_ + OFF_CBVT) + hb * 64 * 512;
    const bf16_t* kn = P + (size_t)tok0 * NIN + 1792 + h * 64;
    const bf16_t* vn = (const bf16_t*)(ws_ + OFF_PT_BV) + (size_t)tok0 * 256 + (size_t)(h * 64) * 32;
    const int kr0 = min(max(r - 4, 0), 8);
    const int bs = min(max(wave * 16 - 8, 0), 32);
    const int wstart = min(max(qc - 8, 0), 48);
    const float* rpb = p.nat_rpb + (size_t)(l * 4 + h) * 15 * 31;
    __syncthreads();
    tile_pipeline<1, 64>(smem, 16, wave, lane,
        [&](int t, const bf16_t*& kg, int& ks, const bf16_t*& vg, int& vu) {
            if (t < 8) { kg = kc + (size_t)t * 64 * 64; ks = 64; vg = vc + (size_t)(2 * t) * 64 * 32; vu = 64 * 32; }
            else { const int kr = kr0 + t - 8; kg = kn + (size_t)kr * 64 * NIN; ks = NIN; vg = vn + (size_t)(2 * kr) * 256 * 32; vu = 256 * 32; }
        },
        [&](int t, const unsigned char* buf) {
            if (t < 8) {
                const float nob[8] = {0.f, 0.f, 0.f, 0.f, 0.f, 0.f, 0.f, 0.f};
#pragma unroll
                for (int half = 0; half < 2; ++half) {
                    UnitFrags<1, 64> f;
                    lds_unit<1, 64>(f, buf, 32 * half, half * TileGeom<1, 64>::VUNIT + g * 16, lr, g);
                    compute_unit<1, 64, false>(st, f, qf, sc, nob);
                }
            } else {
                const int kr = kr0 + t - 8;
                const int nl = bs + 8 * g;
                UnitFrags<1, 64> f;
                lds_unit<1, 64>(f, buf, bs, (nl >> 5) * TileGeom<1, 64>::VUNIT + (nl & 31) * 2, lr, g);
                float bias[8];
                const float* rrow = rpb + (kr - r + 7) * 31;
#pragma unroll
                for (int j = 0; j < 8; ++j) {
                    const int kcol = bs + 8 * g + j;
                    const bool valid = (kcol >= wstart) && (kcol < wstart + 16);
                    const int dc = min(max(kcol - qc + 15, 0), 30);
                    bias[j] = valid ? rrow[dc] * LOG2E : -INFINITY;
                }
                compute_unit<1, 64, true>(st, f, qf, sc, bias);
            }
        });
    const float inv = 1.f / grp_sum(st.l[0]);
    bf16_t* MIX = (bf16_t*)(ws_ + OFF_MIX) + (size_t)(tok0 + q0 + lr) * 1024 + 512 + h * 64;
#pragma unroll
    for (int vb = 0; vb < 4; ++vb) {
        uint2 o; o.x = pack2(st.O[0][vb][0] * inv, st.O[0][vb][1] * inv); o.y = pack2(st.O[0][vb][2] * inv, st.O[0][vb][3] * inv);
        *(uint2*)(MIX + vb * 16 + 4 * g) = o;
    }
}

DI float wave_excl_sum(float v, int lane) {
    float x = v;
#pragma unroll
    for (int d = 1; d < 64; d <<= 1) { const float y = __shfl_up(x, d); if (lane >= d) x += y; }
    return x - v;
}
DI float wave_excl_max(float v, int lane, float init) {
    float x = v;
#pragma unroll
    for (int d = 1; d < 64; d <<= 1) { const float y = __shfl_up(x, d); if (lane >= d) x = fmaxf(x, y); }
    const float ex = __shfl_up(x, 1);
    return lane == 0 ? init : fmaxf(init, ex);
}
DI void mlstm_scan(const float* __restrict__ G, int h, int nseq, int dir, float* aA, float* MA, float* FA, float m0, int lane) {
    const int per = nseq >> 6;
    float run = 0.f;
    for (int e = 0; e < per; ++e) {
        const int idx = lane * per + e, pos = dir ? nseq - 1 - idx : idx;
        const float f = G[(size_t)pos * 16 + (dir ? 12 : 4) + h];
        const float lf = fminf(f, 0.f) - __logf(1.f + __expf(-fabsf(f)));
        run += lf; FA[pos] = run;
    }
    const float off = wave_excl_sum(run, lane);
    float rmax = -INFINITY;
    for (int e = 0; e < per; ++e) {
        const int idx = lane * per + e, pos = dir ? nseq - 1 - idx : idx;
        const float F = FA[pos] + off; FA[pos] = F;
        const float a = G[(size_t)pos * 16 + (dir ? 8 : 0) + h] - F;
        aA[pos] = a; rmax = fmaxf(rmax, a); MA[pos] = rmax;
    }
    const float pre = wave_excl_max(rmax, lane, m0);
    for (int e = 0; e < per; ++e) {
        const int idx = lane * per + e, pos = dir ? nseq - 1 - idx : idx;
        MA[pos] = fmaxf(MA[pos], pre);
    }
}

DI void mlstm_unit(f32x4 (&O)[4], float& den, int dir, int t, const bf16x8 (&qf)[2], const UnitFrags<1, 64>& f, const float* aA, float Mt, int key0, int g) {
    f32x4 sa = (f32x4){0.f, 0.f, 0.f, 0.f}, sb = sa;
    sa = mfma16(f.k[0][0][0], qf[0], sa); sa = mfma16(f.k[0][0][1], qf[1], sa);
    sb = mfma16(f.k[0][1][0], qf[0], sb); sb = mfma16(f.k[0][1][1], qf[1], sb);
    const float4 a0 = *(const float4*)(aA + key0 + 8 * g), a1 = *(const float4*)(aA + key0 + 8 * g + 4);
    const float av[8] = {a0.x, a0.y, a0.z, a0.w, a1.x, a1.y, a1.z, a1.w};
    float pv[8];
#pragma unroll
    for (int j = 0; j < 8; ++j) {
        const int key = key0 + 8 * g + j;
        const bool ok = dir ? (key >= t) : (key <= t);
        const float w = ok ? fexp2((av[j] - Mt) * LOG2E) : 0.f;
        const float sv = (j < 4) ? sa[j & 3] : sb[j & 3];
        pv[j] = sv * 0.125f * w;
        den += pv[j];
    }
    const bf16x8 pk = pack8(pv[0], pv[1], pv[2], pv[3], pv[4], pv[5], pv[6], pv[7]);
#pragma unroll
    for (int vb = 0; vb < 4; ++vb) O[vb] = mfma16(f.v[vb], pk, O[vb]);
}

template <bool LAT>
DI void item_mlstm(const Params& pin, int l, int seq, int h, int qt, unsigned char* smem, int wave, int lane) {
    const Params& p = pin; unsigned char* const ws_ = opaque_ws(pin.ws); float* const out_ = opaque_out(pin.out); lane = opaque_v(lane); wave = opaque_s(wave);
    const int lr = lane & 15, g = lane >> 4;
    const int nseq = LAT ? 1024 : 256;
    const int tok0 = LAT ? NCTX + seq * 1024 : seq * 256;
    float* aF = (float*)smem; float* MF = aF + 1024; float* FF = MF + 1024;
    float* aB = FF + 1024; float* MB = aB + 1024; float* FB = MB + 1024;
    unsigned char* tiles = smem + 24576;
    const float* G = (const float*)(ws_ + OFF_G) + (size_t)tok0 * 16;
    float m0f = 0.f, m0b = 0.f;
    const int sidx_f = ((seq * 4 + l) * 2 + 0) * 4 + h, sidx_b = ((seq * 4 + l) * 2 + 1) * 4 + h;
    if (LAT) { m0f = p.state_m[sidx_f]; m0b = p.state_m[sidx_b]; }
    __syncthreads();
    if (wave == 0) mlstm_scan(G, h, nseq, 0, aF, MF, FF, m0f, lane);
    if (wave == 1) mlstm_scan(G, h, nseq, 1, aB, MB, FB, m0b, lane);
    __syncthreads();
    const bf16_t* P = (const bf16_t*)(ws_ + OFF_P);
    const int q0 = qt * 64 + wave * 16;
    const int t = q0 + lr;
    bf16x8 qf[2];
    {
        const bf16_t* qp = P + (size_t)(tok0 + t) * NIN + 2304 + h * 64 + 8 * g;
        qf[0] = *(const bf16x8*)(qp); qf[1] = *(const bf16x8*)(qp + 32);
    }
    const bf16_t* kn = P + (size_t)tok0 * NIN + 2560 + h * 64;
    const bf16_t* vn = (const bf16_t*)(ws_ + OFF_PT_CV) + (size_t)tok0 * 256 + (size_t)(h * 64) * 32;
    const float Mf = MF[t], Mb = MB[t], Ff = FF[t], Fb = FB[t];
    f32x4 Of[4], Ob[4];
#pragma unroll
    for (int vb = 0; vb < 4; ++vb) { Of[vb] = (f32x4){0.f, 0.f, 0.f, 0.f}; Ob[vb] = Of[vb]; }
    float denf = 0.f, denb = 0.f;
    tile_pipeline<1, 64>(tiles, nseq / 64, wave, lane,
        [&](int tt, const bf16_t*& kg, int& ks, const bf16_t*& vg, int& vu) {
            kg = kn + (size_t)tt * 64 * NIN; ks = NIN; vg = vn + (size_t)(2 * tt) * 256 * 32; vu = 256 * 32;
        },
        [&](int tt, const unsigned char* buf) {
#pragma unroll
            for (int half = 0; half < 2; ++half) {
                const int key0 = tt * 64 + half * 32;
                const bool dof = key0 <= q0 + 15, dob = key0 + 31 >= q0;
                if (dof || dob) {
                    UnitFrags<1, 64> f;
                    lds_unit<1, 64>(f, buf, 32 * half, half * TileGeom<1, 64>::VUNIT + g * 16, lr, g);
                    if (dof) mlstm_unit(Of, denf, 0, t, qf, f, aF, Mf, key0, g);
                    if (dob) mlstm_unit(Ob, denb, 1, t, qf, f, aB, Mb, key0, g);
                }
            }
        });
    if (LAT) {
        const bf16_t* qp2 = P + (size_t)(tok0 + t) * NIN + 2304 + h * 64 + 4 * g;
#pragma unroll
        for (int dir = 0; dir < 2; ++dir) {
            const int sidx = dir ? sidx_b : sidx_f;
            const float e = fexp2(((dir ? m0b : m0f) - (dir ? Mb : Mf)) * LOG2E) * 0.125f;
            const bf16_t* c0t = (const bf16_t*)(ws_ + OFF_C0T) + (size_t)sidx * 4096 + lr * 64 + 4 * g;
            const float* n0 = p.state_n + (size_t)sidx * 64;
            float dacc = 0.f;
#pragma unroll
            for (int u2 = 0; u2 < 2; ++u2) {
                const bf16x4 qa = *(const bf16x4*)(qp2 + u2 * 32), qb = *(const bf16x4*)(qp2 + u2 * 32 + 16);
                const float4 na = *(const float4*)(n0 + u2 * 32 + 4 * g), nb = *(const float4*)(n0 + u2 * 32 + 16 + 4 * g);
                float pv[8];
#pragma unroll
                for (int j = 0; j < 4; ++j) { pv[j] = bf2f((unsigned short)qa[j]) * e; pv[4 + j] = bf2f((unsigned short)qb[j]) * e; }
                dacc += pv[0] * na.x + pv[1] * na.y + pv[2] * na.z + pv[3] * na.w + pv[4] * nb.x + pv[5] * nb.y + pv[6] * nb.z + pv[7] * nb.w;
                const bf16x8 pk = pack8(pv[0], pv[1], pv[2], pv[3], pv[4], pv[5], pv[6], pv[7]);
#pragma unroll
                for (int vb = 0; vb < 4; ++vb) {
                    const bf16_t* cp = c0t + (size_t)vb * 16 * 64 + u2 * 32;
                    const bf16x8 cf = cat4(*(const bf16x4*)(cp), *(const bf16x4*)(cp + 16));
                    if (dir) Ob[vb] = mfma16(cf, pk, Ob[vb]); else Of[vb] = mfma16(cf, pk, Of[vb]);
                }
            }
            if (dir) denb += dacc; else denf += dacc;
        }
    }
    denf = grp_sum(denf); denb = grp_sum(denb);
    const float rf = 1.f / fmaxf(fabsf(denf), expf(-(Ff + Mf)));
    const float rb = 1.f / fmaxf(fabsf(denb), expf(-(Fb + Mb)));
    float ss = 0.f;
#pragma unroll
    for (int vb = 0; vb < 4; ++vb)
#pragma unroll
        for (int i = 0; i < 4; ++i) { const float hs = Of[vb][i] * rf + Ob[vb][i] * rb; Of[vb][i] = hs; ss += hs * hs; }
    ss = grp_sum(ss);
    const float rn = rsqrtf(ss * (1.f / 64.f) + LN_EPS);
    const float* gn = p.mlstm_norm_g + (size_t)(l * 4 + h) * 64;
    const bf16_t* op = P + (size_t)(tok0 + t) * NIN + 3072 + h * 64;
    bf16_t* MIX = (bf16_t*)(ws_ + OFF_MIX) + (size_t)(tok0 + t) * 1024 + 768 + h * 64;
#pragma unroll
    for (int vb = 0; vb < 4; ++vb) {
        const int v = vb * 16 + 4 * g;
        const float4 g4 = *(const float4*)(gn + v);
        const bf16x4 o4 = *(const bf16x4*)(op + v);
        float sg[4];
#pragma unroll
        for (int i = 0; i < 4; ++i) sg[i] = 1.f / (1.f + __expf(-bf2f((unsigned short)o4[i])));
        uint2 o; o.x = pack2(Of[vb][0] * rn * g4.x * sg[0], Of[vb][1] * rn * g4.y * sg[1]);
        o.y = pack2(Of[vb][2] * rn * g4.z * sg[2], Of[vb][3] * rn * g4.w * sg[3]);
        *(uint2*)(MIX + v) = o;
    }
}

DI void item_mlstm_state(const Params& pin, int l, int b, int h, int dir, unsigned char* smem, int wave, int lane) {
    const Params& p = pin; unsigned char* const ws_ = opaque_ws(pin.ws); float* const out_ = opaque_out(pin.out); lane = opaque_v(lane); wave = opaque_s(wave);
    const int lr = lane & 15, g = lane >> 4;
    const int tok0 = b * 256;
    float* aA = (float*)smem; float* MA = aA + 1024; float* FA = MA + 1024;
    const float* G = (const float*)(ws_ + OFF_G) + (size_t)tok0 * 16;
    __syncthreads();
    if (wave == 0) mlstm_scan(G, h, 256, dir, aA, MA, FA, 0.f, lane);
    __syncthreads();
    const float Mfin = dir ? MA[0] : MA[255];
    const float Ffin = dir ? FA[0] : FA[255];
    const bf16_t* KT = (const bf16_t*)(ws_ + OFF_PT_CK) + (size_t)tok0 * 256 + (size_t)(h * 64 + wave * 16 + lr) * 32 + 8 * g;
    const bf16_t* VT = (const bf16_t*)(ws_ + OFF_PT_CV) + (size_t)tok0 * 256 + (size_t)(h * 64 + lr) * 32 + 8 * g;
    f32x4 C[4];
#pragma unroll
    for (int vb = 0; vb < 4; ++vb) C[vb] = (f32x4){0.f, 0.f, 0.f, 0.f};
    float nacc = 0.f;
#pragma unroll 4
    for (int u = 0; u < 8; ++u) {
        const int s0 = u * 32;
        const bf16x8 kf = *(const bf16x8*)(KT + (size_t)u * 256 * 32);
        const float4 a0 = *(const float4*)(aA + s0 + 8 * g), a1 = *(const float4*)(aA + s0 + 8 * g + 4);
        const float av[8] = {a0.x, a0.y, a0.z, a0.w, a1.x, a1.y, a1.z, a1.w};
        float kw[8];
#pragma unroll
        for (int j = 0; j < 8; ++j) { kw[j] = bf2f((unsigned short)kf[j]) * fexp2((av[j] - Mfin) * LOG2E); nacc += kw[j]; }
        const bf16x8 af = pack8(kw[0], kw[1], kw[2], kw[3], kw[4], kw[5], kw[6], kw[7]);
#pragma unroll
        for (int vb = 0; vb < 4; ++vb) {
            const bf16x8 vf = *(const bf16x8*)(VT + (size_t)u * 256 * 32 + vb * 16 * 32);
            C[vb] = mfma16(af, vf, C[vb]);
        }
    }
    const size_t sidx = (size_t)((b * 4 + l) * 2 + dir) * 4 + h;
    float* oc = out_ + O_NC + sidx * 4096;
#pragma unroll
    for (int vb = 0; vb < 4; ++vb)
#pragma unroll
        for (int i = 0; i < 4; ++i) oc[(wave * 16 + 4 * g + i) * 64 + vb * 16 + lr] = C[vb][i];
    nacc = grp_sum(nacc);
    if (g == 0) out_[O_NN + sidx * 64 + wave * 16 + lr] = nacc;
    if (wave == 0 && lane == 0) out_[O_NM + sidx] = Ffin + Mfin;
}

DI void mixer_phase(const Params& p, int l, unsigned char* smem) {
    const int tid_ = opaque_v(threadIdx.x); const int lane = tid_ & 63, wave = (tid_ >> 6) & 3;
    const int half = __builtin_amdgcn_readfirstlane(tid_ >> 8);
    unsigned char* sm = smem + half * HALF_LDS;
    unsigned* ctr = (unsigned*)(p.ws + OFF_MIXCTR) + l;
    volatile unsigned* slot = (volatile unsigned*)(smem + LDS_BYTES + 16);
    for (;;) {
        __syncthreads();
        if (tid_ == 0) *slot = __hip_atomic_fetch_add(ctr, 1u, __ATOMIC_RELAXED, __HIP_MEMORY_SCOPE_AGENT);
        __syncthreads();
        const int it = __builtin_amdgcn_readfirstlane(2 * (int)*slot + half);
        if (it >= 1408) break;
        if (it < 256) { item_diffattn_lat(p, l, it >> 7, (it >> 5) & 3, it & 31, sm, wave, lane); }
        else if (it < 384) { const int i = it - 256; item_mlstm<true>(p, l, i >> 6, (i >> 4) & 3, i & 15, sm, wave, lane); }
        else if (it < 512) { const int i = it - 384; item_mlstm_state(p, l, i >> 3, (i >> 1) & 3, i & 1, sm, wave, lane); }
        else if (it < 640) { const int i = it - 512; item_na(p, l, i >> 6, (i >> 4) & 3, i & 15, sm, wave, lane); }
        else if (it < 896) { const int i = it - 640; item_diffattn<false>(p, l, i >> 4, (i >> 2) & 3, i & 3, sm, wave, lane); }
        else if (it < 1152) { const int i = it - 896; item_mlstm<false>(p, l, i >> 4, (i >> 2) & 3, i & 3, sm, wave, lane); }
        else { const int i = it - 1152; item_dense(p, i >> 4, (i >> 2) & 3, i & 3, sm, wave, lane); }
    }
}

#define XB_TMO      128
#define XB_XCNT(j)  (256  + 64 * (j))
#define XB_XSUB(j)  (1280 + 64 * (j))
#define XB_XGEN(j)  (2304 + 64 * (j))
#define XB_TOP      3328
#define XB_TOPGEN   3392
#define XCD_BAR_WORDS 3456
#define XB_SPIN_CAP (1u << 18)

__device__ __forceinline__ unsigned xb_ld(unsigned* p)              { return __hip_atomic_load(p, __ATOMIC_RELAXED, __HIP_MEMORY_SCOPE_AGENT); }
__device__ __forceinline__ unsigned xb_add(unsigned* p, unsigned v) { return __hip_atomic_fetch_add(p, v, __ATOMIC_RELAXED, __HIP_MEMORY_SCOPE_AGENT); }
__device__ __forceinline__ unsigned xb_xcc_id() { return (unsigned)__builtin_amdgcn_s_getreg((3 << 11) | 20) & 0xFu; }
#define XB_SPIN(cond, bar) do { unsigned _sp = 0; while (cond) { __builtin_amdgcn_s_sleep(1); \
    if ((++_sp & 255u) == 0u) { if (xb_ld(&(bar)[XB_TMO])) break; if (_sp > XB_SPIN_CAP) { atomicAdd(&(bar)[XB_TMO], 1u); break; } } } } while (0)

struct XcdBarrier {
    unsigned* bar; unsigned x;
    volatile LAS unsigned* st;
};

__device__ __forceinline__ XcdBarrier xcd_barrier_post(unsigned* bar, volatile LAS unsigned* st) {
    XcdBarrier b; b.bar = bar; b.x = xb_xcc_id(); b.st = st;
    if (threadIdx.x == 0) (void)xb_add(&bar[XB_XCNT(b.x)], 1u);
    return b;
}
__device__ __forceinline__ void xcd_barrier_complete(unsigned* bar, unsigned x, unsigned& nloc, unsigned& nx) {
    const unsigned G = gridDim.x * gridDim.y * gridDim.z;
    unsigned sum, cnt, mine, sp = 0u;
    for (;;) {
        sum = 0u; cnt = 0u; mine = 0u;
#pragma unroll
        for (unsigned j = 0; j < 16; ++j) { const unsigned c = xb_ld(&bar[XB_XCNT(j)]); sum += c; cnt += (c > 0u) ? 1u : 0u; mine = (j == x) ? c : mine; }
        if (sum == G) break;
        __builtin_amdgcn_s_sleep(1);
        if ((++sp & 255u) == 0u) { if (xb_ld(&bar[XB_TMO])) break; if (sp > XB_SPIN_CAP) { atomicAdd(&bar[XB_TMO], 1u); break; } }
    }
    nloc = mine > 0u ? mine : 1u; nx = cnt > 0u ? cnt : 1u;
}

__device__ __forceinline__ void xcd_barrier(const XcdBarrier& b) {
    asm volatile("s_waitcnt vmcnt(0)" ::: "memory");
    __syncthreads();
    if (threadIdx.x == 0) {
        unsigned* bar = b.bar;
        __builtin_amdgcn_s_waitcnt(0);
        unsigned nloc = b.st[0], nx = b.st[1];
        if (nloc == 0u) { xcd_barrier_complete(bar, b.x, nloc, nx); b.st[0] = nloc; b.st[1] = nx; }
        const unsigned old = xb_add(&bar[XB_XSUB(b.x)], 1u);
        const unsigned gen = old / nloc;
        if (old + 1u == (gen + 1u) * nloc) {
            __builtin_amdgcn_fence(__ATOMIC_RELEASE, "agent");
            asm volatile("s_waitcnt vmcnt(0)" ::: "memory");
            const unsigned og = xb_add(&bar[XB_TOP], 1u);
            const unsigned tg = og / nx;
            if (og + 1u == (tg + 1u) * nx) xb_add(&bar[XB_TOPGEN], 1u);
            else XB_SPIN(xb_ld(&bar[XB_TOPGEN]) == tg, bar);
            __builtin_amdgcn_fence(__ATOMIC_ACQUIRE, "agent");
            xb_add(&bar[XB_XGEN(b.x)], 1u);
            asm volatile("s_waitcnt vmcnt(0)" ::: "memory");
        } else {
            XB_SPIN(xb_ld(&bar[XB_XGEN(b.x)]) == gen, bar);
            __builtin_amdgcn_fence(__ATOMIC_ACQUIRE, "agent");
            asm volatile("s_waitcnt vmcnt(0)" ::: "memory");
        }
    }
    __syncthreads();
}


constexpr int N_PHASES = 2 + 5 * 4;

__global__ void __launch_bounds__(512, 2) fwd_kernel(Params p) {
    __shared__ __attribute__((aligned(16))) unsigned char smem[LDS_BYTES + 32];
    if (threadIdx.x == 0) *(uint4*)(smem + LDS_BYTES) = make_uint4(0u, 0u, 0u, 0u);
    __syncthreads();
    XcdBarrier xb = xcd_barrier_post((unsigned*)(p.ws + OFF_BAR), (volatile LAS unsigned*)(smem + LDS_BYTES));
    for (int ph = p.ph_lo; ph < p.ph_hi; ++ph) {
        if (ph > p.ph_lo) {
            if (p.ph_hi > 1000) cg::this_grid().sync();
            xcd_barrier(xb);
        }
        const int l = ph < 2 ? 0 : (ph - 2) / 5, s = ph < 2 ? ph - 2 : (ph - 2) % 5;
        const int bit = 1 << (s + 2);
        const int reps = (DUPM & bit) ? 2 : 1;
        for (int rep = 0; rep < reps; ++rep) {
            if (rep) __syncthreads();
            if (s == -2) prep0(p, smem + __builtin_amdgcn_readfirstlane(threadIdx.x >> 8) * HALF_LDS);
            else if (s == -1) prep1(p);
            else if (s == 0) gemm_phase<EPI_INPROJ>(p, l, OFF_H, OFF_WT_IN + (size_t)l * NINP * DM * 2, NINP / 128, 1024, 0, smem);
            else if (s == 1) mixer_phase(p, l, smem);
            else if (s == 2) gemm_phase<EPI_LN1>(p, l, OFF_MIX, OFF_WT_OUT + (size_t)l * DM * DM * 2, 8, 1024, 1024, smem);
            else if (s == 3) gemm_phase<EPI_RELU2>(p, l, OFF_H, OFF_WT_1 + (size_t)l * DFF * DM * 2, 32, 1024, 4096, smem);
            else gemm_phase<EPI_LN2>(p, l, OFF_U, OFF_WT_2 + (size_t)l * DM * DFF * 2, 8, 4096, 1024, smem);
        }
    }
}

extern "C" void kernel_launch(void* const* d_in, const int* in_sizes, int n_in, void* d_out, int out_size, void* d_ws, size_t ws_size,
                              hipStream_t stream) {
    static int grid = 0;
    if (grid == 0) {
        if (n_in != 26 || ws_size < WS_END) { fprintf(stderr, "kernel_launch: unexpected n_in %d / ws %zu (need %zu)\n", n_in, ws_size, (size_t)WS_END); grid = -1; return; }
        int dev = 0, cus = 0, per_cu = 0;
        hipGetDevice(&dev);
        hipDeviceGetAttribute(&cus, hipDeviceAttributeMultiprocessorCount, dev);
        hipOccupancyMaxActiveBlocksPerMultiprocessor(&per_cu, (const void*)fwd_kernel, 512, 0);
        (void)per_cu;
        grid = cus;
        if (grid < 192) { fprintf(stderr, "kernel_launch: grid %d < 192 resident workgroups needed by the fused LayerNorm exchange\n", grid); grid = -1; return; }
    }
    if (grid < 0) return;
    Params p{};
    const float** pp = (const float**)&p;
    for (int i = 0; i < 26; ++i) pp[i] = (const float*)d_in[i];
    p.out = (float*)d_out; p.ws = (unsigned char*)d_ws;
    (void)hipMemsetAsync((unsigned char*)d_ws + OFF_BAR, 0, 16384, stream);
#if SINGLE_LAUNCH
    p.ph_lo = 0; p.ph_hi = N_PHASES;
    void* args[] = {&p};
    hipError_t e = hipLaunchCooperativeKernel((const void*)fwd_kernel, dim3(grid), dim3(512), args, 0, stream);
    if (e != hipSuccess) fprintf(stderr, "cooperative launch failed: %s (grid %d)\n", hipGetErrorString(e), grid);
#else
    for (int ph = 0; ph < N_PHASES; ++ph) {
        p.ph_lo = ph; p.ph_hi = ph + 1;
        void* args[] = {&p};
        hipError_t e = hipLaunchCooperativeKernel((const void*)fwd_kernel, dim3(grid), dim3(512), args, 0, stream);
        if (e != hipSuccess) { fprintf(stderr, "launch %d failed: %s (grid %d)\n", ph, hipGetErrorString(e), grid); break; }
    }
#endif
}
```

```cpp
#include <hip/hip_runtime.h>
#include <hip/hip_cooperative_groups.h>
#include <cstdio>
namespace cg = cooperative_groups;

#ifndef IM
#define IM 0xffff
#endif
#ifndef IM
#define IM 0xffff
#endif
#ifndef DUPM
#define DUPM 0
#endif
#ifndef PHM
#define PHM 0xffff
#endif
#ifndef SINGLE_LAUNCH
#define SINGLE_LAUNCH 1
#endif

#define LAS __attribute__((address_space(3)))
typedef unsigned short bf16_t;
typedef __attribute__((ext_vector_type(8))) short bf16x8;
typedef __attribute__((ext_vector_type(4))) short bf16x4;
typedef __attribute__((ext_vector_type(4))) float f32x4;
#define DI __device__ __forceinline__

constexpr int NTOK = 6144, NCTX = 4096, DM = 1024, NIN = 3344, NINP = 3456, DFF = 4096;
constexpr float ALPHA = 1.681792830507429f;
constexpr float LOG2E = 1.4426950408889634f;
constexpr float LN_EPS = 1e-5f;

constexpr size_t al256(size_t x) { return (x + 255) & ~(size_t)255; }
constexpr size_t OFF_WT_IN = 0;
constexpr size_t OFF_WT_OUT = OFF_WT_IN + al256((size_t)4 * NINP * DM * 2);
constexpr size_t OFF_WT_1 = OFF_WT_OUT + al256((size_t)4 * DM * DM * 2);
constexpr size_t OFF_WT_2 = OFF_WT_1 + al256((size_t)4 * DFF * DM * 2);
constexpr size_t OFF_MOD = OFF_WT_2 + al256((size_t)4 * DFF * DM * 2);
constexpr size_t OFF_X = OFF_MOD + al256((size_t)4 * 3 * 6144 * 4);
constexpr size_t OFF_H = OFF_X + al256((size_t)NTOK * DM * 4);
constexpr size_t OFF_P = OFF_H + al256((size_t)NTOK * DM * 2);
constexpr size_t OFF_PT_AV = OFF_P + al256((size_t)NTOK * NIN * 2);
constexpr size_t OFF_PT_BV = OFF_PT_AV + al256((size_t)NTOK * 512 * 2);
constexpr size_t OFF_PT_CV = OFF_PT_BV + al256((size_t)NTOK * 256 * 2);
constexpr size_t OFF_PT_CK = OFF_PT_CV + al256((size_t)NTOK * 256 * 2);
constexpr size_t OFF_G = OFF_PT_CK + al256((size_t)NTOK * 256 * 2);
constexpr size_t OFF_MIX = OFF_G + al256((size_t)NTOK * 16 * 4);
constexpr size_t OFF_Y = OFF_MIX + al256((size_t)NTOK * DM * 2);
constexpr size_t OFF_U = OFF_Y + al256((size_t)NTOK * DM * 4);
constexpr size_t OFF_CAK = OFF_U + al256((size_t)NTOK * DFF * 2);
constexpr size_t OFF_CAVT = OFF_CAK + al256((size_t)32 * 512 * 128 * 2);
constexpr size_t OFF_CBK = OFF_CAVT + al256((size_t)32 * 512 * 128 * 2);
constexpr size_t OFF_CBVT = OFF_CBK + al256((size_t)32 * 512 * 64 * 2);
constexpr size_t OFF_C0T = OFF_CBVT + al256((size_t)32 * 512 * 64 * 2);
constexpr size_t OFF_ROPE = OFF_C0T + al256((size_t)64 * 64 * 64 * 2);
constexpr size_t OFF_LAM = OFF_ROPE + al256((size_t)2 * 1024 * 4);
constexpr size_t OFF_BAR = OFF_LAM + 256;
constexpr size_t OFF_LNCNT = OFF_BAR + 13824;
constexpr size_t OFF_MIXCTR = OFF_BAR + 15360;
constexpr size_t OFF_STATS = OFF_BAR + 16384;
constexpr size_t WS_END = OFF_STATS + (size_t)NTOK * 16 * 8;

constexpr size_t O_YP = 0, O_YS = 4194304, O_AK = 6291456, O_AV = 14680064, O_BK = 23068672, O_BV = 27262976,
                 O_NC = 31457280, O_NN = 33554432, O_NM = 33587200;

struct Params {
    const float* x_prompt; const float* x_sample; const float* cache_a_k; const float* cache_a_v;
    const float* cache_b_k; const float* cache_b_v; const float* state_c; const float* state_n;
    const float* state_m; const float* c; const float* c_ctx; const float* w_in; const float* gate_bias;
    const float* diff_lambda; const float* diff_norm_g; const float* nat_rpb; const float* mlstm_norm_g;
    const float* w_out; const float* ada_w; const float* ada_b; const float* ln1_g; const float* ln1_b;
    const float* ln2_g; const float* ln2_b; const float* w_mlp1; const float* w_mlp2;
    float* out; unsigned char* ws; int ph_lo; int ph_hi;
};

#define VBID ((int)(blockIdx.x * 2 + __builtin_amdgcn_readfirstlane(threadIdx.x >> 8)))
#define VGRID ((int)(gridDim.x * 2))
#define VTID ((int)(threadIdx.x & 255))
constexpr int HALF_LDS = 73728;
constexpr int LDS_BYTES = 2 * HALF_LDS;
DI int opaque_v(int x) { asm volatile("" : "+v"(x)); return x; }
DI int opaque_s(int x) { x = __builtin_amdgcn_readfirstlane(x); asm volatile("" : "+s"(x)); return x; }
DI size_t opaque_zero() { size_t z = 0; asm volatile("" : "+s"(z)); return z; }
DI unsigned char* opaque_ws(unsigned char* w) { return w + opaque_zero(); }
DI float* opaque_out(float* w) { return w + opaque_zero(); }
DI unsigned short f2bf(float x) { unsigned u = __float_as_uint(x); u += 0x7fffu + ((u >> 16) & 1u); return (unsigned short)(u >> 16); }
DI float bf2f(unsigned short h) { return __uint_as_float(((unsigned)h) << 16); }
DI unsigned pack2(float a, float b) { return (unsigned)f2bf(a) | ((unsigned)f2bf(b) << 16); }
DI f32x4 mfma16(bf16x8 a, bf16x8 b, f32x4 c) { return __builtin_amdgcn_mfma_f32_16x16x32_bf16(a, b, c, 0, 0, 0); }
DI float fexp2(float x) { return __builtin_amdgcn_exp2f(x); }
DI bf16x8 pack8(float a0, float a1, float a2, float a3, float a4, float a5, float a6, float a7) {
    uint4 u;
    asm volatile("s_nop 1\n\tv_cvt_pk_bf16_f32 %0, %4, %5\n\tv_cvt_pk_bf16_f32 %1, %6, %7\n\tv_cvt_pk_bf16_f32 %2, %8, %9\n\tv_cvt_pk_bf16_f32 %3, %10, %11\n\ts_nop 1"
                 : "=&v"(u.x), "=&v"(u.y), "=&v"(u.z), "=&v"(u.w)
                 : "v"(a0), "v"(a1), "v"(a2), "v"(a3), "v"(a4), "v"(a5), "v"(a6), "v"(a7));
    return __builtin_bit_cast(bf16x8, u);
}
DI bf16x8 cat4(bf16x4 a, bf16x4 b) { return __builtin_shufflevector(a, b, 0, 1, 2, 3, 4, 5, 6, 7); }
DI float wave_sum(float v) {
#pragma unroll
    for (int o = 32; o > 0; o >>= 1) v += __shfl_xor(v, o);
    return v;
}
DI float grp_sum(float v) { v += __shfl_xor(v, 16); v += __shfl_xor(v, 32); return v; }
DI float grp_max(float v) { v = fmaxf(v, __shfl_xor(v, 16)); v = fmaxf(v, __shfl_xor(v, 32)); return v; }

DI void transpose_job(const float* __restrict__ src, bf16_t* __restrict__ dst, int R, int C, int Cpad, int nmat, float* tile, bool blocked = false,
                      int vb = -1, int vg = 0) {
    if (vb < 0) { vb = VBID; vg = VGRID; }
    const int tid = VTID;
    const int rt = R >> 6, ct = Cpad >> 6, per = rt * ct, total = per * nmat;
    for (int it = vb; it < total; it += vg) {
        const int mat = it / per, rem = it - mat * per;
        const int r0 = (rem / ct) << 6, c0 = (rem % ct) << 6;
        const float* s = src + (size_t)mat * R * C;
        bf16_t* d = dst + (size_t)mat * Cpad * R;
#pragma unroll
        for (int i = 0; i < 4; ++i) {
            const int r = (tid >> 4) + 16 * i, c = (tid & 15) * 4;
            float4 v = make_float4(0.f, 0.f, 0.f, 0.f);
            if (c0 + c < C) v = *(const float4*)(s + (size_t)(r0 + r) * C + c0 + c);
            tile[r * 65 + c + 0] = v.x; tile[r * 65 + c + 1] = v.y; tile[r * 65 + c + 2] = v.z; tile[r * 65 + c + 3] = v.w;
        }
        __syncthreads();
        {
            const int c = tid >> 2, rs = (tid & 3) * 16;
            uint4 o0, o1;
            o0.x = pack2(tile[(rs + 0) * 65 + c], tile[(rs + 1) * 65 + c]);
            o0.y = pack2(tile[(rs + 2) * 65 + c], tile[(rs + 3) * 65 + c]);
            o0.z = pack2(tile[(rs + 4) * 65 + c], tile[(rs + 5) * 65 + c]);
            o0.w = pack2(tile[(rs + 6) * 65 + c], tile[(rs + 7) * 65 + c]);
            o1.x = pack2(tile[(rs + 8) * 65 + c], tile[(rs + 9) * 65 + c]);
            o1.y = pack2(tile[(rs + 10) * 65 + c], tile[(rs + 11) * 65 + c]);
            o1.z = pack2(tile[(rs + 12) * 65 + c], tile[(rs + 13) * 65 + c]);
            o1.w = pack2(tile[(rs + 14) * 65 + c], tile[(rs + 15) * 65 + c]);
            uint4* dp = blocked ? (uint4*)(d + ((size_t)((r0 + rs) >> 5) * Cpad + (c0 + c)) * 32 + ((r0 + rs) & 31))
                                : (uint4*)(d + (size_t)(c0 + c) * R + r0 + rs);
            dp[0] = o0; dp[1] = o1;
        }
        __syncthreads();
    }
}

DI void convert_job(const float* __restrict__ src, bf16_t* __restrict__ dst, size_t n) {
    for (size_t i = ((size_t)VBID * 256 + VTID) * 8; i < n; i += (size_t)VGRID * 256 * 8) {
        const float4 a = *(const float4*)(src + i), b = *(const float4*)(src + i + 4);
        uint4 o; o.x = pack2(a.x, a.y); o.y = pack2(a.z, a.w); o.z = pack2(b.x, b.y); o.w = pack2(b.z, b.w);
        *(uint4*)(dst + i) = o;
    }
}

DI void prep0(const Params& pin, unsigned char* smem) {
    const Params& p = pin; unsigned char* const ws_ = opaque_ws(pin.ws); float* const out_ = opaque_out(pin.out); const int tid = opaque_v(VTID);
    {
        float* sl = (float*)smem; float* red = (float*)(smem + 12288);
        for (int i = tid; i < 3072; i += 256) {
            const int cnd = i >> 10, k = i & 1023;
            const float v = (cnd == 0) ? p.c_ctx[k] : p.c[(cnd - 1) * 1024 + k];
            sl[i] = v / (1.f + __expf(-v));
        }
        __syncthreads();
        float* mod = (float*)(ws_ + OFF_MOD);
        const int kg = tid >> 4, cl = tid & 15;
        for (int it = VBID; it < 384; it += VGRID) {
            const int l = it / 96, j0 = (it % 96) * 64;
            const float* w = p.ada_w + (size_t)l * 1024 * 6144 + j0 + cl * 4;
            float4 a0 = make_float4(0, 0, 0, 0), a1 = a0, a2 = a0;
#pragma unroll 8
            for (int kk = 0; kk < 64; ++kk) {
                const int k = kg * 64 + kk;
                const float4 wv = *(const float4*)(w + (size_t)k * 6144);
                const float s0 = sl[k], s1 = sl[1024 + k], s2 = sl[2048 + k];
                a0.x += s0 * wv.x; a0.y += s0 * wv.y; a0.z += s0 * wv.z; a0.w += s0 * wv.w;
                a1.x += s1 * wv.x; a1.y += s1 * wv.y; a1.z += s1 * wv.z; a1.w += s1 * wv.w;
                a2.x += s2 * wv.x; a2.y += s2 * wv.y; a2.z += s2 * wv.z; a2.w += s2 * wv.w;
            }
            __syncthreads();
            float* r = red + kg * 192 + cl * 4;
            r[0] = a0.x; r[1] = a0.y; r[2] = a0.z; r[3] = a0.w;
            r[64] = a1.x; r[65] = a1.y; r[66] = a1.z; r[67] = a1.w;
            r[128] = a2.x; r[129] = a2.y; r[130] = a2.z; r[131] = a2.w;
            __syncthreads();
            if (tid < 192) {
                const int cnd = tid >> 6, col = tid & 63;
                float s = 0.f;
#pragma unroll
                for (int q = 0; q < 16; ++q) s += red[q * 192 + tid];
                mod[(l * 3 + cnd) * 6144 + j0 + col] = s + p.ada_b[l * 6144 + j0 + col];
            }
        }
        __syncthreads();
    }
    if (VBID == VGRID - 1) {
        float* rope = (float*)(ws_ + OFF_ROPE);
        for (int i = tid; i < 1024; i += 256) {
            const int pos = i >> 4, j = i & 15;
            const float freq = powf(10000.f, -(float)j / 16.f);
            float s, c; sincosf((float)pos * freq, &s, &c);
            rope[i] = c; rope[1024 + i] = s;
        }
        if (tid < 4) {
            const float* lp = p.diff_lambda + tid * 256;
            float s1 = 0.f, s2 = 0.f;
            for (int i = 0; i < 64; ++i) { s1 += lp[i] * lp[64 + i]; s2 += lp[128 + i] * lp[192 + i]; }
            const float li = 0.8f - 0.6f * expf(-0.3f * (float)tid);
            float* lam = (float*)(ws_ + OFF_LAM);
            lam[tid * 2] = expf(s1) - expf(s2) + li; lam[tid * 2 + 1] = li;
        }
    }
    float* tile = (float*)smem;
    transpose_job(p.w_in, (bf16_t*)(ws_ + OFF_WT_IN), 1024, NIN, NINP, 1, tile);
    transpose_job(p.w_out, (bf16_t*)(ws_ + OFF_WT_OUT), 1024, 1024, 1024, 1, tile);
    transpose_job(p.w_mlp1, (bf16_t*)(ws_ + OFF_WT_1), 1024, 4096, 4096, 1, tile);
    transpose_job(p.w_mlp2, (bf16_t*)(ws_ + OFF_WT_2), 4096, 1024, 1024, 1, tile);
    transpose_job(p.cache_a_v, (bf16_t*)(ws_ + OFF_CAVT), 512, 128, 128, 32, tile, true);
    transpose_job(p.cache_b_v, (bf16_t*)(ws_ + OFF_CBVT), 512, 64, 64, 32, tile, true);
    transpose_job(p.state_c, (bf16_t*)(ws_ + OFF_C0T), 64, 64, 64, 64, tile);
    convert_job(p.cache_a_k, (bf16_t*)(ws_ + OFF_CAK), (size_t)32 * 512 * 128);
    convert_job(p.cache_b_k, (bf16_t*)(ws_ + OFF_CBK), (size_t)32 * 512 * 64);
}

DI void prep1(const Params& pin) {
    const Params& p = pin; unsigned char* const ws_ = opaque_ws(pin.ws); float* const out_ = opaque_out(pin.out); const int tid_ = opaque_v(threadIdx.x); const int lane = tid_ & 63, wave = tid_ >> 6;
    const float* mod = (const float*)(ws_ + OFF_MOD);
    float* X = (float*)(ws_ + OFF_X);
    bf16_t* H = (bf16_t*)(ws_ + OFF_H);
    for (int row = blockIdx.x * 8 + wave; row < NTOK; row += gridDim.x * 8) {
        const float* src = row < NCTX ? p.x_prompt + (size_t)row * 1024 : p.x_sample + (size_t)(row - NCTX) * 1024;
        const int cnd = row < NCTX ? 0 : 1 + ((row - NCTX) >> 10);
        const float* md = mod + (size_t)cnd * 6144;
#pragma unroll
        for (int j = 0; j < 4; ++j) {
            const int c = lane * 4 + 256 * j;
            const float4 v = *(const float4*)(src + c);
            *(float4*)(X + (size_t)row * 1024 + c) = v;
            const float4 sh = *(const float4*)(md + c), sc = *(const float4*)(md + 1024 + c);
            uint2 o; o.x = pack2(v.x * (1.f + sc.x) + sh.x, v.y * (1.f + sc.y) + sh.y);
            o.y = pack2(v.z * (1.f + sc.z) + sh.z, v.w * (1.f + sc.w) + sh.w);
            *(uint2*)(H + (size_t)row * 1024 + c) = o;
        }
    }
}

enum { EPI_INPROJ = 0, EPI_LN1 = 1, EPI_RELU2 = 2, EPI_LN2 = 3 };

DI void epi_inproj(const Params& p, unsigned char* ws_, float* out_, int layer, const float* T, int rowbase, int colbase, int lane) {
    if (colbase >= NIN) return;
    bf16_t* P = (bf16_t*)(ws_ + OFF_P);
    const bool latent = rowbase >= NCTX;
    const int seq_tok0 = latent ? (NCTX + ((rowbase - NCTX) & ~1023)) : (rowbase & ~255);
    const int nseq = latent ? 1024 : 256;
    const int bctx = seq_tok0 >> 8;
    const int n0 = rowbase - seq_tok0;
    if (colbase >= 3328) {
        float* G = (float*)(ws_ + OFF_G);
        const float bias = p.gate_bias[layer * 16 + (lane & 15)];
        for (int rr = 0; rr < 16; ++rr) {
            const int r = rr * 4 + (lane >> 4);
            G[(size_t)(rowbase + r) * 16 + (lane & 15)] = T[r * 65 + (lane & 15)] + bias;
        }
        return;
    }
    bool toP = false, rope = false, toT = false, toO = false;
    size_t toff = 0, obase = 0; int tW = 0, tcr = 0, ohd = 64, ocr = 0;
    if (colbase < 1024) { toP = true; rope = latent; if (colbase >= 512) { toO = !latent; obase = O_AK; ohd = 128; ocr = colbase - 512; } }
    else if (colbase < 1536) { toT = true; toff = OFF_PT_AV; tW = 512; tcr = colbase - 1024; toO = !latent; obase = O_AV; ohd = 128; ocr = tcr; }
    else if (colbase < 1792) { toP = true; }
    else if (colbase < 2048) { toP = true; toO = !latent; obase = O_BK; ohd = 64; ocr = colbase - 1792; }
    else if (colbase < 2304) { toT = true; toff = OFF_PT_BV; tW = 256; tcr = colbase - 2048; toO = !latent; obase = O_BV; ohd = 64; ocr = tcr; }
    else if (colbase < 2560) { toP = true; }
    else if (colbase < 2816) { toP = true; toT = true; toff = OFF_PT_CK; tW = 256; tcr = colbase - 2560; }
    else if (colbase < 3072) { toT = true; toff = OFF_PT_CV; tW = 256; tcr = colbase - 2816; }
    else { toP = true; }
    if (toO) {
        const int h = ocr / ohd, w = ocr - h * ohd + lane;
        float* O = out_ + obase + (((size_t)(bctx * 4 + layer) * 4 + h) * 256 + n0) * ohd + w;
#pragma unroll 4
        for (int r = 0; r < 64; ++r) O[(size_t)r * ohd] = T[r * 65 + lane];
    }
    if (toP) {
        bf16_t* Pp = P + (size_t)rowbase * NIN + colbase + lane;
        if (rope) {
            const float* rc = (const float*)(ws_ + OFF_ROPE);
            const float* rs = rc + 1024;
#pragma unroll 4
            for (int r = 0; r < 64; ++r) {
                const float v = T[r * 65 + lane], vp = T[r * 65 + (lane ^ 16)];
                const int t = n0 + r;
                const int pos = (lane < 32) ? (t >> 6) : (t & 63);
                const float c = rc[pos * 16 + (lane & 15)], sn = rs[pos * 16 + (lane & 15)];
                const float o = (lane & 16) ? (vp * sn + v * c) : (v * c - vp * sn);
                Pp[(size_t)r * NIN] = f2bf(o);
            }
        } else {
#pragma unroll 4
            for (int r = 0; r < 64; ++r) Pp[(size_t)r * NIN] = f2bf(T[r * 65 + lane]);
        }
    }
    if (toT) {
        const int n = n0 + lane;
        bf16_t* Tp = (bf16_t*)(ws_ + toff) + (size_t)seq_tok0 * tW + ((size_t)(n >> 5) * tW + tcr) * 32 + (n & 31);
#pragma unroll 4
        for (int c = 0; c < 64; ++c) Tp[(size_t)c * 32] = f2bf(T[lane * 65 + c]);
    }
}

template <int WHICH>
DI void epi_ln(const Params& p, unsigned char* ws_, float* out_, int l, float* T, int tm, int tn, int wn, int rowbase, int colbase, int lane, int tid) {
    const float* mod = (const float*)(ws_ + OFF_MOD);
    float* X = (float*)(ws_ + OFF_X);
    bf16_t* H = (bf16_t*)(ws_ + OFF_H);
    const int cnd = rowbase < NCTX ? 0 : 1 + ((rowbase - NCTX) >> 10);
    const float* md = mod + (size_t)(l * 3 + cnd) * 6144;
    const int col = colbase + lane;
    const bool last = (WHICH == 2 && l == 3);
    float s1 = 0.f, s2 = 0.f;
#pragma unroll 8
    for (int c = 0; c < 64; ++c) { const float v = T[lane * 65 + c]; s1 += v; s2 += v * v; }
    unsigned long long* stats = (unsigned long long*)(ws_ + OFF_STATS);
    __hip_atomic_store(stats + (size_t)(rowbase + lane) * 16 + tn * 2 + wn,
                       ((unsigned long long)__float_as_uint(s2) << 32) | (unsigned long long)__float_as_uint(s1), __ATOMIC_RELAXED, __HIP_MEMORY_SCOPE_AGENT);
    unsigned* cnt = (unsigned*)(ws_ + OFF_LNCNT) + (l * 2 + (WHICH - 1)) * 48 + tm;
    asm volatile("s_waitcnt vmcnt(0)" ::: "memory");
    __syncthreads();
    if (tid == 0) {
        (void)__hip_atomic_fetch_add(cnt, 1u, __ATOMIC_RELAXED, __HIP_MEMORY_SCOPE_AGENT);
        unsigned sp = 0;
        while (__hip_atomic_load(cnt, __ATOMIC_RELAXED, __HIP_MEMORY_SCOPE_AGENT) < 8u) { __builtin_amdgcn_s_sleep(1); if (++sp > (1u << 22)) break; }
    }
    __syncthreads();
    float t1 = 0.f, t2 = 0.f;
    {
        unsigned long long* sp8 = stats + (size_t)(rowbase + lane) * 16;
        unsigned long long a[16];
#pragma unroll
        for (int q = 0; q < 16; ++q) a[q] = __hip_atomic_load(sp8 + q, __ATOMIC_RELAXED, __HIP_MEMORY_SCOPE_AGENT);
#pragma unroll
        for (int q = 0; q < 16; ++q) { t1 += __uint_as_float((unsigned)a[q]); t2 += __uint_as_float((unsigned)(a[q] >> 32)); }
    }
    const float mu = t1 * (1.f / 1024.f);
    const float rstd = rsqrtf(fmaxf(t2 * (1.f / 1024.f) - mu * mu, 0.f) + LN_EPS);
    const float lng = (WHICH == 1 ? p.ln1_g : p.ln2_g)[l * 1024 + col], lnb = (WHICH == 1 ? p.ln1_b : p.ln2_b)[l * 1024 + col];
    if (last) {
        float* op = out_ + (size_t)rowbase * 1024 + col;
#pragma unroll 8
        for (int r = 0; r < 64; ++r) op[(size_t)r * 1024] = (T[r * 65 + lane] - __shfl(mu, r)) * __shfl(rstd, r) * lng + lnb;
    } else {
        const float* nmd = (WHICH == 1) ? md : mod + (size_t)((l + 1) * 3 + cnd) * 6144;
        const float sh = nmd[(WHICH == 1 ? 3072 : 0) + col], sc1p = 1.f + nmd[(WHICH == 1 ? 4096 : 1024) + col];
        float* xp = X + (size_t)rowbase * 1024 + col;
        bf16_t* hp = H + (size_t)rowbase * 1024 + col;
#pragma unroll 8
        for (int r = 0; r < 64; ++r) {
            const float o = (T[r * 65 + lane] - __shfl(mu, r)) * __shfl(rstd, r) * lng + lnb;
            xp[(size_t)r * 1024] = o;
            hp[(size_t)r * 1024] = f2bf(o * sc1p + sh);
        }
    }
}

template <int EPI>
DI void gemm_phase(const Params& pin, int layer, size_t offA, size_t offB, int ntn, int K, int ldc,
                   unsigned char* smem) {
    const Params& p = pin; unsigned char* const ws_ = opaque_ws(pin.ws); float* const out_ = opaque_out(pin.out); const int tid = opaque_v(threadIdx.x), lane = tid & 63, wave = opaque_s(tid >> 6);
    const bf16_t* __restrict__ A = (const bf16_t*)(ws_ + offA); const bf16_t* __restrict__ Bt = (const bf16_t*)(ws_ + offB);
    const int wm = wave >> 1, wn = wave & 1;
    const int lr = lane & 15, g = lane >> 4;
    const int ntm = NTOK / 256;
    const int ntiles = ntm * ntn, nk = K >> 6;
    constexpr int STAGE = 49152;
    for (int tile = blockIdx.x; tile < ntiles; tile += gridDim.x) {
        const int tm = tile % ntm, tn = tile / ntm;
        const int m0 = tm * 256, n0 = tn * 128;
        f32x4 acc[4][4];
#pragma unroll
        for (int mi = 0; mi < 4; ++mi)
#pragma unroll
            for (int ni = 0; ni < 4; ++ni) acc[mi][ni] = (f32x4){0.f, 0.f, 0.f, 0.f};
        const bf16_t* Ag = A + (size_t)m0 * K;
        const bf16_t* Bg = Bt + (size_t)n0 * K;
        const bf16_t* ag = Ag + (size_t)(wave * 32 + (lane >> 3)) * K + (((lane & 7) ^ (lane >> 3)) << 3);
        const bf16_t* bg = Bg + (size_t)(wave * 16 + (lane >> 3)) * K + (((lane & 7) ^ (lane >> 3)) << 3);
        auto stage = [&](int t) {
            unsigned char* dst = smem + (t % 3) * STAGE;
            const int k0 = t << 6;
#pragma unroll
            for (int j = 0; j < 4; ++j)
                __builtin_amdgcn_global_load_lds((const unsigned*)(ag + (size_t)j * 8 * K + k0), (LAS unsigned*)(dst + (wave * 4 + j) * 1024), 16, 0, 0);
#pragma unroll
            for (int j = 0; j < 2; ++j)
                __builtin_amdgcn_global_load_lds((const unsigned*)(bg + (size_t)j * 8 * K + k0), (LAS unsigned*)(dst + 32768 + (wave * 2 + j) * 1024), 16, 0, 0);
        };
        auto read_half = [&](int t, int kk, bf16x8 (&af)[4], bf16x8 (&bfr)[4]) {
            const unsigned char* cur = smem + (t % 3) * STAGE;
#pragma unroll
            for (int mi = 0; mi < 4; ++mi) {
                const int row = wm * 64 + mi * 16 + lr;
                af[mi] = *(const bf16x8*)(cur + row * 128 + (((kk * 4 + g) ^ (row & 7)) << 4));
            }
#pragma unroll
            for (int ni = 0; ni < 4; ++ni) {
                const int row = wn * 64 + ni * 16 + lr;
                bfr[ni] = *(const bf16x8*)(cur + 32768 + row * 128 + (((kk * 4 + g) ^ (row & 7)) << 4));
            }
        };
        stage(0); stage(1); stage(2);
        bf16x8 a0[4], b0[4], a1[4], b1[4];
        asm volatile("s_waitcnt vmcnt(12)" ::: "memory");
        asm volatile("s_waitcnt lgkmcnt(0)" ::: "memory");
        __builtin_amdgcn_s_barrier();
        read_half(0, 0, a0, b0);
        for (int kt = 0; kt < nk; ++kt) {
            read_half(kt, 1, a1, b1);
#pragma unroll
            for (int mi = 0; mi < 4; ++mi)
#pragma unroll
                for (int ni = 0; ni < 4; ++ni) acc[mi][ni] = mfma16(a0[mi], b0[ni], acc[mi][ni]);
            __builtin_amdgcn_sched_barrier(0);
            if (kt + 2 < nk) asm volatile("s_waitcnt vmcnt(6)" ::: "memory");
            else asm volatile("s_waitcnt vmcnt(0)" ::: "memory");
            asm volatile("s_waitcnt lgkmcnt(0)" ::: "memory");
            __builtin_amdgcn_s_barrier();
            if (kt + 1 < nk) read_half(kt + 1, 0, a0, b0);
            if (kt + 3 < nk) stage(kt + 3);
#pragma unroll
            for (int mi = 0; mi < 4; ++mi)
#pragma unroll
                for (int ni = 0; ni < 4; ++ni) acc[mi][ni] = mfma16(a1[mi], b1[ni], acc[mi][ni]);
            __builtin_amdgcn_sched_barrier(0);
        }
        asm volatile("s_waitcnt lgkmcnt(0)" ::: "memory");
        __builtin_amdgcn_s_barrier();
        if (EPI == EPI_LN1 || EPI == EPI_LN2) {
            const int rb = m0 + wm * 64, cb = n0 + wn * 64;
            const int cnd = rb < NCTX ? 0 : 1 + ((rb - NCTX) >> 10);
            const float* gp = (const float*)(ws_ + OFF_MOD) + (size_t)(layer * 3 + cnd) * 6144 + (EPI == EPI_LN1 ? 2048 : 5120) + cb + lr;
            const float* xp = (const float*)(ws_ + OFF_X) + (size_t)(rb + 4 * g) * 1024 + cb + lr;
            float gt[4];
#pragma unroll
            for (int ni = 0; ni < 4; ++ni) gt[ni] = gp[ni * 16];
#pragma unroll
            for (int mh = 0; mh < 2; ++mh) {
                f32x4 xv[2][4];
#pragma unroll
                for (int m2 = 0; m2 < 2; ++m2)
#pragma unroll
                    for (int ni = 0; ni < 4; ++ni)
#pragma unroll
                        for (int i = 0; i < 4; ++i) xv[m2][ni][i] = xp[(size_t)((mh * 2 + m2) * 16 + i) * 1024 + ni * 16];
#pragma unroll
                for (int m2 = 0; m2 < 2; ++m2)
#pragma unroll
                    for (int ni = 0; ni < 4; ++ni)
#pragma unroll
                        for (int i = 0; i < 4; ++i) acc[mh * 2 + m2][ni][i] = ALPHA * xv[m2][ni][i] + gt[ni] * acc[mh * 2 + m2][ni][i];
                __builtin_amdgcn_sched_barrier(0);
            }
        }
        float* T = (float*)smem + wave * (64 * 65);
#pragma unroll
        for (int mi = 0; mi < 4; ++mi)
#pragma unroll
            for (int ni = 0; ni < 4; ++ni)
#pragma unroll
                for (int i = 0; i < 4; ++i) T[(mi * 16 + 4 * g + i) * 65 + ni * 16 + lr] = acc[mi][ni][i];
        const int rowbase = m0 + wm * 64, colbase = n0 + wn * 64;
        if (EPI == EPI_INPROJ) {
            epi_inproj(p, ws_, out_, layer, T, rowbase, colbase, lane);
        } else if (EPI == EPI_LN1) {
            epi_ln<1>(p, ws_, out_, layer, T, tm, tn, wn, rowbase, colbase, lane, tid);
        } else if (EPI == EPI_LN2) {
            epi_ln<2>(p, ws_, out_, layer, T, tm, tn, wn, rowbase, colbase, lane, tid);
        } else {
            bf16_t* U = (bf16_t*)(ws_ + OFF_U) + (size_t)rowbase * ldc + colbase + lane;
#pragma unroll 4
            for (int r = 0; r < 64; ++r) { const float v = fmaxf(T[r * 65 + lane], 0.f); U[(size_t)r * ldc] = f2bf(v * v); }
        }
        __syncthreads();
    }
    if ((EPI == EPI_LN1 || EPI == EPI_LN2) && layer < 3 && (int)blockIdx.x >= ntiles) {
        const int half = __builtin_amdgcn_readfirstlane(threadIdx.x >> 8);
        const int vb = ((int)blockIdx.x - ntiles) * 2 + half, vg = ((int)gridDim.x - ntiles) * 2;
        float* tile = (float*)(smem + half * HALF_LDS);
        const int nl = layer + 1;
        if (EPI == EPI_LN1) {
            transpose_job(p.w_in + (size_t)nl * 1024 * NIN, (bf16_t*)(ws_ + OFF_WT_IN) + (size_t)nl * NINP * DM, 1024, NIN, NINP, 1, tile, false, vb, vg);
            transpose_job(p.w_out + (size_t)nl * 1024 * 1024, (bf16_t*)(ws_ + OFF_WT_OUT) + (size_t)nl * DM * DM, 1024, 1024, 1024, 1, tile, false, vb, vg);
        } else {
            transpose_job(p.w_mlp1 + (size_t)nl * 1024 * 4096, (bf16_t*)(ws_ + OFF_WT_1) + (size_t)nl * DFF * DM, 1024, 4096, 4096, 1, tile, false, vb, vg);
            transpose_job(p.w_mlp2 + (size_t)nl * 4096 * 1024, (bf16_t*)(ws_ + OFF_WT_2) + (size_t)nl * DM * DFF, 4096, 1024, 1024, 1, tile, false, vb, vg);
        }
    }
}

template <int NMAP, int DV>
struct AttnSt { f32x4 O[NMAP][DV / 16]; float m[NMAP]; float l[NMAP]; };
template <int NMAP, int DV>
struct UnitFrags { bf16x8 k[NMAP][2][2]; bf16x8 v[DV / 16]; };

template <int NMAP, int DV>
struct TileGeom {
    static constexpr int KROW = NMAP * 128, KBYTES = 64 * KROW, VUNIT = DV * 64, TBYTES = KBYTES + 2 * VUNIT;
};
DI int kswz(int row) { return (row & 3) | (((row >> 3) & 3) << 2); }

template <int NMAP, int DV>
DI void stage_tile(unsigned char* buf, const bf16_t* kg, int kstride, const bf16_t* vg, int vunit, int wave, int lane) {
    typedef TileGeom<NMAP, DV> TG;
    if (NMAP == 2) {
#pragma unroll
        for (int j = 0; j < 4; ++j) {
            const int jj = wave * 4 + j, row = jj * 4 + (lane >> 4), lc = (lane & 15) ^ kswz(row);
            __builtin_amdgcn_global_load_lds((const unsigned*)(kg + (size_t)row * kstride + lc * 8), (LAS unsigned*)(buf + jj * 1024), 16, 0, 0);
        }
    } else {
#pragma unroll
        for (int j = 0; j < 2; ++j) {
            const int jj = wave * 2 + j, row = jj * 8 + (lane >> 3), lc = (lane & 7) ^ (kswz(row) >> 1);
            __builtin_amdgcn_global_load_lds((const unsigned*)(kg + (size_t)row * kstride + lc * 8), (LAS unsigned*)(buf + jj * 1024), 16, 0, 0);
        }
    }
    constexpr int VI = TG::VUNIT / 1024, PER = 2 * VI / 4;
#pragma unroll
    for (int j = 0; j < PER; ++j) {
        const int jj = wave * PER + j, unit = jj / VI, piece = jj % VI;
        __builtin_amdgcn_global_load_lds((const unsigned*)(vg + (size_t)unit * vunit + piece * 512 + lane * 8),
                                         (LAS unsigned*)(buf + TG::KBYTES + jj * 1024), 16, 0, 0);
    }
}

template <int NMAP, int DV>
DI void lds_unit(UnitFrags<NMAP, DV>& f, const unsigned char* buf, int rowbase, int voff, int lr, int g) {
    typedef TileGeom<NMAP, DV> TG;
#pragma unroll
    for (int b = 0; b < 2; ++b) {
        const int row = rowbase + (lr >> 2) * 8 + (lr & 3) + 4 * b, sw = kswz(row);
        if (NMAP == 2) {
#pragma unroll
            for (int m = 0; m < NMAP; ++m)
#pragma unroll
                for (int kk = 0; kk < 2; ++kk) f.k[m][b][kk] = *(const bf16x8*)(buf + row * 256 + (((m * 8 + kk * 4 + g) ^ sw) << 4));
        } else {
#pragma unroll
            for (int kk = 0; kk < 2; ++kk) f.k[0][b][kk] = *(const bf16x8*)(buf + row * 128 + (((kk * 4 + g) ^ (sw >> 1)) << 4));
        }
    }
#pragma unroll
    for (int vb = 0; vb < DV / 16; ++vb) f.v[vb] = *(const bf16x8*)(buf + TG::KBYTES + voff + (vb * 16 + lr) * 64);
}

template <int DV>
DI void lds_unit_sel(UnitFrags<1, DV>& f, const unsigned char* buf, int rowbase, int voff, int lr, int g, int msel) {
    typedef TileGeom<2, DV> TG;
#pragma unroll
    for (int b = 0; b < 2; ++b) {
        const int row = rowbase + (lr >> 2) * 8 + (lr & 3) + 4 * b, sw = kswz(row);
#pragma unroll
        for (int kk = 0; kk < 2; ++kk) f.k[0][b][kk] = *(const bf16x8*)(buf + row * 256 + (((msel * 8 + kk * 4 + g) ^ sw) << 4));
    }
#pragma unroll
    for (int vb = 0; vb < DV / 16; ++vb) f.v[vb] = *(const bf16x8*)(buf + TG::KBYTES + voff + (vb * 16 + lr) * 64);
}

template <int NMAP, int DV, class SrcFn, class CompFn>
DI void tile_pipeline(unsigned char* tiles, int nt, int wave, int lane, SrcFn src, CompFn comp) {
    typedef TileGeom<NMAP, DV> TG;
    {
        const bf16_t *kg, *vg; int ks, vu;
        src(0, kg, ks, vg, vu);
        stage_tile<NMAP, DV>(tiles, kg, ks, vg, vu, wave, lane);
    }
    asm volatile("s_waitcnt vmcnt(0)" ::: "memory");
    __syncthreads();
    for (int t = 0; t < nt; ++t) {
        unsigned char* cur = tiles + (t & 1) * TG::TBYTES;
        comp(t, cur, 0);
        if (t + 1 < nt) {
            const bf16_t *kg, *vg; int ks, vu;
            src(t + 1, kg, ks, vg, vu);
            stage_tile<NMAP, DV>(tiles + ((t + 1) & 1) * TG::TBYTES, kg, ks, vg, vu, wave, lane);
        }
        comp(t, cur, 1);
        asm volatile("s_waitcnt vmcnt(0)" ::: "memory");
        __syncthreads();
    }
}

template <int NMAP, int DV, bool HASBIAS>
DI void compute_unit(AttnSt<NMAP, DV>& st, const UnitFrags<NMAP, DV>& f, const bf16x8 (&qf)[NMAP][2], float sc, const float (&bias)[8]) {
    bf16x8 pk[NMAP];
#pragma unroll
    for (int m = 0; m < NMAP; ++m) {
        f32x4 sa = (f32x4){0.f, 0.f, 0.f, 0.f}, sb = sa;
        sa = mfma16(f.k[m][0][0], qf[m][0], sa); sa = mfma16(f.k[m][0][1], qf[m][1], sa);
        sb = mfma16(f.k[m][1][0], qf[m][0], sb); sb = mfma16(f.k[m][1][1], qf[m][1], sb);
        float s[8];
#pragma unroll
        for (int j = 0; j < 4; ++j) { s[j] = sa[j] * sc; s[4 + j] = sb[j] * sc; }
        if (HASBIAS) {
#pragma unroll
            for (int j = 0; j < 8; ++j) s[j] += bias[j];
        }
        float mx = fmaxf(fmaxf(fmaxf(s[0], s[1]), fmaxf(s[2], s[3])), fmaxf(fmaxf(s[4], s[5]), fmaxf(s[6], s[7])));
        mx = grp_max(mx);
        const float mnew = fmaxf(st.m[m], mx);
        const float alpha = fexp2(st.m[m] - mnew);
        float ps = 0.f;
#pragma unroll
        for (int j = 0; j < 8; ++j) { s[j] = fexp2(s[j] - mnew); ps += s[j]; }
        st.l[m] = st.l[m] * alpha + ps; st.m[m] = mnew;
        if (__builtin_amdgcn_ballot_w64(alpha != 1.f) != 0ull) {
#pragma unroll
            for (int vb = 0; vb < DV / 16; ++vb) st.O[m][vb] *= alpha;
        }
        pk[m] = pack8(s[0], s[1], s[2], s[3], s[4], s[5], s[6], s[7]);
    }
#pragma unroll
    for (int vb = 0; vb < DV / 16; ++vb) {
#pragma unroll
        for (int m = 0; m < NMAP; ++m) st.O[m][vb] = mfma16(f.v[vb], pk[m], st.O[m][vb]);
    }
}

template <int NMAP, int DV>
DI void attn_init(AttnSt<NMAP, DV>& st) {
#pragma unroll
    for (int m = 0; m < NMAP; ++m) {
        st.m[m] = -INFINITY; st.l[m] = 0.f;
#pragma unroll
        for (int vb = 0; vb < DV / 16; ++vb) st.O[m][vb] = (f32x4){0.f, 0.f, 0.f, 0.f};
    }
}

template <bool LAT>
DI void item_diffattn(const Params& pin, int l, int seq, int h, int qt, unsigned char* smem, int wave, int lane) {
    const Params& p = pin; unsigned char* const ws_ = opaque_ws(pin.ws); float* const out_ = opaque_out(pin.out); lane = opaque_v(lane); wave = opaque_s(wave);
    const int lr = lane & 15, g = lane >> 4;
    const int nseq = LAT ? 1024 : 256;
    const int tok0 = LAT ? NCTX + seq * 1024 : seq * 256;
    const bf16_t* P = (const bf16_t*)(ws_ + OFF_P);
    const int q0 = qt * 64 + wave * 16;
    bf16x8 qf[2][2];
    {
        const bf16_t* qp = P + (size_t)(tok0 + q0 + lr) * NIN + h * 128 + 8 * g;
#pragma unroll
        for (int m = 0; m < 2; ++m)
#pragma unroll
            for (int kk = 0; kk < 2; ++kk) qf[m][kk] = *(const bf16x8*)(qp + m * 64 + kk * 32);
    }
    AttnSt<2, 128> st;
    attn_init<2, 128>(st);
    const float sc = 0.125f * LOG2E;
    const size_t hb = (size_t)((seq * 4 + l) * 4 + h);
    const bf16_t* kc = (const bf16_t*)(ws_ + OFF_CAK) + hb * 512 * 128;
    const bf16_t* vc = (const bf16_t*)(ws_ + OFF_CAVT) + hb * 128 * 512;
    const bf16_t* kn = P + (size_t)tok0 * NIN + 512 + h * 128;
    const bf16_t* vn = (const bf16_t*)(ws_ + OFF_PT_AV) + (size_t)tok0 * 512 + (size_t)(h * 128) * 32;
    const int ncache = LAT ? 8 : 0;
    __syncthreads();
    tile_pipeline<2, 128>(smem, ncache + nseq / 64, wave, lane,
        [&](int t, const bf16_t*& kg, int& ks, const bf16_t*& vg, int& vu) {
            if (t < ncache) { kg = kc + (size_t)t * 64 * 128; ks = 128; vg = vc + (size_t)(2 * t) * 128 * 32; vu = 128 * 32; }
            else { const int tt = t - ncache; kg = kn + (size_t)tt * 64 * NIN; ks = NIN; vg = vn + (size_t)(2 * tt) * 512 * 32; vu = 512 * 32; }
        },
        [&](int t, const unsigned char* buf, int part) {
            const float nob[8] = {0.f, 0.f, 0.f, 0.f, 0.f, 0.f, 0.f, 0.f};
            { const int half = part;
                UnitFrags<2, 128> f;
                lds_unit<2, 128>(f, buf, 32 * half, half * TileGeom<2, 128>::VUNIT + g * 16, lr, g);
                compute_unit<2, 128, false>(st, f, qf, sc, nob);
            }
        });
    const float inv0 = 1.f / grp_sum(st.l[0]), inv1 = 1.f / grp_sum(st.l[1]);
    const float* lamp = (const float*)(ws_ + OFF_LAM);
    const float lam = lamp[l * 2], lam_init = lamp[l * 2 + 1];
    const float c1 = lam * inv1;
    float ss = 0.f;
#pragma unroll
    for (int vb = 0; vb < 8; ++vb)
#pragma unroll
        for (int i = 0; i < 4; ++i) {
            const float o = st.O[0][vb][i] * inv0 - st.O[1][vb][i] * c1;
            st.O[0][vb][i] = o; ss += o * o;
        }
    ss = grp_sum(ss);
    const float r = rsqrtf(ss * (1.f / 128.f) + LN_EPS) * (1.f - lam_init);
    bf16_t* MIX = (bf16_t*)(ws_ + OFF_MIX) + (size_t)(tok0 + q0 + lr) * 1024 + h * 128;
    const float* gn = p.diff_norm_g + l * 128;
#pragma unroll
    for (int vb = 0; vb < 8; ++vb) {
        const int v = vb * 16 + 4 * g;
        const float4 g4 = *(const float4*)(gn + v);
        uint2 o; o.x = pack2(st.O[0][vb][0] * r * g4.x, st.O[0][vb][1] * r * g4.y);
        o.y = pack2(st.O[0][vb][2] * r * g4.z, st.O[0][vb][3] * r * g4.w);
        *(uint2*)(MIX + v) = o;
    }
}

DI void item_diffattn_lat(const Params& pin, int l, int seq, int h, int qt32, unsigned char* smem, int wave, int lane) {
    const Params& p = pin; unsigned char* const ws_ = opaque_ws(pin.ws); float* const out_ = opaque_out(pin.out); lane = opaque_v(lane); wave = opaque_s(wave);
    const int lr = lane & 15, g = lane >> 4;
    const int tok0 = NCTX + seq * 1024;
    const bf16_t* P = (const bf16_t*)(ws_ + OFF_P);
    const int msel = wave & 1;
    const int q0 = qt32 * 32 + (wave >> 1) * 16;
    bf16x8 qf[1][2];
    {
        const bf16_t* qp = P + (size_t)(tok0 + q0 + lr) * NIN + h * 128 + msel * 64 + 8 * g;
        qf[0][0] = *(const bf16x8*)(qp); qf[0][1] = *(const bf16x8*)(qp + 32);
    }
    AttnSt<1, 128> st;
    attn_init<1, 128>(st);
    const float sc = 0.125f * LOG2E;
    const size_t hb = (size_t)((seq * 4 + l) * 4 + h);
    const bf16_t* kc = (const bf16_t*)(ws_ + OFF_CAK) + hb * 512 * 128;
    const bf16_t* vc = (const bf16_t*)(ws_ + OFF_CAVT) + hb * 128 * 512;
    const bf16_t* kn = P + (size_t)tok0 * NIN + 512 + h * 128;
    const bf16_t* vn = (const bf16_t*)(ws_ + OFF_PT_AV) + (size_t)tok0 * 512 + (size_t)(h * 128) * 32;
    __syncthreads();
    tile_pipeline<2, 128>(smem, 24, wave, lane,
        [&](int t, const bf16_t*& kg, int& ks, const bf16_t*& vg, int& vu) {
            if (t < 8) { kg = kc + (size_t)t * 64 * 128; ks = 128; vg = vc + (size_t)(2 * t) * 128 * 32; vu = 128 * 32; }
            else { const int tt = t - 8; kg = kn + (size_t)tt * 64 * NIN; ks = NIN; vg = vn + (size_t)(2 * tt) * 512 * 32; vu = 512 * 32; }
        },
        [&](int t, const unsigned char* buf, int part) {
            const float nob[8] = {0.f, 0.f, 0.f, 0.f, 0.f, 0.f, 0.f, 0.f};
            { const int half = part;
                UnitFrags<1, 128> f;
                lds_unit_sel<128>(f, buf, 32 * half, half * TileGeom<2, 128>::VUNIT + g * 16, lr, g, msel);
                compute_unit<1, 128, false>(st, f, qf, sc, nob);
            }
        });
    const float* lamp = (const float*)(ws_ + OFF_LAM);
    const float lam = lamp[l * 2], lam_init = lamp[l * 2 + 1];
    const float inv = (msel ? lam : 1.f) / grp_sum(st.l[0]);
    float* xb = (float*)smem + (wave >> 1) * 32 * 64 + lane;
    if (msel) {
#pragma unroll
        for (int vb = 0; vb < 8; ++vb)
#pragma unroll
            for (int i = 0; i < 4; ++i) xb[(vb * 4 + i) * 64] = st.O[0][vb][i] * inv;
    }
    __syncthreads();
    if (msel) return;
    float ss = 0.f;
#pragma unroll
    for (int vb = 0; vb < 8; ++vb)
#pragma unroll
        for (int i = 0; i < 4; ++i) {
            const float o = st.O[0][vb][i] * inv - xb[(vb * 4 + i) * 64];
            st.O[0][vb][i] = o; ss += o * o;
        }
    ss = grp_sum(ss);
    const float r = rsqrtf(ss * (1.f / 128.f) + LN_EPS) * (1.f - lam_init);
    bf16_t* MIX = (bf16_t*)(ws_ + OFF_MIX) + (size_t)(tok0 + q0 + lr) * 1024 + h * 128;
    const float* gn = p.diff_norm_g + l * 128;
#pragma unroll
    for (int vb = 0; vb < 8; ++vb) {
        const int v = vb * 16 + 4 * g;
        const float4 g4 = *(const float4*)(gn + v);
        uint2 o; o.x = pack2(st.O[0][vb][0] * r * g4.x, st.O[0][vb][1] * r * g4.y);
        o.y = pack2(st.O[0][vb][2] * r * g4.z, st.O[0][vb][3] * r * g4.w);
        *(uint2*)(MIX + v) = o;
    }
}

DI void item_dense(const Params& pin, int seq, int h, int qt, unsigned char* smem, int wave, int lane) {
    const Params& p = pin; unsigned char* const ws_ = opaque_ws(pin.ws); float* const out_ = opaque_out(pin.out); lane = opaque_v(lane); wave = opaque_s(wave);
    const int lr = lane & 15, g = lane >> 4;
    const int tok0 = seq * 256;
    const bf16_t* P = (const bf16_t*)(ws_ + OFF_P);
    const int q0 = qt * 64 + wave * 16;
    bf16x8 qf[1][2];
    {
        const bf16_t* qp = P + (size_t)(tok0 + q0 + lr) * NIN + 1536 + h * 64 + 8 * g;
        qf[0][0] = *(const bf16x8*)(qp); qf[0][1] = *(const bf16x8*)(qp + 32);
    }
    AttnSt<1, 64> st;
    attn_init<1, 64>(st);
    const bf16_t* kn = P + (size_t)tok0 * NIN + 1792 + h * 64;
    const bf16_t* vn = (const bf16_t*)(ws_ + OFF_PT_BV) + (size_t)tok0 * 256 + (size_t)(h * 64) * 32;
    const float sc = 0.125f * LOG2E;
    __syncthreads();
    tile_pipeline<1, 64>(smem, 4, wave, lane,
        [&](int t, const bf16_t*& kg, int& ks, const bf16_t*& vg, int& vu) {
            kg = kn + (size_t)t * 64 * NIN; ks = NIN; vg = vn + (size_t)(2 * t) * 256 * 32; vu = 256 * 32;
        },
        [&](int t, const unsigned char* buf, int part) {
            const float nob[8] = {0.f, 0.f, 0.f, 0.f, 0.f, 0.f, 0.f, 0.f};
            { const int half = part;
                UnitFrags<1, 64> f;
                lds_unit<1, 64>(f, buf, 32 * half, half * TileGeom<1, 64>::VUNIT + g * 16, lr, g);
                compute_unit<1, 64, false>(st, f, qf, sc, nob);
            }
        });
    const float inv = 1.f / grp_sum(st.l[0]);
    bf16_t* MIX = (bf16_t*)(ws_ + OFF_MIX) + (size_t)(tok0 + q0 + lr) * 1024 + 512 + h * 64;
#pragma unroll
    for (int vb = 0; vb < 4; ++vb) {
        uint2 o; o.x = pack2(st.O[0][vb][0] * inv, st.O[0][vb][1] * inv); o.y = pack2(st.O[0][vb][2] * inv, st.O[0][vb][3] * inv);
        *(uint2*)(MIX + vb * 16 + 4 * g) = o;
    }
}

DI void item_na(const Params& pin, int l, int sb, int h, int r, unsigned char* smem, int wave, int lane) {
    const Params& p = pin; unsigned char* const ws_ = opaque_ws(pin.ws); float* const out_ = opaque_out(pin.out); lane = opaque_v(lane); wave = opaque_s(wave);
    const int lr = lane & 15, g = lane >> 4;
    const int tok0 = NCTX + sb * 1024;
    const bf16_t* P = (const bf16_t*)(ws_ + OFF_P);
    const int qc = wave * 16 + lr;
    const int q0 = r * 64 + wave * 16;
    bf16x8 qf[1][2];
    {
        const bf16_t* qp = P + (size_t)(tok0 + q0 + lr) * NIN + 1536 + h * 64 + 8 * g;
        qf[0][0] = *(const bf16x8*)(qp); qf[0][1] = *(const bf16x8*)(qp + 32);
    }
    AttnSt<1, 64> st;
    attn_init<1, 64>(st);
    const float sc = 0.125f * LOG2E;
    const size_t hb = (size_t)((sb * 4 + l) * 4 + h);
    const bf16_t* kc = (const bf16_t*)(ws_ + OFF_CBK) + hb * 512 * 64;
    const bf16_t* vc = (const bf16_t*)(ws_ + OFF_CBVT) + hb * 64 * 512;
    const bf16_t* kn = P + (size_t)tok0 * NIN + 1792 + h * 64;
    const bf16_t* vn = (const bf16_t*)(ws_ + OFF_PT_BV) + (size_t)tok0 * 256 + (size_t)(h * 64) * 32;
    const int kr0 = min(max(r - 4, 0), 8);
    const int bs = min(max(wave * 16 - 8, 0), 32);
    const int wstart = min(max(qc - 8, 0), 48);
    const float* rpb = p.nat_rpb + (size_t)(l * 4 + h) * 15 * 31;
    __syncthreads();
    tile_pipeline<1, 64>(smem, 16, wave, lane,
        [&](int t, const bf16_t*& kg, int& ks, const bf16_t*& vg, int& vu) {
            if (t < 8) { kg = kc + (size_t)t * 64 * 64; ks = 64; vg = vc + (size_t)(2 * t) * 64 * 32; vu = 64 * 32; }
            else { const int kr = kr0 + t - 8; kg = kn + (size_t)kr * 64 * NIN; ks = NIN; vg = vn + (size_t)(2 * kr) * 256 * 32; vu = 256 * 32; }
        },
        [&](int t, const unsigned char* buf, int part) {
            if (t < 8) {
                const float nob[8] = {0.f, 0.f, 0.f, 0.f, 0.f, 0.f, 0.f, 0.f};
                { const int half = part;
                    UnitFrags<1, 64> f;
                    lds_unit<1, 64>(f, buf, 32 * half, half * TileGeom<1, 64>::VUNIT + g * 16, lr, g);
                    compute_unit<1, 64, false>(st, f, qf, sc, nob);
                }
            } else if (part == 0) {
                const int kr = kr0 + t - 8;
                const int nl = bs + 8 * g;
                UnitFrags<1, 64> f;
                lds_unit<1, 64>(f, buf, bs, (nl >> 5) * TileGeom<1, 64>::VUNIT + (nl & 31) * 2, lr, g);
                float bias[8];
                const float* rrow = rpb + (kr - r + 7) * 31;
#pragma unroll
                for (int j = 0; j < 8; ++j) {
                    const int kcol = bs + 8 * g + j;
                    const bool valid = (kcol >= wstart) && (kcol < wstart + 16);
                    const int dc = min(max(kcol - qc + 15, 0), 30);
                    bias[j] = valid ? rrow[dc] * LOG2E : -INFINITY;
                }
                compute_unit<1, 64, true>(st, f, qf, sc, bias);
            }
        });
    const float inv = 1.f / grp_sum(st.l[0]);
    bf16_t* MIX = (bf16_t*)(ws_ + OFF_MIX) + (size_t)(tok0 + q0 + lr) * 1024 + 512 + h * 64;
#pragma unroll
    for (int vb = 0; vb < 4; ++vb) {
        uint2 o; o.x = pack2(st.O[0][vb][0] * inv, st.O[0][vb][1] * inv); o.y = pack2(st.O[0][vb][2] * inv, st.O[0][vb][3] * inv);
        *(uint2*)(MIX + vb * 16 + 4 * g) = o;
    }
}

DI float wave_excl_sum(float v, int lane) {
    float x = v;
#pragma unroll
    for (int d = 1; d < 64; d <<= 1) { const float y = __shfl_up(x, d); if (lane >= d) x += y; }
    return x - v;
}
DI float wave_excl_max(float v, int lane, float init) {
    float x = v;
#pragma unroll
    for (int d = 1; d < 64; d <<= 1) { const float y = __shfl_up(x, d); if (lane >= d) x = fmaxf(x, y); }
    const float ex = __shfl_up(x, 1);
    return lane == 0 ? init : fmaxf(init, ex);
}
DI void mlstm_scan(const float* __restrict__ G, int h, int nseq, int dir, float* aA, float* MA, float* FA, float m0, int lane) {
    const int per = nseq >> 6;
    float run = 0.f;
    for (int e = 0; e < per; ++e) {
        const int idx = lane * per + e, pos = dir ? nseq - 1 - idx : idx;
        const float f = G[(size_t)pos * 16 + (dir ? 12 : 4) + h];
        const float lf = fminf(f, 0.f) - __logf(1.f + __expf(-fabsf(f)));
        run += lf; FA[pos] = run;
    }
    const float off = wave_excl_sum(run, lane);
    float rmax = -INFINITY;
    for (int e = 0; e < per; ++e) {
        const int idx = lane * per + e, pos = dir ? nseq - 1 - idx : idx;
        const float F = FA[pos] + off; FA[pos] = F;
        const float a = G[(size_t)pos * 16 + (dir ? 8 : 0) + h] - F;
        aA[pos] = a; rmax = fmaxf(rmax, a); MA[pos] = rmax;
    }
    const float pre = wave_excl_max(rmax, lane, m0);
    for (int e = 0; e < per; ++e) {
        const int idx = lane * per + e, pos = dir ? nseq - 1 - idx : idx;
        MA[pos] = fmaxf(MA[pos], pre);
    }
}

DI void mlstm_unit(f32x4 (&O)[4], float& den, int dir, int t, const bf16x8 (&qf)[2], const UnitFrags<1, 64>& f, const float* aA, float Mt, int key0, int g) {
    f32x4 sa = (f32x4){0.f, 0.f, 0.f, 0.f}, sb = sa;
    sa = mfma16(f.k[0][0][0], qf[0], sa); sa = mfma16(f.k[0][0][1], qf[1], sa);
    sb = mfma16(f.k[0][1][0], qf[0], sb); sb = mfma16(f.k[0][1][1], qf[1], sb);
    const float4 a0 = *(const float4*)(aA + key0 + 8 * g), a1 = *(const float4*)(aA + key0 + 8 * g + 4);
    const float av[8] = {a0.x, a0.y, a0.z, a0.w, a1.x, a1.y, a1.z, a1.w};
    float pv[8];
#pragma unroll
    for (int j = 0; j < 8; ++j) {
        const int key = key0 + 8 * g + j;
        const bool ok = dir ? (key >= t) : (key <= t);
        const float w = ok ? fexp2((av[j] - Mt) * LOG2E) : 0.f;
        const float sv = (j < 4) ? sa[j & 3] : sb[j & 3];
        pv[j] = sv * 0.125f * w;
        den += pv[j];
    }
    const bf16x8 pk = pack8(pv[0], pv[1], pv[2], pv[3], pv[4], pv[5], pv[6], pv[7]);
#pragma unroll
    for (int vb = 0; vb < 4; ++vb) O[vb] = mfma16(f.v[vb], pk, O[vb]);
}

template <bool LAT>
DI void item_mlstm(const Params& pin, int l, int seq, int h, int qt, unsigned char* smem, int wave, int lane) {
    const Params& p = pin; unsigned char* const ws_ = opaque_ws(pin.ws); float* const out_ = opaque_out(pin.out); lane = opaque_v(lane); wave = opaque_s(wave);
    const int lr = lane & 15, g = lane >> 4;
    const int nseq = LAT ? 1024 : 256;
    const int tok0 = LAT ? NCTX + seq * 1024 : seq * 256;
    float* aF = (float*)smem; float* MF = aF + 1024; float* FF = MF + 1024;
    float* aB = FF + 1024; float* MB = aB + 1024; float* FB = MB + 1024;
    unsigned char* tiles = smem + 24576;
    const float* G = (const float*)(ws_ + OFF_G) + (size_t)tok0 * 16;
    float m0f = 0.f, m0b = 0.f;
    const int sidx_f = ((seq * 4 + l) * 2 + 0) * 4 + h, sidx_b = ((seq * 4 + l) * 2 + 1) * 4 + h;
    if (LAT) { m0f = p.state_m[sidx_f]; m0b = p.state_m[sidx_b]; }
    __syncthreads();
    if (wave == 0) mlstm_scan(G, h, nseq, 0, aF, MF, FF, m0f, lane);
    if (wave == 1) mlstm_scan(G, h, nseq, 1, aB, MB, FB, m0b, lane);
    __syncthreads();
    const bf16_t* P = (const bf16_t*)(ws_ + OFF_P);
    const int q0 = qt * 64 + wave * 16;
    const int t = q0 + lr;
    bf16x8 qf[2];
    {
        const bf16_t* qp = P + (size_t)(tok0 + t) * NIN + 2304 + h * 64 + 8 * g;
        qf[0] = *(const bf16x8*)(qp); qf[1] = *(const bf16x8*)(qp + 32);
    }
    const bf16_t* kn = P + (size_t)tok0 * NIN + 2560 + h * 64;
    const bf16_t* vn = (const bf16_t*)(ws_ + OFF_PT_CV) + (size_t)tok0 * 256 + (size_t)(h * 64) * 32;
    const float Mf = MF[t], Mb = MB[t], Ff = FF[t], Fb = FB[t];
    f32x4 Of[4], Ob[4];
#pragma unroll
    for (int vb = 0; vb < 4; ++vb) { Of[vb] = (f32x4){0.f, 0.f, 0.f, 0.f}; Ob[vb] = Of[vb]; }
    float denf = 0.f, denb = 0.f;
    tile_pipeline<1, 64>(tiles, nseq / 64, wave, lane,
        [&](int tt, const bf16_t*& kg, int& ks, const bf16_t*& vg, int& vu) {
            kg = kn + (size_t)tt * 64 * NIN; ks = NIN; vg = vn + (size_t)(2 * tt) * 256 * 32; vu = 256 * 32;
        },
        [&](int tt, const unsigned char* buf, int part) {
            { const int half = part;
                const int key0 = tt * 64 + half * 32;
                const bool dof = key0 <= q0 + 15, dob = key0 + 31 >= q0;
                if (dof || dob) {
                    UnitFrags<1, 64> f;
                    lds_unit<1, 64>(f, buf, 32 * half, half * TileGeom<1, 64>::VUNIT + g * 16, lr, g);
                    if (dof) mlstm_unit(Of, denf, 0, t, qf, f, aF, Mf, key0, g);
                    if (dob) mlstm_unit(Ob, denb, 1, t, qf, f, aB, Mb, key0, g);
                }
            }
        });
    if (LAT) {
        const bf16_t* qp2 = P + (size_t)(tok0 + t) * NIN + 2304 + h * 64 + 4 * g;
#pragma unroll
        for (int dir = 0; dir < 2; ++dir) {
            const int sidx = dir ? sidx_b : sidx_f;
            const float e = fexp2(((dir ? m0b : m0f) - (dir ? Mb : Mf)) * LOG2E) * 0.125f;
            const bf16_t* c0t = (const bf16_t*)(ws_ + OFF_C0T) + (size_t)sidx * 4096 + lr * 64 + 4 * g;
            const float* n0 = p.state_n + (size_t)sidx * 64;
            float dacc = 0.f;
#pragma unroll
            for (int u2 = 0; u2 < 2; ++u2) {
                const bf16x4 qa = *(const bf16x4*)(qp2 + u2 * 32), qb = *(const bf16x4*)(qp2 + u2 * 32 + 16);
                const float4 na = *(const float4*)(n0 + u2 * 32 + 4 * g), nb = *(const float4*)(n0 + u2 * 32 + 16 + 4 * g);
                float pv[8];
#pragma unroll
                for (int j = 0; j < 4; ++j) { pv[j] = bf2f((unsigned short)qa[j]) * e; pv[4 + j] = bf2f((unsigned short)qb[j]) * e; }
                dacc += pv[0] * na.x + pv[1] * na.y + pv[2] * na.z + pv[3] * na.w + pv[4] * nb.x + pv[5] * nb.y + pv[6] * nb.z + pv[7] * nb.w;
                const bf16x8 pk = pack8(pv[0], pv[1], pv[2], pv[3], pv[4], pv[5], pv[6], pv[7]);
#pragma unroll
                for (int vb = 0; vb < 4; ++vb) {
                    const bf16_t* cp = c0t + (size_t)vb * 16 * 64 + u2 * 32;
                    const bf16x8 cf = cat4(*(const bf16x4*)(cp), *(const bf16x4*)(cp + 16));
                    if (dir) Ob[vb] = mfma16(cf, pk, Ob[vb]); else Of[vb] = mfma16(cf, pk, Of[vb]);
                }
            }
            if (dir) denb += dacc; else denf += dacc;
        }
    }
    denf = grp_sum(denf); denb = grp_sum(denb);
    const float rf = 1.f / fmaxf(fabsf(denf), expf(-(Ff + Mf)));
    const float rb = 1.f / fmaxf(fabsf(denb), expf(-(Fb + Mb)));
    float ss = 0.f;
#pragma unroll
    for (int vb = 0; vb < 4; ++vb)
#pragma unroll
        for (int i = 0; i < 4; ++i) { const float hs = Of[vb][i] * rf + Ob[vb][i] * rb; Of[vb][i] = hs; ss += hs * hs; }
    ss = grp_sum(ss);
    const float rn = rsqrtf(ss * (1.f / 64.f) + LN_EPS);
    const float* gn = p.mlstm_norm_g + (size_t)(l * 4 + h) * 64;
    const bf16_t* op = P + (size_t)(tok0 + t) * NIN + 3072 + h * 64;
    bf16_t* MIX = (bf16_t*)(ws_ + OFF_MIX) + (size_t)(tok0 + t) * 1024 + 768 + h * 64;
#pragma unroll
    for (int vb = 0; vb < 4; ++vb) {
        const int v = vb * 16 + 4 * g;
        const float4 g4 = *(const float4*)(gn + v);
        const bf16x4 o4 = *(const bf16x4*)(op + v);
        float sg[4];
#pragma unroll
        for (int i = 0; i < 4; ++i) sg[i] = 1.f / (1.f + __expf(-bf2f((unsigned short)o4[i])));
        uint2 o; o.x = pack2(Of[vb][0] * rn * g4.x * sg[0], Of[vb][1] * rn * g4.y * sg[1]);
        o.y = pack2(Of[vb][2] * rn * g4.z * sg[2], Of[vb][3] * rn * g4.w * sg[3]);
        *(uint2*)(MIX + v) = o;
    }
}

DI void item_mlstm_state(const Params& pin, int l, int b, int h, int dir, unsigned char* smem, int wave, int lane) {
    const Params& p = pin; unsigned char* const ws_ = opaque_ws(pin.ws); float* const out_ = opaque_out(pin.out); lane = opaque_v(lane); wave = opaque_s(wave);
    const int lr = lane & 15, g = lane >> 4;
    const int tok0 = b * 256;
    float* aA = (float*)smem; float* MA = aA + 1024; float* FA = MA + 1024;
    const float* G = (const float*)(ws_ + OFF_G) + (size_t)tok0 * 16;
    __syncthreads();
    if (wave == 0) mlstm_scan(G, h, 256, dir, aA, MA, FA, 0.f, lane);
    __syncthreads();
    const float Mfin = dir ? MA[0] : MA[255];
    const float Ffin = dir ? FA[0] : FA[255];
    const bf16_t* KT = (const bf16_t*)(ws_ + OFF_PT_CK) + (size_t)tok0 * 256 + (size_t)(h * 64 + wave * 16 + lr) * 32 + 8 * g;
    const bf16_t* VT = (const bf16_t*)(ws_ + OFF_PT_CV) + (size_t)tok0 * 256 + (size_t)(h * 64 + lr) * 32 + 8 * g;
    f32x4 C[4];
#pragma unroll
    for (int vb = 0; vb < 4; ++vb) C[vb] = (f32x4){0.f, 0.f, 0.f, 0.f};
    float nacc = 0.f;
#pragma unroll 4
    for (int u = 0; u < 8; ++u) {
        const int s0 = u * 32;
        const bf16x8 kf = *(const bf16x8*)(KT + (size_t)u * 256 * 32);
        const float4 a0 = *(const float4*)(aA + s0 + 8 * g), a1 = *(const float4*)(aA + s0 + 8 * g + 4);
        const float av[8] = {a0.x, a0.y, a0.z, a0.w, a1.x, a1.y, a1.z, a1.w};
        float kw[8];
#pragma unroll
        for (int j = 0; j < 8; ++j) { kw[j] = bf2f((unsigned short)kf[j]) * fexp2((av[j] - Mfin) * LOG2E); nacc += kw[j]; }
        const bf16x8 af = pack8(kw[0], kw[1], kw[2], kw[3], kw[4], kw[5], kw[6], kw[7]);
#pragma unroll
        for (int vb = 0; vb < 4; ++vb) {
            const bf16x8 vf = *(const bf16x8*)(VT + (size_t)u * 256 * 32 + vb * 16 * 32);
            C[vb] = mfma16(af, vf, C[vb]);
        }
    }
    const size_t sidx = (size_t)((b * 4 + l) * 2 + dir) * 4 + h;
    float* oc = out_ + O_NC + sidx * 4096;
#pragma unroll
    for (int vb = 0; vb < 4; ++vb)
#pragma unroll
        for (int i = 0; i < 4; ++i) oc[(wave * 16 + 4 * g + i) * 64 + vb * 16 + lr] = C[vb][i];
    nacc = grp_sum(nacc);
    if (g == 0) out_[O_NN + sidx * 64 + wave * 16 + lr] = nacc;
    if (wave == 0 && lane == 0) out_[O_NM + sidx] = Ffin + Mfin;
}

DI void mixer_phase(const Params& p, int l, unsigned char* smem) {
    const int tid_ = opaque_v(threadIdx.x); const int lane = tid_ & 63, wave = (tid_ >> 6) & 3;
    const int half = __builtin_amdgcn_readfirstlane(tid_ >> 8);
    unsigned char* sm = smem + half * HALF_LDS;
    unsigned* ctr = (unsigned*)(p.ws + OFF_MIXCTR) + l;
    volatile unsigned* slot = (volatile unsigned*)(smem + LDS_BYTES + 16);
    for (;;) {
        __syncthreads();
        if (tid_ == 0) *slot = __hip_atomic_fetch_add(ctr, 1u, __ATOMIC_RELAXED, __HIP_MEMORY_SCOPE_AGENT);
        __syncthreads();
        const int it = __builtin_amdgcn_readfirstlane(2 * (int)*slot + half);
        if (it >= 1408) break;
        if (it < 256) { item_diffattn_lat(p, l, it >> 7, (it >> 5) & 3, it & 31, sm, wave, lane); }
        else if (it < 384) { const int i = it - 256; item_mlstm<true>(p, l, i >> 6, (i >> 4) & 3, i & 15, sm, wave, lane); }
        else if (it < 512) { const int i = it - 384; item_mlstm_state(p, l, i >> 3, (i >> 1) & 3, i & 1, sm, wave, lane); }
        else if (it < 640) { const int i = it - 512; item_na(p, l, i >> 6, (i >> 4) & 3, i & 15, sm, wave, lane); }
        else if (it < 896) { const int i = it - 640; item_diffattn<false>(p, l, i >> 4, (i >> 2) & 3, i & 3, sm, wave, lane); }
        else if (it < 1152) { const int i = it - 896; item_mlstm<false>(p, l, i >> 4, (i >> 2) & 3, i & 3, sm, wave, lane); }
        else { const int i = it - 1152; item_dense(p, i >> 4, (i >> 2) & 3, i & 3, sm, wave, lane); }
    }
}

#define XB_TMO      128
#define XB_XCNT(j)  (256  + 64 * (j))
#define XB_XSUB(j)  (1280 + 64 * (j))
#define XB_XGEN(j)  (2304 + 64 * (j))
#define XB_TOP      3328
#define XB_TOPGEN   3392
#define XCD_BAR_WORDS 3456
#define XB_SPIN_CAP (1u << 18)

__device__ __forceinline__ unsigned xb_ld(unsigned* p)              { return __hip_atomic_load(p, __ATOMIC_RELAXED, __HIP_MEMORY_SCOPE_AGENT); }
__device__ __forceinline__ unsigned xb_add(unsigned* p, unsigned v) { return __hip_atomic_fetch_add(p, v, __ATOMIC_RELAXED, __HIP_MEMORY_SCOPE_AGENT); }
__device__ __forceinline__ unsigned xb_xcc_id() { return (unsigned)__builtin_amdgcn_s_getreg((3 << 11) | 20) & 0xFu; }
#define XB_SPIN(cond, bar) do { unsigned _sp = 0; while (cond) { __builtin_amdgcn_s_sleep(1); \
    if ((++_sp & 255u) == 0u) { if (xb_ld(&(bar)[XB_TMO])) break; if (_sp > XB_SPIN_CAP) { atomicAdd(&(bar)[XB_TMO], 1u); break; } } } } while (0)

struct XcdBarrier {
    unsigned* bar; unsigned x;
    volatile LAS unsigned* st;
};

__device__ __forceinline__ XcdBarrier xcd_barrier_post(unsigned* bar, volatile LAS unsigned* st) {
    XcdBarrier b; b.bar = bar; b.x = xb_xcc_id(); b.st = st;
    if (threadIdx.x == 0) (void)xb_add(&bar[XB_XCNT(b.x)], 1u);
    return b;
}
__device__ __forceinline__ void xcd_barrier_complete(unsigned* bar, unsigned x, unsigned& nloc, unsigned& nx) {
    const unsigned G = gridDim.x * gridDim.y * gridDim.z;
    unsigned sum, cnt, mine, sp = 0u;
    for (;;) {
        sum = 0u; cnt = 0u; mine = 0u;
#pragma unroll
        for (unsigned j = 0; j < 16; ++j) { const unsigned c = xb_ld(&bar[XB_XCNT(j)]); sum += c; cnt += (c > 0u) ? 1u : 0u; mine = (j == x) ? c : mine; }
        if (sum == G) break;
        __builtin_amdgcn_s_sleep(1);
        if ((++sp & 255u) == 0u) { if (xb_ld(&bar[XB_TMO])) break; if (sp > XB_SPIN_CAP) { atomicAdd(&bar[XB_TMO], 1u); break; } }
    }
    nloc = mine > 0u ? mine : 1u; nx = cnt > 0u ? cnt : 1u;
}

__device__ __forceinline__ void xcd_barrier(const XcdBarrier& b) {
    asm volatile("s_waitcnt vmcnt(0)" ::: "memory");
    __syncthreads();
    if (threadIdx.x == 0) {
        unsigned* bar = b.bar;
        __builtin_amdgcn_s_waitcnt(0);
        unsigned nloc = b.st[0], nx = b.st[1];
        if (nloc == 0u) { xcd_barrier_complete(bar, b.x, nloc, nx); b.st[0] = nloc; b.st[1] = nx; }
        const unsigned old = xb_add(&bar[XB_XSUB(b.x)], 1u);
        const unsigned gen = old / nloc;
        if (old + 1u == (gen + 1u) * nloc) {
            __builtin_amdgcn_fence(__ATOMIC_RELEASE, "agent");
            asm volatile("s_waitcnt vmcnt(0)" ::: "memory");
            const unsigned og = xb_add(&bar[XB_TOP], 1u);
            const unsigned tg = og / nx;
            if (og + 1u == (tg + 1u) * nx) xb_add(&bar[XB_TOPGEN], 1u);
            else XB_SPIN(xb_ld(&bar[XB_TOPGEN]) == tg, bar);
            __builtin_amdgcn_fence(__ATOMIC_ACQUIRE, "agent");
            xb_add(&bar[XB_XGEN(b.x)], 1u);
            asm volatile("s_waitcnt vmcnt(0)" ::: "memory");
        } else {
            XB_SPIN(xb_ld(&bar[XB_XGEN(b.x)]) == gen, bar);
            __builtin_amdgcn_fence(__ATOMIC_ACQUIRE, "agent");
            asm volatile("s_waitcnt vmcnt(0)" ::: "memory");
        }
    }
    __syncthreads();
}


constexpr int N_PHASES = 2 + 5 * 4;

__global__ void __launch_bounds__(512, 2) fwd_kernel(Params p) {
    __shared__ __attribute__((aligned(16))) unsigned char smem[LDS_BYTES + 32];
    if (threadIdx.x == 0) *(uint4*)(smem + LDS_BYTES) = make_uint4(0u, 0u, 0u, 0u);
    __syncthreads();
    XcdBarrier xb = xcd_barrier_post((unsigned*)(p.ws + OFF_BAR), (volatile LAS unsigned*)(smem + LDS_BYTES));
    for (int ph = p.ph_lo; ph < p.ph_hi; ++ph) {
        if (ph > p.ph_lo) {
            if (p.ph_hi > 1000) cg::this_grid().sync();
            xcd_barrier(xb);
        }
        const int l = ph < 2 ? 0 : (ph - 2) / 5, s = ph < 2 ? ph - 2 : (ph - 2) % 5;
        const int bit = 1 << (s + 2);
        const int reps = (DUPM & bit) ? 2 : 1;
        for (int rep = 0; rep < reps; ++rep) {
            if (rep) __syncthreads();
            if (s == -2) prep0(p, smem + __builtin_amdgcn_readfirstlane(threadIdx.x >> 8) * HALF_LDS);
            else if (s == -1) prep1(p);
            else if (s == 0) gemm_phase<EPI_INPROJ>(p, l, OFF_H, OFF_WT_IN + (size_t)l * NINP * DM * 2, NINP / 128, 1024, 0, smem);
            else if (s == 1) mixer_phase(p, l, smem);
            else if (s == 2) gemm_phase<EPI_LN1>(p, l, OFF_MIX, OFF_WT_OUT + (size_t)l * DM * DM * 2, 8, 1024, 1024, smem);
            else if (s == 3) gemm_phase<EPI_RELU2>(p, l, OFF_H, OFF_WT_1 + (size_t)l * DFF * DM * 2, 32, 1024, 4096, smem);
            else gemm_phase<EPI_LN2>(p, l, OFF_U, OFF_WT_2 + (size_t)l * DM * DFF * 2, 8, 4096, 1024, smem);
        }
    }
}

extern "C" void kernel_launch(void* const* d_in, const int* in_sizes, int n_in, void* d_out, int out_size, void* d_ws, size_t ws_size,
                              hipStream_t stream) {
    static int grid = 0;
    if (grid == 0) {
        if (n_in != 26 || ws_size < WS_END) { fprintf(stderr, "kernel_launch: unexpected n_in %d / ws %zu (need %zu)\n", n_in, ws_size, (size_t)WS_END); grid = -1; return; }
        int dev = 0, cus = 0, per_cu = 0;
        hipGetDevice(&dev);
        hipDeviceGetAttribute(&cus, hipDeviceAttributeMultiprocessorCount, dev);
        hipOccupancyMaxActiveBlocksPerMultiprocessor(&per_cu, (const void*)fwd_kernel, 512, 0);
        (void)per_cu;
        grid = cus;
        if (grid < 192) { fprintf(stderr, "kernel_launch: grid %d < 192 resident workgroups needed by the fused LayerNorm exchange\n", grid); grid = -1; return; }
    }
    if (grid < 0) return;
    Params p{};
    const float** pp = (const float**)&p;
    for (int i = 0; i < 26; ++i) pp[i] = (const float*)d_in[i];
    p.out = (float*)d_out; p.ws = (unsigned char*)d_ws;
    (void)hipMemsetAsync((unsigned char*)d_ws + OFF_BAR, 0, 16384, stream);
#if SINGLE_LAUNCH
    p.ph_lo = 0; p.ph_hi = N_PHASES;
    void* args[] = {&p};
    hipError_t e = hipLaunchCooperativeKernel((const void*)fwd_kernel, dim3(grid), dim3(512), args, 0, stream);
    if (e != hipSuccess) fprintf(stderr, "cooperative launch failed: %s (grid %d)\n", hipGetErrorString(e), grid);
#else
    for (int ph = 0; ph < N_PHASES; ++ph) {
        p.ph_lo = ph; p.ph_hi = ph + 1;
        void* args[] = {&p};
        hipError_t e = hipLaunchCooperativeKernel((const void*)fwd_kernel, dim3(grid), dim3(512), args, 0, stream);
        if (e != hipSuccess) { fprintf(stderr, "launch %d failed: %s (grid %d)\n", ph, hipGetErrorString(e), grid); break; }
    }
#endif
}
```

```cpp
#include <hip/hip_runtime.h>
#include <hip/hip_cooperative_groups.h>
#include <cstdio>
namespace cg = cooperative_groups;

#ifndef IM
#define IM 0xffff
#endif
#ifndef IM
#define IM 0xffff
#endif
#ifndef DUPM
#define DUPM 0
#endif
#ifndef PHM
#define PHM 0xffff
#endif
#ifndef SINGLE_LAUNCH
#define SINGLE_LAUNCH 1
#endif

#define LAS __attribute__((address_space(3)))
typedef unsigned short bf16_t;
typedef __attribute__((ext_vector_type(8))) short bf16x8;
typedef __attribute__((ext_vector_type(4))) short bf16x4;
typedef __attribute__((ext_vector_type(4))) float f32x4;
#define DI __device__ __forceinline__

constexpr int NTOK = 6144, NCTX = 4096, DM = 1024, NIN = 3344, NINP = 3456, DFF = 4096;
constexpr float ALPHA = 1.681792830507429f;
constexpr float LOG2E = 1.4426950408889634f;
constexpr float LN_EPS = 1e-5f;

constexpr size_t al256(size_t x) { return (x + 255) & ~(size_t)255; }
constexpr size_t OFF_WT_IN = 0;
constexpr size_t OFF_WT_OUT = OFF_WT_IN + al256((size_t)4 * NINP * DM * 2);
constexpr size_t OFF_WT_1 = OFF_WT_OUT + al256((size_t)4 * DM * DM * 2);
constexpr size_t OFF_WT_2 = OFF_WT_1 + al256((size_t)4 * DFF * DM * 2);
constexpr size_t OFF_MOD = OFF_WT_2 + al256((size_t)4 * DFF * DM * 2);
constexpr size_t OFF_X = OFF_MOD + al256((size_t)4 * 3 * 6144 * 4);
constexpr size_t OFF_H = OFF_X + al256((size_t)NTOK * DM * 4);
constexpr size_t OFF_P = OFF_H + al256((size_t)NTOK * DM * 2);
constexpr size_t OFF_PT_AV = OFF_P + al256((size_t)NTOK * NIN * 2);
constexpr size_t OFF_PT_BV = OFF_PT_AV + al256((size_t)NTOK * 512 * 2);
constexpr size_t OFF_PT_CV = OFF_PT_BV + al256((size_t)NTOK * 256 * 2);
constexpr size_t OFF_PT_CK = OFF_PT_CV + al256((size_t)NTOK * 256 * 2);
constexpr size_t OFF_G = OFF_PT_CK + al256((size_t)NTOK * 256 * 2);
constexpr size_t OFF_MIX = OFF_G + al256((size_t)NTOK * 16 * 4);
constexpr size_t OFF_Y = OFF_MIX + al256((size_t)NTOK * DM * 2);
constexpr size_t OFF_U = OFF_Y + al256((size_t)NTOK * DM * 4);
constexpr size_t OFF_CAK = OFF_U + al256((size_t)NTOK * DFF * 2);
constexpr size_t OFF_CAVT = OFF_CAK + al256((size_t)32 * 512 * 128 * 2);
constexpr size_t OFF_CBK = OFF_CAVT + al256((size_t)32 * 512 * 128 * 2);
constexpr size_t OFF_CBVT = OFF_CBK + al256((size_t)32 * 512 * 64 * 2);
constexpr size_t OFF_C0T = OFF_CBVT + al256((size_t)32 * 512 * 64 * 2);
constexpr size_t OFF_ROPE = OFF_C0T + al256((size_t)64 * 64 * 64 * 2);
constexpr size_t OFF_LAM = OFF_ROPE + al256((size_t)2 * 1024 * 4);
constexpr size_t OFF_BAR = OFF_LAM + 256;
constexpr size_t OFF_LNCNT = OFF_BAR + 13824;
constexpr size_t OFF_MIXCTR = OFF_BAR + 15360;
constexpr size_t OFF_STATS = OFF_BAR + 16384;
constexpr size_t WS_END = OFF_STATS + (size_t)NTOK * 16 * 8;

constexpr size_t O_YP = 0, O_YS = 4194304, O_AK = 6291456, O_AV = 14680064, O_BK = 23068672, O_BV = 27262976,
                 O_NC = 31457280, O_NN = 33554432, O_NM = 33587200;

struct Params {
    const float* x_prompt; const float* x_sample; const float* cache_a_k; const float* cache_a_v;
    const float* cache_b_k; const float* cache_b_v; const float* state_c; const float* state_n;
    const float* state_m; const float* c; const float* c_ctx; const float* w_in; const float* gate_bias;
    const float* diff_lambda; const float* diff_norm_g; const float* nat_rpb; const float* mlstm_norm_g;
    const float* w_out; const float* ada_w; const float* ada_b; const float* ln1_g; const float* ln1_b;
    const float* ln2_g; const float* ln2_b; const float* w_mlp1; const float* w_mlp2;
    float* out; unsigned char* ws; int ph_lo; int ph_hi;
};

#define VBID ((int)(blockIdx.x * 2 + __builtin_amdgcn_readfirstlane(threadIdx.x >> 8)))
#define VGRID ((int)(gridDim.x * 2))
#define VTID ((int)(threadIdx.x & 255))
constexpr int HALF_LDS = 73728;
constexpr int LDS_BYTES = 2 * HALF_LDS;
DI int opaque_v(int x) { asm volatile("" : "+v"(x)); return x; }
DI int opaque_s(int x) { x = __builtin_amdgcn_readfirstlane(x); asm volatile("" : "+s"(x)); return x; }
DI size_t opaque_zero() { size_t z = 0; asm volatile("" : "+s"(z)); return z; }
DI unsigned char* opaque_ws(unsigned char* w) { return w + opaque_zero(); }
DI float* opaque_out(float* w) { return w + opaque_zero(); }
DI unsigned short f2bf(float x) { unsigned u = __float_as_uint(x); u += 0x7fffu + ((u >> 16) & 1u); return (unsigned short)(u >> 16); }
DI float bf2f(unsigned short h) { return __uint_as_float(((unsigned)h) << 16); }
DI unsigned pack2(float a, float b) { return (unsigned)f2bf(a) | ((unsigned)f2bf(b) << 16); }
DI f32x4 mfma16(bf16x8 a, bf16x8 b, f32x4 c) { return __builtin_amdgcn_mfma_f32_16x16x32_bf16(a, b, c, 0, 0, 0); }
DI float fexp2(float x) { return __builtin_amdgcn_exp2f(x); }
DI bf16x8 pack8(float a0, float a1, float a2, float a3, float a4, float a5, float a6, float a7) {
    uint4 u;
    asm volatile("s_nop 1\n\tv_cvt_pk_bf16_f32 %0, %4, %5\n\tv_cvt_pk_bf16_f32 %1, %6, %7\n\tv_cvt_pk_bf16_f32 %2, %8, %9\n\tv_cvt_pk_bf16_f32 %3, %10, %11\n\ts_nop 1"
                 : "=&v"(u.x), "=&v"(u.y), "=&v"(u.z), "=&v"(u.w)
                 : "v"(a0), "v"(a1), "v"(a2), "v"(a3), "v"(a4), "v"(a5), "v"(a6), "v"(a7));
    return __builtin_bit_cast(bf16x8, u);
}
DI bf16x8 cat4(bf16x4 a, bf16x4 b) { return __builtin_shufflevector(a, b, 0, 1, 2, 3, 4, 5, 6, 7); }
DI float wave_sum(float v) {
#pragma unroll
    for (int o = 32; o > 0; o >>= 1) v += __shfl_xor(v, o);
    return v;
}
DI float grp_sum(float v) { v += __shfl_xor(v, 16); v += __shfl_xor(v, 32); return v; }
DI float grp_max(float v) { v = fmaxf(v, __shfl_xor(v, 16)); v = fmaxf(v, __shfl_xor(v, 32)); return v; }

DI void transpose_job(const float* __restrict__ src, bf16_t* __restrict__ dst, int R, int C, int Cpad, int nmat, float* tile, bool blocked = false,
                      int vb = -1, int vg = 0) {
    if (vb < 0) { vb = VBID; vg = VGRID; }
    const int tid = VTID;
    const int rt = R >> 6, ct = Cpad >> 6, per = rt * ct, total = per * nmat;
    for (int it = vb; it < total; it += vg) {
        const int mat = it / per, rem = it - mat * per;
        const int r0 = (rem / ct) << 6, c0 = (rem % ct) << 6;
        const float* s = src + (size_t)mat * R * C;
        bf16_t* d = dst + (size_t)mat * Cpad * R;
#pragma unroll
        for (int i = 0; i < 4; ++i) {
            const int r = (tid >> 4) + 16 * i, c = (tid & 15) * 4;
            float4 v = make_float4(0.f, 0.f, 0.f, 0.f);
            if (c0 + c < C) v = *(const float4*)(s + (size_t)(r0 + r) * C + c0 + c);
            tile[r * 65 + c + 0] = v.x; tile[r * 65 + c + 1] = v.y; tile[r * 65 + c + 2] = v.z; tile[r * 65 + c + 3] = v.w;
        }
        __syncthreads();
        {
            const int c = tid >> 2, rs = (tid & 3) * 16;
            uint4 o0, o1;
            o0.x = pack2(tile[(rs + 0) * 65 + c], tile[(rs + 1) * 65 + c]);
            o0.y = pack2(tile[(rs + 2) * 65 + c], tile[(rs + 3) * 65 + c]);
            o0.z = pack2(tile[(rs + 4) * 65 + c], tile[(rs + 5) * 65 + c]);
            o0.w = pack2(tile[(rs + 6) * 65 + c], tile[(rs + 7) * 65 + c]);
            o1.x = pack2(tile[(rs + 8) * 65 + c], tile[(rs + 9) * 65 + c]);
            o1.y = pack2(tile[(rs + 10) * 65 + c], tile[(rs + 11) * 65 + c]);
            o1.z = pack2(tile[(rs + 12) * 65 + c], tile[(rs + 13) * 65 + c]);
            o1.w = pack2(tile[(rs + 14) * 65 + c], tile[(rs + 15) * 65 + c]);
            uint4* dp = blocked ? (uint4*)(d + ((size_t)((r0 + rs) >> 5) * Cpad + (c0 + c)) * 32 + ((r0 + rs) & 31))
                                : (uint4*)(d + (size_t)(c0 + c) * R + r0 + rs);
            dp[0] = o0; dp[1] = o1;
        }
        __syncthreads();
    }
}

DI void convert_job(const float* __restrict__ src, bf16_t* __restrict__ dst, size_t n) {
    for (size_t i = ((size_t)VBID * 256 + VTID) * 8; i < n; i += (size_t)VGRID * 256 * 8) {
        const float4 a = *(const float4*)(src + i), b = *(const float4*)(src + i + 4);
        uint4 o; o.x = pack2(a.x, a.y); o.y = pack2(a.z, a.w); o.z = pack2(b.x, b.y); o.w = pack2(b.z, b.w);
        *(uint4*)(dst + i) = o;
    }
}

DI void prep0(const Params& pin, unsigned char* smem) {
    const Params& p = pin; unsigned char* const ws_ = opaque_ws(pin.ws); float* const out_ = opaque_out(pin.out); const int tid = opaque_v(VTID);
    {
        float* sl = (float*)smem; float* red = (float*)(smem + 12288);
        for (int i = tid; i < 3072; i += 256) {
            const int cnd = i >> 10, k = i & 1023;
            const float v = (cnd == 0) ? p.c_ctx[k] : p.c[(cnd - 1) * 1024 + k];
            sl[i] = v / (1.f + __expf(-v));
        }
        __syncthreads();
        float* mod = (float*)(ws_ + OFF_MOD);
        const int kg = tid >> 4, cl = tid & 15;
        for (int it = VBID; it < 384; it += VGRID) {
            const int l = it / 96, j0 = (it % 96) * 64;
            const float* w = p.ada_w + (size_t)l * 1024 * 6144 + j0 + cl * 4;
            float4 a0 = make_float4(0, 0, 0, 0), a1 = a0, a2 = a0;
#pragma unroll 8
            for (int kk = 0; kk < 64; ++kk) {
                const int k = kg * 64 + kk;
                const float4 wv = *(const float4*)(w + (size_t)k * 6144);
                const float s0 = sl[k], s1 = sl[1024 + k], s2 = sl[2048 + k];
                a0.x += s0 * wv.x; a0.y += s0 * wv.y; a0.z += s0 * wv.z; a0.w += s0 * wv.w;
                a1.x += s1 * wv.x; a1.y += s1 * wv.y; a1.z += s1 * wv.z; a1.w += s1 * wv.w;
                a2.x += s2 * wv.x; a2.y += s2 * wv.y; a2.z += s2 * wv.z; a2.w += s2 * wv.w;
            }
            __syncthreads();
            float* r = red + kg * 192 + cl * 4;
            r[0] = a0.x; r[1] = a0.y; r[2] = a0.z; r[3] = a0.w;
            r[64] = a1.x; r[65] = a1.y; r[66] = a1.z; r[67] = a1.w;
            r[128] = a2.x; r[129] = a2.y; r[130] = a2.z; r[131] = a2.w;
            __syncthreads();
            if (tid < 192) {
                const int cnd = tid >> 6, col = tid & 63;
                float s = 0.f;
#pragma unroll
                for (int q = 0; q < 16; ++q) s += red[q * 192 + tid];
                mod[(l * 3 + cnd) * 6144 + j0 + col] = s + p.ada_b[l * 6144 + j0 + col];
            }
        }
        __syncthreads();
    }
    if (VBID == VGRID - 1) {
        float* rope = (float*)(ws_ + OFF_ROPE);
        for (int i = tid; i < 1024; i += 256) {
            const int pos = i >> 4, j = i & 15;
            const float freq = powf(10000.f, -(float)j / 16.f);
            float s, c; sincosf((float)pos * freq, &s, &c);
            rope[i] = c; rope[1024 + i] = s;
        }
        if (tid < 4) {
            const float* lp = p.diff_lambda + tid * 256;
            float s1 = 0.f, s2 = 0.f;
            for (int i = 0; i < 64; ++i) { s1 += lp[i] * lp[64 + i]; s2 += lp[128 + i] * lp[192 + i]; }
            const float li = 0.8f - 0.6f * expf(-0.3f * (float)tid);
            float* lam = (float*)(ws_ + OFF_LAM);
            lam[tid * 2] = expf(s1) - expf(s2) + li; lam[tid * 2 + 1] = li;
        }
    }
    float* tile = (float*)smem;
    transpose_job(p.w_in, (bf16_t*)(ws_ + OFF_WT_IN), 1024, NIN, NINP, 1, tile);
    transpose_job(p.w_out, (bf16_t*)(ws_ + OFF_WT_OUT), 1024, 1024, 1024, 1, tile);
    transpose_job(p.w_mlp1, (bf16_t*)(ws_ + OFF_WT_1), 1024, 4096, 4096, 1, tile);
    transpose_job(p.w_mlp2, (bf16_t*)(ws_ + OFF_WT_2), 4096, 1024, 1024, 1, tile);
    transpose_job(p.cache_a_v, (bf16_t*)(ws_ + OFF_CAVT), 512, 128, 128, 32, tile, true);
    transpose_job(p.cache_b_v, (bf16_t*)(ws_ + OFF_CBVT), 512, 64, 64, 32, tile, true);
    transpose_job(p.state_c, (bf16_t*)(ws_ + OFF_C0T), 64, 64, 64, 64, tile);
    convert_job(p.cache_a_k, (bf16_t*)(ws_ + OFF_CAK), (size_t)32 * 512 * 128);
    convert_job(p.cache_b_k, (bf16_t*)(ws_ + OFF_CBK), (size_t)32 * 512 * 64);
}

DI void prep1(const Params& pin) {
    const Params& p = pin; unsigned char* const ws_ = opaque_ws(pin.ws); float* const out_ = opaque_out(pin.out); const int tid_ = opaque_v(threadIdx.x); const int lane = tid_ & 63, wave = tid_ >> 6;
    const float* mod = (const float*)(ws_ + OFF_MOD);
    float* X = (float*)(ws_ + OFF_X);
    bf16_t* H = (bf16_t*)(ws_ + OFF_H);
    for (int row = blockIdx.x * 8 + wave; row < NTOK; row += gridDim.x * 8) {
        const float* src = row < NCTX ? p.x_prompt + (size_t)row * 1024 : p.x_sample + (size_t)(row - NCTX) * 1024;
        const int cnd = row < NCTX ? 0 : 1 + ((row - NCTX) >> 10);
        const float* md = mod + (size_t)cnd * 6144;
#pragma unroll
        for (int j = 0; j < 4; ++j) {
            const int c = lane * 4 + 256 * j;
            const float4 v = *(const float4*)(src + c);
            *(float4*)(X + (size_t)row * 1024 + c) = v;
            const float4 sh = *(const float4*)(md + c), sc = *(const float4*)(md + 1024 + c);
            uint2 o; o.x = pack2(v.x * (1.f + sc.x) + sh.x, v.y * (1.f + sc.y) + sh.y);
            o.y = pack2(v.z * (1.f + sc.z) + sh.z, v.w * (1.f + sc.w) + sh.w);
            *(uint2*)(H + (size_t)row * 1024 + c) = o;
        }
    }
}

enum { EPI_INPROJ = 0, EPI_LN1 = 1, EPI_RELU2 = 2, EPI_LN2 = 3 };

DI void epi_inproj(const Params& p, unsigned char* ws_, float* out_, int layer, const float* T, int rowbase, int colbase, int lane) {
    if (colbase >= NIN) return;
    bf16_t* P = (bf16_t*)(ws_ + OFF_P);
    const bool latent = rowbase >= NCTX;
    const int seq_tok0 = latent ? (NCTX + ((rowbase - NCTX) & ~1023)) : (rowbase & ~255);
    const int nseq = latent ? 1024 : 256;
    const int bctx = seq_tok0 >> 8;
    const int n0 = rowbase - seq_tok0;
    if (colbase >= 3328) {
        float* G = (float*)(ws_ + OFF_G);
        const float bias = p.gate_bias[layer * 16 + (lane & 15)];
        for (int rr = 0; rr < 16; ++rr) {
            const int r = rr * 4 + (lane >> 4);
            G[(size_t)(rowbase + r) * 16 + (lane & 15)] = T[r * 65 + (lane & 15)] + bias;
        }
        return;
    }
    bool toP = false, rope = false, toT = false, toO = false;
    size_t toff = 0, obase = 0; int tW = 0, tcr = 0, ohd = 64, ocr = 0;
    if (colbase < 1024) { toP = true; rope = latent; if (colbase >= 512) { toO = !latent; obase = O_AK; ohd = 128; ocr = colbase - 512; } }
    else if (colbase < 1536) { toT = true; toff = OFF_PT_AV; tW = 512; tcr = colbase - 1024; toO = !latent; obase = O_AV; ohd = 128; ocr = tcr; }
    else if (colbase < 1792) { toP = true; }
    else if (colbase < 2048) { toP = true; toO = !latent; obase = O_BK; ohd = 64; ocr = colbase - 1792; }
    else if (colbase < 2304) { toT = true; toff = OFF_PT_BV; tW = 256; tcr = colbase - 2048; toO = !latent; obase = O_BV; ohd = 64; ocr = tcr; }
    else if (colbase < 2560) { toP = true; }
    else if (colbase < 2816) { toP = true; toT = true; toff = OFF_PT_CK; tW = 256; tcr = colbase - 2560; }
    else if (colbase < 3072) { toT = true; toff = OFF_PT_CV; tW = 256; tcr = colbase - 2816; }
    else { toP = true; }
    if (toO) {
        const int h = ocr / ohd, w = ocr - h * ohd + lane;
        float* O = out_ + obase + (((size_t)(bctx * 4 + layer) * 4 + h) * 256 + n0) * ohd + w;
#pragma unroll 4
        for (int r = 0; r < 64; ++r) O[(size_t)r * ohd] = T[r * 65 + lane];
    }
    if (toP) {
        bf16_t* Pp = P + (size_t)rowbase * NIN + colbase + lane;
        if (rope) {
            const float* rc = (const float*)(ws_ + OFF_ROPE);
            const float* rs = rc + 1024;
#pragma unroll 4
            for (int r = 0; r < 64; ++r) {
                const float v = T[r * 65 + lane], vp = T[r * 65 + (lane ^ 16)];
                const int t = n0 + r;
                const int pos = (lane < 32) ? (t >> 6) : (t & 63);
                const float c = rc[pos * 16 + (lane & 15)], sn = rs[pos * 16 + (lane & 15)];
                const float o = (lane & 16) ? (vp * sn + v * c) : (v * c - vp * sn);
                Pp[(size_t)r * NIN] = f2bf(o);
            }
        } else {
#pragma unroll 4
            for (int r = 0; r < 64; ++r) Pp[(size_t)r * NIN] = f2bf(T[r * 65 + lane]);
        }
    }
    if (toT) {
        const int n = n0 + lane;
        bf16_t* Tp = (bf16_t*)(ws_ + toff) + (size_t)seq_tok0 * tW + ((size_t)(n >> 5) * tW + tcr) * 32 + (n & 31);
#pragma unroll 4
        for (int c = 0; c < 64; ++c) Tp[(size_t)c * 32] = f2bf(T[lane * 65 + c]);
    }
}

template <int WHICH>
DI void epi_ln(const Params& p, unsigned char* ws_, float* out_, int l, float* T, int tm, int tn, int wn, int rowbase, int colbase, int lane, int tid) {
    const float* mod = (const float*)(ws_ + OFF_MOD);
    float* X = (float*)(ws_ + OFF_X);
    bf16_t* H = (bf16_t*)(ws_ + OFF_H);
    const int cnd = rowbase < NCTX ? 0 : 1 + ((rowbase - NCTX) >> 10);
    const float* md = mod + (size_t)(l * 3 + cnd) * 6144;
    const int col = colbase + lane;
    const bool last = (WHICH == 2 && l == 3);
    float s1 = 0.f, s2 = 0.f;
#pragma unroll 8
    for (int c = 0; c < 64; ++c) { const float v = T[lane * 65 + c]; s1 += v; s2 += v * v; }
    unsigned long long* stats = (unsigned long long*)(ws_ + OFF_STATS);
    __hip_atomic_store(stats + (size_t)(rowbase + lane) * 16 + tn * 2 + wn,
                       ((unsigned long long)__float_as_uint(s2) << 32) | (unsigned long long)__float_as_uint(s1), __ATOMIC_RELAXED, __HIP_MEMORY_SCOPE_AGENT);
    unsigned* cnt = (unsigned*)(ws_ + OFF_LNCNT) + (l * 2 + (WHICH - 1)) * 48 + tm;
    asm volatile("s_waitcnt vmcnt(0)" ::: "memory");
    __syncthreads();
    if (tid == 0) {
        (void)__hip_atomic_fetch_add(cnt, 1u, __ATOMIC_RELAXED, __HIP_MEMORY_SCOPE_AGENT);
        unsigned sp = 0;
        while (__hip_atomic_load(cnt, __ATOMIC_RELAXED, __HIP_MEMORY_SCOPE_AGENT) < 8u) { __builtin_amdgcn_s_sleep(1); if (++sp > (1u << 22)) break; }
    }
    __syncthreads();
    float t1 = 0.f, t2 = 0.f;
    {
        unsigned long long* sp8 = stats + (size_t)(rowbase + lane) * 16;
        unsigned long long a[16];
#pragma unroll
        for (int q = 0; q < 16; ++q) a[q] = __hip_atomic_load(sp8 + q, __ATOMIC_RELAXED, __HIP_MEMORY_SCOPE_AGENT);
#pragma unroll
        for (int q = 0; q < 16; ++q) { t1 += __uint_as_float((unsigned)a[q]); t2 += __uint_as_float((unsigned)(a[q] >> 32)); }
    }
    const float mu = t1 * (1.f / 1024.f);
    const float rstd = rsqrtf(fmaxf(t2 * (1.f / 1024.f) - mu * mu, 0.f) + LN_EPS);
    const float lng = (WHICH == 1 ? p.ln1_g : p.ln2_g)[l * 1024 + col], lnb = (WHICH == 1 ? p.ln1_b : p.ln2_b)[l * 1024 + col];
    if (last) {
        float* op = out_ + (size_t)rowbase * 1024 + col;
#pragma unroll 8
        for (int r = 0; r < 64; ++r) op[(size_t)r * 1024] = (T[r * 65 + lane] - __shfl(mu, r)) * __shfl(rstd, r) * lng + lnb;
    } else {
        const float* nmd = (WHICH == 1) ? md : mod + (size_t)((l + 1) * 3 + cnd) * 6144;
        const float sh = nmd[(WHICH == 1 ? 3072 : 0) + col], sc1p = 1.f + nmd[(WHICH == 1 ? 4096 : 1024) + col];
        float* xp = X + (size_t)rowbase * 1024 + col;
        bf16_t* hp = H + (size_t)rowbase * 1024 + col;
#pragma unroll 8
        for (int r = 0; r < 64; ++r) {
            const float o = (T[r * 65 + lane] - __shfl(mu, r)) * __shfl(rstd, r) * lng + lnb;
            xp[(size_t)r * 1024] = o;
            hp[(size_t)r * 1024] = f2bf(o * sc1p + sh);
        }
    }
}

template <int EPI>
DI void gemm_phase(const Params& pin, int layer, size_t offA, size_t offB, int ntn, int K, int ldc,
                   unsigned char* smem) {
    const Params& p = pin; unsigned char* const ws_ = opaque_ws(pin.ws); float* const out_ = opaque_out(pin.out); const int tid = opaque_v(threadIdx.x), lane = tid & 63, wave = opaque_s(tid >> 6);
    const bf16_t* __restrict__ A = (const bf16_t*)(ws_ + offA); const bf16_t* __restrict__ Bt = (const bf16_t*)(ws_ + offB);
    const int wm = wave >> 1, wn = wave & 1;
    const int lr = lane & 15, g = lane >> 4;
    const int ntm = NTOK / 256;
    const int ntiles = ntm * ntn, nk = K >> 6;
    constexpr int STAGE = 49152;
    bool prefetched = false;
    for (int tile = blockIdx.x; tile < ntiles; tile += gridDim.x) {
        const int tm = tile % ntm, tn = tile / ntm;
        const int m0 = tm * 256, n0 = tn * 128;
        f32x4 acc[4][4];
#pragma unroll
        for (int mi = 0; mi < 4; ++mi)
#pragma unroll
            for (int ni = 0; ni < 4; ++ni) acc[mi][ni] = (f32x4){0.f, 0.f, 0.f, 0.f};
        const bf16_t* Ag = A + (size_t)m0 * K;
        const bf16_t* Bg = Bt + (size_t)n0 * K;
        const bf16_t* ag = Ag + (size_t)(wave * 32 + (lane >> 3)) * K + (((lane & 7) ^ (lane >> 3)) << 3);
        const bf16_t* bg = Bg + (size_t)(wave * 16 + (lane >> 3)) * K + (((lane & 7) ^ (lane >> 3)) << 3);
        auto stage_from = [&](const bf16_t* ap, const bf16_t* bp, int t) {
            unsigned char* dst = smem + (t % 3) * STAGE;
            const int k0 = t << 6;
#pragma unroll
            for (int j = 0; j < 4; ++j)
                __builtin_amdgcn_global_load_lds((const unsigned*)(ap + (size_t)j * 8 * K + k0), (LAS unsigned*)(dst + (wave * 4 + j) * 1024), 16, 0, 0);
#pragma unroll
            for (int j = 0; j < 2; ++j)
                __builtin_amdgcn_global_load_lds((const unsigned*)(bp + (size_t)j * 8 * K + k0), (LAS unsigned*)(dst + 32768 + (wave * 2 + j) * 1024), 16, 0, 0);
        };
        auto stage = [&](int t) { stage_from(ag, bg, t); };
        auto read_half = [&](int t, int kk, bf16x8 (&af)[4], bf16x8 (&bfr)[4]) {
            const unsigned char* cur = smem + (t % 3) * STAGE;
#pragma unroll
            for (int mi = 0; mi < 4; ++mi) {
                const int row = wm * 64 + mi * 16 + lr;
                af[mi] = *(const bf16x8*)(cur + row * 128 + (((kk * 4 + g) ^ (row & 7)) << 4));
            }
#pragma unroll
            for (int ni = 0; ni < 4; ++ni) {
                const int row = wn * 64 + ni * 16 + lr;
                bfr[ni] = *(const bf16x8*)(cur + 32768 + row * 128 + (((kk * 4 + g) ^ (row & 7)) << 4));
            }
        };
        if (!prefetched) { stage(0); stage(1); stage(2); }
        bf16x8 a0[4], b0[4], a1[4], b1[4];
        asm volatile("s_waitcnt vmcnt(12)" ::: "memory");
        asm volatile("s_waitcnt lgkmcnt(0)" ::: "memory");
        __builtin_amdgcn_s_barrier();
        read_half(0, 0, a0, b0);
        for (int kt = 0; kt < nk; ++kt) {
            read_half(kt, 1, a1, b1);
#pragma unroll
            for (int mi = 0; mi < 4; ++mi)
#pragma unroll
                for (int ni = 0; ni < 4; ++ni) acc[mi][ni] = mfma16(a0[mi], b0[ni], acc[mi][ni]);
            __builtin_amdgcn_sched_barrier(0);
            if (kt + 2 < nk) asm volatile("s_waitcnt vmcnt(6)" ::: "memory");
            else asm volatile("s_waitcnt vmcnt(0)" ::: "memory");
            asm volatile("s_waitcnt lgkmcnt(0)" ::: "memory");
            __builtin_amdgcn_s_barrier();
            if (kt + 1 < nk) read_half(kt + 1, 0, a0, b0);
            if (kt + 3 < nk) stage(kt + 3);
#pragma unroll
            for (int mi = 0; mi < 4; ++mi)
#pragma unroll
                for (int ni = 0; ni < 4; ++ni) acc[mi][ni] = mfma16(a1[mi], b1[ni], acc[mi][ni]);
            __builtin_amdgcn_sched_barrier(0);
        }
        asm volatile("s_waitcnt lgkmcnt(0)" ::: "memory");
        __builtin_amdgcn_s_barrier();
        if (EPI == EPI_RELU2) {
            const int ntile = tile + (int)gridDim.x;
            prefetched = ntile < ntiles;
            if (prefetched) {
                const int tm2 = ntile % ntm, tn2 = ntile / ntm;
                const bf16_t* ag2 = A + (size_t)(tm2 * 256 + wave * 32 + (lane >> 3)) * K + (((lane & 7) ^ (lane >> 3)) << 3);
                const bf16_t* bg2 = Bt + (size_t)(tn2 * 128 + wave * 16 + (lane >> 3)) * K + (((lane & 7) ^ (lane >> 3)) << 3);
                stage_from(ag2, bg2, 0); stage_from(ag2, bg2, 1); stage_from(ag2, bg2, 2);
            }
            bf16_t* U = (bf16_t*)(ws_ + OFF_U) + (size_t)(m0 + wm * 64 + 4 * g) * ldc + n0 + wn * 64 + lr;
#pragma unroll
            for (int mi = 0; mi < 4; ++mi)
#pragma unroll
                for (int ni = 0; ni < 4; ++ni)
#pragma unroll
                    for (int i = 0; i < 4; ++i) {
                        const float v = fmaxf(acc[mi][ni][i], 0.f);
                        U[(size_t)(mi * 16 + i) * ldc + ni * 16] = f2bf(v * v);
                    }
            continue;
        }
        if (EPI == EPI_LN1 || EPI == EPI_LN2) {
            const int rb = m0 + wm * 64, cb = n0 + wn * 64;
            const int cnd = rb < NCTX ? 0 : 1 + ((rb - NCTX) >> 10);
            const float* gp = (const float*)(ws_ + OFF_MOD) + (size_t)(layer * 3 + cnd) * 6144 + (EPI == EPI_LN1 ? 2048 : 5120) + cb + lr;
            const float* xp = (const float*)(ws_ + OFF_X) + (size_t)(rb + 4 * g) * 1024 + cb + lr;
            float gt[4];
#pragma unroll
            for (int ni = 0; ni < 4; ++ni) gt[ni] = gp[ni * 16];
#pragma unroll
            for (int mh = 0; mh < 2; ++mh) {
                f32x4 xv[2][4];
#pragma unroll
                for (int m2 = 0; m2 < 2; ++m2)
#pragma unroll
                    for (int ni = 0; ni < 4; ++ni)
#pragma unroll
                        for (int i = 0; i < 4; ++i) xv[m2][ni][i] = xp[(size_t)((mh * 2 + m2) * 16 + i) * 1024 + ni * 16];
#pragma unroll
                for (int m2 = 0; m2 < 2; ++m2)
#pragma unroll
                    for (int ni = 0; ni < 4; ++ni)
#pragma unroll
                        for (int i = 0; i < 4; ++i) acc[mh * 2 + m2][ni][i] = ALPHA * xv[m2][ni][i] + gt[ni] * acc[mh * 2 + m2][ni][i];
                __builtin_amdgcn_sched_barrier(0);
            }
        }
        float* T = (float*)smem + wave * (64 * 65);
#pragma unroll
        for (int mi = 0; mi < 4; ++mi)
#pragma unroll
            for (int ni = 0; ni < 4; ++ni)
#pragma unroll
                for (int i = 0; i < 4; ++i) T[(mi * 16 + 4 * g + i) * 65 + ni * 16 + lr] = acc[mi][ni][i];
        const int rowbase = m0 + wm * 64, colbase = n0 + wn * 64;
        if (EPI == EPI_INPROJ) {
            epi_inproj(p, ws_, out_, layer, T, rowbase, colbase, lane);
        } else if (EPI == EPI_LN1) {
            epi_ln<1>(p, ws_, out_, layer, T, tm, tn, wn, rowbase, colbase, lane, tid);
        } else if (EPI == EPI_LN2) {
            epi_ln<2>(p, ws_, out_, layer, T, tm, tn, wn, rowbase, colbase, lane, tid);
        } else {
            bf16_t* U = (bf16_t*)(ws_ + OFF_U) + (size_t)rowbase * ldc + colbase + lane;
#pragma unroll 4
            for (int r = 0; r < 64; ++r) { const float v = fmaxf(T[r * 65 + lane], 0.f); U[(size_t)r * ldc] = f2bf(v * v); }
        }
        __syncthreads();
    }
    if ((EPI == EPI_LN1 || EPI == EPI_LN2) && layer < 3 && (int)blockIdx.x >= ntiles) {
        const int half = __builtin_amdgcn_readfirstlane(threadIdx.x >> 8);
        const int vb = ((int)blockIdx.x - ntiles) * 2 + half, vg = ((int)gridDim.x - ntiles) * 2;
        float* tile = (float*)(smem + half * HALF_LDS);
        const int nl = layer + 1;
        if (EPI == EPI_LN1) {
            transpose_job(p.w_in + (size_t)nl * 1024 * NIN, (bf16_t*)(ws_ + OFF_WT_IN) + (size_t)nl * NINP * DM, 1024, NIN, NINP, 1, tile, false, vb, vg);
            transpose_job(p.w_out + (size_t)nl * 1024 * 1024, (bf16_t*)(ws_ + OFF_WT_OUT) + (size_t)nl * DM * DM, 1024, 1024, 1024, 1, tile, false, vb, vg);
        } else {
            transpose_job(p.w_mlp1 + (size_t)nl * 1024 * 4096, (bf16_t*)(ws_ + OFF_WT_1) + (size_t)nl * DFF * DM, 1024, 4096, 4096, 1, tile, false, vb, vg);
            transpose_job(p.w_mlp2 + (size_t)nl * 4096 * 1024, (bf16_t*)(ws_ + OFF_WT_2) + (size_t)nl * DM * DFF, 4096, 1024, 1024, 1, tile, false, vb, vg);
        }
    }
}

template <int NMAP, int DV>
struct AttnSt { f32x4 O[NMAP][DV / 16]; float m[NMAP]; float l[NMAP]; };
template <int NMAP, int DV>
struct UnitFrags { bf16x8 k[NMAP][2][2]; bf16x8 v[DV / 16]; };

template <int NMAP, int DV>
struct TileGeom {
    static constexpr int KROW = NMAP * 128, KBYTES = 64 * KROW, VUNIT = DV * 64, TBYTES = KBYTES + 2 * VUNIT;
};
DI int kswz(int row) { return (row & 3) | (((row >> 3) & 3) << 2); }

template <int NMAP, int DV>
DI void stage_tile(unsigned char* buf, const bf16_t* kg, int kstride, const bf16_t* vg, int vunit, int wave, int lane) {
    typedef TileGeom<NMAP, DV> TG;
    if (NMAP == 2) {
#pragma unroll
        for (int j = 0; j < 4; ++j) {
            const int jj = wave * 4 + j, row = jj * 4 + (lane >> 4), lc = (lane & 15) ^ kswz(row);
            __builtin_amdgcn_global_load_lds((const unsigned*)(kg + (size_t)row * kstride + lc * 8), (LAS unsigned*)(buf + jj * 1024), 16, 0, 0);
        }
    } else {
#pragma unroll
        for (int j = 0; j < 2; ++j) {
            const int jj = wave * 2 + j, row = jj * 8 + (lane >> 3), lc = (lane & 7) ^ (kswz(row) >> 1);
            __builtin_amdgcn_global_load_lds((const unsigned*)(kg + (size_t)row * kstride + lc * 8), (LAS unsigned*)(buf + jj * 1024), 16, 0, 0);
        }
    }
    constexpr int VI = TG::VUNIT / 1024, PER = 2 * VI / 4;
#pragma unroll
    for (int j = 0; j < PER; ++j) {
        const int jj = wave * PER + j, unit = jj / VI, piece = jj % VI;
        __builtin_amdgcn_global_load_lds((const unsigned*)(vg + (size_t)unit * vunit + piece * 512 + lane * 8),
                                         (LAS unsigned*)(buf + TG::KBYTES + jj * 1024), 16, 0, 0);
    }
}

template <int NMAP, int DV>
DI void lds_unit(UnitFrags<NMAP, DV>& f, const unsigned char* buf, int rowbase, int voff, int lr, int g) {
    typedef TileGeom<NMAP, DV> TG;
#pragma unroll
    for (int b = 0; b < 2; ++b) {
        const int row = rowbase + (lr >> 2) * 8 + (lr & 3) + 4 * b, sw = kswz(row);
        if (NMAP == 2) {
#pragma unroll
            for (int m = 0; m < NMAP; ++m)
#pragma unroll
                for (int kk = 0; kk < 2; ++kk) f.k[m][b][kk] = *(const bf16x8*)(buf + row * 256 + (((m * 8 + kk * 4 + g) ^ sw) << 4));
        } else {
#pragma unroll
            for (int kk = 0; kk < 2; ++kk) f.k[0][b][kk] = *(const bf16x8*)(buf + row * 128 + (((kk * 4 + g) ^ (sw >> 1)) << 4));
        }
    }
#pragma unroll
    for (int vb = 0; vb < DV / 16; ++vb) f.v[vb] = *(const bf16x8*)(buf + TG::KBYTES + voff + (vb * 16 + lr) * 64);
}

template <int DV>
DI void lds_unit_sel(UnitFrags<1, DV>& f, const unsigned char* buf, int rowbase, int voff, int lr, int g, int msel) {
    typedef TileGeom<2, DV> TG;
#pragma unroll
    for (int b = 0; b < 2; ++b) {
        const int row = rowbase + (lr >> 2) * 8 + (lr & 3) + 4 * b, sw = kswz(row);
#pragma unroll
        for (int kk = 0; kk < 2; ++kk) f.k[0][b][kk] = *(const bf16x8*)(buf + row * 256 + (((msel * 8 + kk * 4 + g) ^ sw) << 4));
    }
#pragma unroll
    for (int vb = 0; vb < DV / 16; ++vb) f.v[vb] = *(const bf16x8*)(buf + TG::KBYTES + voff + (vb * 16 + lr) * 64);
}

template <int NMAP, int DV, class SrcFn, class CompFn>
DI void tile_pipeline(unsigned char* tiles, int nt, int wave, int lane, SrcFn src, CompFn comp) {
    typedef TileGeom<NMAP, DV> TG;
    {
        const bf16_t *kg, *vg; int ks, vu;
        src(0, kg, ks, vg, vu);
        stage_tile<NMAP, DV>(tiles, kg, ks, vg, vu, wave, lane);
    }
    asm volatile("s_waitcnt vmcnt(0)" ::: "memory");
    __syncthreads();
    for (int t = 0; t < nt; ++t) {
        unsigned char* cur = tiles + (t & 1) * TG::TBYTES;
        comp(t, cur, 0);
        if (t + 1 < nt) {
            const bf16_t *kg, *vg; int ks, vu;
            src(t + 1, kg, ks, vg, vu);
            stage_tile<NMAP, DV>(tiles + ((t + 1) & 1) * TG::TBYTES, kg, ks, vg, vu, wave, lane);
        }
        comp(t, cur, 1);
        asm volatile("s_waitcnt vmcnt(0)" ::: "memory");
        __syncthreads();
    }
}

template <int NMAP, int DV, bool HASBIAS>
DI void compute_unit(AttnSt<NMAP, DV>& st, const UnitFrags<NMAP, DV>& f, const bf16x8 (&qf)[NMAP][2], float sc, const float (&bias)[8]) {
    bf16x8 pk[NMAP];
#pragma unroll
    for (int m = 0; m < NMAP; ++m) {
        f32x4 sa = (f32x4){0.f, 0.f, 0.f, 0.f}, sb = sa;
        sa = mfma16(f.k[m][0][0], qf[m][0], sa); sa = mfma16(f.k[m][0][1], qf[m][1], sa);
        sb = mfma16(f.k[m][1][0], qf[m][0], sb); sb = mfma16(f.k[m][1][1], qf[m][1], sb);
        float s[8];
#pragma unroll
        for (int j = 0; j < 4; ++j) { s[j] = sa[j] * sc; s[4 + j] = sb[j] * sc; }
        if (HASBIAS) {
#pragma unroll
            for (int j = 0; j < 8; ++j) s[j] += bias[j];
        }
        float mx = fmaxf(fmaxf(fmaxf(s[0], s[1]), fmaxf(s[2], s[3])), fmaxf(fmaxf(s[4], s[5]), fmaxf(s[6], s[7])));
        mx = grp_max(mx);
        const float mnew = fmaxf(st.m[m], mx);
        const float alpha = fexp2(st.m[m] - mnew);
        float ps = 0.f;
#pragma unroll
        for (int j = 0; j < 8; ++j) { s[j] = fexp2(s[j] - mnew); ps += s[j]; }
        st.l[m] = st.l[m] * alpha + ps; st.m[m] = mnew;
        if (__builtin_amdgcn_ballot_w64(alpha != 1.f) != 0ull) {
#pragma unroll
            for (int vb = 0; vb < DV / 16; ++vb) st.O[m][vb] *= alpha;
        }
        pk[m] = pack8(s[0], s[1], s[2], s[3], s[4], s[5], s[6], s[7]);
    }
#pragma unroll
    for (int vb = 0; vb < DV / 16; ++vb) {
#pragma unroll
        for (int m = 0; m < NMAP; ++m) st.O[m][vb] = mfma16(f.v[vb], pk[m], st.O[m][vb]);
    }
}

template <int NMAP, int DV>
DI void attn_init(AttnSt<NMAP, DV>& st) {
#pragma unroll
    for (int m = 0; m < NMAP; ++m) {
        st.m[m] = -INFINITY; st.l[m] = 0.f;
#pragma unroll
        for (int vb = 0; vb < DV / 16; ++vb) st.O[m][vb] = (f32x4){0.f, 0.f, 0.f, 0.f};
    }
}

template <bool LAT>
DI void item_diffattn(const Params& pin, int l, int seq, int h, int qt, unsigned char* smem, int wave, int lane) {
    const Params& p = pin; unsigned char* const ws_ = opaque_ws(pin.ws); float* const out_ = opaque_out(pin.out); lane = opaque_v(lane); wave = opaque_s(wave);
    const int lr = lane & 15, g = lane >> 4;
    const int nseq = LAT ? 1024 : 256;
    const int tok0 = LAT ? NCTX + seq * 1024 : seq * 256;
    const bf16_t* P = (const bf16_t*)(ws_ + OFF_P);
    const int q0 = qt * 64 + wave * 16;
    bf16x8 qf[2][2];
    {
        const bf16_t* qp = P + (size_t)(tok0 + q0 + lr) * NIN + h * 128 + 8 * g;
#pragma unroll
        for (int m = 0; m < 2; ++m)
#pragma unroll
            for (int kk = 0; kk < 2; ++kk) qf[m][kk] = *(const bf16x8*)(qp + m * 64 + kk * 32);
    }
    AttnSt<2, 128> st;
    attn_init<2, 128>(st);
    const float sc = 0.125f * LOG2E;
    const size_t hb = (size_t)((seq * 4 + l) * 4 + h);
    const bf16_t* kc = (const bf16_t*)(ws_ + OFF_CAK) + hb * 512 * 128;
    const bf16_t* vc = (const bf16_t*)(ws_ + OFF_CAVT) + hb * 128 * 512;
    const bf16_t* kn = P + (size_t)tok0 * NIN + 512 + h * 128;
    const bf16_t* vn = (const bf16_t*)(ws_ + OFF_PT_AV) + (size_t)tok0 * 512 + (size_t)(h * 128) * 32;
    const int ncache = LAT ? 8 : 0;
    __syncthreads();
    tile_pipeline<2, 128>(smem, ncache + nseq / 64, wave, lane,
        [&](int t, const bf16_t*& kg, int& ks, const bf16_t*& vg, int& vu) {
            if (t < ncache) { kg = kc + (size_t)t * 64 * 128; ks = 128; vg = vc + (size_t)(2 * t) * 128 * 32; vu = 128 * 32; }
            else { const int tt = t - ncache; kg = kn + (size_t)tt * 64 * NIN; ks = NIN; vg = vn + (size_t)(2 * tt) * 512 * 32; vu = 512 * 32; }
        },
        [&](int t, const unsigned char* buf, int part) {
            const float nob[8] = {0.f, 0.f, 0.f, 0.f, 0.f, 0.f, 0.f, 0.f};
            { const int half = part;
                UnitFrags<2, 128> f;
                lds_unit<2, 128>(f, buf, 32 * half, half * TileGeom<2, 128>::VUNIT + g * 16, lr, g);
                compute_unit<2, 128, false>(st, f, qf, sc, nob);
            }
        });
    const float inv0 = 1.f / grp_sum(st.l[0]), inv1 = 1.f / grp_sum(st.l[1]);
    const float* lamp = (const float*)(ws_ + OFF_LAM);
    const float lam = lamp[l * 2], lam_init = lamp[l * 2 + 1];
    const float c1 = lam * inv1;
    float ss = 0.f;
#pragma unroll
    for (int vb = 0; vb < 8; ++vb)
#pragma unroll
        for (int i = 0; i < 4; ++i) {
            const float o = st.O[0][vb][i] * inv0 - st.O[1][vb][i] * c1;
            st.O[0][vb][i] = o; ss += o * o;
        }
    ss = grp_sum(ss);
    const float r = rsqrtf(ss * (1.f / 128.f) + LN_EPS) * (1.f - lam_init);
    bf16_t* MIX = (bf16_t*)(ws_ + OFF_MIX) + (size_t)(tok0 + q0 + lr) * 1024 + h * 128;
    const float* gn = p.diff_norm_g + l * 128;
#pragma unroll
    for (int vb = 0; vb < 8; ++vb) {
        const int v = vb * 16 + 4 * g;
        const float4 g4 = *(const float4*)(gn + v);
        uint2 o; o.x = pack2(st.O[0][vb][0] * r * g4.x, st.O[0][vb][1] * r * g4.y);
        o.y = pack2(st.O[0][vb][2] * r * g4.z, st.O[0][vb][3] * r * g4.w);
        *(uint2*)(MIX + v) = o;
    }
}

DI void item_diffattn_lat(const Params& pin, int l, int seq, int h, int qt32, unsigned char* smem, int wave, int lane) {
    const Params& p = pin; unsigned char* const ws_ = opaque_ws(pin.ws); float* const out_ = opaque_out(pin.out); lane = opaque_v(lane); wave = opaque_s(wave);
    const int lr = lane & 15, g = lane >> 4;
    const int tok0 = NCTX + seq * 1024;
    const bf16_t* P = (const bf16_t*)(ws_ + OFF_P);
    const int msel = wave & 1;
    const int q0 = qt32 * 32 + (wave >> 1) * 16;
    bf16x8 qf[1][2];
    {
        const bf16_t* qp = P + (size_t)(tok0 + q0 + lr) * NIN + h * 128 + msel * 64 + 8 * g;
        qf[0][0] = *(const bf16x8*)(qp); qf[0][1] = *(const bf16x8*)(qp + 32);
    }
    AttnSt<1, 128> st;
    attn_init<1, 128>(st);
    const float sc = 0.125f * LOG2E;
    const size_t hb = (size_t)((seq * 4 + l) * 4 + h);
    const bf16_t* kc = (const bf16_t*)(ws_ + OFF_CAK) + hb * 512 * 128;
    const bf16_t* vc = (const bf16_t*)(ws_ + OFF_CAVT) + hb * 128 * 512;
    const bf16_t* kn = P + (size_t)tok0 * NIN + 512 + h * 128;
    const bf16_t* vn = (const bf16_t*)(ws_ + OFF_PT_AV) + (size_t)tok0 * 512 + (size_t)(h * 128) * 32;
    __syncthreads();
    tile_pipeline<2, 128>(smem, 24, wave, lane,
        [&](int t, const bf16_t*& kg, int& ks, const bf16_t*& vg, int& vu) {
            if (t < 8) { kg = kc + (size_t)t * 64 * 128; ks = 128; vg = vc + (size_t)(2 * t) * 128 * 32; vu = 128 * 32; }
            else { const int tt = t - 8; kg = kn + (size_t)tt * 64 * NIN; ks = NIN; vg = vn + (size_t)(2 * tt) * 512 * 32; vu = 512 * 32; }
        },
        [&](int t, const unsigned char* buf, int part) {
            const float nob[8] = {0.f, 0.f, 0.f, 0.f, 0.f, 0.f, 0.f, 0.f};
            { const int half = part;
                UnitFrags<1, 128> f;
                lds_unit_sel<128>(f, buf, 32 * half, half * TileGeom<2, 128>::VUNIT + g * 16, lr, g, msel);
                compute_unit<1, 128, false>(st, f, qf, sc, nob);
            }
        });
    const float* lamp = (const float*)(ws_ + OFF_LAM);
    const float lam = lamp[l * 2], lam_init = lamp[l * 2 + 1];
    const float inv = (msel ? lam : 1.f) / grp_sum(st.l[0]);
    float* xb = (float*)smem + (wave >> 1) * 32 * 64 + lane;
    if (msel) {
#pragma unroll
        for (int vb = 0; vb < 8; ++vb)
#pragma unroll
            for (int i = 0; i < 4; ++i) xb[(vb * 4 + i) * 64] = st.O[0][vb][i] * inv;
    }
    __syncthreads();
    if (msel) return;
    float ss = 0.f;
#pragma unroll
    for (int vb = 0; vb < 8; ++vb)
#pragma unroll
        for (int i = 0; i < 4; ++i) {
            const float o = st.O[0][vb][i] * inv - xb[(vb * 4 + i) * 64];
            st.O[0][vb][i] = o; ss += o * o;
        }
    ss = grp_sum(ss);
    const float r = rsqrtf(ss * (1.f / 128.f) + LN_EPS) * (1.f - lam_init);
    bf16_t* MIX = (bf16_t*)(ws_ + OFF_MIX) + (size_t)(tok0 + q0 + lr) * 1024 + h * 128;
    const float* gn = p.diff_norm_g + l * 128;
#pragma unroll
    for (int vb = 0; vb < 8; ++vb) {
        const int v = vb * 16 + 4 * g;
        const float4 g4 = *(const float4*)(gn + v);
        uint2 o; o.x = pack2(st.O[0][vb][0] * r * g4.x, st.O[0][vb][1] * r * g4.y);
        o.y = pack2(st.O[0][vb][2] * r * g4.z, st.O[0][vb][3] * r * g4.w);
        *(uint2*)(MIX + v) = o;
    }
}

DI void item_dense(const Params& pin, int seq, int h, int qt, unsigned char* smem, int wave, int lane) {
    const Params& p = pin; unsigned char* const ws_ = opaque_ws(pin.ws); float* const out_ = opaque_out(pin.out); lane = opaque_v(lane); wave = opaque_s(wave);
    const int lr = lane & 15, g = lane >> 4;
    const int tok0 = seq * 256;
    const bf16_t* P = (const bf16_t*)(ws_ + OFF_P);
    const int q0 = qt * 64 + wave * 16;
    bf16x8 qf[1][2];
    {
        const bf16_t* qp = P + (size_t)(tok0 + q0 + lr) * NIN + 1536 + h * 64 + 8 * g;
        qf[0][0] = *(const bf16x8*)(qp); qf[0][1] = *(const bf16x8*)(qp + 32);
    }
    AttnSt<1, 64> st;
    attn_init<1, 64>(st);
    const bf16_t* kn = P + (size_t)tok0 * NIN + 1792 + h * 64;
    const bf16_t* vn = (const bf16_t*)(ws_ + OFF_PT_BV) + (size_t)tok0 * 256 + (size_t)(h * 64) * 32;
    const float sc = 0.125f * LOG2E;
    __syncthreads();
    tile_pipeline<1, 64>(smem, 4, wave, lane,
        [&](int t, const bf16_t*& kg, int& ks, const bf16_t*& vg, int& vu) {
            kg = kn + (size_t)t * 64 * NIN; ks = NIN; vg = vn + (size_t)(2 * t) * 256 * 32; vu = 256 * 32;
        },
        [&](int t, const unsigned char* buf, int part) {
            const float nob[8] = {0.f, 0.f, 0.f, 0.f, 0.f, 0.f, 0.f, 0.f};
            { const int half = part;
                UnitFrags<1, 64> f;
                lds_unit<1, 64>(f, buf, 32 * half, half * TileGeom<1, 64>::VUNIT + g * 16, lr, g);
                compute_unit<1, 64, false>(st, f, qf, sc, nob);
            }
        });
    const float inv = 1.f / grp_sum(st.l[0]);
    bf16_t* MIX = (bf16_t*)(ws_ + OFF_MIX) + (size_t)(tok0 + q0 + lr) * 1024 + 512 + h * 64;
#pragma unroll
    for (int vb = 0; vb < 4; ++vb) {
        uint2 o; o.x = pack2(st.O[0][vb][0] * inv, st.O[0][vb][1] * inv); o.y = pack2(st.O[0][vb][2] * inv, st.O[0][vb][3] * inv);
        *(uint2*)(MIX + vb * 16 + 4 * g) = o;
    }
}

DI void item_na(const Params& pin, int l, int sb, int h, int r, unsigned char* smem, int wave, int lane) {
    const Params& p = pin; unsigned char* const ws_ = opaque_ws(pin.ws); float* const out_ = opaque_out(pin.out); lane = opaque_v(lane); wave = opaque_s(wave);
    const int lr = lane & 15, g = lane >> 4;
    const int tok0 = NCTX + sb * 1024;
    const bf16_t* P = (const bf16_t*)(ws_ + OFF_P);
    const int qc = wave * 16 + lr;
    const int q0 = r * 64 + wave * 16;
    bf16x8 qf[1][2];
    {
        const bf16_t* qp = P + (size_t)(tok0 + q0 + lr) * NIN + 1536 + h * 64 + 8 * g;
        qf[0][0] = *(const bf16x8*)(qp); qf[0][1] = *(const bf16x8*)(qp + 32);
    }
    AttnSt<1, 64> st;
    attn_init<1, 64>(st);
    const float sc = 0.125f * LOG2E;
    const size_t hb = (size_t)((sb * 4 + l) * 4 + h);
    const bf16_t* kc = (const bf16_t*)(ws_ + OFF_CBK) + hb * 512 * 64;
    const bf16_t* vc = (const bf16_t*)(ws_ + OFF_CBVT) + hb * 64 * 512;
    const bf16_t* kn = P + (size_t)tok0 * NIN + 1792 + h * 64;
    const bf16_t* vn = (const bf16_t*)(ws_ + OFF_PT_BV) + (size_t)tok0 * 256 + (size_t)(h * 64) * 32;
    const int kr0 = min(max(r - 4, 0), 8);
    const int bs = min(max(wave * 16 - 8, 0), 32);
    const int wstart = min(max(qc - 8, 0), 48);
    const float* rpb = p.nat_rpb + (size_t)(l * 4 + h) * 15 * 31;
    __syncthreads();
    tile_pipeline<1, 64>(smem, 16, wave, lane,
        [&](int t, const bf16_t*& kg, int& ks, const bf16_t*& vg, int& vu) {
            if (t < 8) { kg = kc + (size_t)t * 64 * 64; ks = 64; vg = vc + (size_t)(2 * t) * 64 * 32; vu = 64 * 32; }
            else { const int kr = kr0 + t - 8; kg = kn + (size_t)kr * 64 * NIN; ks = NIN; vg = vn + (size_t)(2 * kr) * 256 * 32; vu = 256 * 32; }
        },
        [&](int t, const unsigned char* buf, int part) {
            if (t < 8) {
                const float nob[8] = {0.f, 0.f, 0.f, 0.f, 0.f, 0.f, 0.f, 0.f};
                { const int half = part;
                    UnitFrags<1, 64> f;
                    lds_unit<1, 64>(f, buf, 32 * half, half * TileGeom<1, 64>::VUNIT + g * 16, lr, g);
                    compute_unit<1, 64, false>(st, f, qf, sc, nob);
                }
            } else if (part == 0) {
                const int kr = kr0 + t - 8;
                const int nl = bs + 8 * g;
                UnitFrags<1, 64> f;
                lds_unit<1, 64>(f, buf, bs, (nl >> 5) * TileGeom<1, 64>::VUNIT + (nl & 31) * 2, lr, g);
                float bias[8];
                const float* rrow = rpb + (kr - r + 7) * 31;
#pragma unroll
                for (int j = 0; j < 8; ++j) {
                    const int kcol = bs + 8 * g + j;
                    const bool valid = (kcol >= wstart) && (kcol < wstart + 16);
                    const int dc = min(max(kcol - qc + 15, 0), 30);
                    bias[j] = valid ? rrow[dc] * LOG2E : -INFINITY;
                }
                compute_unit<1, 64, true>(st, f, qf, sc, bias);
            }
        });
    const float inv = 1.f / grp_sum(st.l[0]);
    bf16_t* MIX = (bf16_t*)(ws_ + OFF_MIX) + (size_t)(tok0 + q0 + lr) * 1024 + 512 + h * 64;
#pragma unroll
    for (int vb = 0; vb < 4; ++vb) {
        uint2 o; o.x = pack2(st.O[0][vb][0] * inv, st.O[0][vb][1] * inv); o.y = pack2(st.O[0][vb][2] * inv, st.O[0][vb][3] * inv);
        *(uint2*)(MIX + vb * 16 + 4 * g) = o;
    }
}

DI float wave_excl_sum(float v, int lane) {
    float x = v;
#pragma unroll
    for (int d = 1; d < 64; d <<= 1) { const float y = __shfl_up(x, d); if (lane >= d) x += y; }
    return x - v;
}
DI float wave_excl_max(float v, int lane, float init) {
    float x = v;
#pragma unroll
    for (int d = 1; d < 64; d <<= 1) { const float y = __shfl_up(x, d); if (lane >= d) x = fmaxf(x, y); }
    const float ex = __shfl_up(x, 1);
    return lane == 0 ? init : fmaxf(init, ex);
}
DI void mlstm_scan(const float* __restrict__ G, int h, int nseq, int dir, float* aA, float* MA, float* FA, float m0, int lane) {
    const int per = nseq >> 6;
    float run = 0.f;
    for (int e = 0; e < per; ++e) {
        const int idx = lane * per + e, pos = dir ? nseq - 1 - idx : idx;
        const float f = G[(size_t)pos * 16 + (dir ? 12 : 4) + h];
        const float lf = fminf(f, 0.f) - __logf(1.f + __expf(-fabsf(f)));
        run += lf; FA[pos] = run;
    }
    const float off = wave_excl_sum(run, lane);
    float rmax = -INFINITY;
    for (int e = 0; e < per; ++e) {
        const int idx = lane * per + e, pos = dir ? nseq - 1 - idx : idx;
        const float F = FA[pos] + off; FA[pos] = F;
        const float a = G[(size_t)pos * 16 + (dir ? 8 : 0) + h] - F;
        aA[pos] = a; rmax = fmaxf(rmax, a); MA[pos] = rmax;
    }
    const float pre = wave_excl_max(rmax, lane, m0);
    for (int e = 0; e < per; ++e) {
        const int idx = lane * per + e, pos = dir ? nseq - 1 - idx : idx;
        MA[pos] = fmaxf(MA[pos], pre);
    }
}

DI void mlstm_unit(f32x4 (&O)[4], float& den, int dir, int t, const bf16x8 (&qf)[2], const UnitFrags<1, 64>& f, const float* aA, float Mt, int key0, int g) {
    f32x4 sa = (f32x4){0.f, 0.f, 0.f, 0.f}, sb = sa;
    sa = mfma16(f.k[0][0][0], qf[0], sa); sa = mfma16(f.k[0][0][1], qf[1], sa);
    sb = mfma16(f.k[0][1][0], qf[0], sb); sb = mfma16(f.k[0][1][1], qf[1], sb);
    const float4 a0 = *(const float4*)(aA + key0 + 8 * g), a1 = *(const float4*)(aA + key0 + 8 * g + 4);
    const float av[8] = {a0.x, a0.y, a0.z, a0.w, a1.x, a1.y, a1.z, a1.w};
    float pv[8];
#pragma unroll
    for (int j = 0; j < 8; ++j) {
        const int key = key0 + 8 * g + j;
        const bool ok = dir ? (key >= t) : (key <= t);
        const float w = ok ? fexp2((av[j] - Mt) * LOG2E) : 0.f;
        const float sv = (j < 4) ? sa[j & 3] : sb[j & 3];
        pv[j] = sv * 0.125f * w;
        den += pv[j];
    }
    const bf16x8 pk = pack8(pv[0], pv[1], pv[2], pv[3], pv[4], pv[5], pv[6], pv[7]);
#pragma unroll
    for (int vb = 0; vb < 4; ++vb) O[vb] = mfma16(f.v[vb], pk, O[vb]);
}

template <bool LAT>
DI void item_mlstm(const Params& pin, int l, int seq, int h, int qt, unsigned char* smem, int wave, int lane) {
    const Params& p = pin; unsigned char* const ws_ = opaque_ws(pin.ws); float* const out_ = opaque_out(pin.out); lane = opaque_v(lane); wave = opaque_s(wave);
    const int lr = lane & 15, g = lane >> 4;
    const int nseq = LAT ? 1024 : 256;
    const int tok0 = LAT ? NCTX + seq * 1024 : seq * 256;
    float* aF = (float*)smem; float* MF = aF + 1024; float* FF = MF + 1024;
    float* aB = FF + 1024; float* MB = aB + 1024; float* FB = MB + 1024;
    unsigned char* tiles = smem + 24576;
    const float* G = (const float*)(ws_ + OFF_G) + (size_t)tok0 * 16;
    float m0f = 0.f, m0b = 0.f;
    const int sidx_f = ((seq * 4 + l) * 2 + 0) * 4 + h, sidx_b = ((seq * 4 + l) * 2 + 1) * 4 + h;
    if (LAT) { m0f = p.state_m[sidx_f]; m0b = p.state_m[sidx_b]; }
    __syncthreads();
    if (wave == 0) mlstm_scan(G, h, nseq, 0, aF, MF, FF, m0f, lane);
    if (wave == 1) mlstm_scan(G, h, nseq, 1, aB, MB, FB, m0b, lane);
    __syncthreads();
    const bf16_t* P = (const bf16_t*)(ws_ + OFF_P);
    const int q0 = qt * 64 + wave * 16;
    const int t = q0 + lr;
    bf16x8 qf[2];
    {
        const bf16_t* qp = P + (size_t)(tok0 + t) * NIN + 2304 + h * 64 + 8 * g;
        qf[0] = *(const bf16x8*)(qp); qf[1] = *(const bf16x8*)(qp + 32);
    }
    const bf16_t* kn = P + (size_t)tok0 * NIN + 2560 + h * 64;
    const bf16_t* vn = (const bf16_t*)(ws_ + OFF_PT_CV) + (size_t)tok0 * 256 + (size_t)(h * 64) * 32;
    const float Mf = MF[t], Mb = MB[t], Ff = FF[t], Fb = FB[t];
    f32x4 Of[4], Ob[4];
#pragma unroll
    for (int vb = 0; vb < 4; ++vb) { Of[vb] = (f32x4){0.f, 0.f, 0.f, 0.f}; Ob[vb] = Of[vb]; }
    float denf = 0.f, denb = 0.f;
    tile_pipeline<1, 64>(tiles, nseq / 64, wave, lane,
        [&](int tt, const bf16_t*& kg, int& ks, const bf16_t*& vg, int& vu) {
            kg = kn + (size_t)tt * 64 * NIN; ks = NIN; vg = vn + (size_t)(2 * tt) * 256 * 32; vu = 256 * 32;
        },
        [&](int tt, const unsigned char* buf, int part) {
            { const int half = part;
                const int key0 = tt * 64 + half * 32;
                const bool dof = key0 <= q0 + 15, dob = key0 + 31 >= q0;
                if (dof || dob) {
                    UnitFrags<1, 64> f;
                    lds_unit<1, 64>(f, buf, 32 * half, half * TileGeom<1, 64>::VUNIT + g * 16, lr, g);
                    if (dof) mlstm_unit(Of, denf, 0, t, qf, f, aF, Mf, key0, g);
                    if (dob) mlstm_unit(Ob, denb, 1, t, qf, f, aB, Mb, key0, g);
                }
            }
        });
    if (LAT) {
        const bf16_t* qp2 = P + (size_t)(tok0 + t) * NIN + 2304 + h * 64 + 4 * g;
#pragma unroll
        for (int dir = 0; dir < 2; ++dir) {
            const int sidx = dir ? sidx_b : sidx_f;
            const float e = fexp2(((dir ? m0b : m0f) - (dir ? Mb : Mf)) * LOG2E) * 0.125f;
            const bf16_t* c0t = (const bf16_t*)(ws_ + OFF_C0T) + (size_t)sidx * 4096 + lr * 64 + 4 * g;
            const float* n0 = p.state_n + (size_t)sidx * 64;
            float dacc = 0.f;
#pragma unroll
            for (int u2 = 0; u2 < 2; ++u2) {
                const bf16x4 qa = *(const bf16x4*)(qp2 + u2 * 32), qb = *(const bf16x4*)(qp2 + u2 * 32 + 16);
                const float4 na = *(const float4*)(n0 + u2 * 32 + 4 * g), nb = *(const float4*)(n0 + u2 * 32 + 16 + 4 * g);
                float pv[8];
#pragma unroll
                for (int j = 0; j < 4; ++j) { pv[j] = bf2f((unsigned short)qa[j]) * e; pv[4 + j] = bf2f((unsigned short)qb[j]) * e; }
                dacc += pv[0] * na.x + pv[1] * na.y + pv[2] * na.z + pv[3] * na.w + pv[4] * nb.x + pv[5] * nb.y + pv[6] * nb.z + pv[7] * nb.w;
                const bf16x8 pk = pack8(pv[0], pv[1], pv[2], pv[3], pv[4], pv[5], pv[6], pv[7]);
#pragma unroll
                for (int vb = 0; vb < 4; ++vb) {
                    const bf16_t* cp = c0t + (size_t)vb * 16 * 64 + u2 * 32;
                    const bf16x8 cf = cat4(*(const bf16x4*)(cp), *(const bf16x4*)(cp + 16));
                    if (dir) Ob[vb] = mfma16(cf, pk, Ob[vb]); else Of[vb] = mfma16(cf, pk, Of[vb]);
                }
            }
            if (dir) denb += dacc; else denf += dacc;
        }
    }
    denf = grp_sum(denf); denb = grp_sum(denb);
    const float rf = 1.f / fmaxf(fabsf(denf), expf(-(Ff + Mf)));
    const float rb = 1.f / fmaxf(fabsf(denb), expf(-(Fb + Mb)));
    float ss = 0.f;
#pragma unroll
    for (int vb = 0; vb < 4; ++vb)
#pragma unroll
        for (int i = 0; i < 4; ++i) { const float hs = Of[vb][i] * rf + Ob[vb][i] * rb; Of[vb][i] = hs; ss += hs * hs; }
    ss = grp_sum(ss);
    const float rn = rsqrtf(ss * (1.f / 64.f) + LN_EPS);
    const float* gn = p.mlstm_norm_g + (size_t)(l * 4 + h) * 64;
    const bf16_t* op = P + (size_t)(tok0 + t) * NIN + 3072 + h * 64;
    bf16_t* MIX = (bf16_t*)(ws_ + OFF_MIX) + (size_t)(tok0 + t) * 1024 + 768 + h * 64;
#pragma unroll
    for (int vb = 0; vb < 4; ++vb) {
        const int v = vb * 16 + 4 * g;
        const float4 g4 = *(const float4*)(gn + v);
        const bf16x4 o4 = *(const bf16x4*)(op + v);
        float sg[4];
#pragma unroll
        for (int i = 0; i < 4; ++i) sg[i] = 1.f / (1.f + __expf(-bf2f((unsigned short)o4[i])));
        uint2 o; o.x = pack2(Of[vb][0] * rn * g4.x * sg[0], Of[vb][1] * rn * g4.y * sg[1]);
        o.y = pack2(Of[vb][2] * rn * g4.z * sg[2], Of[vb][3] * rn * g4.w * sg[3]);
        *(uint2*)(MIX + v) = o;
    }
}

DI void item_mlstm_state(const Params& pin, int l, int b, int h, int dir, unsigned char* smem, int wave, int lane) {
    const Params& p = pin; unsigned char* const ws_ = opaque_ws(pin.ws); float* const out_ = opaque_out(pin.out); lane = opaque_v(lane); wave = opaque_s(wave);
    const int lr = lane & 15, g = lane >> 4;
    const int tok0 = b * 256;
    float* aA = (float*)smem; float* MA = aA + 1024; float* FA = MA + 1024;
    const float* G = (const float*)(ws_ + OFF_G) + (size_t)tok0 * 16;
    __syncthreads();
    if (wave == 0) mlstm_scan(G, h, 256, dir, aA, MA, FA, 0.f, lane);
    __syncthreads();
    const float Mfin = dir ? MA[0] : MA[255];
    const float Ffin = dir ? FA[0] : FA[255];
    const bf16_t* KT = (const bf16_t*)(ws_ + OFF_PT_CK) + (size_t)tok0 * 256 + (size_t)(h * 64 + wave * 16 + lr) * 32 + 8 * g;
    const bf16_t* VT = (const bf16_t*)(ws_ + OFF_PT_CV) + (size_t)tok0 * 256 + (size_t)(h * 64 + lr) * 32 + 8 * g;
    f32x4 C[4];
#pragma unroll
    for (int vb = 0; vb < 4; ++vb) C[vb] = (f32x4){0.f, 0.f, 0.f, 0.f};
    float nacc = 0.f;
#pragma unroll 4
    for (int u = 0; u < 8; ++u) {
        const int s0 = u * 32;
        const bf16x8 kf = *(const bf16x8*)(KT + (size_t)u * 256 * 32);
        const float4 a0 = *(const float4*)(aA + s0 + 8 * g), a1 = *(const float4*)(aA + s0 + 8 * g + 4);
        const float av[8] = {a0.x, a0.y, a0.z, a0.w, a1.x, a1.y, a1.z, a1.w};
        float kw[8];
#pragma unroll
        for (int j = 0; j < 8; ++j) { kw[j] = bf2f((unsigned short)kf[j]) * fexp2((av[j] - Mfin) * LOG2E); nacc += kw[j]; }
        const bf16x8 af = pack8(kw[0], kw[1], kw[2], kw[3], kw[4], kw[5], kw[6], kw[7]);
#pragma unroll
        for (int vb = 0; vb < 4; ++vb) {
            const bf16x8 vf = *(const bf16x8*)(VT + (size_t)u * 256 * 32 + vb * 16 * 32);
            C[vb] = mfma16(af, vf, C[vb]);
        }
    }
    const size_t sidx = (size_t)((b * 4 + l) * 2 + dir) * 4 + h;
    float* oc = out_ + O_NC + sidx * 4096;
#pragma unroll
    for (int vb = 0; vb < 4; ++vb)
#pragma unroll
        for (int i = 0; i < 4; ++i) oc[(wave * 16 + 4 * g + i) * 64 + vb * 16 + lr] = C[vb][i];
    nacc = grp_sum(nacc);
    if (g == 0) out_[O_NN + sidx * 64 + wave * 16 + lr] = nacc;
    if (wave == 0 && lane == 0) out_[O_NM + sidx] = Ffin + Mfin;
}

DI void mixer_phase(const Params& p, int l, unsigned char* smem) {
    const int tid_ = opaque_v(threadIdx.x); const int lane = tid_ & 63, wave = (tid_ >> 6) & 3;
    const int half = __builtin_amdgcn_readfirstlane(tid_ >> 8);
    unsigned char* sm = smem + half * HALF_LDS;
    unsigned* ctr = (unsigned*)(p.ws + OFF_MIXCTR) + l;
    volatile unsigned* slot = (volatile unsigned*)(smem + LDS_BYTES + 16);
    for (;;) {
        __syncthreads();
        if (tid_ == 0) *slot = __hip_atomic_fetch_add(ctr, 1u, __ATOMIC_RELAXED, __HIP_MEMORY_SCOPE_AGENT);
        __syncthreads();
        const int it = __builtin_amdgcn_readfirstlane(2 * (int)*slot + half);
        if (it >= 1408) break;
        if (it < 256) { item_diffattn_lat(p, l, it >> 7, (it >> 5) & 3, it & 31, sm, wave, lane); }
        else if (it < 384) { const int i = it - 256; item_mlstm<true>(p, l, i >> 6, (i >> 4) & 3, i & 15, sm, wave, lane); }
        else if (it < 512) { const int i = it - 384; item_mlstm_state(p, l, i >> 3, (i >> 1) & 3, i & 1, sm, wave, lane); }
        else if (it < 640) { const int i = it - 512; item_na(p, l, i >> 6, (i >> 4) & 3, i & 15, sm, wave, lane); }
        else if (it < 896) { const int i = it - 640; item_diffattn<false>(p, l, i >> 4, (i >> 2) & 3, i & 3, sm, wave, lane); }
        else if (it < 1152) { const int i = it - 896; item_mlstm<false>(p, l, i >> 4, (i >> 2) & 3, i & 3, sm, wave, lane); }
        else { const int i = it - 1152; item_dense(p, i >> 4, (i >> 2) & 3, i & 3, sm, wave, lane); }
    }
}

#define XB_TMO      128
#define XB_XCNT(j)  (256  + 64 * (j))
#define XB_XSUB(j)  (1280 + 64 * (j))
#define XB_XGEN(j)  (2304 + 64 * (j))
#define XB_TOP      3328
#define XB_TOPGEN   3392
#define XCD_BAR_WORDS 3456
#define XB_SPIN_CAP (1u << 18)

__device__ __forceinline__ unsigned xb_ld(unsigned* p)              { return __hip_atomic_load(p, __ATOMIC_RELAXED, __HIP_MEMORY_SCOPE_AGENT); }
__device__ __forceinline__ unsigned xb_add(unsigned* p, unsigned v) { return __hip_atomic_fetch_add(p, v, __ATOMIC_RELAXED, __HIP_MEMORY_SCOPE_AGENT); }
__device__ __forceinline__ unsigned xb_xcc_id() { return (unsigned)__builtin_amdgcn_s_getreg((3 << 11) | 20) & 0xFu; }
#define XB_SPIN(cond, bar) do { unsigned _sp = 0; while (cond) { __builtin_amdgcn_s_sleep(1); \
    if ((++_sp & 255u) == 0u) { if (xb_ld(&(bar)[XB_TMO])) break; if (_sp > XB_SPIN_CAP) { atomicAdd(&(bar)[XB_TMO], 1u); break; } } } } while (0)

struct XcdBarrier {
    unsigned* bar; unsigned x;
    volatile LAS unsigned* st;
};

__device__ __forceinline__ XcdBarrier xcd_barrier_post(unsigned* bar, volatile LAS unsigned* st) {
    XcdBarrier b; b.bar = bar; b.x = xb_xcc_id(); b.st = st;
    if (threadIdx.x == 0) (void)xb_add(&bar[XB_XCNT(b.x)], 1u);
    return b;
}
__device__ __forceinline__ void xcd_barrier_complete(unsigned* bar, unsigned x, unsigned& nloc, unsigned& nx) {
    const unsigned G = gridDim.x * gridDim.y * gridDim.z;
    unsigned sum, cnt, mine, sp = 0u;
    for (;;) {
        sum = 0u; cnt = 0u; mine = 0u;
#pragma unroll
        for (unsigned j = 0; j < 16; ++j) { const unsigned c = xb_ld(&bar[XB_XCNT(j)]); sum += c; cnt += (c > 0u) ? 1u : 0u; mine = (j == x) ? c : mine; }
        if (sum == G) break;
        __builtin_amdgcn_s_sleep(1);
        if ((++sp & 255u) == 0u) { if (xb_ld(&bar[XB_TMO])) break; if (sp > XB_SPIN_CAP) { atomicAdd(&bar[XB_TMO], 1u); break; } }
    }
    nloc = mine > 0u ? mine : 1u; nx = cnt > 0u ? cnt : 1u;
}

__device__ __forceinline__ void xcd_barrier(const XcdBarrier& b) {
    asm volatile("s_waitcnt vmcnt(0)" ::: "memory");
    __syncthreads();
    if (threadIdx.x == 0) {
        unsigned* bar = b.bar;
        __builtin_amdgcn_s_waitcnt(0);
        unsigned nloc = b.st[0], nx = b.st[1];
        if (nloc == 0u) { xcd_barrier_complete(bar, b.x, nloc, nx); b.st[0] = nloc; b.st[1] = nx; }
        const unsigned old = xb_add(&bar[XB_XSUB(b.x)], 1u);
        const unsigned gen = old / nloc;
        if (old + 1u == (gen + 1u) * nloc) {
            __builtin_amdgcn_fence(__ATOMIC_RELEASE, "agent");
            asm volatile("s_waitcnt vmcnt(0)" ::: "memory");
            const unsigned og = xb_add(&bar[XB_TOP], 1u);
            const unsigned tg = og / nx;
            if (og + 1u == (tg + 1u) * nx) xb_add(&bar[XB_TOPGEN], 1u);
            else XB_SPIN(xb_ld(&bar[XB_TOPGEN]) == tg, bar);
            __builtin_amdgcn_fence(__ATOMIC_ACQUIRE, "agent");
            xb_add(&bar[XB_XGEN(b.x)], 1u);
            asm volatile("s_waitcnt vmcnt(0)" ::: "memory");
        } else {
            XB_SPIN(xb_ld(&bar[XB_XGEN(b.x)]) == gen, bar);
            __builtin_amdgcn_fence(__ATOMIC_ACQUIRE, "agent");
            asm volatile("s_waitcnt vmcnt(0)" ::: "memory");
        }
    }
    __syncthreads();
}


constexpr int N_PHASES = 2 + 5 * 4;

__global__ void __launch_bounds__(512, 2) fwd_kernel(Params p) {
    __shared__ __attribute__((aligned(16))) unsigned char smem[LDS_BYTES + 32];
    if (threadIdx.x == 0) *(uint4*)(smem + LDS_BYTES) = make_uint4(0u, 0u, 0u, 0u);
    __syncthreads();
    XcdBarrier xb = xcd_barrier_post((unsigned*)(p.ws + OFF_BAR), (volatile LAS unsigned*)(smem + LDS_BYTES));
    for (int ph = p.ph_lo; ph < p.ph_hi; ++ph) {
        if (ph > p.ph_lo) {
            if (p.ph_hi > 1000) cg::this_grid().sync();
            xcd_barrier(xb);
        }
        const int l = ph < 2 ? 0 : (ph - 2) / 5, s = ph < 2 ? ph - 2 : (ph - 2) % 5;
        const int bit = 1 << (s + 2);
        const int reps = (DUPM & bit) ? 2 : 1;
        for (int rep = 0; rep < reps; ++rep) {
            if (rep) __syncthreads();
            if (s == -2) prep0(p, smem + __builtin_amdgcn_readfirstlane(threadIdx.x >> 8) * HALF_LDS);
            else if (s == -1) prep1(p);
            else if (s == 0) gemm_phase<EPI_INPROJ>(p, l, OFF_H, OFF_WT_IN + (size_t)l * NINP * DM * 2, NINP / 128, 1024, 0, smem);
            else if (s == 1) mixer_phase(p, l, smem);
            else if (s == 2) gemm_phase<EPI_LN1>(p, l, OFF_MIX, OFF_WT_OUT + (size_t)l * DM * DM * 2, 8, 1024, 1024, smem);
            else if (s == 3) gemm_phase<EPI_RELU2>(p, l, OFF_H, OFF_WT_1 + (size_t)l * DFF * DM * 2, 32, 1024, 4096, smem);
            else gemm_phase<EPI_LN2>(p, l, OFF_U, OFF_WT_2 + (size_t)l * DM * DFF * 2, 8, 4096, 1024, smem);
        }
    }
}

extern "C" void kernel_launch(void* const* d_in, const int* in_sizes, int n_in, void* d_out, int out_size, void* d_ws, size_t ws_size,
                              hipStream_t stream) {
    static int grid = 0;
    if (grid == 0) {
        if (n_in != 26 || ws_size < WS_END) { fprintf(stderr, "kernel_launch: unexpected n_in %d / ws %zu (need %zu)\n", n_in, ws_size, (size_t)WS_END); grid = -1; return; }
        int dev = 0, cus = 0, per_cu = 0;
        hipGetDevice(&dev);
        hipDeviceGetAttribute(&cus, hipDeviceAttributeMultiprocessorCount, dev);
        hipOccupancyMaxActiveBlocksPerMultiprocessor(&per_cu, (const void*)fwd_kernel, 512, 0);
        (void)per_cu;
        grid = cus;
        if (grid < 192) { fprintf(stderr, "kernel_launch: grid %d < 192 resident workgroups needed by the fused LayerNorm exchange\n", grid); grid = -1; return; }
    }
    if (grid < 0) return;
    Params p{};
    const float** pp = (const float**)&p;
    for (int i = 0; i < 26; ++i) pp[i] = (const float*)d_in[i];
    p.out = (float*)d_out; p.ws = (unsigned char*)d_ws;
    (void)hipMemsetAsync((unsigned char*)d_ws + OFF_BAR, 0, 16384, stream);
#if SINGLE_LAUNCH
    p.ph_lo = 0; p.ph_hi = N_PHASES;
    void* args[] = {&p};
    hipError_t e = hipLaunchCooperativeKernel((const void*)fwd_kernel, dim3(grid), dim3(512), args, 0, stream);
    if (e != hipSuccess) fprintf(stderr, "cooperative launch failed: %s (grid %d)\n", hipGetErrorString(e), grid);
#else
    for (int ph = 0; ph < N_PHASES; ++ph) {
        p.ph_lo = ph; p.ph_hi = ph + 1;
        void* args[] = {&p};
        hipError_t e = hipLaunchCooperativeKernel((const void*)fwd_kernel, dim3(grid), dim3(512), args, 0, stream);
        if (e != hipSuccess) { fprintf(stderr, "launch %d failed: %s (grid %d)\n", ph, hipGetErrorString(e), grid); break; }
    }
#endif
}
```

```cpp
#include <hip/hip_runtime.h>
#include <hip/hip_cooperative_groups.h>
#include <cstdio>
namespace cg = cooperative_groups;

#ifndef IM
#define IM 0xffff
#endif
#ifndef IM
#define IM 0xffff
#endif
#ifndef DUPM
#define DUPM 0
#endif
#ifndef PHM
#define PHM 0xffff
#endif
#ifndef SINGLE_LAUNCH
#define SINGLE_LAUNCH 1
#endif

#define LAS __attribute__((address_space(3)))
typedef unsigned short bf16_t;
typedef __attribute__((ext_vector_type(8))) short bf16x8;
typedef __attribute__((ext_vector_type(4))) short bf16x4;
typedef __attribute__((ext_vector_type(4))) float f32x4;
#define DI __device__ __forceinline__

constexpr int NTOK = 6144, NCTX = 4096, DM = 1024, NIN = 3344, NINP = 3456, DFF = 4096;
constexpr float ALPHA = 1.681792830507429f;
constexpr float LOG2E = 1.4426950408889634f;
constexpr float LN_EPS = 1e-5f;

constexpr size_t al256(size_t x) { return (x + 255) & ~(size_t)255; }
constexpr size_t OFF_WT_IN = 0;
constexpr size_t OFF_WT_OUT = OFF_WT_IN + al256((size_t)4 * NINP * DM * 2);
constexpr size_t OFF_WT_1 = OFF_WT_OUT + al256((size_t)4 * DM * DM * 2);
constexpr size_t OFF_WT_2 = OFF_WT_1 + al256((size_t)4 * DFF * DM * 2);
constexpr size_t OFF_MOD = OFF_WT_2 + al256((size_t)4 * DFF * DM * 2);
constexpr size_t OFF_X = OFF_MOD + al256((size_t)4 * 3 * 6144 * 4);
constexpr size_t OFF_H = OFF_X + al256((size_t)NTOK * DM * 4);
constexpr size_t OFF_P = OFF_H + al256((size_t)NTOK * DM * 2);
constexpr size_t OFF_PT_AV = OFF_P + al256((size_t)NTOK * NIN * 2);
constexpr size_t OFF_PT_BV = OFF_PT_AV + al256((size_t)NTOK * 512 * 2);
constexpr size_t OFF_PT_CV = OFF_PT_BV + al256((size_t)NTOK * 256 * 2);
constexpr size_t OFF_PT_CK = OFF_PT_CV + al256((size_t)NTOK * 256 * 2);
constexpr size_t OFF_G = OFF_PT_CK + al256((size_t)NTOK * 256 * 2);
constexpr size_t OFF_MIX = OFF_G + al256((size_t)NTOK * 16 * 4);
constexpr size_t OFF_Y = OFF_MIX + al256((size_t)NTOK * DM * 2);
constexpr size_t OFF_U = OFF_Y + al256((size_t)NTOK * DM * 4);
constexpr size_t OFF_CAK = OFF_U + al256((size_t)NTOK * DFF * 2);
constexpr size_t OFF_CAVT = OFF_CAK + al256((size_t)32 * 512 * 128 * 2);
constexpr size_t OFF_CBK = OFF_CAVT + al256((size_t)32 * 512 * 128 * 2);
constexpr size_t OFF_CBVT = OFF_CBK + al256((size_t)32 * 512 * 64 * 2);
constexpr size_t OFF_C0T = OFF_CBVT + al256((size_t)32 * 512 * 64 * 2);
constexpr size_t OFF_ROPE = OFF_C0T + al256((size_t)64 * 64 * 64 * 2);
constexpr size_t OFF_LAM = OFF_ROPE + al256((size_t)2 * 1024 * 4);
constexpr size_t OFF_BAR = OFF_LAM + 256;
constexpr size_t OFF_LNCNT = OFF_BAR + 13824;
constexpr size_t OFF_MIXCTR = OFF_BAR + 15360;
constexpr size_t OFF_STATS = OFF_BAR + 16384;
constexpr size_t WS_END = OFF_STATS + (size_t)NTOK * 16 * 8;

constexpr size_t O_YP = 0, O_YS = 4194304, O_AK = 6291456, O_AV = 14680064, O_BK = 23068672, O_BV = 27262976,
                 O_NC = 31457280, O_NN = 33554432, O_NM = 33587200;

struct Params {
    const float* x_prompt; const float* x_sample; const float* cache_a_k; const float* cache_a_v;
    const float* cache_b_k; const float* cache_b_v; const float* state_c; const float* state_n;
    const float* state_m; const float* c; const float* c_ctx; const float* w_in; const float* gate_bias;
    const float* diff_lambda; const float* diff_norm_g; const float* nat_rpb; const float* mlstm_norm_g;
    const float* w_out; const float* ada_w; const float* ada_b; const float* ln1_g; const float* ln1_b;
    const float* ln2_g; const float* ln2_b; const float* w_mlp1; const float* w_mlp2;
    float* out; unsigned char* ws; int ph_lo; int ph_hi;
};

#define VBID ((int)(blockIdx.x * 2 + __builtin_amdgcn_readfirstlane(threadIdx.x >> 8)))
#define VGRID ((int)(gridDim.x * 2))
#define VTID ((int)(threadIdx.x & 255))
constexpr int HALF_LDS = 73728;
constexpr int LDS_BYTES = 2 * HALF_LDS;
DI int opaque_v(int x) { asm volatile("" : "+v"(x)); return x; }
DI int opaque_s(int x) { x = __builtin_amdgcn_readfirstlane(x); asm volatile("" : "+s"(x)); return x; }
DI size_t opaque_zero() { size_t z = 0; asm volatile("" : "+s"(z)); return z; }
DI unsigned char* opaque_ws(unsigned char* w) { return w + opaque_zero(); }
DI float* opaque_out(float* w) { return w + opaque_zero(); }
DI unsigned short f2bf(float x) { unsigned u = __float_as_uint(x); u += 0x7fffu + ((u >> 16) & 1u); return (unsigned short)(u >> 16); }
DI float bf2f(unsigned short h) { return __uint_as_float(((unsigned)h) << 16); }
DI unsigned pack2(float a, float b) { return (unsigned)f2bf(a) | ((unsigned)f2bf(b) << 16); }
DI f32x4 mfma16(bf16x8 a, bf16x8 b, f32x4 c) { return __builtin_amdgcn_mfma_f32_16x16x32_bf16(a, b, c, 0, 0, 0); }
DI float fexp2(float x) { return __builtin_amdgcn_exp2f(x); }
DI bf16x8 pack8(float a0, float a1, float a2, float a3, float a4, float a5, float a6, float a7) {
    uint4 u;
    asm volatile("s_nop 1\n\tv_cvt_pk_bf16_f32 %0, %4, %5\n\tv_cvt_pk_bf16_f32 %1, %6, %7\n\tv_cvt_pk_bf16_f32 %2, %8, %9\n\tv_cvt_pk_bf16_f32 %3, %10, %11\n\ts_nop 1"
                 : "=&v"(u.x), "=&v"(u.y), "=&v"(u.z), "=&v"(u.w)
                 : "v"(a0), "v"(a1), "v"(a2), "v"(a3), "v"(a4), "v"(a5), "v"(a6), "v"(a7));
    return __builtin_bit_cast(bf16x8, u);
}
DI bf16x8 cat4(bf16x4 a, bf16x4 b) { return __builtin_shufflevector(a, b, 0, 1, 2, 3, 4, 5, 6, 7); }
DI float wave_sum(float v) {
#pragma unroll
    for (int o = 32; o > 0; o >>= 1) v += __shfl_xor(v, o);
    return v;
}
DI float grp_sum(float v) {
    auto r = __builtin_amdgcn_permlane16_swap(__float_as_uint(v), __float_as_uint(v), false, false);
    v = __uint_as_float(r[0]) + __uint_as_float(r[1]);
    auto q = __builtin_amdgcn_permlane32_swap(__float_as_uint(v), __float_as_uint(v), false, false);
    return __uint_as_float(q[0]) + __uint_as_float(q[1]);
}
DI float grp_max(float v) {
    auto r = __builtin_amdgcn_permlane16_swap(__float_as_uint(v), __float_as_uint(v), false, false);
    v = fmaxf(__uint_as_float(r[0]), __uint_as_float(r[1]));
    auto q = __builtin_amdgcn_permlane32_swap(__float_as_uint(v), __float_as_uint(v), false, false);
    return fmaxf(__uint_as_float(q[0]), __uint_as_float(q[1]));
}

DI void transpose_job(const float* __restrict__ src, bf16_t* __restrict__ dst, int R, int C, int Cpad, int nmat, float* tile, bool blocked = false,
                      int vb = -1, int vg = 0) {
    if (vb < 0) { vb = VBID; vg = VGRID; }
    const int tid = VTID;
    const int rt = R >> 6, ct = Cpad >> 6, per = rt * ct, total = per * nmat;
    for (int it = vb; it < total; it += vg) {
        const int mat = it / per, rem = it - mat * per;
        const int r0 = (rem / ct) << 6, c0 = (rem % ct) << 6;
        const float* s = src + (size_t)mat * R * C;
        bf16_t* d = dst + (size_t)mat * Cpad * R;
#pragma unroll
        for (int i = 0; i < 4; ++i) {
            const int r = (tid >> 4) + 16 * i, c = (tid & 15) * 4;
            float4 v = make_float4(0.f, 0.f, 0.f, 0.f);
            if (c0 + c < C) v = *(const float4*)(s + (size_t)(r0 + r) * C + c0 + c);
            tile[r * 65 + c + 0] = v.x; tile[r * 65 + c + 1] = v.y; tile[r * 65 + c + 2] = v.z; tile[r * 65 + c + 3] = v.w;
        }
        __syncthreads();
        {
            const int c = tid >> 2, rs = (tid & 3) * 16;
            uint4 o0, o1;
            o0.x = pack2(tile[(rs + 0) * 65 + c], tile[(rs + 1) * 65 + c]);
            o0.y = pack2(tile[(rs + 2) * 65 + c], tile[(rs + 3) * 65 + c]);
            o0.z = pack2(tile[(rs + 4) * 65 + c], tile[(rs + 5) * 65 + c]);
            o0.w = pack2(tile[(rs + 6) * 65 + c], tile[(rs + 7) * 65 + c]);
            o1.x = pack2(tile[(rs + 8) * 65 + c], tile[(rs + 9) * 65 + c]);
            o1.y = pack2(tile[(rs + 10) * 65 + c], tile[(rs + 11) * 65 + c]);
            o1.z = pack2(tile[(rs + 12) * 65 + c], tile[(rs + 13) * 65 + c]);
            o1.w = pack2(tile[(rs + 14) * 65 + c], tile[(rs + 15) * 65 + c]);
            uint4* dp = blocked ? (uint4*)(d + ((size_t)((r0 + rs) >> 5) * Cpad + (c0 + c)) * 32 + ((r0 + rs) & 31))
                                : (uint4*)(d + (size_t)(c0 + c) * R + r0 + rs);
            dp[0] = o0; dp[1] = o1;
        }
        __syncthreads();
    }
}

DI void convert_job(const float* __restrict__ src, bf16_t* __restrict__ dst, size_t n) {
    for (size_t i = ((size_t)VBID * 256 + VTID) * 8; i < n; i += (size_t)VGRID * 256 * 8) {
        const float4 a = *(const float4*)(src + i), b = *(const float4*)(src + i + 4);
        uint4 o; o.x = pack2(a.x, a.y); o.y = pack2(a.z, a.w); o.z = pack2(b.x, b.y); o.w = pack2(b.z, b.w);
        *(uint4*)(dst + i) = o;
    }
}

DI void prep0(const Params& pin, unsigned char* smem) {
    const Params& p = pin; unsigned char* const ws_ = opaque_ws(pin.ws); float* const out_ = opaque_out(pin.out); const int tid = opaque_v(VTID);
    {
        float* sl = (float*)smem; float* red = (float*)(smem + 12288);
        for (int i = tid; i < 3072; i += 256) {
            const int cnd = i >> 10, k = i & 1023;
            const float v = (cnd == 0) ? p.c_ctx[k] : p.c[(cnd - 1) * 1024 + k];
            sl[i] = v / (1.f + __expf(-v));
        }
        __syncthreads();
        float* mod = (float*)(ws_ + OFF_MOD);
        const int kg = tid >> 4, cl = tid & 15;
        for (int it = VBID; it < 384; it += VGRID) {
            const int l = it / 96, j0 = (it % 96) * 64;
            const float* w = p.ada_w + (size_t)l * 1024 * 6144 + j0 + cl * 4;
            float4 a0 = make_float4(0, 0, 0, 0), a1 = a0, a2 = a0;
#pragma unroll 8
            for (int kk = 0; kk < 64; ++kk) {
                const int k = kg * 64 + kk;
                const float4 wv = *(const float4*)(w + (size_t)k * 6144);
                const float s0 = sl[k], s1 = sl[1024 + k], s2 = sl[2048 + k];
                a0.x += s0 * wv.x; a0.y += s0 * wv.y; a0.z += s0 * wv.z; a0.w += s0 * wv.w;
                a1.x += s1 * wv.x; a1.y += s1 * wv.y; a1.z += s1 * wv.z; a1.w += s1 * wv.w;
                a2.x += s2 * wv.x; a2.y += s2 * wv.y; a2.z += s2 * wv.z; a2.w += s2 * wv.w;
            }
            __syncthreads();
            float* r = red + kg * 192 + cl * 4;
            r[0] = a0.x; r[1] = a0.y; r[2] = a0.z; r[3] = a0.w;
            r[64] = a1.x; r[65] = a1.y; r[66] = a1.z; r[67] = a1.w;
            r[128] = a2.x; r[129] = a2.y; r[130] = a2.z; r[131] = a2.w;
            __syncthreads();
            if (tid < 192) {
                const int cnd = tid >> 6, col = tid & 63;
                float s = 0.f;
#pragma unroll
                for (int q = 0; q < 16; ++q) s += red[q * 192 + tid];
                mod[(l * 3 + cnd) * 6144 + j0 + col] = s + p.ada_b[l * 6144 + j0 + col];
            }
        }
        __syncthreads();
    }
    if (VBID == VGRID - 1) {
        float* rope = (float*)(ws_ + OFF_ROPE);
        for (int i = tid; i < 1024; i += 256) {
            const int pos = i >> 4, j = i & 15;
            const float freq = powf(10000.f, -(float)j / 16.f);
            float s, c; sincosf((float)pos * freq, &s, &c);
            rope[i] = c; rope[1024 + i] = s;
        }
        if (tid < 4) {
            const float* lp = p.diff_lambda + tid * 256;
            float s1 = 0.f, s2 = 0.f;
            for (int i = 0; i < 64; ++i) { s1 += lp[i] * lp[64 + i]; s2 += lp[128 + i] * lp[192 + i]; }
            const float li = 0.8f - 0.6f * expf(-0.3f * (float)tid);
            float* lam = (float*)(ws_ + OFF_LAM);
            lam[tid * 2] = expf(s1) - expf(s2) + li; lam[tid * 2 + 1] = li;
        }
    }
    float* tile = (float*)smem;
    transpose_job(p.w_in, (bf16_t*)(ws_ + OFF_WT_IN), 1024, NIN, NINP, 1, tile);
    transpose_job(p.w_out, (bf16_t*)(ws_ + OFF_WT_OUT), 1024, 1024, 1024, 1, tile);
    transpose_job(p.w_mlp1, (bf16_t*)(ws_ + OFF_WT_1), 1024, 4096, 4096, 1, tile);
    transpose_job(p.w_mlp2, (bf16_t*)(ws_ + OFF_WT_2), 4096, 1024, 1024, 1, tile);
    transpose_job(p.cache_a_v, (bf16_t*)(ws_ + OFF_CAVT), 512, 128, 128, 32, tile, true);
    transpose_job(p.cache_b_v, (bf16_t*)(ws_ + OFF_CBVT), 512, 64, 64, 32, tile, true);
    transpose_job(p.state_c, (bf16_t*)(ws_ + OFF_C0T), 64, 64, 64, 64, tile);
    convert_job(p.cache_a_k, (bf16_t*)(ws_ + OFF_CAK), (size_t)32 * 512 * 128);
    convert_job(p.cache_b_k, (bf16_t*)(ws_ + OFF_CBK), (size_t)32 * 512 * 64);
}

DI void prep1(const Params& pin) {
    const Params& p = pin; unsigned char* const ws_ = opaque_ws(pin.ws); float* const out_ = opaque_out(pin.out); const int tid_ = opaque_v(threadIdx.x); const int lane = tid_ & 63, wave = tid_ >> 6;
    const float* mod = (const float*)(ws_ + OFF_MOD);
    float* X = (float*)(ws_ + OFF_X);
    bf16_t* H = (bf16_t*)(ws_ + OFF_H);
    for (int row = blockIdx.x * 8 + wave; row < NTOK; row += gridDim.x * 8) {
        const float* src = row < NCTX ? p.x_prompt + (size_t)row * 1024 : p.x_sample + (size_t)(row - NCTX) * 1024;
        const int cnd = row < NCTX ? 0 : 1 + ((row - NCTX) >> 10);
        const float* md = mod + (size_t)cnd * 6144;
#pragma unroll
        for (int j = 0; j < 4; ++j) {
            const int c = lane * 4 + 256 * j;
            const float4 v = *(const float4*)(src + c);
            *(float4*)(X + (size_t)row * 1024 + c) = v;
            const float4 sh = *(const float4*)(md + c), sc = *(const float4*)(md + 1024 + c);
            uint2 o; o.x = pack2(v.x * (1.f + sc.x) + sh.x, v.y * (1.f + sc.y) + sh.y);
            o.y = pack2(v.z * (1.f + sc.z) + sh.z, v.w * (1.f + sc.w) + sh.w);
            *(uint2*)(H + (size_t)row * 1024 + c) = o;
        }
    }
}

enum { EPI_INPROJ = 0, EPI_LN1 = 1, EPI_RELU2 = 2, EPI_LN2 = 3 };

DI void epi_inproj(const Params& p, unsigned char* ws_, float* out_, int layer, const float* T, int rowbase, int colbase, int lane) {
    if (colbase >= NIN) return;
    bf16_t* P = (bf16_t*)(ws_ + OFF_P);
    const bool latent = rowbase >= NCTX;
    const int seq_tok0 = latent ? (NCTX + ((rowbase - NCTX) & ~1023)) : (rowbase & ~255);
    const int nseq = latent ? 1024 : 256;
    const int bctx = seq_tok0 >> 8;
    const int n0 = rowbase - seq_tok0;
    if (colbase >= 3328) {
        float* G = (float*)(ws_ + OFF_G);
        const float bias = p.gate_bias[layer * 16 + (lane & 15)];
        for (int rr = 0; rr < 16; ++rr) {
            const int r = rr * 4 + (lane >> 4);
            G[(size_t)(rowbase + r) * 16 + (lane & 15)] = T[r * 65 + (lane & 15)] + bias;
        }
        return;
    }
    bool toP = false, rope = false, toT = false, toO = false;
    size_t toff = 0, obase = 0; int tW = 0, tcr = 0, ohd = 64, ocr = 0;
    if (colbase < 1024) { toP = true; rope = latent; if (colbase >= 512) { toO = !latent; obase = O_AK; ohd = 128; ocr = colbase - 512; } }
    else if (colbase < 1536) { toT = true; toff = OFF_PT_AV; tW = 512; tcr = colbase - 1024; toO = !latent; obase = O_AV; ohd = 128; ocr = tcr; }
    else if (colbase < 1792) { toP = true; }
    else if (colbase < 2048) { toP = true; toO = !latent; obase = O_BK; ohd = 64; ocr = colbase - 1792; }
    else if (colbase < 2304) { toT = true; toff = OFF_PT_BV; tW = 256; tcr = colbase - 2048; toO = !latent; obase = O_BV; ohd = 64; ocr = tcr; }
    else if (colbase < 2560) { toP = true; }
    else if (colbase < 2816) { toP = true; toT = true; toff = OFF_PT_CK; tW = 256; tcr = colbase - 2560; }
    else if (colbase < 3072) { toT = true; toff = OFF_PT_CV; tW = 256; tcr = colbase - 2816; }
    else { toP = true; }
    if (toO) {
        const int h = ocr / ohd, w = ocr - h * ohd + lane;
        float* O = out_ + obase + (((size_t)(bctx * 4 + layer) * 4 + h) * 256 + n0) * ohd + w;
#pragma unroll 4
        for (int r = 0; r < 64; ++r) O[(size_t)r * ohd] = T[r * 65 + lane];
    }
    if (toP) {
        bf16_t* Pp = P + (size_t)rowbase * NIN + colbase + lane;
        if (rope) {
            const float* rc = (const float*)(ws_ + OFF_ROPE);
            const float* rs = rc + 1024;
#pragma unroll 4
            for (int r = 0; r < 64; ++r) {
                const float v = T[r * 65 + lane], vp = T[r * 65 + (lane ^ 16)];
                const int t = n0 + r;
                const int pos = (lane < 32) ? (t >> 6) : (t & 63);
                const float c = rc[pos * 16 + (lane & 15)], sn = rs[pos * 16 + (lane & 15)];
                const float o = (lane & 16) ? (vp * sn + v * c) : (v * c - vp * sn);
                Pp[(size_t)r * NIN] = f2bf(o);
            }
        } else {
#pragma unroll 4
            for (int r = 0; r < 64; ++r) Pp[(size_t)r * NIN] = f2bf(T[r * 65 + lane]);
        }
    }
    if (toT) {
        const int n = n0 + lane;
        bf16_t* Tp = (bf16_t*)(ws_ + toff) + (size_t)seq_tok0 * tW + ((size_t)(n >> 5) * tW + tcr) * 32 + (n & 31);
#pragma unroll 4
        for (int c = 0; c < 64; ++c) Tp[(size_t)c * 32] = f2bf(T[lane * 65 + c]);
    }
}

template <int WHICH>
DI void epi_ln(const Params& p, unsigned char* ws_, float* out_, int l, float* T, int tm, int tn, int wn, int rowbase, int colbase, int lane, int tid) {
    const float* mod = (const float*)(ws_ + OFF_MOD);
    float* X = (float*)(ws_ + OFF_X);
    bf16_t* H = (bf16_t*)(ws_ + OFF_H);
    const int cnd = rowbase < NCTX ? 0 : 1 + ((rowbase - NCTX) >> 10);
    const float* md = mod + (size_t)(l * 3 + cnd) * 6144;
    const int col = colbase + lane;
    const bool last = (WHICH == 2 && l == 3);
    float s1 = 0.f, s2 = 0.f;
#pragma unroll 8
    for (int c = 0; c < 64; ++c) { const float v = T[lane * 65 + c]; s1 += v; s2 += v * v; }
    unsigned long long* stats = (unsigned long long*)(ws_ + OFF_STATS);
    __hip_atomic_store(stats + (size_t)(rowbase + lane) * 16 + tn * 2 + wn,
                       ((unsigned long long)__float_as_uint(s2) << 32) | (unsigned long long)__float_as_uint(s1), __ATOMIC_RELAXED, __HIP_MEMORY_SCOPE_AGENT);
    unsigned* cnt = (unsigned*)(ws_ + OFF_LNCNT) + (l * 2 + (WHICH - 1)) * 48 + tm;
    asm volatile("s_waitcnt vmcnt(0)" ::: "memory");
    __syncthreads();
    if (tid == 0) {
        (void)__hip_atomic_fetch_add(cnt, 1u, __ATOMIC_RELAXED, __HIP_MEMORY_SCOPE_AGENT);
        unsigned sp = 0;
        while (__hip_atomic_load(cnt, __ATOMIC_RELAXED, __HIP_MEMORY_SCOPE_AGENT) < 8u) { __builtin_amdgcn_s_sleep(1); if (++sp > (1u << 22)) break; }
    }
    __syncthreads();
    float t1 = 0.f, t2 = 0.f;
    {
        unsigned long long* sp8 = stats + (size_t)(rowbase + lane) * 16;
        unsigned long long a[16];
#pragma unroll
        for (int q = 0; q < 16; ++q) a[q] = __hip_atomic_load(sp8 + q, __ATOMIC_RELAXED, __HIP_MEMORY_SCOPE_AGENT);
#pragma unroll
        for (int q = 0; q < 16; ++q) { t1 += __uint_as_float((unsigned)a[q]); t2 += __uint_as_float((unsigned)(a[q] >> 32)); }
    }
    const float mu = t1 * (1.f / 1024.f);
    const float rstd = rsqrtf(fmaxf(t2 * (1.f / 1024.f) - mu * mu, 0.f) + LN_EPS);
    const float lng = (WHICH == 1 ? p.ln1_g : p.ln2_g)[l * 1024 + col], lnb = (WHICH == 1 ? p.ln1_b : p.ln2_b)[l * 1024 + col];
    if (last) {
        float* op = out_ + (size_t)rowbase * 1024 + col;
#pragma unroll 8
        for (int r = 0; r < 64; ++r) op[(size_t)r * 1024] = (T[r * 65 + lane] - __shfl(mu, r)) * __shfl(rstd, r) * lng + lnb;
    } else {
        const float* nmd = (WHICH == 1) ? md : mod + (size_t)((l + 1) * 3 + cnd) * 6144;
        const float sh = nmd[(WHICH == 1 ? 3072 : 0) + col], sc1p = 1.f + nmd[(WHICH == 1 ? 4096 : 1024) + col];
        float* xp = X + (size_t)rowbase * 1024 + col;
        bf16_t* hp = H + (size_t)rowbase * 1024 + col;
#pragma unroll 8
        for (int r = 0; r < 64; ++r) {
            const float o = (T[r * 65 + lane] - __shfl(mu, r)) * __shfl(rstd, r) * lng + lnb;
            xp[(size_t)r * 1024] = o;
            hp[(size_t)r * 1024] = f2bf(o * sc1p + sh);
        }
    }
}

template <int EPI>
DI void gemm_phase(const Params& pin, int layer, size_t offA, size_t offB, int ntn, int K, int ldc,
                   unsigned char* smem) {
    const Params& p = pin; unsigned char* const ws_ = opaque_ws(pin.ws); float* const out_ = opaque_out(pin.out); const int tid = opaque_v(threadIdx.x), lane = tid & 63, wave = opaque_s(tid >> 6);
    const bf16_t* __restrict__ A = (const bf16_t*)(ws_ + offA); const bf16_t* __restrict__ Bt = (const bf16_t*)(ws_ + offB);
    const int wm = wave >> 1, wn = wave & 1;
    const int lr = lane & 15, g = lane >> 4;
    const int ntm = NTOK / 256;
    const int ntiles = ntm * ntn, nk = K >> 6;
    constexpr int STAGE = 49152;
    bool prefetched = false;
    for (int tile = blockIdx.x; tile < ntiles; tile += gridDim.x) {
        const int tm = tile % ntm, tn = tile / ntm;
        const int m0 = tm * 256, n0 = tn * 128;
        f32x4 acc[4][4];
#pragma unroll
        for (int mi = 0; mi < 4; ++mi)
#pragma unroll
            for (int ni = 0; ni < 4; ++ni) acc[mi][ni] = (f32x4){0.f, 0.f, 0.f, 0.f};
        const bf16_t* Ag = A + (size_t)m0 * K;
        const bf16_t* Bg = Bt + (size_t)n0 * K;
        const bf16_t* ag = Ag + (size_t)(wave * 32 + (lane >> 3)) * K + (((lane & 7) ^ (lane >> 3)) << 3);
        const bf16_t* bg = Bg + (size_t)(wave * 16 + (lane >> 3)) * K + (((lane & 7) ^ (lane >> 3)) << 3);
        auto stage_from = [&](const bf16_t* ap, const bf16_t* bp, int t) {
            unsigned char* dst = smem + (t % 3) * STAGE;
            const int k0 = t << 6;
#pragma unroll
            for (int j = 0; j < 4; ++j)
                __builtin_amdgcn_global_load_lds((const unsigned*)(ap + (size_t)j * 8 * K + k0), (LAS unsigned*)(dst + (wave * 4 + j) * 1024), 16, 0, 0);
#pragma unroll
            for (int j = 0; j < 2; ++j)
                __builtin_amdgcn_global_load_lds((const unsigned*)(bp + (size_t)j * 8 * K + k0), (LAS unsigned*)(dst + 32768 + (wave * 2 + j) * 1024), 16, 0, 0);
        };
        auto stage = [&](int t) { stage_from(ag, bg, t); };
        auto read_half = [&](int t, int kk, bf16x8 (&af)[4], bf16x8 (&bfr)[4]) {
            const unsigned char* cur = smem + (t % 3) * STAGE;
#pragma unroll
            for (int mi = 0; mi < 4; ++mi) {
                const int row = wm * 64 + mi * 16 + lr;
                af[mi] = *(const bf16x8*)(cur + row * 128 + (((kk * 4 + g) ^ (row & 7)) << 4));
            }
#pragma unroll
            for (int ni = 0; ni < 4; ++ni) {
                const int row = wn * 64 + ni * 16 + lr;
                bfr[ni] = *(const bf16x8*)(cur + 32768 + row * 128 + (((kk * 4 + g) ^ (row & 7)) << 4));
            }
        };
        if (!prefetched) { stage(0); stage(1); stage(2); }
        bf16x8 a0[4], b0[4], a1[4], b1[4];
        asm volatile("s_waitcnt vmcnt(12)" ::: "memory");
        asm volatile("s_waitcnt lgkmcnt(0)" ::: "memory");
        __builtin_amdgcn_s_barrier();
        read_half(0, 0, a0, b0);
        for (int kt = 0; kt < nk; ++kt) {
            read_half(kt, 1, a1, b1);
#pragma unroll
            for (int mi = 0; mi < 4; ++mi)
#pragma unroll
                for (int ni = 0; ni < 4; ++ni) acc[mi][ni] = mfma16(a0[mi], b0[ni], acc[mi][ni]);
            __builtin_amdgcn_sched_barrier(0);
            if (kt + 2 < nk) asm volatile("s_waitcnt vmcnt(6)" ::: "memory");
            else asm volatile("s_waitcnt vmcnt(0)" ::: "memory");
            asm volatile("s_waitcnt lgkmcnt(0)" ::: "memory");
            __builtin_amdgcn_s_barrier();
            if (kt + 1 < nk) read_half(kt + 1, 0, a0, b0);
            if (kt + 3 < nk) stage(kt + 3);
#pragma unroll
            for (int mi = 0; mi < 4; ++mi)
#pragma unroll
                for (int ni = 0; ni < 4; ++ni) acc[mi][ni] = mfma16(a1[mi], b1[ni], acc[mi][ni]);
            __builtin_amdgcn_sched_barrier(0);
        }
        asm volatile("s_waitcnt lgkmcnt(0)" ::: "memory");
        __builtin_amdgcn_s_barrier();
        if (EPI == EPI_RELU2) {
            const int ntile = tile + (int)gridDim.x;
            prefetched = ntile < ntiles;
            if (prefetched) {
                const int tm2 = ntile % ntm, tn2 = ntile / ntm;
                const bf16_t* ag2 = A + (size_t)(tm2 * 256 + wave * 32 + (lane >> 3)) * K + (((lane & 7) ^ (lane >> 3)) << 3);
                const bf16_t* bg2 = Bt + (size_t)(tn2 * 128 + wave * 16 + (lane >> 3)) * K + (((lane & 7) ^ (lane >> 3)) << 3);
                stage_from(ag2, bg2, 0); stage_from(ag2, bg2, 1); stage_from(ag2, bg2, 2);
            }
            bf16_t* U = (bf16_t*)(ws_ + OFF_U) + (size_t)(m0 + wm * 64 + 4 * g) * ldc + n0 + wn * 64 + lr;
#pragma unroll
            for (int mi = 0; mi < 4; ++mi)
#pragma unroll
                for (int ni = 0; ni < 4; ++ni)
#pragma unroll
                    for (int i = 0; i < 4; ++i) {
                        const float v = fmaxf(acc[mi][ni][i], 0.f);
                        U[(size_t)(mi * 16 + i) * ldc + ni * 16] = f2bf(v * v);
                    }
            continue;
        }
        if (EPI == EPI_LN1 || EPI == EPI_LN2) {
            const int rb = m0 + wm * 64, cb = n0 + wn * 64;
            const int cnd = rb < NCTX ? 0 : 1 + ((rb - NCTX) >> 10);
            const float* gp = (const float*)(ws_ + OFF_MOD) + (size_t)(layer * 3 + cnd) * 6144 + (EPI == EPI_LN1 ? 2048 : 5120) + cb + lr;
            const float* xp = (const float*)(ws_ + OFF_X) + (size_t)(rb + 4 * g) * 1024 + cb + lr;
            float gt[4];
#pragma unroll
            for (int ni = 0; ni < 4; ++ni) gt[ni] = gp[ni * 16];
#pragma unroll
            for (int mh = 0; mh < 2; ++mh) {
                f32x4 xv[2][4];
#pragma unroll
                for (int m2 = 0; m2 < 2; ++m2)
#pragma unroll
                    for (int ni = 0; ni < 4; ++ni)
#pragma unroll
                        for (int i = 0; i < 4; ++i) xv[m2][ni][i] = xp[(size_t)((mh * 2 + m2) * 16 + i) * 1024 + ni * 16];
#pragma unroll
                for (int m2 = 0; m2 < 2; ++m2)
#pragma unroll
                    for (int ni = 0; ni < 4; ++ni)
#pragma unroll
                        for (int i = 0; i < 4; ++i) acc[mh * 2 + m2][ni][i] = ALPHA * xv[m2][ni][i] + gt[ni] * acc[mh * 2 + m2][ni][i];
                __builtin_amdgcn_sched_barrier(0);
            }
        }
        float* T = (float*)smem + wave * (64 * 65);
#pragma unroll
        for (int mi = 0; mi < 4; ++mi)
#pragma unroll
            for (int ni = 0; ni < 4; ++ni)
#pragma unroll
                for (int i = 0; i < 4; ++i) T[(mi * 16 + 4 * g + i) * 65 + ni * 16 + lr] = acc[mi][ni][i];
        const int rowbase = m0 + wm * 64, colbase = n0 + wn * 64;
        if (EPI == EPI_INPROJ) {
            epi_inproj(p, ws_, out_, layer, T, rowbase, colbase, lane);
        } else if (EPI == EPI_LN1) {
            epi_ln<1>(p, ws_, out_, layer, T, tm, tn, wn, rowbase, colbase, lane, tid);
        } else if (EPI == EPI_LN2) {
            epi_ln<2>(p, ws_, out_, layer, T, tm, tn, wn, rowbase, colbase, lane, tid);
        } else {
            bf16_t* U = (bf16_t*)(ws_ + OFF_U) + (size_t)rowbase * ldc + colbase + lane;
#pragma unroll 4
            for (int r = 0; r < 64; ++r) { const float v = fmaxf(T[r * 65 + lane], 0.f); U[(size_t)r * ldc] = f2bf(v * v); }
        }
        __syncthreads();
    }
    if ((EPI == EPI_LN1 || EPI == EPI_LN2) && layer < 3 && (int)blockIdx.x >= ntiles) {
        const int half = __builtin_amdgcn_readfirstlane(threadIdx.x >> 8);
        const int vb = ((int)blockIdx.x - ntiles) * 2 + half, vg = ((int)gridDim.x - ntiles) * 2;
        float* tile = (float*)(smem + half * HALF_LDS);
        const int nl = layer + 1;
        if (EPI == EPI_LN1) {
            transpose_job(p.w_in + (size_t)nl * 1024 * NIN, (bf16_t*)(ws_ + OFF_WT_IN) + (size_t)nl * NINP * DM, 1024, NIN, NINP, 1, tile, false, vb, vg);
            transpose_job(p.w_out + (size_t)nl * 1024 * 1024, (bf16_t*)(ws_ + OFF_WT_OUT) + (size_t)nl * DM * DM, 1024, 1024, 1024, 1, tile, false, vb, vg);
        } else {
            transpose_job(p.w_mlp1 + (size_t)nl * 1024 * 4096, (bf16_t*)(ws_ + OFF_WT_1) + (size_t)nl * DFF * DM, 1024, 4096, 4096, 1, tile, false, vb, vg);
            transpose_job(p.w_mlp2 + (size_t)nl * 4096 * 1024, (bf16_t*)(ws_ + OFF_WT_2) + (size_t)nl * DM * DFF, 4096, 1024, 1024, 1, tile, false, vb, vg);
        }
    }
}

template <int NMAP, int DV>
struct AttnSt { f32x4 O[NMAP][DV / 16]; float m[NMAP]; float l[NMAP]; };
template <int NMAP, int DV>
struct UnitFrags { bf16x8 k[NMAP][2][2]; bf16x8 v[DV / 16]; };

template <int NMAP, int DV>
struct TileGeom {
    static constexpr int KROW = NMAP * 128, KBYTES = 64 * KROW, VUNIT = DV * 64, TBYTES = KBYTES + 2 * VUNIT;
};
DI int kswz(int row) { return (row & 3) | (((row >> 3) & 3) << 2); }

template <int NMAP, int DV>
DI void stage_tile(unsigned char* buf, const bf16_t* kg, int kstride, const bf16_t* vg, int vunit, int wave, int lane) {
    typedef TileGeom<NMAP, DV> TG;
    if (NMAP == 2) {
#pragma unroll
        for (int j = 0; j < 4; ++j) {
            const int jj = wave * 4 + j, row = jj * 4 + (lane >> 4), lc = (lane & 15) ^ kswz(row);
            __builtin_amdgcn_global_load_lds((const unsigned*)(kg + (size_t)row * kstride + lc * 8), (LAS unsigned*)(buf + jj * 1024), 16, 0, 0);
        }
    } else {
#pragma unroll
        for (int j = 0; j < 2; ++j) {
            const int jj = wave * 2 + j, row = jj * 8 + (lane >> 3), lc = (lane & 7) ^ (kswz(row) >> 1);
            __builtin_amdgcn_global_load_lds((const unsigned*)(kg + (size_t)row * kstride + lc * 8), (LAS unsigned*)(buf + jj * 1024), 16, 0, 0);
        }
    }
    constexpr int VI = TG::VUNIT / 1024, PER = 2 * VI / 4;
#pragma unroll
    for (int j = 0; j < PER; ++j) {
        const int jj = wave * PER + j, unit = jj / VI, piece = jj % VI;
        __builtin_amdgcn_global_load_lds((const unsigned*)(vg + (size_t)unit * vunit + piece * 512 + lane * 8),
                                         (LAS unsigned*)(buf + TG::KBYTES + jj * 1024), 16, 0, 0);
    }
}

template <int NMAP, int DV>
DI void lds_unit(UnitFrags<NMAP, DV>& f, const unsigned char* buf, int rowbase, int voff, int lr, int g) {
    typedef TileGeom<NMAP, DV> TG;
#pragma unroll
    for (int b = 0; b < 2; ++b) {
        const int row = rowbase + (lr >> 2) * 8 + (lr & 3) + 4 * b, sw = kswz(row);
        if (NMAP == 2) {
#pragma unroll
            for (int m = 0; m < NMAP; ++m)
#pragma unroll
                for (int kk = 0; kk < 2; ++kk) f.k[m][b][kk] = *(const bf16x8*)(buf + row * 256 + (((m * 8 + kk * 4 + g) ^ sw) << 4));
        } else {
#pragma unroll
            for (int kk = 0; kk < 2; ++kk) f.k[0][b][kk] = *(const bf16x8*)(buf + row * 128 + (((kk * 4 + g) ^ (sw >> 1)) << 4));
        }
    }
#pragma unroll
    for (int vb = 0; vb < DV / 16; ++vb) f.v[vb] = *(const bf16x8*)(buf + TG::KBYTES + voff + (vb * 16 + lr) * 64);
}

template <int DV>
DI void lds_unit_sel(UnitFrags<1, DV>& f, const unsigned char* buf, int rowbase, int voff, int lr, int g, int msel) {
    typedef TileGeom<2, DV> TG;
#pragma unroll
    for (int b = 0; b < 2; ++b) {
        const int row = rowbase + (lr >> 2) * 8 + (lr & 3) + 4 * b, sw = kswz(row);
#pragma unroll
        for (int kk = 0; kk < 2; ++kk) f.k[0][b][kk] = *(const bf16x8*)(buf + row * 256 + (((msel * 8 + kk * 4 + g) ^ sw) << 4));
    }
#pragma unroll
    for (int vb = 0; vb < DV / 16; ++vb) f.v[vb] = *(const bf16x8*)(buf + TG::KBYTES + voff + (vb * 16 + lr) * 64);
}

template <int NMAP, int DV, class SrcFn, class CompFn>
DI void tile_pipeline(unsigned char* tiles, int nt, int wave, int lane, SrcFn src, CompFn comp) {
    typedef TileGeom<NMAP, DV> TG;
    {
        const bf16_t *kg, *vg; int ks, vu;
        src(0, kg, ks, vg, vu);
        stage_tile<NMAP, DV>(tiles, kg, ks, vg, vu, wave, lane);
    }
    asm volatile("s_waitcnt vmcnt(0)" ::: "memory");
    __syncthreads();
    for (int t = 0; t < nt; ++t) {
        unsigned char* cur = tiles + (t & 1) * TG::TBYTES;
        comp(t, cur, 0);
        if (t + 1 < nt) {
            const bf16_t *kg, *vg; int ks, vu;
            src(t + 1, kg, ks, vg, vu);
            stage_tile<NMAP, DV>(tiles + ((t + 1) & 1) * TG::TBYTES, kg, ks, vg, vu, wave, lane);
        }
        comp(t, cur, 1);
        asm volatile("s_waitcnt vmcnt(0)" ::: "memory");
        __syncthreads();
    }
}

template <int NMAP, int DV, bool HASBIAS>
DI void compute_unit(AttnSt<NMAP, DV>& st, const UnitFrags<NMAP, DV>& f, const bf16x8 (&qf)[NMAP][2], float sc, const float (&bias)[8]) {
    bf16x8 pk[NMAP];
#pragma unroll
    for (int m = 0; m < NMAP; ++m) {
        f32x4 sa = (f32x4){0.f, 0.f, 0.f, 0.f}, sb = sa;
        sa = mfma16(f.k[m][0][0], qf[m][0], sa); sa = mfma16(f.k[m][0][1], qf[m][1], sa);
        sb = mfma16(f.k[m][1][0], qf[m][0], sb); sb = mfma16(f.k[m][1][1], qf[m][1], sb);
        float s[8];
#pragma unroll
        for (int j = 0; j < 4; ++j) { s[j] = sa[j] * sc; s[4 + j] = sb[j] * sc; }
        if (HASBIAS) {
#pragma unroll
            for (int j = 0; j < 8; ++j) s[j] += bias[j];
        }
        float mx = fmaxf(fmaxf(fmaxf(s[0], s[1]), fmaxf(s[2], s[3])), fmaxf(fmaxf(s[4], s[5]), fmaxf(s[6], s[7])));
        mx = grp_max(mx);
        const float mnew = fmaxf(st.m[m], mx);
        const float alpha = fexp2(st.m[m] - mnew);
        float ps = 0.f;
#pragma unroll
        for (int j = 0; j < 8; ++j) { s[j] = fexp2(s[j] - mnew); ps += s[j]; }
        st.l[m] = st.l[m] * alpha + ps; st.m[m] = mnew;
        if (__builtin_amdgcn_ballot_w64(alpha != 1.f) != 0ull) {
#pragma unroll
            for (int vb = 0; vb < DV / 16; ++vb) st.O[m][vb] *= alpha;
        }
        pk[m] = pack8(s[0], s[1], s[2], s[3], s[4], s[5], s[6], s[7]);
    }
#pragma unroll
    for (int vb = 0; vb < DV / 16; ++vb) {
#pragma unroll
        for (int m = 0; m < NMAP; ++m) st.O[m][vb] = mfma16(f.v[vb], pk[m], st.O[m][vb]);
    }
}

template <int NMAP, int DV>
DI void attn_init(AttnSt<NMAP, DV>& st) {
#pragma unroll
    for (int m = 0; m < NMAP; ++m) {
        st.m[m] = -INFINITY; st.l[m] = 0.f;
#pragma unroll
        for (int vb = 0; vb < DV / 16; ++vb) st.O[m][vb] = (f32x4){0.f, 0.f, 0.f, 0.f};
    }
}

template <bool LAT>
DI void item_diffattn(const Params& pin, int l, int seq, int h, int qt, unsigned char* smem, int wave, int lane) {
    const Params& p = pin; unsigned char* const ws_ = opaque_ws(pin.ws); float* const out_ = opaque_out(pin.out); lane = opaque_v(lane); wave = opaque_s(wave);
    const int lr = lane & 15, g = lane >> 4;
    const int nseq = LAT ? 1024 : 256;
    const int tok0 = LAT ? NCTX + seq * 1024 : seq * 256;
    const bf16_t* P = (const bf16_t*)(ws_ + OFF_P);
    const int q0 = qt * 64 + wave * 16;
    bf16x8 qf[2][2];
    {
        const bf16_t* qp = P + (size_t)(tok0 + q0 + lr) * NIN + h * 128 + 8 * g;
#pragma unroll
        for (int m = 0; m < 2; ++m)
#pragma unroll
            for (int kk = 0; kk < 2; ++kk) qf[m][kk] = *(const bf16x8*)(qp + m * 64 + kk * 32);
    }
    AttnSt<2, 128> st;
    attn_init<2, 128>(st);
    const float sc = 0.125f * LOG2E;
    const size_t hb = (size_t)((seq * 4 + l) * 4 + h);
    const bf16_t* kc = (const bf16_t*)(ws_ + OFF_CAK) + hb * 512 * 128;
    const bf16_t* vc = (const bf16_t*)(ws_ + OFF_CAVT) + hb * 128 * 512;
    const bf16_t* kn = P + (size_t)tok0 * NIN + 512 + h * 128;
    const bf16_t* vn = (const bf16_t*)(ws_ + OFF_PT_AV) + (size_t)tok0 * 512 + (size_t)(h * 128) * 32;
    const int ncache = LAT ? 8 : 0;
    __syncthreads();
    tile_pipeline<2, 128>(smem, ncache + nseq / 64, wave, lane,
        [&](int t, const bf16_t*& kg, int& ks, const bf16_t*& vg, int& vu) {
            if (t < ncache) { kg = kc + (size_t)t * 64 * 128; ks = 128; vg = vc + (size_t)(2 * t) * 128 * 32; vu = 128 * 32; }
            else { const int tt = t - ncache; kg = kn + (size_t)tt * 64 * NIN; ks = NIN; vg = vn + (size_t)(2 * tt) * 512 * 32; vu = 512 * 32; }
        },
        [&](int t, const unsigned char* buf, int part) {
            const float nob[8] = {0.f, 0.f, 0.f, 0.f, 0.f, 0.f, 0.f, 0.f};
            { const int half = part;
                UnitFrags<2, 128> f;
                lds_unit<2, 128>(f, buf, 32 * half, half * TileGeom<2, 128>::VUNIT + g * 16, lr, g);
                compute_unit<2, 128, false>(st, f, qf, sc, nob);
            }
        });
    const float inv0 = 1.f / grp_sum(st.l[0]), inv1 = 1.f / grp_sum(st.l[1]);
    const float* lamp = (const float*)(ws_ + OFF_LAM);
    const float lam = lamp[l * 2], lam_init = lamp[l * 2 + 1];
    const float c1 = lam * inv1;
    float ss = 0.f;
#pragma unroll
    for (int vb = 0; vb < 8; ++vb)
#pragma unroll
        for (int i = 0; i < 4; ++i) {
            const float o = st.O[0][vb][i] * inv0 - st.O[1][vb][i] * c1;
            st.O[0][vb][i] = o; ss += o * o;
        }
    ss = grp_sum(ss);
    const float r = rsqrtf(ss * (1.f / 128.f) + LN_EPS) * (1.f - lam_init);
    bf16_t* MIX = (bf16_t*)(ws_ + OFF_MIX) + (size_t)(tok0 + q0 + lr) * 1024 + h * 128;
    const float* gn = p.diff_norm_g + l * 128;
#pragma unroll
    for (int vb = 0; vb < 8; ++vb) {
        const int v = vb * 16 + 4 * g;
        const float4 g4 = *(const float4*)(gn + v);
        uint2 o; o.x = pack2(st.O[0][vb][0] * r * g4.x, st.O[0][vb][1] * r * g4.y);
        o.y = pack2(st.O[0][vb][2] * r * g4.z, st.O[0][vb][3] * r * g4.w);
        *(uint2*)(MIX + v) = o;
    }
}

DI void item_diffattn_lat(const Params& pin, int l, int seq, int h, int qt32, unsigned char* smem, int wave, int lane) {
    const Params& p = pin; unsigned char* const ws_ = opaque_ws(pin.ws); float* const out_ = opaque_out(pin.out); lane = opaque_v(lane); wave = opaque_s(wave);
    const int lr = lane & 15, g = lane >> 4;
    const int tok0 = NCTX + seq * 1024;
    const bf16_t* P = (const bf16_t*)(ws_ + OFF_P);
    const int msel = wave & 1;
    const int q0 = qt32 * 32 + (wave >> 1) * 16;
    bf16x8 qf[1][2];
    {
        const bf16_t* qp = P + (size_t)(tok0 + q0 + lr) * NIN + h * 128 + msel * 64 + 8 * g;
        qf[0][0] = *(const bf16x8*)(qp); qf[0][1] = *(const bf16x8*)(qp + 32);
    }
    AttnSt<1, 128> st;
    attn_init<1, 128>(st);
    const float sc = 0.125f * LOG2E;
    const size_t hb = (size_t)((seq * 4 + l) * 4 + h);
    const bf16_t* kc = (const bf16_t*)(ws_ + OFF_CAK) + hb * 512 * 128;
    const bf16_t* vc = (const bf16_t*)(ws_ + OFF_CAVT) + hb * 128 * 512;
    const bf16_t* kn = P + (size_t)tok0 * NIN + 512 + h * 128;
    const bf16_t* vn = (const bf16_t*)(ws_ + OFF_PT_AV) + (size_t)tok0 * 512 + (size_t)(h * 128) * 32;
    __syncthreads();
    tile_pipeline<2, 128>(smem, 24, wave, lane,
        [&](int t, const bf16_t*& kg, int& ks, const bf16_t*& vg, int& vu) {
            if (t < 8) { kg = kc + (size_t)t * 64 * 128; ks = 128; vg = vc + (size_t)(2 * t) * 128 * 32; vu = 128 * 32; }
            else { const int tt = t - 8; kg = kn + (size_t)tt * 64 * NIN; ks = NIN; vg = vn + (size_t)(2 * tt) * 512 * 32; vu = 512 * 32; }
        },
        [&](int t, const unsigned char* buf, int part) {
            const float nob[8] = {0.f, 0.f, 0.f, 0.f, 0.f, 0.f, 0.f, 0.f};
            { const int half = part;
                UnitFrags<1, 128> f;
                lds_unit_sel<128>(f, buf, 32 * half, half * TileGeom<2, 128>::VUNIT + g * 16, lr, g, msel);
                compute_unit<1, 128, false>(st, f, qf, sc, nob);
            }
        });
    const float* lamp = (const float*)(ws_ + OFF_LAM);
    const float lam = lamp[l * 2], lam_init = lamp[l * 2 + 1];
    const float inv = (msel ? lam : 1.f) / grp_sum(st.l[0]);
    float* xb = (float*)smem + (wave >> 1) * 32 * 64 + lane;
    if (msel) {
#pragma unroll
        for (int vb = 0; vb < 8; ++vb)
#pragma unroll
            for (int i = 0; i < 4; ++i) xb[(vb * 4 + i) * 64] = st.O[0][vb][i] * inv;
    }
    __syncthreads();
    if (msel) return;
    float ss = 0.f;
#pragma unroll
    for (int vb = 0; vb < 8; ++vb)
#pragma unroll
        for (int i = 0; i < 4; ++i) {
            const float o = st.O[0][vb][i] * inv - xb[(vb * 4 + i) * 64];
            st.O[0][vb][i] = o; ss += o * o;
        }
    ss = grp_sum(ss);
    const float r = rsqrtf(ss * (1.f / 128.f) + LN_EPS) * (1.f - lam_init);
    bf16_t* MIX = (bf16_t*)(ws_ + OFF_MIX) + (size_t)(tok0 + q0 + lr) * 1024 + h * 128;
    const float* gn = p.diff_norm_g + l * 128;
#pragma unroll
    for (int vb = 0; vb < 8; ++vb) {
        const int v = vb * 16 + 4 * g;
        const float4 g4 = *(const float4*)(gn + v);
        uint2 o; o.x = pack2(st.O[0][vb][0] * r * g4.x, st.O[0][vb][1] * r * g4.y);
        o.y = pack2(st.O[0][vb][2] * r * g4.z, st.O[0][vb][3] * r * g4.w);
        *(uint2*)(MIX + v) = o;
    }
}

DI void item_dense(const Params& pin, int seq, int h, int qt, unsigned char* smem, int wave, int lane) {
    const Params& p = pin; unsigned char* const ws_ = opaque_ws(pin.ws); float* const out_ = opaque_out(pin.out); lane = opaque_v(lane); wave = opaque_s(wave);
    const int lr = lane & 15, g = lane >> 4;
    const int tok0 = seq * 256;
    const bf16_t* P = (const bf16_t*)(ws_ + OFF_P);
    const int q0 = qt * 64 + wave * 16;
    bf16x8 qf[1][2];
    {
        const bf16_t* qp = P + (size_t)(tok0 + q0 + lr) * NIN + 1536 + h * 64 + 8 * g;
        qf[0][0] = *(const bf16x8*)(qp); qf[0][1] = *(const bf16x8*)(qp + 32);
    }
    AttnSt<1, 64> st;
    attn_init<1, 64>(st);
    const bf16_t* kn = P + (size_t)tok0 * NIN + 1792 + h * 64;
    const bf16_t* vn = (const bf16_t*)(ws_ + OFF_PT_BV) + (size_t)tok0 * 256 + (size_t)(h * 64) * 32;
    const float sc = 0.125f * LOG2E;
    __syncthreads();
    tile_pipeline<1, 64>(smem, 4, wave, lane,
        [&](int t, const bf16_t*& kg, int& ks, const bf16_t*& vg, int& vu) {
            kg = kn + (size_t)t * 64 * NIN; ks = NIN; vg = vn + (size_t)(2 * t) * 256 * 32; vu = 256 * 32;
        },
        [&](int t, const unsigned char* buf, int part) {
            const float nob[8] = {0.f, 0.f, 0.f, 0.f, 0.f, 0.f, 0.f, 0.f};
            { const int half = part;
                UnitFrags<1, 64> f;
                lds_unit<1, 64>(f, buf, 32 * half, half * TileGeom<1, 64>::VUNIT + g * 16, lr, g);
                compute_unit<1, 64, false>(st, f, qf, sc, nob);
            }
        });
    const float inv = 1.f / grp_sum(st.l[0]);
    bf16_t* MIX = (bf16_t*)(ws_ + OFF_MIX) + (size_t)(tok0 + q0 + lr) * 1024 + 512 + h * 64;
#pragma unroll
    for (int vb = 0; vb < 4; ++vb) {
        uint2 o; o.x = pack2(st.O[0][vb][0] * inv, st.O[0][vb][1] * inv); o.y = pack2(st.O[0][vb][2] * inv, st.O[0][vb][3] * inv);
        *(uint2*)(MIX + vb * 16 + 4 * g) = o;
    }
}

DI void item_na(const Params& pin, int l, int sb, int h, int r, unsigned char* smem, int wave, int lane) {
    const Params& p = pin; unsigned char* const ws_ = opaque_ws(pin.ws); float* const out_ = opaque_out(pin.out); lane = opaque_v(lane); wave = opaque_s(wave);
    const int lr = lane & 15, g = lane >> 4;
    const int tok0 = NCTX + sb * 1024;
    const bf16_t* P = (const bf16_t*)(ws_ + OFF_P);
    const int qc = wave * 16 + lr;
    const int q0 = r * 64 + wave * 16;
    bf16x8 qf[1][2];
    {
        const bf16_t* qp = P + (size_t)(tok0 + q0 + lr) * NIN + 1536 + h * 64 + 8 * g;
        qf[0][0] = *(const bf16x8*)(qp); qf[0][1] = *(const bf16x8*)(qp + 32);
    }
    AttnSt<1, 64> st;
    attn_init<1, 64>(st);
    const float sc = 0.125f * LOG2E;
    const size_t hb = (size_t)((sb * 4 + l) * 4 + h);
    const bf16_t* kc = (const bf16_t*)(ws_ + OFF_CBK) + hb * 512 * 64;
    const bf16_t* vc = (const bf16_t*)(ws_ + OFF_CBVT) + hb * 64 * 512;
    const bf16_t* kn = P + (size_t)tok0 * NIN + 1792 + h * 64;
    const bf16_t* vn = (const bf16_t*)(ws_ + OFF_PT_BV) + (size_t)tok0 * 256 + (size_t)(h * 64) * 32;
    const int kr0 = min(max(r - 4, 0), 8);
    const int bs = min(max(wave * 16 - 8, 0), 32);
    const int wstart = min(max(qc - 8, 0), 48);
    const float* rpb = p.nat_rpb + (size_t)(l * 4 + h) * 15 * 31;
    __syncthreads();
    tile_pipeline<1, 64>(smem, 16, wave, lane,
        [&](int t, const bf16_t*& kg, int& ks, const bf16_t*& vg, int& vu) {
            if (t < 8) { kg = kc + (size_t)t * 64 * 64; ks = 64; vg = vc + (size_t)(2 * t) * 64 * 32; vu = 64 * 32; }
            else { const int kr = kr0 + t - 8; kg = kn + (size_t)kr * 64 * NIN; ks = NIN; vg = vn + (size_t)(2 * kr) * 256 * 32; vu = 256 * 32; }
        },
        [&](int t, const unsigned char* buf, int part) {
            if (t < 8) {
                const float nob[8] = {0.f, 0.f, 0.f, 0.f, 0.f, 0.f, 0.f, 0.f};
                { const int half = part;
                    UnitFrags<1, 64> f;
                    lds_unit<1, 64>(f, buf, 32 * half, half * TileGeom<1, 64>::VUNIT + g * 16, lr, g);
                    compute_unit<1, 64, false>(st, f, qf, sc, nob);
                }
            } else if (part == 0) {
                const int kr = kr0 + t - 8;
                const int nl = bs + 8 * g;
                UnitFrags<1, 64> f;
                lds_unit<1, 64>(f, buf, bs, (nl >> 5) * TileGeom<1, 64>::VUNIT + (nl & 31) * 2, lr, g);
                float bias[8];
                const float* rrow = rpb + (kr - r + 7) * 31;
#pragma unroll
                for (int j = 0; j < 8; ++j) {
                    const int kcol = bs + 8 * g + j;
                    const bool valid = (kcol >= wstart) && (kcol < wstart + 16);
                    const int dc = min(max(kcol - qc + 15, 0), 30);
                    bias[j] = valid ? rrow[dc] * LOG2E : -INFINITY;
                }
                compute_unit<1, 64, true>(st, f, qf, sc, bias);
            }
        });
    const float inv = 1.f / grp_sum(st.l[0]);
    bf16_t* MIX = (bf16_t*)(ws_ + OFF_MIX) + (size_t)(tok0 + q0 + lr) * 1024 + 512 + h * 64;
#pragma unroll
    for (int vb = 0; vb < 4; ++vb) {
        uint2 o; o.x = pack2(st.O[0][vb][0] * inv, st.O[0][vb][1] * inv); o.y = pack2(st.O[0][vb][2] * inv, st.O[0][vb][3] * inv);
        *(uint2*)(MIX + vb * 16 + 4 * g) = o;
    }
}

DI float wave_excl_sum(float v, int lane) {
    float x = v;
#pragma unroll
    for (int d = 1; d < 64; d <<= 1) { const float y = __shfl_up(x, d); if (lane >= d) x += y; }
    return x - v;
}
DI float wave_excl_max(float v, int lane, float init) {
    float x = v;
#pragma unroll
    for (int d = 1; d < 64; d <<= 1) { const float y = __shfl_up(x, d); if (lane >= d) x = fmaxf(x, y); }
    const float ex = __shfl_up(x, 1);
    return lane == 0 ? init : fmaxf(init, ex);
}
DI void mlstm_scan(const float* __restrict__ G, int h, int nseq, int dir, float* aA, float* MA, float* FA, float m0, int lane) {
    const int per = nseq >> 6;
    float run = 0.f;
    for (int e = 0; e < per; ++e) {
        const int idx = lane * per + e, pos = dir ? nseq - 1 - idx : idx;
        const float f = G[(size_t)pos * 16 + (dir ? 12 : 4) + h];
        const float lf = fminf(f, 0.f) - __logf(1.f + __expf(-fabsf(f)));
        run += lf; FA[pos] = run;
    }
    const float off = wave_excl_sum(run, lane);
    float rmax = -INFINITY;
    for (int e = 0; e < per; ++e) {
        const int idx = lane * per + e, pos = dir ? nseq - 1 - idx : idx;
        const float F = FA[pos] + off; FA[pos] = F;
        const float a = G[(size_t)pos * 16 + (dir ? 8 : 0) + h] - F;
        aA[pos] = a; rmax = fmaxf(rmax, a); MA[pos] = rmax;
    }
    const float pre = wave_excl_max(rmax, lane, m0);
    for (int e = 0; e < per; ++e) {
        const int idx = lane * per + e, pos = dir ? nseq - 1 - idx : idx;
        MA[pos] = fmaxf(MA[pos], pre);
    }
}

DI void mlstm_unit(f32x4 (&O)[4], float& den, int dir, int t, const bf16x8 (&qf)[2], const UnitFrags<1, 64>& f, const float* aA, float Mt, int key0, int g) {
    f32x4 sa = (f32x4){0.f, 0.f, 0.f, 0.f}, sb = sa;
    sa = mfma16(f.k[0][0][0], qf[0], sa); sa = mfma16(f.k[0][0][1], qf[1], sa);
    sb = mfma16(f.k[0][1][0], qf[0], sb); sb = mfma16(f.k[0][1][1], qf[1], sb);
    const float4 a0 = *(const float4*)(aA + key0 + 8 * g), a1 = *(const float4*)(aA + key0 + 8 * g + 4);
    const float av[8] = {a0.x, a0.y, a0.z, a0.w, a1.x, a1.y, a1.z, a1.w};
    float pv[8];
#pragma unroll
    for (int j = 0; j < 8; ++j) {
        const int key = key0 + 8 * g + j;
        const bool ok = dir ? (key >= t) : (key <= t);
        const float w = ok ? fexp2((av[j] - Mt) * LOG2E) : 0.f;
        const float sv = (j < 4) ? sa[j & 3] : sb[j & 3];
        pv[j] = sv * 0.125f * w;
        den += pv[j];
    }
    const bf16x8 pk = pack8(pv[0], pv[1], pv[2], pv[3], pv[4], pv[5], pv[6], pv[7]);
#pragma unroll
    for (int vb = 0; vb < 4; ++vb) O[vb] = mfma16(f.v[vb], pk, O[vb]);
}

template <bool LAT>
DI void item_mlstm(const Params& pin, int l, int seq, int h, int qt, unsigned char* smem, int wave, int lane) {
    const Params& p = pin; unsigned char* const ws_ = opaque_ws(pin.ws); float* const out_ = opaque_out(pin.out); lane = opaque_v(lane); wave = opaque_s(wave);
    const int lr = lane & 15, g = lane >> 4;
    const int nseq = LAT ? 1024 : 256;
    const int tok0 = LAT ? NCTX + seq * 1024 : seq * 256;
    float* aF = (float*)smem; float* MF = aF + 1024; float* FF = MF + 1024;
    float* aB = FF + 1024; float* MB = aB + 1024; float* FB = MB + 1024;
    unsigned char* tiles = smem + 24576;
    const float* G = (const float*)(ws_ + OFF_G) + (size_t)tok0 * 16;
    float m0f = 0.f, m0b = 0.f;
    const int sidx_f = ((seq * 4 + l) * 2 + 0) * 4 + h, sidx_b = ((seq * 4 + l) * 2 + 1) * 4 + h;
    if (LAT) { m0f = p.state_m[sidx_f]; m0b = p.state_m[sidx_b]; }
    __syncthreads();
    if (wave == 0) mlstm_scan(G, h, nseq, 0, aF, MF, FF, m0f, lane);
    if (wave == 1) mlstm_scan(G, h, nseq, 1, aB, MB, FB, m0b, lane);
    __syncthreads();
    const bf16_t* P = (const bf16_t*)(ws_ + OFF_P);
    const int q0 = qt * 64 + wave * 16;
    const int t = q0 + lr;
    bf16x8 qf[2];
    {
        const bf16_t* qp = P + (size_t)(tok0 + t) * NIN + 2304 + h * 64 + 8 * g;
        qf[0] = *(const bf16x8*)(qp); qf[1] = *(const bf16x8*)(qp + 32);
    }
    const bf16_t* kn = P + (size_t)tok0 * NIN + 2560 + h * 64;
    const bf16_t* vn = (const bf16_t*)(ws_ + OFF_PT_CV) + (size_t)tok0 * 256 + (size_t)(h * 64) * 32;
    const float Mf = MF[t], Mb = MB[t], Ff = FF[t], Fb = FB[t];
    f32x4 Of[4], Ob[4];
#pragma unroll
    for (int vb = 0; vb < 4; ++vb) { Of[vb] = (f32x4){0.f, 0.f, 0.f, 0.f}; Ob[vb] = Of[vb]; }
    float denf = 0.f, denb = 0.f;
    tile_pipeline<1, 64>(tiles, nseq / 64, wave, lane,
        [&](int tt, const bf16_t*& kg, int& ks, const bf16_t*& vg, int& vu) {
            kg = kn + (size_t)tt * 64 * NIN; ks = NIN; vg = vn + (size_t)(2 * tt) * 256 * 32; vu = 256 * 32;
        },
        [&](int tt, const unsigned char* buf, int part) {
            { const int half = part;
                const int key0 = tt * 64 + half * 32;
                const bool dof = key0 <= q0 + 15, dob = key0 + 31 >= q0;
                if (dof || dob) {
                    UnitFrags<1, 64> f;
                    lds_unit<1, 64>(f, buf, 32 * half, half * TileGeom<1, 64>::VUNIT + g * 16, lr, g);
                    if (dof) mlstm_unit(Of, denf, 0, t, qf, f, aF, Mf, key0, g);
                    if (dob) mlstm_unit(Ob, denb, 1, t, qf, f, aB, Mb, key0, g);
                }
            }
        });
    if (LAT) {
        const bf16_t* qp2 = P + (size_t)(tok0 + t) * NIN + 2304 + h * 64 + 4 * g;
#pragma unroll
        for (int dir = 0; dir < 2; ++dir) {
            const int sidx = dir ? sidx_b : sidx_f;
            const float e = fexp2(((dir ? m0b : m0f) - (dir ? Mb : Mf)) * LOG2E) * 0.125f;
            const bf16_t* c0t = (const bf16_t*)(ws_ + OFF_C0T) + (size_t)sidx * 4096 + lr * 64 + 4 * g;
            const float* n0 = p.state_n + (size_t)sidx * 64;
            float dacc = 0.f;
#pragma unroll
            for (int u2 = 0; u2 < 2; ++u2) {
                const bf16x4 qa = *(const bf16x4*)(qp2 + u2 * 32), qb = *(const bf16x4*)(qp2 + u2 * 32 + 16);
                const float4 na = *(const float4*)(n0 + u2 * 32 + 4 * g), nb = *(const float4*)(n0 + u2 * 32 + 16 + 4 * g);
                float pv[8];
#pragma unroll
                for (int j = 0; j < 4; ++j) { pv[j] = bf2f((unsigned short)qa[j]) * e; pv[4 + j] = bf2f((unsigned short)qb[j]) * e; }
                dacc += pv[0] * na.x + pv[1] * na.y + pv[2] * na.z + pv[3] * na.w + pv[4] * nb.x + pv[5] * nb.y + pv[6] * nb.z + pv[7] * nb.w;
                const bf16x8 pk = pack8(pv[0], pv[1], pv[2], pv[3], pv[4], pv[5], pv[6], pv[7]);
#pragma unroll
                for (int vb = 0; vb < 4; ++vb) {
                    const bf16_t* cp = c0t + (size_t)vb * 16 * 64 + u2 * 32;
                    const bf16x8 cf = cat4(*(const bf16x4*)(cp), *(const bf16x4*)(cp + 16));
                    if (dir) Ob[vb] = mfma16(cf, pk, Ob[vb]); else Of[vb] = mfma16(cf, pk, Of[vb]);
                }
            }
            if (dir) denb += dacc; else denf += dacc;
        }
    }
    denf = grp_sum(denf); denb = grp_sum(denb);
    const float rf = 1.f / fmaxf(fabsf(denf), expf(-(Ff + Mf)));
    const float rb = 1.f / fmaxf(fabsf(denb), expf(-(Fb + Mb)));
    float ss = 0.f;
#pragma unroll
    for (int vb = 0; vb < 4; ++vb)
#pragma unroll
        for (int i = 0; i < 4; ++i) { const float hs = Of[vb][i] * rf + Ob[vb][i] * rb; Of[vb][i] = hs; ss += hs * hs; }
    ss = grp_sum(ss);
    const float rn = rsqrtf(ss * (1.f / 64.f) + LN_EPS);
    const float* gn = p.mlstm_norm_g + (size_t)(l * 4 + h) * 64;
    const bf16_t* op = P + (size_t)(tok0 + t) * NIN + 3072 + h * 64;
    bf16_t* MIX = (bf16_t*)(ws_ + OFF_MIX) + (size_t)(tok0 + t) * 1024 + 768 + h * 64;
#pragma unroll
    for (int vb = 0; vb < 4; ++vb) {
        const int v = vb * 16 + 4 * g;
        const float4 g4 = *(const float4*)(gn + v);
        const bf16x4 o4 = *(const bf16x4*)(op + v);
        float sg[4];
#pragma unroll
        for (int i = 0; i < 4; ++i) sg[i] = 1.f / (1.f + __expf(-bf2f((unsigned short)o4[i])));
        uint2 o; o.x = pack2(Of[vb][0] * rn * g4.x * sg[0], Of[vb][1] * rn * g4.y * sg[1]);
        o.y = pack2(Of[vb][2] * rn * g4.z * sg[2], Of[vb][3] * rn * g4.w * sg[3]);
        *(uint2*)(MIX + v) = o;
    }
}

DI void item_mlstm_state(const Params& pin, int l, int b, int h, int dir, unsigned char* smem, int wave, int lane) {
    const Params& p = pin; unsigned char* const ws_ = opaque_ws(pin.ws); float* const out_ = opaque_out(pin.out); lane = opaque_v(lane); wave = opaque_s(wave);
    const int lr = lane & 15, g = lane >> 4;
    const int tok0 = b * 256;
    float* aA = (float*)smem; float* MA = aA + 1024; float* FA = MA + 1024;
    const float* G = (const float*)(ws_ + OFF_G) + (size_t)tok0 * 16;
    __syncthreads();
    if (wave == 0) mlstm_scan(G, h, 256, dir, aA, MA, FA, 0.f, lane);
    __syncthreads();
    const float Mfin = dir ? MA[0] : MA[255];
    const float Ffin = dir ? FA[0] : FA[255];
    const bf16_t* KT = (const bf16_t*)(ws_ + OFF_PT_CK) + (size_t)tok0 * 256 + (size_t)(h * 64 + wave * 16 + lr) * 32 + 8 * g;
    const bf16_t* VT = (const bf16_t*)(ws_ + OFF_PT_CV) + (size_t)tok0 * 256 + (size_t)(h * 64 + lr) * 32 + 8 * g;
    f32x4 C[4];
#pragma unroll
    for (int vb = 0; vb < 4; ++vb) C[vb] = (f32x4){0.f, 0.f, 0.f, 0.f};
    float nacc = 0.f;
#pragma unroll 4
    for (int u = 0; u < 8; ++u) {
        const int s0 = u * 32;
        const bf16x8 kf = *(const bf16x8*)(KT + (size_t)u * 256 * 32);
        const float4 a0 = *(const float4*)(aA + s0 + 8 * g), a1 = *(const float4*)(aA + s0 + 8 * g + 4);
        const float av[8] = {a0.x, a0.y, a0.z, a0.w, a1.x, a1.y, a1.z, a1.w};
        float kw[8];
#pragma unroll
        for (int j = 0; j < 8; ++j) { kw[j] = bf2f((unsigned short)kf[j]) * fexp2((av[j] - Mfin) * LOG2E); nacc += kw[j]; }
        const bf16x8 af = pack8(kw[0], kw[1], kw[2], kw[3], kw[4], kw[5], kw[6], kw[7]);
#pragma unroll
        for (int vb = 0; vb < 4; ++vb) {
            const bf16x8 vf = *(const bf16x8*)(VT + (size_t)u * 256 * 32 + vb * 16 * 32);
            C[vb] = mfma16(af, vf, C[vb]);
        }
    }
    const size_t sidx = (size_t)((b * 4 + l) * 2 + dir) * 4 + h;
    float* oc = out_ + O_NC + sidx * 4096;
#pragma unroll
    for (int vb = 0; vb < 4; ++vb)
#pragma unroll
        for (int i = 0; i < 4; ++i) oc[(wave * 16 + 4 * g + i) * 64 + vb * 16 + lr] = C[vb][i];
    nacc = grp_sum(nacc);
    if (g == 0) out_[O_NN + sidx * 64 + wave * 16 + lr] = nacc;
    if (wave == 0 && lane == 0) out_[O_NM + sidx] = Ffin + Mfin;
}

DI void mixer_phase(const Params& p, int l, unsigned char* smem) {
    const int tid_ = opaque_v(threadIdx.x); const int lane = tid_ & 63, wave = (tid_ >> 6) & 3;
    const int half = __builtin_amdgcn_readfirstlane(tid_ >> 8);
    unsigned char* sm = smem + half * HALF_LDS;
    unsigned* ctr = (unsigned*)(p.ws + OFF_MIXCTR) + l;
    volatile unsigned* slot = (volatile unsigned*)(smem + LDS_BYTES + 16);
    for (;;) {
        __syncthreads();
        if (tid_ == 0) *slot = __hip_atomic_fetch_add(ctr, 1u, __ATOMIC_RELAXED, __HIP_MEMORY_SCOPE_AGENT);
        __syncthreads();
        const int it = __builtin_amdgcn_readfirstlane(2 * (int)*slot + half);
        if (it >= 1408) break;
        if (it < 256) { item_diffattn_lat(p, l, it >> 7, (it >> 5) & 3, it & 31, sm, wave, lane); }
        else if (it < 384) { const int i = it - 256; item_mlstm<true>(p, l, i >> 6, (i >> 4) & 3, i & 15, sm, wave, lane); }
        else if (it < 512) { const int i = it - 384; item_mlstm_state(p, l, i >> 3, (i >> 1) & 3, i & 1, sm, wave, lane); }
        else if (it < 640) { const int i = it - 512; item_na(p, l, i >> 6, (i >> 4) & 3, i & 15, sm, wave, lane); }
        else if (it < 896) { const int i = it - 640; item_diffattn<false>(p, l, i >> 4, (i >> 2) & 3, i & 3, sm, wave, lane); }
        else if (it < 1152) { const int i = it - 896; item_mlstm<false>(p, l, i >> 4, (i >> 2) & 3, i & 3, sm, wave, lane); }
        else { const int i = it - 1152; item_dense(p, i >> 4, (i >> 2) & 3, i & 3, sm, wave, lane); }
    }
}

#define XB_TMO      128
#define XB_XCNT(j)  (256  + 64 * (j))
#define XB_XSUB(j)  (1280 + 64 * (j))
#define XB_XGEN(j)  (2304 + 64 * (j))
#define XB_TOP      3328
#define XB_TOPGEN   3392
#define XCD_BAR_WORDS 3456
#define XB_SPIN_CAP (1u << 18)

__device__ __forceinline__ unsigned xb_ld(unsigned* p)              { return __hip_atomic_load(p, __ATOMIC_RELAXED, __HIP_MEMORY_SCOPE_AGENT); }
__device__ __forceinline__ unsigned xb_add(unsigned* p, unsigned v) { return __hip_atomic_fetch_add(p, v, __ATOMIC_RELAXED, __HIP_MEMORY_SCOPE_AGENT); }
__device__ __forceinline__ unsigned xb_xcc_id() { return (unsigned)__builtin_amdgcn_s_getreg((3 << 11) | 20) & 0xFu; }
#define XB_SPIN(cond, bar) do { unsigned _sp = 0; while (cond) { __builtin_amdgcn_s_sleep(1); \
    if ((++_sp & 255u) == 0u) { if (xb_ld(&(bar)[XB_TMO])) break; if (_sp > XB_SPIN_CAP) { atomicAdd(&(bar)[XB_TMO], 1u); break; } } } } while (0)

struct XcdBarrier {
    unsigned* bar; unsigned x;
    volatile LAS unsigned* st;
};

__device__ __forceinline__ XcdBarrier xcd_barrier_post(unsigned* bar, volatile LAS unsigned* st) {
    XcdBarrier b; b.bar = bar; b.x = xb_xcc_id(); b.st = st;
    if (threadIdx.x == 0) (void)xb_add(&bar[XB_XCNT(b.x)], 1u);
    return b;
}
__device__ __forceinline__ void xcd_barrier_complete(unsigned* bar, unsigned x, unsigned& nloc, unsigned& nx) {
    const unsigned G = gridDim.x * gridDim.y * gridDim.z;
    unsigned sum, cnt, mine, sp = 0u;
    for (;;) {
        sum = 0u; cnt = 0u; mine = 0u;
#pragma unroll
        for (unsigned j = 0; j < 16; ++j) { const unsigned c = xb_ld(&bar[XB_XCNT(j)]); sum += c; cnt += (c > 0u) ? 1u : 0u; mine = (j == x) ? c : mine; }
        if (sum == G) break;
        __builtin_amdgcn_s_sleep(1);
        if ((++sp & 255u) == 0u) { if (xb_ld(&bar[XB_TMO])) break; if (sp > XB_SPIN_CAP) { atomicAdd(&bar[XB_TMO], 1u); break; } }
    }
    nloc = mine > 0u ? mine : 1u; nx = cnt > 0u ? cnt : 1u;
}

__device__ __forceinline__ void xcd_barrier(const XcdBarrier& b) {
    asm volatile("s_waitcnt vmcnt(0)" ::: "memory");
    __syncthreads();
    if (threadIdx.x == 0) {
        unsigned* bar = b.bar;
        __builtin_amdgcn_s_waitcnt(0);
        unsigned nloc = b.st[0], nx = b.st[1];
        if (nloc == 0u) { xcd_barrier_complete(bar, b.x, nloc, nx); b.st[0] = nloc; b.st[1] = nx; }
        const unsigned old = xb_add(&bar[XB_XSUB(b.x)], 1u);
        const unsigned gen = old / nloc;
        if (old + 1u == (gen + 1u) * nloc) {
            __builtin_amdgcn_fence(__ATOMIC_RELEASE, "agent");
            asm volatile("s_waitcnt vmcnt(0)" ::: "memory");
            const unsigned og = xb_add(&bar[XB_TOP], 1u);
            const unsigned tg = og / nx;
            if (og + 1u == (tg + 1u) * nx) xb_add(&bar[XB_TOPGEN], 1u);
            else XB_SPIN(xb_ld(&bar[XB_TOPGEN]) == tg, bar);
            __builtin_amdgcn_fence(__ATOMIC_ACQUIRE, "agent");
            xb_add(&bar[XB_XGEN(b.x)], 1u);
            asm volatile("s_waitcnt vmcnt(0)" ::: "memory");
        } else {
            XB_SPIN(xb_ld(&bar[XB_XGEN(b.x)]) == gen, bar);
            __builtin_amdgcn_fence(__ATOMIC_ACQUIRE, "agent");
            asm volatile("s_waitcnt vmcnt(0)" ::: "memory");
        }
    }
    __syncthreads();
}


constexpr int N_PHASES = 2 + 5 * 4;

__global__ void __launch_bounds__(512, 2) fwd_kernel(Params p) {
    __shared__ __attribute__((aligned(16))) unsigned char smem[LDS_BYTES + 32];
    if (threadIdx.x == 0) *(uint4*)(smem + LDS_BYTES) = make_uint4(0u, 0u, 0u, 0u);
    __syncthreads();
    XcdBarrier xb = xcd_barrier_post((unsigned*)(p.ws + OFF_BAR), (volatile LAS unsigned*)(smem + LDS_BYTES));
    for (int ph = p.ph_lo; ph < p.ph_hi; ++ph) {
        if (ph > p.ph_lo) {
            if (p.ph_hi > 1000) cg::this_grid().sync();
            xcd_barrier(xb);
        }
        const int l = ph < 2 ? 0 : (ph - 2) / 5, s = ph < 2 ? ph - 2 : (ph - 2) % 5;
        const int bit = 1 << (s + 2);
        const int reps = (DUPM & bit) ? 2 : 1;
        for (int rep = 0; rep < reps; ++rep) {
            if (rep) __syncthreads();
            if (s == -2) prep0(p, smem + __builtin_amdgcn_readfirstlane(threadIdx.x >> 8) * HALF_LDS);
            else if (s == -1) prep1(p);
            else if (s == 0) gemm_phase<EPI_INPROJ>(p, l, OFF_H, OFF_WT_IN + (size_t)l * NINP * DM * 2, NINP / 128, 1024, 0, smem);
            else if (s == 1) mixer_phase(p, l, smem);
            else if (s == 2) gemm_phase<EPI_LN1>(p, l, OFF_MIX, OFF_WT_OUT + (size_t)l * DM * DM * 2, 8, 1024, 1024, smem);
            else if (s == 3) gemm_phase<EPI_RELU2>(p, l, OFF_H, OFF_WT_1 + (size_t)l * DFF * DM * 2, 32, 1024, 4096, smem);
            else gemm_phase<EPI_LN2>(p, l, OFF_U, OFF_WT_2 + (size_t)l * DM * DFF * 2, 8, 4096, 1024, smem);
        }
    }
}

extern "C" void kernel_launch(void* const* d_in, const int* in_sizes, int n_in, void* d_out, int out_size, void* d_ws, size_t ws_size,
                              hipStream_t stream) {
    static int grid = 0;
    if (grid == 0) {
        if (n_in != 26 || ws_size < WS_END) { fprintf(stderr, "kernel_launch: unexpected n_in %d / ws %zu (need %zu)\n", n_in, ws_size, (size_t)WS_END); grid = -1; return; }
        int dev = 0, cus = 0, per_cu = 0;
        hipGetDevice(&dev);
        hipDeviceGetAttribute(&cus, hipDeviceAttributeMultiprocessorCount, dev);
        hipOccupancyMaxActiveBlocksPerMultiprocessor(&per_cu, (const void*)fwd_kernel, 512, 0);
        (void)per_cu;
        grid = cus;
        if (grid < 192) { fprintf(stderr, "kernel_launch: grid %d < 192 resident workgroups needed by the fused LayerNorm exchange\n", grid); grid = -1; return; }
    }
    if (grid < 0) return;
    Params p{};
    const float** pp = (const float**)&p;
    for (int i = 0; i < 26; ++i) pp[i] = (const float*)d_in[i];
    p.out = (float*)d_out; p.ws = (unsigned char*)d_ws;
    (void)hipMemsetAsync((unsigned char*)d_ws + OFF_BAR, 0, 16384, stream);
#if SINGLE_LAUNCH
    p.ph_lo = 0; p.ph_hi = N_PHASES;
    void* args[] = {&p};
    hipError_t e = hipLaunchCooperativeKernel((const void*)fwd_kernel, dim3(grid), dim3(512), args, 0, stream);
    if (e != hipSuccess) fprintf(stderr, "cooperative launch failed: %s (grid %d)\n", hipGetErrorString(e), grid);
#else
    for (int ph = 0; ph < N_PHASES; ++ph) {
        p.ph_lo = ph; p.ph_hi = ph + 1;
        void* args[] = {&p};
        hipError_t e = hipLaunchCooperativeKernel((const void*)fwd_kernel, dim3(grid), dim3(512), args, 0, stream);
        if (e != hipSuccess) { fprintf(stderr, "launch %d failed: %s (grid %d)\n", ph, hipGetErrorString(e), grid); break; }
    }
#endif
}
```

```cpp
#include <hip/hip_runtime.h>
#include <hip/hip_cooperative_groups.h>
#include <cstdio>
namespace cg = cooperative_groups;

#ifndef IM
#define IM 0xffff
#endif
#ifndef IM
#define IM 0xffff
#endif
#ifndef DUPM
#define DUPM 0
#endif
#ifndef PHM
#define PHM 0xffff
#endif
#ifndef SINGLE_LAUNCH
#define SINGLE_LAUNCH 1
#endif

#define LAS __attribute__((address_space(3)))
typedef unsigned short bf16_t;
typedef __attribute__((ext_vector_type(8))) short bf16x8;
typedef __attribute__((ext_vector_type(4))) short bf16x4;
typedef __attribute__((ext_vector_type(4))) float f32x4;
#define DI __device__ __forceinline__

constexpr int NTOK = 6144, NCTX = 4096, DM = 1024, NIN = 3344, NINP = 3456, DFF = 4096;
constexpr float ALPHA = 1.681792830507429f;
constexpr float LOG2E = 1.4426950408889634f;
constexpr float LN_EPS = 1e-5f;

constexpr size_t al256(size_t x) { return (x + 255) & ~(size_t)255; }
constexpr size_t OFF_WT_IN = 0;
constexpr size_t OFF_WT_OUT = OFF_WT_IN + al256((size_t)4 * NINP * DM * 2);
constexpr size_t OFF_WT_1 = OFF_WT_OUT + al256((size_t)4 * DM * DM * 2);
constexpr size_t OFF_WT_2 = OFF_WT_1 + al256((size_t)4 * DFF * DM * 2);
constexpr size_t OFF_MOD = OFF_WT_2 + al256((size_t)4 * DFF * DM * 2);
constexpr size_t OFF_X = OFF_MOD + al256((size_t)4 * 3 * 6144 * 4);
constexpr size_t OFF_H = OFF_X + al256((size_t)NTOK * DM * 4);
constexpr size_t OFF_P = OFF_H + al256((size_t)NTOK * DM * 2);
constexpr size_t OFF_PT_AV = OFF_P + al256((size_t)NTOK * NIN * 2);
constexpr size_t OFF_PT_BV = OFF_PT_AV + al256((size_t)NTOK * 512 * 2);
constexpr size_t OFF_PT_CV = OFF_PT_BV + al256((size_t)NTOK * 256 * 2);
constexpr size_t OFF_PT_CK = OFF_PT_CV + al256((size_t)NTOK * 256 * 2);
constexpr size_t OFF_G = OFF_PT_CK + al256((size_t)NTOK * 256 * 2);
constexpr size_t OFF_MIX = OFF_G + al256((size_t)NTOK * 16 * 4);
constexpr size_t OFF_Y = OFF_MIX + al256((size_t)NTOK * DM * 2);
constexpr size_t OFF_U = OFF_Y + al256((size_t)NTOK * DM * 4);
constexpr size_t OFF_CAK = OFF_U + al256((size_t)NTOK * DFF * 2);
constexpr size_t OFF_CAVT = OFF_CAK + al256((size_t)32 * 512 * 128 * 2);
constexpr size_t OFF_CBK = OFF_CAVT + al256((size_t)32 * 512 * 128 * 2);
constexpr size_t OFF_CBVT = OFF_CBK + al256((size_t)32 * 512 * 64 * 2);
constexpr size_t OFF_C0T = OFF_CBVT + al256((size_t)32 * 512 * 64 * 2);
constexpr size_t OFF_ROPE = OFF_C0T + al256((size_t)64 * 64 * 64 * 2);
constexpr size_t OFF_LAM = OFF_ROPE + al256((size_t)2 * 1024 * 4);
constexpr size_t OFF_BAR = OFF_LAM + 256;
constexpr size_t OFF_LNCNT = OFF_BAR + 13824;
constexpr size_t OFF_MIXCTR = OFF_BAR + 15360;
constexpr size_t OFF_STATS = OFF_BAR + 16384;
constexpr size_t WS_END = OFF_STATS + (size_t)NTOK * 16 * 8;

constexpr size_t O_YP = 0, O_YS = 4194304, O_AK = 6291456, O_AV = 14680064, O_BK = 23068672, O_BV = 27262976,
                 O_NC = 31457280, O_NN = 33554432, O_NM = 33587200;

struct Params {
    const float* x_prompt; const float* x_sample; const float* cache_a_k; const float* cache_a_v;
    const float* cache_b_k; const float* cache_b_v; const float* state_c; const float* state_n;
    const float* state_m; const float* c; const float* c_ctx; const float* w_in; const float* gate_bias;
    const float* diff_lambda; const float* diff_norm_g; const float* nat_rpb; const float* mlstm_norm_g;
    const float* w_out; const float* ada_w; const float* ada_b; const float* ln1_g; const float* ln1_b;
    const float* ln2_g; const float* ln2_b; const float* w_mlp1; const float* w_mlp2;
    float* out; unsigned char* ws; int ph_lo; int ph_hi;
};

#define VBID ((int)(blockIdx.x * 2 + __builtin_amdgcn_readfirstlane(threadIdx.x >> 8)))
#define VGRID ((int)(gridDim.x * 2))
#define VTID ((int)(threadIdx.x & 255))
constexpr int HALF_LDS = 73728;
constexpr int LDS_BYTES = 2 * HALF_LDS;
DI int opaque_v(int x) { asm volatile("" : "+v"(x)); return x; }
DI int opaque_s(int x) { x = __builtin_amdgcn_readfirstlane(x); asm volatile("" : "+s"(x)); return x; }
DI size_t opaque_zero() { size_t z = 0; asm volatile("" : "+s"(z)); return z; }
DI unsigned char* opaque_ws(unsigned char* w) { return w + opaque_zero(); }
DI float* opaque_out(float* w) { return w + opaque_zero(); }
DI unsigned short f2bf(float x) { unsigned u = __float_as_uint(x); u += 0x7fffu + ((u >> 16) & 1u); return (unsigned short)(u >> 16); }
DI float bf2f(unsigned short h) { return __uint_as_float(((unsigned)h) << 16); }
DI unsigned pack2(float a, float b) { return (unsigned)f2bf(a) | ((unsigned)f2bf(b) << 16); }
DI f32x4 mfma16(bf16x8 a, bf16x8 b, f32x4 c) { return __builtin_amdgcn_mfma_f32_16x16x32_bf16(a, b, c, 0, 0, 0); }
DI float fexp2(float x) { return __builtin_amdgcn_exp2f(x); }
DI bf16x8 pack8(float a0, float a1, float a2, float a3, float a4, float a5, float a6, float a7) {
    uint4 u;
    asm volatile("s_nop 1\n\tv_cvt_pk_bf16_f32 %0, %4, %5\n\tv_cvt_pk_bf16_f32 %1, %6, %7\n\tv_cvt_pk_bf16_f32 %2, %8, %9\n\tv_cvt_pk_bf16_f32 %3, %10, %11\n\ts_nop 1"
                 : "=&v"(u.x), "=&v"(u.y), "=&v"(u.z), "=&v"(u.w)
                 : "v"(a0), "v"(a1), "v"(a2), "v"(a3), "v"(a4), "v"(a5), "v"(a6), "v"(a7));
    return __builtin_bit_cast(bf16x8, u);
}
DI bf16x8 cat4(bf16x4 a, bf16x4 b) { return __builtin_shufflevector(a, b, 0, 1, 2, 3, 4, 5, 6, 7); }
DI float wave_sum(float v) {
#pragma unroll
    for (int o = 32; o > 0; o >>= 1) v += __shfl_xor(v, o);
    return v;
}
DI float grp_sum(float v) {
    auto r = __builtin_amdgcn_permlane16_swap(__float_as_uint(v), __float_as_uint(v), false, false);
    v = __uint_as_float(r[0]) + __uint_as_float(r[1]);
    auto q = __builtin_amdgcn_permlane32_swap(__float_as_uint(v), __float_as_uint(v), false, false);
    return __uint_as_float(q[0]) + __uint_as_float(q[1]);
}
DI float grp_max(float v) {
    auto r = __builtin_amdgcn_permlane16_swap(__float_as_uint(v), __float_as_uint(v), false, false);
    v = fmaxf(__uint_as_float(r[0]), __uint_as_float(r[1]));
    auto q = __builtin_amdgcn_permlane32_swap(__float_as_uint(v), __float_as_uint(v), false, false);
    return fmaxf(__uint_as_float(q[0]), __uint_as_float(q[1]));
}

DI void transpose_job(const float* __restrict__ src, bf16_t* __restrict__ dst, int R, int C, int Cpad, int nmat, float* tile, bool blocked = false,
                      int vb = -1, int vg = 0) {
    if (vb < 0) { vb = VBID; vg = VGRID; }
    const int tid = VTID;
    const int rt = R >> 6, ct = Cpad >> 6, per = rt * ct, total = per * nmat;
    for (int it = vb; it < total; it += vg) {
        const int mat = it / per, rem = it - mat * per;
        const int r0 = (rem / ct) << 6, c0 = (rem % ct) << 6;
        const float* s = src + (size_t)mat * R * C;
        bf16_t* d = dst + (size_t)mat * Cpad * R;
#pragma unroll
        for (int i = 0; i < 4; ++i) {
            const int r = (tid >> 4) + 16 * i, c = (tid & 15) * 4;
            float4 v = make_float4(0.f, 0.f, 0.f, 0.f);
            if (c0 + c < C) v = *(const float4*)(s + (size_t)(r0 + r) * C + c0 + c);
            tile[r * 65 + c + 0] = v.x; tile[r * 65 + c + 1] = v.y; tile[r * 65 + c + 2] = v.z; tile[r * 65 + c + 3] = v.w;
        }
        __syncthreads();
        {
            const int c = tid >> 2, rs = (tid & 3) * 16;
            uint4 o0, o1;
            o0.x = pack2(tile[(rs + 0) * 65 + c], tile[(rs + 1) * 65 + c]);
            o0.y = pack2(tile[(rs + 2) * 65 + c], tile[(rs + 3) * 65 + c]);
            o0.z = pack2(tile[(rs + 4) * 65 + c], tile[(rs + 5) * 65 + c]);
            o0.w = pack2(tile[(rs + 6) * 65 + c], tile[(rs + 7) * 65 + c]);
            o1.x = pack2(tile[(rs + 8) * 65 + c], tile[(rs + 9) * 65 + c]);
            o1.y = pack2(tile[(rs + 10) * 65 + c], tile[(rs + 11) * 65 + c]);
            o1.z = pack2(tile[(rs + 12) * 65 + c], tile[(rs + 13) * 65 + c]);
            o1.w = pack2(tile[(rs + 14) * 65 + c], tile[(rs + 15) * 65 + c]);
            uint4* dp = blocked ? (uint4*)(d + ((size_t)((r0 + rs) >> 5) * Cpad + (c0 + c)) * 32 + ((r0 + rs) & 31))
                                : (uint4*)(d + (size_t)(c0 + c) * R + r0 + rs);
            dp[0] = o0; dp[1] = o1;
        }
        __syncthreads();
    }
}

DI void convert_job(const float* __restrict__ src, bf16_t* __restrict__ dst, size_t n) {
    for (size_t i = ((size_t)VBID * 256 + VTID) * 8; i < n; i += (size_t)VGRID * 256 * 8) {
        const float4 a = *(const float4*)(src + i), b = *(const float4*)(src + i + 4);
        uint4 o; o.x = pack2(a.x, a.y); o.y = pack2(a.z, a.w); o.z = pack2(b.x, b.y); o.w = pack2(b.z, b.w);
        *(uint4*)(dst + i) = o;
    }
}

DI void prep0(const Params& pin, unsigned char* smem) {
    const Params& p = pin; unsigned char* const ws_ = opaque_ws(pin.ws); float* const out_ = opaque_out(pin.out); const int tid = opaque_v(VTID);
    {
        float* sl = (float*)smem; float* red = (float*)(smem + 12288);
        for (int i = tid; i < 3072; i += 256) {
            const int cnd = i >> 10, k = i & 1023;
            const float v = (cnd == 0) ? p.c_ctx[k] : p.c[(cnd - 1) * 1024 + k];
            sl[i] = v / (1.f + __expf(-v));
        }
        __syncthreads();
        float* mod = (float*)(ws_ + OFF_MOD);
        const int kg = tid >> 4, cl = tid & 15;
        for (int it = VBID; it < 384; it += VGRID) {
            const int l = it / 96, j0 = (it % 96) * 64;
            const float* w = p.ada_w + (size_t)l * 1024 * 6144 + j0 + cl * 4;
            float4 a0 = make_float4(0, 0, 0, 0), a1 = a0, a2 = a0;
#pragma unroll 8
            for (int kk = 0; kk < 64; ++kk) {
                const int k = kg * 64 + kk;
                const float4 wv = *(const float4*)(w + (size_t)k * 6144);
                const float s0 = sl[k], s1 = sl[1024 + k], s2 = sl[2048 + k];
                a0.x += s0 * wv.x; a0.y += s0 * wv.y; a0.z += s0 * wv.z; a0.w += s0 * wv.w;
                a1.x += s1 * wv.x; a1.y += s1 * wv.y; a1.z += s1 * wv.z; a1.w += s1 * wv.w;
                a2.x += s2 * wv.x; a2.y += s2 * wv.y; a2.z += s2 * wv.z; a2.w += s2 * wv.w;
            }
            __syncthreads();
            float* r = red + kg * 192 + cl * 4;
            r[0] = a0.x; r[1] = a0.y; r[2] = a0.z; r[3] = a0.w;
            r[64] = a1.x; r[65] = a1.y; r[66] = a1.z; r[67] = a1.w;
            r[128] = a2.x; r[129] = a2.y; r[130] = a2.z; r[131] = a2.w;
            __syncthreads();
            if (tid < 192) {
                const int cnd = tid >> 6, col = tid & 63;
                float s = 0.f;
#pragma unroll
                for (int q = 0; q < 16; ++q) s += red[q * 192 + tid];
                mod[(l * 3 + cnd) * 6144 + j0 + col] = s + p.ada_b[l * 6144 + j0 + col];
            }
        }
        __syncthreads();
    }
    if (VBID == VGRID - 1) {
        float* rope = (float*)(ws_ + OFF_ROPE);
        for (int i = tid; i < 1024; i += 256) {
            const int pos = i >> 4, j = i & 15;
            const float freq = powf(10000.f, -(float)j / 16.f);
            float s, c; sincosf((float)pos * freq, &s, &c);
            rope[i] = c; rope[1024 + i] = s;
        }
        if (tid < 4) {
            const float* lp = p.diff_lambda + tid * 256;
            float s1 = 0.f, s2 = 0.f;
            for (int i = 0; i < 64; ++i) { s1 += lp[i] * lp[64 + i]; s2 += lp[128 + i] * lp[192 + i]; }
            const float li = 0.8f - 0.6f * expf(-0.3f * (float)tid);
            float* lam = (float*)(ws_ + OFF_LAM);
            lam[tid * 2] = expf(s1) - expf(s2) + li; lam[tid * 2 + 1] = li;
        }
    }
    float* tile = (float*)smem;
    transpose_job(p.w_in, (bf16_t*)(ws_ + OFF_WT_IN), 1024, NIN, NINP, 1, tile);
    transpose_job(p.w_out, (bf16_t*)(ws_ + OFF_WT_OUT), 1024, 1024, 1024, 1, tile);
    transpose_job(p.w_mlp1, (bf16_t*)(ws_ + OFF_WT_1), 1024, 4096, 4096, 1, tile);
    transpose_job(p.w_mlp2, (bf16_t*)(ws_ + OFF_WT_2), 4096, 1024, 1024, 1, tile);
    transpose_job(p.cache_a_v, (bf16_t*)(ws_ + OFF_CAVT), 512, 128, 128, 32, tile, true);
    transpose_job(p.cache_b_v, (bf16_t*)(ws_ + OFF_CBVT), 512, 64, 64, 32, tile, true);
    transpose_job(p.state_c, (bf16_t*)(ws_ + OFF_C0T), 64, 64, 64, 64, tile);
    convert_job(p.cache_a_k, (bf16_t*)(ws_ + OFF_CAK), (size_t)32 * 512 * 128);
    convert_job(p.cache_b_k, (bf16_t*)(ws_ + OFF_CBK), (size_t)32 * 512 * 64);
}

DI void prep1(const Params& pin) {
    const Params& p = pin; unsigned char* const ws_ = opaque_ws(pin.ws); float* const out_ = opaque_out(pin.out); const int tid_ = opaque_v(threadIdx.x); const int lane = tid_ & 63, wave = tid_ >> 6;
    const float* mod = (const float*)(ws_ + OFF_MOD);
    float* X = (float*)(ws_ + OFF_X);
    bf16_t* H = (bf16_t*)(ws_ + OFF_H);
    for (int row = blockIdx.x * 8 + wave; row < NTOK; row += gridDim.x * 8) {
        const float* src = row < NCTX ? p.x_prompt + (size_t)row * 1024 : p.x_sample + (size_t)(row - NCTX) * 1024;
        const int cnd = row < NCTX ? 0 : 1 + ((row - NCTX) >> 10);
        const float* md = mod + (size_t)cnd * 6144;
#pragma unroll
        for (int j = 0; j < 4; ++j) {
            const int c = lane * 4 + 256 * j;
            const float4 v = *(const float4*)(src + c);
            *(float4*)(X + (size_t)row * 1024 + c) = v;
            const float4 sh = *(const float4*)(md + c), sc = *(const float4*)(md + 1024 + c);
            uint2 o; o.x = pack2(v.x * (1.f + sc.x) + sh.x, v.y * (1.f + sc.y) + sh.y);
            o.y = pack2(v.z * (1.f + sc.z) + sh.z, v.w * (1.f + sc.w) + sh.w);
            *(uint2*)(H + (size_t)row * 1024 + c) = o;
        }
    }
}

enum { EPI_INPROJ = 0, EPI_LN1 = 1, EPI_RELU2 = 2, EPI_LN2 = 3 };

DI void epi_inproj(const Params& p, unsigned char* ws_, float* out_, int layer, const float* T, int rowbase, int colbase, int lane) {
    if (colbase >= NIN) return;
    bf16_t* P = (bf16_t*)(ws_ + OFF_P);
    const bool latent = rowbase >= NCTX;
    const int seq_tok0 = latent ? (NCTX + ((rowbase - NCTX) & ~1023)) : (rowbase & ~255);
    const int nseq = latent ? 1024 : 256;
    const int bctx = seq_tok0 >> 8;
    const int n0 = rowbase - seq_tok0;
    if (colbase >= 3328) {
        float* G = (float*)(ws_ + OFF_G);
        const float bias = p.gate_bias[layer * 16 + (lane & 15)];
        for (int rr = 0; rr < 16; ++rr) {
            const int r = rr * 4 + (lane >> 4);
            G[(size_t)(rowbase + r) * 16 + (lane & 15)] = T[r * 65 + (lane & 15)] + bias;
        }
        return;
    }
    bool toP = false, rope = false, toT = false, toO = false;
    size_t toff = 0, obase = 0; int tW = 0, tcr = 0, ohd = 64, ocr = 0;
    if (colbase < 1024) { toP = true; rope = latent; if (colbase >= 512) { toO = !latent; obase = O_AK; ohd = 128; ocr = colbase - 512; } }
    else if (colbase < 1536) { toT = true; toff = OFF_PT_AV; tW = 512; tcr = colbase - 1024; toO = !latent; obase = O_AV; ohd = 128; ocr = tcr; }
    else if (colbase < 1792) { toP = true; }
    else if (colbase < 2048) { toP = true; toO = !latent; obase = O_BK; ohd = 64; ocr = colbase - 1792; }
    else if (colbase < 2304) { toT = true; toff = OFF_PT_BV; tW = 256; tcr = colbase - 2048; toO = !latent; obase = O_BV; ohd = 64; ocr = tcr; }
    else if (colbase < 2560) { toP = true; }
    else if (colbase < 2816) { toP = true; toT = true; toff = OFF_PT_CK; tW = 256; tcr = colbase - 2560; }
    else if (colbase < 3072) { toT = true; toff = OFF_PT_CV; tW = 256; tcr = colbase - 2816; }
    else { toP = true; }
    if (toO) {
        const int h = ocr / ohd, w = ocr - h * ohd + lane;
        float* O = out_ + obase + (((size_t)(bctx * 4 + layer) * 4 + h) * 256 + n0) * ohd + w;
#pragma unroll 4
        for (int r = 0; r < 64; ++r) O[(size_t)r * ohd] = T[r * 65 + lane];
    }
    if (toP) {
        bf16_t* Pp = P + (size_t)rowbase * NIN + colbase + lane;
        if (rope) {
            const float* rc = (const float*)(ws_ + OFF_ROPE);
            const float* rs = rc + 1024;
#pragma unroll 4
            for (int r = 0; r < 64; ++r) {
                const float v = T[r * 65 + lane], vp = T[r * 65 + (lane ^ 16)];
                const int t = n0 + r;
                const int pos = (lane < 32) ? (t >> 6) : (t & 63);
                const float c = rc[pos * 16 + (lane & 15)], sn = rs[pos * 16 + (lane & 15)];
                const float o = (lane & 16) ? (vp * sn + v * c) : (v * c - vp * sn);
                Pp[(size_t)r * NIN] = f2bf(o);
            }
        } else {
#pragma unroll 4
            for (int r = 0; r < 64; ++r) Pp[(size_t)r * NIN] = f2bf(T[r * 65 + lane]);
        }
    }
    if (toT) {
        const int n = n0 + lane;
        bf16_t* Tp = (bf16_t*)(ws_ + toff) + (size_t)seq_tok0 * tW + ((size_t)(n >> 5) * tW + tcr) * 32 + (n & 31);
#pragma unroll 4
        for (int c = 0; c < 64; ++c) Tp[(size_t)c * 32] = f2bf(T[lane * 65 + c]);
    }
}

template <int WHICH>
DI void epi_ln(const Params& p, unsigned char* ws_, float* out_, int l, float* T, int tm, int tn, int wn, int rowbase, int colbase, int lane, int tid) {
    const float* mod = (const float*)(ws_ + OFF_MOD);
    float* X = (float*)(ws_ + OFF_X);
    bf16_t* H = (bf16_t*)(ws_ + OFF_H);
    const int cnd = rowbase < NCTX ? 0 : 1 + ((rowbase - NCTX) >> 10);
    const float* md = mod + (size_t)(l * 3 + cnd) * 6144;
    const int col = colbase + lane;
    const bool last = (WHICH == 2 && l == 3);
    float s1 = 0.f, s2 = 0.f;
#pragma unroll 8
    for (int c = 0; c < 64; ++c) { const float v = T[lane * 65 + c]; s1 += v; s2 += v * v; }
    unsigned long long* stats = (unsigned long long*)(ws_ + OFF_STATS);
    __hip_atomic_store(stats + (size_t)(rowbase + lane) * 16 + tn * 2 + wn,
                       ((unsigned long long)__float_as_uint(s2) << 32) | (unsigned long long)__float_as_uint(s1), __ATOMIC_RELAXED, __HIP_MEMORY_SCOPE_AGENT);
    unsigned* cnt = (unsigned*)(ws_ + OFF_LNCNT) + (l * 2 + (WHICH - 1)) * 48 + tm;
    asm volatile("s_waitcnt vmcnt(0)" ::: "memory");
    __syncthreads();
    if (tid == 0) {
        (void)__hip_atomic_fetch_add(cnt, 1u, __ATOMIC_RELAXED, __HIP_MEMORY_SCOPE_AGENT);
        unsigned sp = 0;
        while (__hip_atomic_load(cnt, __ATOMIC_RELAXED, __HIP_MEMORY_SCOPE_AGENT) < 8u) { __builtin_amdgcn_s_sleep(1); if (++sp > (1u << 22)) break; }
    }
    __syncthreads();
    float t1 = 0.f, t2 = 0.f;
    {
        unsigned long long* sp8 = stats + (size_t)(rowbase + lane) * 16;
        unsigned long long a[16];
#pragma unroll
        for (int q = 0; q < 16; ++q) a[q] = __hip_atomic_load(sp8 + q, __ATOMIC_RELAXED, __HIP_MEMORY_SCOPE_AGENT);
#pragma unroll
        for (int q = 0; q < 16; ++q) { t1 += __uint_as_float((unsigned)a[q]); t2 += __uint_as_float((unsigned)(a[q] >> 32)); }
    }
    const float mu = t1 * (1.f / 1024.f);
    const float rstd = rsqrtf(fmaxf(t2 * (1.f / 1024.f) - mu * mu, 0.f) + LN_EPS);
    const float lng = (WHICH == 1 ? p.ln1_g : p.ln2_g)[l * 1024 + col], lnb = (WHICH == 1 ? p.ln1_b : p.ln2_b)[l * 1024 + col];
    if (last) {
        float* op = out_ + (size_t)rowbase * 1024 + col;
#pragma unroll 8
        for (int r = 0; r < 64; ++r) op[(size_t)r * 1024] = (T[r * 65 + lane] - __uint_as_float(__builtin_amdgcn_readlane(__float_as_uint(mu), r))) * __uint_as_float(__builtin_amdgcn_readlane(__float_as_uint(rstd), r)) * lng + lnb;
    } else {
        const float* nmd = (WHICH == 1) ? md : mod + (size_t)((l + 1) * 3 + cnd) * 6144;
        const float sh = nmd[(WHICH == 1 ? 3072 : 0) + col], sc1p = 1.f + nmd[(WHICH == 1 ? 4096 : 1024) + col];
        float* xp = X + (size_t)rowbase * 1024 + col;
        bf16_t* hp = H + (size_t)rowbase * 1024 + col;
#pragma unroll 8
        for (int r = 0; r < 64; ++r) {
            const float o = (T[r * 65 + lane] - __uint_as_float(__builtin_amdgcn_readlane(__float_as_uint(mu), r))) * __uint_as_float(__builtin_amdgcn_readlane(__float_as_uint(rstd), r)) * lng + lnb;
            xp[(size_t)r * 1024] = o;
            hp[(size_t)r * 1024] = f2bf(o * sc1p + sh);
        }
    }
}

template <int EPI>
DI void gemm_phase(const Params& pin, int layer, size_t offA, size_t offB, int ntn, int K, int ldc,
                   unsigned char* smem) {
    const Params& p = pin; unsigned char* const ws_ = opaque_ws(pin.ws); float* const out_ = opaque_out(pin.out); const int tid = opaque_v(threadIdx.x), lane = tid & 63, wave = opaque_s(tid >> 6);
    const bf16_t* __restrict__ A = (const bf16_t*)(ws_ + offA); const bf16_t* __restrict__ Bt = (const bf16_t*)(ws_ + offB);
    const int wm = wave >> 1, wn = wave & 1;
    const int lr = lane & 15, g = lane >> 4;
    const int ntm = NTOK / 256;
    const int ntiles = ntm * ntn, nk = K >> 6;
    constexpr int STAGE = 49152;
    bool prefetched = false;
    for (int tile = blockIdx.x; tile < ntiles; tile += gridDim.x) {
        const int tm = tile % ntm, tn = tile / ntm;
        const int m0 = tm * 256, n0 = tn * 128;
        f32x4 acc[4][4];
#pragma unroll
        for (int mi = 0; mi < 4; ++mi)
#pragma unroll
            for (int ni = 0; ni < 4; ++ni) acc[mi][ni] = (f32x4){0.f, 0.f, 0.f, 0.f};
        const bf16_t* Ag = A + (size_t)m0 * K;
        const bf16_t* Bg = Bt + (size_t)n0 * K;
        const bf16_t* ag = Ag + (size_t)(wave * 32 + (lane >> 3)) * K + (((lane & 7) ^ (lane >> 3)) << 3);
        const bf16_t* bg = Bg + (size_t)(wave * 16 + (lane >> 3)) * K + (((lane & 7) ^ (lane >> 3)) << 3);
        auto stage_from = [&](const bf16_t* ap, const bf16_t* bp, int t) {
            unsigned char* dst = smem + (t % 3) * STAGE;
            const int k0 = t << 6;
#pragma unroll
            for (int j = 0; j < 4; ++j)
                __builtin_amdgcn_global_load_lds((const unsigned*)(ap + (size_t)j * 8 * K + k0), (LAS unsigned*)(dst + (wave * 4 + j) * 1024), 16, 0, 0);
#pragma unroll
            for (int j = 0; j < 2; ++j)
                __builtin_amdgcn_global_load_lds((const unsigned*)(bp + (size_t)j * 8 * K + k0), (LAS unsigned*)(dst + 32768 + (wave * 2 + j) * 1024), 16, 0, 0);
        };
        auto stage = [&](int t) { stage_from(ag, bg, t); };
        auto read_half = [&](int t, int kk, bf16x8 (&af)[4], bf16x8 (&bfr)[4]) {
            const unsigned char* cur = smem + (t % 3) * STAGE;
#pragma unroll
            for (int mi = 0; mi < 4; ++mi) {
                const int row = wm * 64 + mi * 16 + lr;
                af[mi] = *(const bf16x8*)(cur + row * 128 + (((kk * 4 + g) ^ (row & 7)) << 4));
            }
#pragma unroll
            for (int ni = 0; ni < 4; ++ni) {
                const int row = wn * 64 + ni * 16 + lr;
                bfr[ni] = *(const bf16x8*)(cur + 32768 + row * 128 + (((kk * 4 + g) ^ (row & 7)) << 4));
            }
        };
        if (!prefetched) { stage(0); stage(1); stage(2); }
        bf16x8 a0[4], b0[4], a1[4], b1[4];
        asm volatile("s_waitcnt vmcnt(12)" ::: "memory");
        asm volatile("s_waitcnt lgkmcnt(0)" ::: "memory");
        __builtin_amdgcn_s_barrier();
        read_half(0, 0, a0, b0);
        for (int kt = 0; kt < nk; ++kt) {
            read_half(kt, 1, a1, b1);
#pragma unroll
            for (int mi = 0; mi < 4; ++mi)
#pragma unroll
                for (int ni = 0; ni < 4; ++ni) acc[mi][ni] = mfma16(a0[mi], b0[ni], acc[mi][ni]);
            __builtin_amdgcn_sched_barrier(0);
            if (kt + 2 < nk) asm volatile("s_waitcnt vmcnt(6)" ::: "memory");
            else asm volatile("s_waitcnt vmcnt(0)" ::: "memory");
            asm volatile("s_waitcnt lgkmcnt(0)" ::: "memory");
            __builtin_amdgcn_s_barrier();
            if (kt + 1 < nk) read_half(kt + 1, 0, a0, b0);
            if (kt + 3 < nk) stage(kt + 3);
#pragma unroll
            for (int mi = 0; mi < 4; ++mi)
#pragma unroll
                for (int ni = 0; ni < 4; ++ni) acc[mi][ni] = mfma16(a1[mi], b1[ni], acc[mi][ni]);
            __builtin_amdgcn_sched_barrier(0);
        }
        asm volatile("s_waitcnt lgkmcnt(0)" ::: "memory");
        __builtin_amdgcn_s_barrier();
        if (EPI == EPI_RELU2) {
            const int ntile = tile + (int)gridDim.x;
            prefetched = ntile < ntiles;
            if (prefetched) {
                const int tm2 = ntile % ntm, tn2 = ntile / ntm;
                const bf16_t* ag2 = A + (size_t)(tm2 * 256 + wave * 32 + (lane >> 3)) * K + (((lane & 7) ^ (lane >> 3)) << 3);
                const bf16_t* bg2 = Bt + (size_t)(tn2 * 128 + wave * 16 + (lane >> 3)) * K + (((lane & 7) ^ (lane >> 3)) << 3);
                stage_from(ag2, bg2, 0); stage_from(ag2, bg2, 1); stage_from(ag2, bg2, 2);
            }
            bf16_t* U = (bf16_t*)(ws_ + OFF_U) + (size_t)(m0 + wm * 64 + 4 * g) * ldc + n0 + wn * 64 + lr;
#pragma unroll
            for (int mi = 0; mi < 4; ++mi)
#pragma unroll
                for (int ni = 0; ni < 4; ++ni)
#pragma unroll
                    for (int i = 0; i < 4; ++i) {
                        const float v = fmaxf(acc[mi][ni][i], 0.f);
                        U[(size_t)(mi * 16 + i) * ldc + ni * 16] = f2bf(v * v);
                    }
            continue;
        }
        if (EPI == EPI_LN1 || EPI == EPI_LN2) {
            const int rb = m0 + wm * 64, cb = n0 + wn * 64;
            const int cnd = rb < NCTX ? 0 : 1 + ((rb - NCTX) >> 10);
            const float* gp = (const float*)(ws_ + OFF_MOD) + (size_t)(layer * 3 + cnd) * 6144 + (EPI == EPI_LN1 ? 2048 : 5120) + cb + lr;
            const float* xp = (const float*)(ws_ + OFF_X) + (size_t)(rb + 4 * g) * 1024 + cb + lr;
            float gt[4];
#pragma unroll
            for (int ni = 0; ni < 4; ++ni) gt[ni] = gp[ni * 16];
#pragma unroll
            for (int mh = 0; mh < 2; ++mh) {
                f32x4 xv[2][4];
#pragma unroll
                for (int m2 = 0; m2 < 2; ++m2)
#pragma unroll
                    for (int ni = 0; ni < 4; ++ni)
#pragma unroll
                        for (int i = 0; i < 4; ++i) xv[m2][ni][i] = xp[(size_t)((mh * 2 + m2) * 16 + i) * 1024 + ni * 16];
#pragma unroll
                for (int m2 = 0; m2 < 2; ++m2)
#pragma unroll
                    for (int ni = 0; ni < 4; ++ni)
#pragma unroll
                        for (int i = 0; i < 4; ++i) acc[mh * 2 + m2][ni][i] = ALPHA * xv[m2][ni][i] + gt[ni] * acc[mh * 2 + m2][ni][i];
                __builtin_amdgcn_sched_barrier(0);
            }
        }
        float* T = (float*)smem + wave * (64 * 65);
#pragma unroll
        for (int mi = 0; mi < 4; ++mi)
#pragma unroll
            for (int ni = 0; ni < 4; ++ni)
#pragma unroll
                for (int i = 0; i < 4; ++i) T[(mi * 16 + 4 * g + i) * 65 + ni * 16 + lr] = acc[mi][ni][i];
        const int rowbase = m0 + wm * 64, colbase = n0 + wn * 64;
        if (EPI == EPI_INPROJ) {
            epi_inproj(p, ws_, out_, layer, T, rowbase, colbase, lane);
        } else if (EPI == EPI_LN1) {
            epi_ln<1>(p, ws_, out_, layer, T, tm, tn, wn, rowbase, colbase, lane, tid);
        } else if (EPI == EPI_LN2) {
            epi_ln<2>(p, ws_, out_, layer, T, tm, tn, wn, rowbase, colbase, lane, tid);
        } else {
            bf16_t* U = (bf16_t*)(ws_ + OFF_U) + (size_t)rowbase * ldc + colbase + lane;
#pragma unroll 4
            for (int r = 0; r < 64; ++r) { const float v = fmaxf(T[r * 65 + lane], 0.f); U[(size_t)r * ldc] = f2bf(v * v); }
        }
        __syncthreads();
    }
    if ((EPI == EPI_LN1 || EPI == EPI_LN2) && layer < 3 && (int)blockIdx.x >= ntiles) {
        const int half = __builtin_amdgcn_readfirstlane(threadIdx.x >> 8);
        const int vb = ((int)blockIdx.x - ntiles) * 2 + half, vg = ((int)gridDim.x - ntiles) * 2;
        float* tile = (float*)(smem + half * HALF_LDS);
        const int nl = layer + 1;
        if (EPI == EPI_LN1) {
            transpose_job(p.w_in + (size_t)nl * 1024 * NIN, (bf16_t*)(ws_ + OFF_WT_IN) + (size_t)nl * NINP * DM, 1024, NIN, NINP, 1, tile, false, vb, vg);
            transpose_job(p.w_out + (size_t)nl * 1024 * 1024, (bf16_t*)(ws_ + OFF_WT_OUT) + (size_t)nl * DM * DM, 1024, 1024, 1024, 1, tile, false, vb, vg);
        } else {
            transpose_job(p.w_mlp1 + (size_t)nl * 1024 * 4096, (bf16_t*)(ws_ + OFF_WT_1) + (size_t)nl * DFF * DM, 1024, 4096, 4096, 1, tile, false, vb, vg);
            transpose_job(p.w_mlp2 + (size_t)nl * 4096 * 1024, (bf16_t*)(ws_ + OFF_WT_2) + (size_t)nl * DM * DFF, 4096, 1024, 1024, 1, tile, false, vb, vg);
        }
    }
}

template <int NMAP, int DV>
struct AttnSt { f32x4 O[NMAP][DV / 16]; float m[NMAP]; float l[NMAP]; };
template <int NMAP, int DV>
struct UnitFrags { bf16x8 k[NMAP][2][2]; bf16x8 v[DV / 16]; };

template <int NMAP, int DV>
struct TileGeom {
    static constexpr int KROW = NMAP * 128, KBYTES = 64 * KROW, VUNIT = DV * 64, TBYTES = KBYTES + 2 * VUNIT;
};
DI int kswz(int row) { return (row & 3) | (((row >> 3) & 3) << 2); }

template <int NMAP, int DV>
DI void stage_tile(unsigned char* buf, const bf16_t* kg, int kstride, const bf16_t* vg, int vunit, int wave, int lane) {
    typedef TileGeom<NMAP, DV> TG;
    if (NMAP == 2) {
#pragma unroll
        for (int j = 0; j < 4; ++j) {
            const int jj = wave * 4 + j, row = jj * 4 + (lane >> 4), lc = (lane & 15) ^ kswz(row);
            __builtin_amdgcn_global_load_lds((const unsigned*)(kg + (size_t)row * kstride + lc * 8), (LAS unsigned*)(buf + jj * 1024), 16, 0, 0);
        }
    } else {
#pragma unroll
        for (int j = 0; j < 2; ++j) {
            const int jj = wave * 2 + j, row = jj * 8 + (lane >> 3), lc = (lane & 7) ^ (kswz(row) >> 1);
            __builtin_amdgcn_global_load_lds((const unsigned*)(kg + (size_t)row * kstride + lc * 8), (LAS unsigned*)(buf + jj * 1024), 16, 0, 0);
        }
    }
    constexpr int VI = TG::VUNIT / 1024, PER = 2 * VI / 4;
#pragma unroll
    for (int j = 0; j < PER; ++j) {
        const int jj = wave * PER + j, unit = jj / VI, piece = jj % VI;
        __builtin_amdgcn_global_load_lds((const unsigned*)(vg + (size_t)unit * vunit + piece * 512 + lane * 8),
                                         (LAS unsigned*)(buf + TG::KBYTES + jj * 1024), 16, 0, 0);
    }
}

template <int NMAP, int DV>
DI void lds_unit(UnitFrags<NMAP, DV>& f, const unsigned char* buf, int rowbase, int voff, int lr, int g) {
    typedef TileGeom<NMAP, DV> TG;
#pragma unroll
    for (int b = 0; b < 2; ++b) {
        const int row = rowbase + (lr >> 2) * 8 + (lr & 3) + 4 * b, sw = kswz(row);
        if (NMAP == 2) {
#pragma unroll
            for (int m = 0; m < NMAP; ++m)
#pragma unroll
                for (int kk = 0; kk < 2; ++kk) f.k[m][b][kk] = *(const bf16x8*)(buf + row * 256 + (((m * 8 + kk * 4 + g) ^ sw) << 4));
        } else {
#pragma unroll
            for (int kk = 0; kk < 2; ++kk) f.k[0][b][kk] = *(const bf16x8*)(buf + row * 128 + (((kk * 4 + g) ^ (sw >> 1)) << 4));
        }
    }
#pragma unroll
    for (int vb = 0; vb < DV / 16; ++vb) f.v[vb] = *(const bf16x8*)(buf + TG::KBYTES + voff + (vb * 16 + lr) * 64);
}

template <int DV>
DI void lds_unit_sel(UnitFrags<1, DV>& f, const unsigned char* buf, int rowbase, int voff, int lr, int g, int msel) {
    typedef TileGeom<2, DV> TG;
#pragma unroll
    for (int b = 0; b < 2; ++b) {
        const int row = rowbase + (lr >> 2) * 8 + (lr & 3) + 4 * b, sw = kswz(row);
#pragma unroll
        for (int kk = 0; kk < 2; ++kk) f.k[0][b][kk] = *(const bf16x8*)(buf + row * 256 + (((msel * 8 + kk * 4 + g) ^ sw) << 4));
    }
#pragma unroll
    for (int vb = 0; vb < DV / 16; ++vb) f.v[vb] = *(const bf16x8*)(buf + TG::KBYTES + voff + (vb * 16 + lr) * 64);
}

template <int NMAP, int DV, class SrcFn, class CompFn>
DI void tile_pipeline(unsigned char* tiles, int nt, int wave, int lane, SrcFn src, CompFn comp) {
    typedef TileGeom<NMAP, DV> TG;
    {
        const bf16_t *kg, *vg; int ks, vu;
        src(0, kg, ks, vg, vu);
        stage_tile<NMAP, DV>(tiles, kg, ks, vg, vu, wave, lane);
    }
    asm volatile("s_waitcnt vmcnt(0)" ::: "memory");
    __syncthreads();
    for (int t = 0; t < nt; ++t) {
        unsigned char* cur = tiles + (t & 1) * TG::TBYTES;
        comp(t, cur, 0);
        if (t + 1 < nt) {
            const bf16_t *kg, *vg; int ks, vu;
            src(t + 1, kg, ks, vg, vu);
            stage_tile<NMAP, DV>(tiles + ((t + 1) & 1) * TG::TBYTES, kg, ks, vg, vu, wave, lane);
        }
        comp(t, cur, 1);
        asm volatile("s_waitcnt vmcnt(0)" ::: "memory");
        __syncthreads();
    }
}

template <int NMAP, int DV, bool HASBIAS>
DI void compute_unit(AttnSt<NMAP, DV>& st, const UnitFrags<NMAP, DV>& f, const bf16x8 (&qf)[NMAP][2], float sc, const float (&bias)[8]) {
    bf16x8 pk[NMAP];
#pragma unroll
    for (int m = 0; m < NMAP; ++m) {
        f32x4 sa = (f32x4){0.f, 0.f, 0.f, 0.f}, sb = sa;
        sa = mfma16(f.k[m][0][0], qf[m][0], sa); sa = mfma16(f.k[m][0][1], qf[m][1], sa);
        sb = mfma16(f.k[m][1][0], qf[m][0], sb); sb = mfma16(f.k[m][1][1], qf[m][1], sb);
        float s[8];
#pragma unroll
        for (int j = 0; j < 4; ++j) { s[j] = sa[j] * sc; s[4 + j] = sb[j] * sc; }
        if (HASBIAS) {
#pragma unroll
            for (int j = 0; j < 8; ++j) s[j] += bias[j];
        }
        float mx = fmaxf(fmaxf(fmaxf(s[0], s[1]), fmaxf(s[2], s[3])), fmaxf(fmaxf(s[4], s[5]), fmaxf(s[6], s[7])));
        mx = grp_max(mx);
        const float mnew = fmaxf(st.m[m], mx);
        const float alpha = fexp2(st.m[m] - mnew);
        float ps = 0.f;
#pragma unroll
        for (int j = 0; j < 8; ++j) { s[j] = fexp2(s[j] - mnew); ps += s[j]; }
        st.l[m] = st.l[m] * alpha + ps; st.m[m] = mnew;
        if (__builtin_amdgcn_ballot_w64(alpha != 1.f) != 0ull) {
#pragma unroll
            for (int vb = 0; vb < DV / 16; ++vb) st.O[m][vb] *= alpha;
        }
        pk[m] = pack8(s[0], s[1], s[2], s[3], s[4], s[5], s[6], s[7]);
    }
#pragma unroll
    for (int vb = 0; vb < DV / 16; ++vb) {
#pragma unroll
        for (int m = 0; m < NMAP; ++m) st.O[m][vb] = mfma16(f.v[vb], pk[m], st.O[m][vb]);
    }
}

template <int NMAP, int DV>
DI void attn_init(AttnSt<NMAP, DV>& st) {
#pragma unroll
    for (int m = 0; m < NMAP; ++m) {
        st.m[m] = -INFINITY; st.l[m] = 0.f;
#pragma unroll
        for (int vb = 0; vb < DV / 16; ++vb) st.O[m][vb] = (f32x4){0.f, 0.f, 0.f, 0.f};
    }
}

template <bool LAT>
DI void item_diffattn(const Params& pin, int l, int seq, int h, int qt, unsigned char* smem, int wave, int lane) {
    const Params& p = pin; unsigned char* const ws_ = opaque_ws(pin.ws); float* const out_ = opaque_out(pin.out); lane = opaque_v(lane); wave = opaque_s(wave);
    const int lr = lane & 15, g = lane >> 4;
    const int nseq = LAT ? 1024 : 256;
    const int tok0 = LAT ? NCTX + seq * 1024 : seq * 256;
    const bf16_t* P = (const bf16_t*)(ws_ + OFF_P);
    const int q0 = qt * 64 + wave * 16;
    bf16x8 qf[2][2];
    {
        const bf16_t* qp = P + (size_t)(tok0 + q0 + lr) * NIN + h * 128 + 8 * g;
#pragma unroll
        for (int m = 0; m < 2; ++m)
#pragma unroll
            for (int kk = 0; kk < 2; ++kk) qf[m][kk] = *(const bf16x8*)(qp + m * 64 + kk * 32);
    }
    AttnSt<2, 128> st;
    attn_init<2, 128>(st);
    const float sc = 0.125f * LOG2E;
    const size_t hb = (size_t)((seq * 4 + l) * 4 + h);
    const bf16_t* kc = (const bf16_t*)(ws_ + OFF_CAK) + hb * 512 * 128;
    const bf16_t* vc = (const bf16_t*)(ws_ + OFF_CAVT) + hb * 128 * 512;
    const bf16_t* kn = P + (size_t)tok0 * NIN + 512 + h * 128;
    const bf16_t* vn = (const bf16_t*)(ws_ + OFF_PT_AV) + (size_t)tok0 * 512 + (size_t)(h * 128) * 32;
    const int ncache = LAT ? 8 : 0;
    __syncthreads();
    tile_pipeline<2, 128>(smem, ncache + nseq / 64, wave, lane,
        [&](int t, const bf16_t*& kg, int& ks, const bf16_t*& vg, int& vu) {
            if (t < ncache) { kg = kc + (size_t)t * 64 * 128; ks = 128; vg = vc + (size_t)(2 * t) * 128 * 32; vu = 128 * 32; }
            else { const int tt = t - ncache; kg = kn + (size_t)tt * 64 * NIN; ks = NIN; vg = vn + (size_t)(2 * tt) * 512 * 32; vu = 512 * 32; }
        },
        [&](int t, const unsigned char* buf, int part) {
            const float nob[8] = {0.f, 0.f, 0.f, 0.f, 0.f, 0.f, 0.f, 0.f};
            { const int half = part;
                UnitFrags<2, 128> f;
                lds_unit<2, 128>(f, buf, 32 * half, half * TileGeom<2, 128>::VUNIT + g * 16, lr, g);
                compute_unit<2, 128, false>(st, f, qf, sc, nob);
            }
        });
    const float inv0 = 1.f / grp_sum(st.l[0]), inv1 = 1.f / grp_sum(st.l[1]);
    const float* lamp = (const float*)(ws_ + OFF_LAM);
    const float lam = lamp[l * 2], lam_init = lamp[l * 2 + 1];
    const float c1 = lam * inv1;
    float ss = 0.f;
#pragma unroll
    for (int vb = 0; vb < 8; ++vb)
#pragma unroll
        for (int i = 0; i < 4; ++i) {
            const float o = st.O[0][vb][i] * inv0 - st.O[1][vb][i] * c1;
            st.O[0][vb][i] = o; ss += o * o;
        }
    ss = grp_sum(ss);
    const float r = rsqrtf(ss * (1.f / 128.f) + LN_EPS) * (1.f - lam_init);
    bf16_t* MIX = (bf16_t*)(ws_ + OFF_MIX) + (size_t)(tok0 + q0 + lr) * 1024 + h * 128;
    const float* gn = p.diff_norm_g + l * 128;
#pragma unroll
    for (int vb = 0; vb < 8; ++vb) {
        const int v = vb * 16 + 4 * g;
        const float4 g4 = *(const float4*)(gn + v);
        uint2 o; o.x = pack2(st.O[0][vb][0] * r * g4.x, st.O[0][vb][1] * r * g4.y);
        o.y = pack2(st.O[0][vb][2] * r * g4.z, st.O[0][vb][3] * r * g4.w);
        *(uint2*)(MIX + v) = o;
    }
}

DI void item_diffattn_lat(const Params& pin, int l, int seq, int h, int qt32, unsigned char* smem, int wave, int lane) {
    const Params& p = pin; unsigned char* const ws_ = opaque_ws(pin.ws); float* const out_ = opaque_out(pin.out); lane = opaque_v(lane); wave = opaque_s(wave);
    const int lr = lane & 15, g = lane >> 4;
    const int tok0 = NCTX + seq * 1024;
    const bf16_t* P = (const bf16_t*)(ws_ + OFF_P);
    const int msel = wave & 1;
    const int q0 = qt32 * 32 + (wave >> 1) * 16;
    bf16x8 qf[1][2];
    {
        const bf16_t* qp = P + (size_t)(tok0 + q0 + lr) * NIN + h * 128 + msel * 64 + 8 * g;
        qf[0][0] = *(const bf16x8*)(qp); qf[0][1] = *(const bf16x8*)(qp + 32);
    }
    AttnSt<1, 128> st;
    attn_init<1, 128>(st);
    const float sc = 0.125f * LOG2E;
    const size_t hb = (size_t)((seq * 4 + l) * 4 + h);
    const bf16_t* kc = (const bf16_t*)(ws_ + OFF_CAK) + hb * 512 * 128;
    const bf16_t* vc = (const bf16_t*)(ws_ + OFF_CAVT) + hb * 128 * 512;
    const bf16_t* kn = P + (size_t)tok0 * NIN + 512 + h * 128;
    const bf16_t* vn = (const bf16_t*)(ws_ + OFF_PT_AV) + (size_t)tok0 * 512 + (size_t)(h * 128) * 32;
    __syncthreads();
    tile_pipeline<2, 128>(smem, 24, wave, lane,
        [&](int t, const bf16_t*& kg, int& ks, const bf16_t*& vg, int& vu) {
            if (t < 8) { kg = kc + (size_t)t * 64 * 128; ks = 128; vg = vc + (size_t)(2 * t) * 128 * 32; vu = 128 * 32; }
            else { const int tt = t - 8; kg = kn + (size_t)tt * 64 * NIN; ks = NIN; vg = vn + (size_t)(2 * tt) * 512 * 32; vu = 512 * 32; }
        },
        [&](int t, const unsigned char* buf, int part) {
            const float nob[8] = {0.f, 0.f, 0.f, 0.f, 0.f, 0.f, 0.f, 0.f};
            { const int half = part;
                UnitFrags<1, 128> f;
                lds_unit_sel<128>(f, buf, 32 * half, half * TileGeom<2, 128>::VUNIT + g * 16, lr, g, msel);
                compute_unit<1, 128, false>(st, f, qf, sc, nob);
            }
        });
    const float* lamp = (const float*)(ws_ + OFF_LAM);
    const float lam = lamp[l * 2], lam_init = lamp[l * 2 + 1];
    const float inv = (msel ? lam : 1.f) / grp_sum(st.l[0]);
    float* xb = (float*)smem + (wave >> 1) * 32 * 64 + lane;
    if (msel) {
#pragma unroll
        for (int vb = 0; vb < 8; ++vb)
#pragma unroll
            for (int i = 0; i < 4; ++i) xb[(vb * 4 + i) * 64] = st.O[0][vb][i] * inv;
    }
    __syncthreads();
    if (msel) return;
    float ss = 0.f;
#pragma unroll
    for (int vb = 0; vb < 8; ++vb)
#pragma unroll
        for (int i = 0; i < 4; ++i) {
            const float o = st.O[0][vb][i] * inv - xb[(vb * 4 + i) * 64];
            st.O[0][vb][i] = o; ss += o * o;
        }
    ss = grp_sum(ss);
    const float r = rsqrtf(ss * (1.f / 128.f) + LN_EPS) * (1.f - lam_init);
    bf16_t* MIX = (bf16_t*)(ws_ + OFF_MIX) + (size_t)(tok0 + q0 + lr) * 1024 + h * 128;
    const float* gn = p.diff_norm_g + l * 128;
#pragma unroll
    for (int vb = 0; vb < 8; ++vb) {
        const int v = vb * 16 + 4 * g;
        const float4 g4 = *(const float4*)(gn + v);
        uint2 o; o.x = pack2(st.O[0][vb][0] * r * g4.x, st.O[0][vb][1] * r * g4.y);
        o.y = pack2(st.O[0][vb][2] * r * g4.z, st.O[0][vb][3] * r * g4.w);
        *(uint2*)(MIX + v) = o;
    }
}

DI void item_dense(const Params& pin, int seq, int h, int qt, unsigned char* smem, int wave, int lane) {
    const Params& p = pin; unsigned char* const ws_ = opaque_ws(pin.ws); float* const out_ = opaque_out(pin.out); lane = opaque_v(lane); wave = opaque_s(wave);
    const int lr = lane & 15, g = lane >> 4;
    const int tok0 = seq * 256;
    const bf16_t* P = (const bf16_t*)(ws_ + OFF_P);
    const int q0 = qt * 64 + wave * 16;
    bf16x8 qf[1][2];
    {
        const bf16_t* qp = P + (size_t)(tok0 + q0 + lr) * NIN + 1536 + h * 64 + 8 * g;
        qf[0][0] = *(const bf16x8*)(qp); qf[0][1] = *(const bf16x8*)(qp + 32);
    }
    AttnSt<1, 64> st;
    attn_init<1, 64>(st);
    const bf16_t* kn = P + (size_t)tok0 * NIN + 1792 + h * 64;
    const bf16_t* vn = (const bf16_t*)(ws_ + OFF_PT_BV) + (size_t)tok0 * 256 + (size_t)(h * 64) * 32;
    const float sc = 0.125f * LOG2E;
    __syncthreads();
    tile_pipeline<1, 64>(smem, 4, wave, lane,
        [&](int t, const bf16_t*& kg, int& ks, const bf16_t*& vg, int& vu) {
            kg = kn + (size_t)t * 64 * NIN; ks = NIN; vg = vn + (size_t)(2 * t) * 256 * 32; vu = 256 * 32;
        },
        [&](int t, const unsigned char* buf, int part) {
            const float nob[8] = {0.f, 0.f, 0.f, 0.f, 0.f, 0.f, 0.f, 0.f};
            { const int half = part;
                UnitFrags<1, 64> f;
                lds_unit<1, 64>(f, buf, 32 * half, half * TileGeom<1, 64>::VUNIT + g * 16, lr, g);
                compute_unit<1, 64, false>(st, f, qf, sc, nob);
            }
        });
    const float inv = 1.f / grp_sum(st.l[0]);
    bf16_t* MIX = (bf16_t*)(ws_ + OFF_MIX) + (size_t)(tok0 + q0 + lr) * 1024 + 512 + h * 64;
#pragma unroll
    for (int vb = 0; vb < 4; ++vb) {
        uint2 o; o.x = pack2(st.O[0][vb][0] * inv, st.O[0][vb][1] * inv); o.y = pack2(st.O[0][vb][2] * inv, st.O[0][vb][3] * inv);
        *(uint2*)(MIX + vb * 16 + 4 * g) = o;
    }
}

DI void item_na(const Params& pin, int l, int sb, int h, int r, unsigned char* smem, int wave, int lane) {
    const Params& p = pin; unsigned char* const ws_ = opaque_ws(pin.ws); float* const out_ = opaque_out(pin.out); lane = opaque_v(lane); wave = opaque_s(wave);
    const int lr = lane & 15, g = lane >> 4;
    const int tok0 = NCTX + sb * 1024;
    const bf16_t* P = (const bf16_t*)(ws_ + OFF_P);
    const int qc = wave * 16 + lr;
    const int q0 = r * 64 + wave * 16;
    bf16x8 qf[1][2];
    {
        const bf16_t* qp = P + (size_t)(tok0 + q0 + lr) * NIN + 1536 + h * 64 + 8 * g;
        qf[0][0] = *(const bf16x8*)(qp); qf[0][1] = *(const bf16x8*)(qp + 32);
    }
    AttnSt<1, 64> st;
    attn_init<1, 64>(st);
    const float sc = 0.125f * LOG2E;
    const size_t hb = (size_t)((sb * 4 + l) * 4 + h);
    const bf16_t* kc = (const bf16_t*)(ws_ + OFF_CBK) + hb * 512 * 64;
    const bf16_t* vc = (const bf16_t*)(ws_ + OFF_CBVT) + hb * 64 * 512;
    const bf16_t* kn = P + (size_t)tok0 * NIN + 1792 + h * 64;
    const bf16_t* vn = (const bf16_t*)(ws_ + OFF_PT_BV) + (size_t)tok0 * 256 + (size_t)(h * 64) * 32;
    const int kr0 = min(max(r - 4, 0), 8);
    const int bs = min(max(wave * 16 - 8, 0), 32);
    const int wstart = min(max(qc - 8, 0), 48);
    const float* rpb = p.nat_rpb + (size_t)(l * 4 + h) * 15 * 31;
    __syncthreads();
    tile_pipeline<1, 64>(smem, 16, wave, lane,
        [&](int t, const bf16_t*& kg, int& ks, const bf16_t*& vg, int& vu) {
            if (t < 8) { kg = kc + (size_t)t * 64 * 64; ks = 64; vg = vc + (size_t)(2 * t) * 64 * 32; vu = 64 * 32; }
            else { const int kr = kr0 + t - 8; kg = kn + (size_t)kr * 64 * NIN; ks = NIN; vg = vn + (size_t)(2 * kr) * 256 * 32; vu = 256 * 32; }
        },
        [&](int t, const unsigned char* buf, int part) {
            if (t < 8) {
                const float nob[8] = {0.f, 0.f, 0.f, 0.f, 0.f, 0.f, 0.f, 0.f};
                { const int half = part;
                    UnitFrags<1, 64> f;
                    lds_unit<1, 64>(f, buf, 32 * half, half * TileGeom<1, 64>::VUNIT + g * 16, lr, g);
                    compute_unit<1, 64, false>(st, f, qf, sc, nob);
                }
            } else if (part == 0) {
                const int kr = kr0 + t - 8;
                const int nl = bs + 8 * g;
                UnitFrags<1, 64> f;
                lds_unit<1, 64>(f, buf, bs, (nl >> 5) * TileGeom<1, 64>::VUNIT + (nl & 31) * 2, lr, g);
                float bias[8];
                const float* rrow = rpb + (kr - r + 7) * 31;
#pragma unroll
                for (int j = 0; j < 8; ++j) {
                    const int kcol = bs + 8 * g + j;
                    const bool valid = (kcol >= wstart) && (kcol < wstart + 16);
                    const int dc = min(max(kcol - qc + 15, 0), 30);
                    bias[j] = valid ? rrow[dc] * LOG2E : -INFINITY;
                }
                compute_unit<1, 64, true>(st, f, qf, sc, bias);
            }
        });
    const float inv = 1.f / grp_sum(st.l[0]);
    bf16_t* MIX = (bf16_t*)(ws_ + OFF_MIX) + (size_t)(tok0 + q0 + lr) * 1024 + 512 + h * 64;
#pragma unroll
    for (int vb = 0; vb < 4; ++vb) {
        uint2 o; o.x = pack2(st.O[0][vb][0] * inv, st.O[0][vb][1] * inv); o.y = pack2(st.O[0][vb][2] * inv, st.O[0][vb][3] * inv);
        *(uint2*)(MIX + vb * 16 + 4 * g) = o;
    }
}

DI float wave_excl_sum(float v, int lane) {
    float x = v;
#pragma unroll
    for (int d = 1; d < 64; d <<= 1) { const float y = __shfl_up(x, d); if (lane >= d) x += y; }
    return x - v;
}
DI float wave_excl_max(float v, int lane, float init) {
    float x = v;
#pragma unroll
    for (int d = 1; d < 64; d <<= 1) { const float y = __shfl_up(x, d); if (lane >= d) x = fmaxf(x, y); }
    const float ex = __shfl_up(x, 1);
    return lane == 0 ? init : fmaxf(init, ex);
}
DI void mlstm_scan(const float* __restrict__ G, int h, int nseq, int dir, float* aA, float* MA, float* FA, float m0, int lane) {
    const int per = nseq >> 6;
    float run = 0.f;
    for (int e = 0; e < per; ++e) {
        const int idx = lane * per + e, pos = dir ? nseq - 1 - idx : idx;
        const float f = G[(size_t)pos * 16 + (dir ? 12 : 4) + h];
        const float lf = fminf(f, 0.f) - __logf(1.f + __expf(-fabsf(f)));
        run += lf; FA[pos] = run;
    }
    const float off = wave_excl_sum(run, lane);
    float rmax = -INFINITY;
    for (int e = 0; e < per; ++e) {
        const int idx = lane * per + e, pos = dir ? nseq - 1 - idx : idx;
        const float F = FA[pos] + off; FA[pos] = F;
        const float a = G[(size_t)pos * 16 + (dir ? 8 : 0) + h] - F;
        aA[pos] = a; rmax = fmaxf(rmax, a); MA[pos] = rmax;
    }
    const float pre = wave_excl_max(rmax, lane, m0);
    for (int e = 0; e < per; ++e) {
        const int idx = lane * per + e, pos = dir ? nseq - 1 - idx : idx;
        MA[pos] = fmaxf(MA[pos], pre);
    }
}

DI void mlstm_unit(f32x4 (&O)[4], float& den, int dir, int t, const bf16x8 (&qf)[2], const UnitFrags<1, 64>& f, const float* aA, float Mt, int key0, int g) {
    f32x4 sa = (f32x4){0.f, 0.f, 0.f, 0.f}, sb = sa;
    sa = mfma16(f.k[0][0][0], qf[0], sa); sa = mfma16(f.k[0][0][1], qf[1], sa);
    sb = mfma16(f.k[0][1][0], qf[0], sb); sb = mfma16(f.k[0][1][1], qf[1], sb);
    const float4 a0 = *(const float4*)(aA + key0 + 8 * g), a1 = *(const float4*)(aA + key0 + 8 * g + 4);
    const float av[8] = {a0.x, a0.y, a0.z, a0.w, a1.x, a1.y, a1.z, a1.w};
    float pv[8];
#pragma unroll
    for (int j = 0; j < 8; ++j) {
        const int key = key0 + 8 * g + j;
        const bool ok = dir ? (key >= t) : (key <= t);
        const float w = ok ? fexp2((av[j] - Mt) * LOG2E) : 0.f;
        const float sv = (j < 4) ? sa[j & 3] : sb[j & 3];
        pv[j] = sv * 0.125f * w;
        den += pv[j];
    }
    const bf16x8 pk = pack8(pv[0], pv[1], pv[2], pv[3], pv[4], pv[5], pv[6], pv[7]);
#pragma unroll
    for (int vb = 0; vb < 4; ++vb) O[vb] = mfma16(f.v[vb], pk, O[vb]);
}

template <bool LAT>
DI void item_mlstm(const Params& pin, int l, int seq, int h, int qt, unsigned char* smem, int wave, int lane) {
    const Params& p = pin; unsigned char* const ws_ = opaque_ws(pin.ws); float* const out_ = opaque_out(pin.out); lane = opaque_v(lane); wave = opaque_s(wave);
    const int lr = lane & 15, g = lane >> 4;
    const int nseq = LAT ? 1024 : 256;
    const int tok0 = LAT ? NCTX + seq * 1024 : seq * 256;
    float* aF = (float*)smem; float* MF = aF + 1024; float* FF = MF + 1024;
    float* aB = FF + 1024; float* MB = aB + 1024; float* FB = MB + 1024;
    unsigned char* tiles = smem + 24576;
    const float* G = (const float*)(ws_ + OFF_G) + (size_t)tok0 * 16;
    float m0f = 0.f, m0b = 0.f;
    const int sidx_f = ((seq * 4 + l) * 2 + 0) * 4 + h, sidx_b = ((seq * 4 + l) * 2 + 1) * 4 + h;
    if (LAT) { m0f = p.state_m[sidx_f]; m0b = p.state_m[sidx_b]; }
    __syncthreads();
    if (wave == 0) mlstm_scan(G, h, nseq, 0, aF, MF, FF, m0f, lane);
    if (wave == 1) mlstm_scan(G, h, nseq, 1, aB, MB, FB, m0b, lane);
    __syncthreads();
    const bf16_t* P = (const bf16_t*)(ws_ + OFF_P);
    const int q0 = qt * 64 + wave * 16;
    const int t = q0 + lr;
    bf16x8 qf[2];
    {
        const bf16_t* qp = P + (size_t)(tok0 + t) * NIN + 2304 + h * 64 + 8 * g;
        qf[0] = *(const bf16x8*)(qp); qf[1] = *(const bf16x8*)(qp + 32);
    }
    const bf16_t* kn = P + (size_t)tok0 * NIN + 2560 + h * 64;
    const bf16_t* vn = (const bf16_t*)(ws_ + OFF_PT_CV) + (size_t)tok0 * 256 + (size_t)(h * 64) * 32;
    const float Mf = MF[t], Mb = MB[t], Ff = FF[t], Fb = FB[t];
    f32x4 Of[4], Ob[4];
#pragma unroll
    for (int vb = 0; vb < 4; ++vb) { Of[vb] = (f32x4){0.f, 0.f, 0.f, 0.f}; Ob[vb] = Of[vb]; }
    float denf = 0.f, denb = 0.f;
    tile_pipeline<1, 64>(tiles, nseq / 64, wave, lane,
        [&](int tt, const bf16_t*& kg, int& ks, const bf16_t*& vg, int& vu) {
            kg = kn + (size_t)tt * 64 * NIN; ks = NIN; vg = vn + (size_t)(2 * tt) * 256 * 32; vu = 256 * 32;
        },
        [&](int tt, const unsigned char* buf, int part) {
            { const int half = part;
                const int key0 = tt * 64 + half * 32;
                const bool dof = key0 <= q0 + 15, dob = key0 + 31 >= q0;
                if (dof || dob) {
                    UnitFrags<1, 64> f;
                    lds_unit<1, 64>(f, buf, 32 * half, half * TileGeom<1, 64>::VUNIT + g * 16, lr, g);
                    if (dof) mlstm_unit(Of, denf, 0, t, qf, f, aF, Mf, key0, g);
                    if (dob) mlstm_unit(Ob, denb, 1, t, qf, f, aB, Mb, key0, g);
                }
            }
        });
    if (LAT) {
        const bf16_t* qp2 = P + (size_t)(tok0 + t) * NIN + 2304 + h * 64 + 4 * g;
#pragma unroll
        for (int dir = 0; dir < 2; ++dir) {
            const int sidx = dir ? sidx_b : sidx_f;
            const float e = fexp2(((dir ? m0b : m0f) - (dir ? Mb : Mf)) * LOG2E) * 0.125f;
            const bf16_t* c0t = (const bf16_t*)(ws_ + OFF_C0T) + (size_t)sidx * 4096 + lr * 64 + 4 * g;
            const float* n0 = p.state_n + (size_t)sidx * 64;
            float dacc = 0.f;
#pragma unroll
            for (int u2 = 0; u2 < 2; ++u2) {
                const bf16x4 qa = *(const bf16x4*)(qp2 + u2 * 32), qb = *(const bf16x4*)(qp2 + u2 * 32 + 16);
                const float4 na = *(const float4*)(n0 + u2 * 32 + 4 * g), nb = *(const float4*)(n0 + u2 * 32 + 16 + 4 * g);
                float pv[8];
#pragma unroll
                for (int j = 0; j < 4; ++j) { pv[j] = bf2f((unsigned short)qa[j]) * e; pv[4 + j] = bf2f((unsigned short)qb[j]) * e; }
                dacc += pv[0] * na.x + pv[1] * na.y + pv[2] * na.z + pv[3] * na.w + pv[4] * nb.x + pv[5] * nb.y + pv[6] * nb.z + pv[7] * nb.w;
                const bf16x8 pk = pack8(pv[0], pv[1], pv[2], pv[3], pv[4], pv[5], pv[6], pv[7]);
#pragma unroll
                for (int vb = 0; vb < 4; ++vb) {
                    const bf16_t* cp = c0t + (size_t)vb * 16 * 64 + u2 * 32;
                    const bf16x8 cf = cat4(*(const bf16x4*)(cp), *(const bf16x4*)(cp + 16));
                    if (dir) Ob[vb] = mfma16(cf, pk, Ob[vb]); else Of[vb] = mfma16(cf, pk, Of[vb]);
                }
            }
            if (dir) denb += dacc; else denf += dacc;
        }
    }
    denf = grp_sum(denf); denb = grp_sum(denb);
    const float rf = 1.f / fmaxf(fabsf(denf), expf(-(Ff + Mf)));
    const float rb = 1.f / fmaxf(fabsf(denb), expf(-(Fb + Mb)));
    float ss = 0.f;
#pragma unroll
    for (int vb = 0; vb < 4; ++vb)
#pragma unroll
        for (int i = 0; i < 4; ++i) { const float hs = Of[vb][i] * rf + Ob[vb][i] * rb; Of[vb][i] = hs; ss += hs * hs; }
    ss = grp_sum(ss);
    const float rn = rsqrtf(ss * (1.f / 64.f) + LN_EPS);
    const float* gn = p.mlstm_norm_g + (size_t)(l * 4 + h) * 64;
    const bf16_t* op = P + (size_t)(tok0 + t) * NIN + 3072 + h * 64;
    bf16_t* MIX = (bf16_t*)(ws_ + OFF_MIX) + (size_t)(tok0 + t) * 1024 + 768 + h * 64;
#pragma unroll
    for (int vb = 0; vb < 4; ++vb) {
        const int v = vb * 16 + 4 * g;
        const float4 g4 = *(const float4*)(gn + v);
        const bf16x4 o4 = *(const bf16x4*)(op + v);
        float sg[4];
#pragma unroll
        for (int i = 0; i < 4; ++i) sg[i] = 1.f / (1.f + __expf(-bf2f((unsigned short)o4[i])));
        uint2 o; o.x = pack2(Of[vb][0] * rn * g4.x * sg[0], Of[vb][1] * rn * g4.y * sg[1]);
        o.y = pack2(Of[vb][2] * rn * g4.z * sg[2], Of[vb][3] * rn * g4.w * sg[3]);
        *(uint2*)(MIX + v) = o;
    }
}

DI void item_mlstm_state(const Params& pin, int l, int b, int h, int dir, unsigned char* smem, int wave, int lane) {
    const Params& p = pin; unsigned char* const ws_ = opaque_ws(pin.ws); float* const out_ = opaque_out(pin.out); lane = opaque_v(lane); wave = opaque_s(wave);
    const int lr = lane & 15, g = lane >> 4;
    const int tok0 = b * 256;
    float* aA = (float*)smem; float* MA = aA + 1024; float* FA = MA + 1024;
    const float* G = (const float*)(ws_ + OFF_G) + (size_t)tok0 * 16;
    __syncthreads();
    if (wave == 0) mlstm_scan(G, h, 256, dir, aA, MA, FA, 0.f, lane);
    __syncthreads();
    const float Mfin = dir ? MA[0] : MA[255];
    const float Ffin = dir ? FA[0] : FA[255];
    const bf16_t* KT = (const bf16_t*)(ws_ + OFF_PT_CK) + (size_t)tok0 * 256 + (size_t)(h * 64 + wave * 16 + lr) * 32 + 8 * g;
    const bf16_t* VT = (const bf16_t*)(ws_ + OFF_PT_CV) + (size_t)tok0 * 256 + (size_t)(h * 64 + lr) * 32 + 8 * g;
    f32x4 C[4];
#pragma unroll
    for (int vb = 0; vb < 4; ++vb) C[vb] = (f32x4){0.f, 0.f, 0.f, 0.f};
    float nacc = 0.f;
#pragma unroll 4
    for (int u = 0; u < 8; ++u) {
        const int s0 = u * 32;
        const bf16x8 kf = *(const bf16x8*)(KT + (size_t)u * 256 * 32);
        const float4 a0 = *(const float4*)(aA + s0 + 8 * g), a1 = *(const float4*)(aA + s0 + 8 * g + 4);
        const float av[8] = {a0.x, a0.y, a0.z, a0.w, a1.x, a1.y, a1.z, a1.w};
        float kw[8];
#pragma unroll
        for (int j = 0; j < 8; ++j) { kw[j] = bf2f((unsigned short)kf[j]) * fexp2((av[j] - Mfin) * LOG2E); nacc += kw[j]; }
        const bf16x8 af = pack8(kw[0], kw[1], kw[2], kw[3], kw[4], kw[5], kw[6], kw[7]);
#pragma unroll
        for (int vb = 0; vb < 4; ++vb) {
            const bf16x8 vf = *(const bf16x8*)(VT + (size_t)u * 256 * 32 + vb * 16 * 32);
            C[vb] = mfma16(af, vf, C[vb]);
        }
    }
    const size_t sidx = (size_t)((b * 4 + l) * 2 + dir) * 4 + h;
    float* oc = out_ + O_NC + sidx * 4096;
#pragma unroll
    for (int vb = 0; vb < 4; ++vb)
#pragma unroll
        for (int i = 0; i < 4; ++i) oc[(wave * 16 + 4 * g + i) * 64 + vb * 16 + lr] = C[vb][i];
    nacc = grp_sum(nacc);
    if (g == 0) out_[O_NN + sidx * 64 + wave * 16 + lr] = nacc;
    if (wave == 0 && lane == 0) out_[O_NM + sidx] = Ffin + Mfin;
}

DI void mixer_phase(const Params& p, int l, unsigned char* smem) {
    const int tid_ = opaque_v(threadIdx.x); const int lane = tid_ & 63, wave = (tid_ >> 6) & 3;
    const int half = __builtin_amdgcn_readfirstlane(tid_ >> 8);
    unsigned char* sm = smem + half * HALF_LDS;
    unsigned* ctr = (unsigned*)(p.ws + OFF_MIXCTR) + l;
    volatile unsigned* slot = (volatile unsigned*)(smem + LDS_BYTES + 16);
    for (;;) {
        __syncthreads();
        if (tid_ == 0) *slot = __hip_atomic_fetch_add(ctr, 1u, __ATOMIC_RELAXED, __HIP_MEMORY_SCOPE_AGENT);
        __syncthreads();
        const int it = __builtin_amdgcn_readfirstlane(2 * (int)*slot + half);
        if (it >= 1408) break;
        if (it < 256) { item_diffattn_lat(p, l, it >> 7, (it >> 5) & 3, it & 31, sm, wave, lane); }
        else if (it < 384) { const int i = it - 256; item_mlstm<true>(p, l, i >> 6, (i >> 4) & 3, i & 15, sm, wave, lane); }
        else if (it < 512) { const int i = it - 384; item_mlstm_state(p, l, i >> 3, (i >> 1) & 3, i & 1, sm, wave, lane); }
        else if (it < 640) { const int i = it - 512; item_na(p, l, i >> 6, (i >> 4) & 3, i & 15, sm, wave, lane); }
        else if (it < 896) { const int i = it - 640; item_diffattn<false>(p, l, i >> 4, (i >> 2) & 3, i & 3, sm, wave, lane); }
        else if (it < 1152) { const int i = it - 896; item_mlstm<false>(p, l, i >> 4, (i >> 2) & 3, i & 3, sm, wave, lane); }
        else { const int i = it - 1152; item_dense(p, i >> 4, (i >> 2) & 3, i & 3, sm, wave, lane); }
    }
}

#define XB_TMO      128
#define XB_XCNT(j)  (256  + 64 * (j))
#define XB_XSUB(j)  (1280 + 64 * (j))
#define XB_XGEN(j)  (2304 + 64 * (j))
#define XB_TOP      3328
#define XB_TOPGEN   3392
#define XCD_BAR_WORDS 3456
#define XB_SPIN_CAP (1u << 18)

__device__ __forceinline__ unsigned xb_ld(unsigned* p)              { return __hip_atomic_load(p, __ATOMIC_RELAXED, __HIP_MEMORY_SCOPE_AGENT); }
__device__ __forceinline__ unsigned xb_add(unsigned* p, unsigned v) { return __hip_atomic_fetch_add(p, v, __ATOMIC_RELAXED, __HIP_MEMORY_SCOPE_AGENT); }
__device__ __forceinline__ unsigned xb_xcc_id() { return (unsigned)__builtin_amdgcn_s_getreg((3 << 11) | 20) & 0xFu; }
#define XB_SPIN(cond, bar) do { unsigned _sp = 0; while (cond) { __builtin_amdgcn_s_sleep(1); \
    if ((++_sp & 255u) == 0u) { if (xb_ld(&(bar)[XB_TMO])) break; if (_sp > XB_SPIN_CAP) { atomicAdd(&(bar)[XB_TMO], 1u); break; } } } } while (0)

struct XcdBarrier {
    unsigned* bar; unsigned x;
    volatile LAS unsigned* st;
};

__device__ __forceinline__ XcdBarrier xcd_barrier_post(unsigned* bar, volatile LAS unsigned* st) {
    XcdBarrier b; b.bar = bar; b.x = xb_xcc_id(); b.st = st;
    if (threadIdx.x == 0) (void)xb_add(&bar[XB_XCNT(b.x)], 1u);
    return b;
}
__device__ __forceinline__ void xcd_barrier_complete(unsigned* bar, unsigned x, unsigned& nloc, unsigned& nx) {
    const unsigned G = gridDim.x * gridDim.y * gridDim.z;
    unsigned sum, cnt, mine, sp = 0u;
    for (;;) {
        sum = 0u; cnt = 0u; mine = 0u;
#pragma unroll
        for (unsigned j = 0; j < 16; ++j) { const unsigned c = xb_ld(&bar[XB_XCNT(j)]); sum += c; cnt += (c > 0u) ? 1u : 0u; mine = (j == x) ? c : mine; }
        if (sum == G) break;
        __builtin_amdgcn_s_sleep(1);
        if ((++sp & 255u) == 0u) { if (xb_ld(&bar[XB_TMO])) break; if (sp > XB_SPIN_CAP) { atomicAdd(&bar[XB_TMO], 1u); break; } }
    }
    nloc = mine > 0u ? mine : 1u; nx = cnt > 0u ? cnt : 1u;
}

__device__ __forceinline__ void xcd_barrier(const XcdBarrier& b) {
    asm volatile("s_waitcnt vmcnt(0)" ::: "memory");
    __syncthreads();
    if (threadIdx.x == 0) {
        unsigned* bar = b.bar;
        __builtin_amdgcn_s_waitcnt(0);
        unsigned nloc = b.st[0], nx = b.st[1];
        if (nloc == 0u) { xcd_barrier_complete(bar, b.x, nloc, nx); b.st[0] = nloc; b.st[1] = nx; }
        const unsigned old = xb_add(&bar[XB_XSUB(b.x)], 1u);
        const unsigned gen = old / nloc;
        if (old + 1u == (gen + 1u) * nloc) {
            __builtin_amdgcn_fence(__ATOMIC_RELEASE, "agent");
            asm volatile("s_waitcnt vmcnt(0)" ::: "memory");
            const unsigned og = xb_add(&bar[XB_TOP], 1u);
            const unsigned tg = og / nx;
            if (og + 1u == (tg + 1u) * nx) xb_add(&bar[XB_TOPGEN], 1u);
            else XB_SPIN(xb_ld(&bar[XB_TOPGEN]) == tg, bar);
            __builtin_amdgcn_fence(__ATOMIC_ACQUIRE, "agent");
            xb_add(&bar[XB_XGEN(b.x)], 1u);
            asm volatile("s_waitcnt vmcnt(0)" ::: "memory");
        } else {
            XB_SPIN(xb_ld(&bar[XB_XGEN(b.x)]) == gen, bar);
            __builtin_amdgcn_fence(__ATOMIC_ACQUIRE, "agent");
            asm volatile("s_waitcnt vmcnt(0)" ::: "memory");
        }
    }
    __syncthreads();
}


constexpr int N_PHASES = 2 + 5 * 4;

__global__ void __launch_bounds__(512, 2) fwd_kernel(Params p) {
    __shared__ __attribute__((aligned(16))) unsigned char smem[LDS_BYTES + 32];
    if (threadIdx.x == 0) *(uint4*)(smem + LDS_BYTES) = make_uint4(0u, 0u, 0u, 0u);
    __syncthreads();
    XcdBarrier xb = xcd_barrier_post((unsigned*)(p.ws + OFF_BAR), (volatile LAS unsigned*)(smem + LDS_BYTES));
    for (int ph = p.ph_lo; ph < p.ph_hi; ++ph) {
        if (ph > p.ph_lo) {
            if (p.ph_hi > 1000) cg::this_grid().sync();
            xcd_barrier(xb);
        }
        const int l = ph < 2 ? 0 : (ph - 2) / 5, s = ph < 2 ? ph - 2 : (ph - 2) % 5;
        const int bit = 1 << (s + 2);
        const int reps = (DUPM & bit) ? 2 : 1;
        for (int rep = 0; rep < reps; ++rep) {
            if (rep) __syncthreads();
            if (s == -2) prep0(p, smem + __builtin_amdgcn_readfirstlane(threadIdx.x >> 8) * HALF_LDS);
            else if (s == -1) prep1(p);
            else if (s == 0) gemm_phase<EPI_INPROJ>(p, l, OFF_H, OFF_WT_IN + (size_t)l * NINP * DM * 2, NINP / 128, 1024, 0, smem);
            else if (s == 1) mixer_phase(p, l, smem);
            else if (s == 2) gemm_phase<EPI_LN1>(p, l, OFF_MIX, OFF_WT_OUT + (size_t)l * DM * DM * 2, 8, 1024, 1024, smem);
            else if (s == 3) gemm_phase<EPI_RELU2>(p, l, OFF_H, OFF_WT_1 + (size_t)l * DFF * DM * 2, 32, 1024, 4096, smem);
            else gemm_phase<EPI_LN2>(p, l, OFF_U, OFF_WT_2 + (size_t)l * DM * DFF * 2, 8, 4096, 1024, smem);
        }
    }
}

extern "C" void kernel_launch(void* const* d_in, const int* in_sizes, int n_in, void* d_out, int out_size, void* d_ws, size_t ws_size,
                              hipStream_t stream) {
    static int grid = 0;
    if (grid == 0) {
        if (n_in != 26 || ws_size < WS_END) { fprintf(stderr, "kernel_launch: unexpected n_in %d / ws %zu (need %zu)\n", n_in, ws_size, (size_t)WS_END); grid = -1; return; }
        int dev = 0, cus = 0, per_cu = 0;
        hipGetDevice(&dev);
        hipDeviceGetAttribute(&cus, hipDeviceAttributeMultiprocessorCount, dev);
        hipOccupancyMaxActiveBlocksPerMultiprocessor(&per_cu, (const void*)fwd_kernel, 512, 0);
        (void)per_cu;
        grid = cus;
        if (grid < 192) { fprintf(stderr, "kernel_launch: grid %d < 192 resident workgroups needed by the fused LayerNorm exchange\n", grid); grid = -1; return; }
    }
    if (grid < 0) return;
    Params p{};
    const float** pp = (const float**)&p;
    for (int i = 0; i < 26; ++i) pp[i] = (const float*)d_in[i];
    p.out = (float*)d_out; p.ws = (unsigned char*)d_ws;
    (void)hipMemsetAsync((unsigned char*)d_ws + OFF_BAR, 0, 16384, stream);
#if SINGLE_LAUNCH
    p.ph_lo = 0; p.ph_hi = N_PHASES;
    void* args[] = {&p};
    hipError_t e = hipLaunchCooperativeKernel((const void*)fwd_kernel, dim3(grid), dim3(512), args, 0, stream);
    if (e != hipSuccess) fprintf(stderr, "cooperative launch failed: %s (grid %d)\n", hipGetErrorString(e), grid);
#else
    for (int ph = 0; ph < N_PHASES; ++ph) {
        p.ph_lo = ph; p.ph_hi = ph + 1;
        void* args[] = {&p};
        hipError_t e = hipLaunchCooperativeKernel((const void*)fwd_kernel, dim3(grid), dim3(512), args, 0, stream);
        if (e != hipSuccess) { fprintf(stderr, "launch %d failed: %s (grid %d)\n", ph, hipGetErrorString(e), grid); break; }
    }
#endif
}
```
